# Optimizing an MI355X kernel written in HIP

```python
import math
import jax, jax.numpy as jnp
from jax import lax
import numpy as np

D_MODEL = 1024
BATCH = 8
SEQ = 4096
DEPTH = 1

CHUNK = 64
D_MIX = D_MODEL
D_LRU = D_MIX // 2
D_SGU = D_MIX - D_LRU
LRU_HEADS = 8
LRU_HEAD_DIM = D_LRU // LRU_HEADS
CONV_WIDTH = 4
LRU_C = 8.0
SGU_HEADS = 8
SGU_HEAD_DIM = D_SGU // SGU_HEADS
SGU_BLOCK = 128
N_GROUPS = 4
EXPERTS_PER_GROUP = 8
N_EXPERTS = N_GROUPS * EXPERTS_PER_GROUP
TOP_K = 2
D_EXPERT = D_MODEL // 2
MOE_BLOCK = 512
EPS = 1e-6

kernel_name = "hybrid_rglru_gmlp_hmoe_block"


def rmsnorm(x, g):
    xf = x.astype(jnp.float32)
    y = xf * lax.rsqrt(jnp.mean(xf * xf, axis=-1, keepdims=True) + EPS)
    return (y * g.astype(jnp.float32)).astype(x.dtype)


def layernorm(x, g, b):
    xf = x.astype(jnp.float32)
    mu = jnp.mean(xf, axis=-1, keepdims=True)
    var = jnp.mean(jnp.square(xf - mu), axis=-1, keepdims=True)
    y = (xf - mu) * lax.rsqrt(var + EPS) * g.astype(jnp.float32) + b.astype(jnp.float32)
    return y.astype(x.dtype)


def causal_conv(x, w, b):
    y = lax.conv_general_dilated(
        x, w[:, None, :].astype(x.dtype), window_strides=(1,),
        padding=[(CONV_WIDTH - 1, 0)], dimension_numbers=('NWC', 'WIO', 'NWC'),
        feature_group_count=x.shape[-1])
    return y + b.astype(x.dtype)


def rg_lru(x, w_a, b_a, w_i, b_i, lam):
    B, S, _ = x.shape
    xf = x.astype(jnp.float32)
    xh = xf.reshape(B, S, LRU_HEADS, LRU_HEAD_DIM)
    r = jax.nn.sigmoid(jnp.einsum('bshd,hde->bshe', xh, w_a.astype(jnp.float32)).reshape(B, S, D_LRU)
                       + b_a.astype(jnp.float32))
    i = jax.nn.sigmoid(jnp.einsum('bshd,hde->bshe', xh, w_i.astype(jnp.float32)).reshape(B, S, D_LRU)
                       + b_i.astype(jnp.float32))
    log_a = -LRU_C * r * jax.nn.softplus(-lam.astype(jnp.float32))
    a = jnp.exp(log_a)
    u = jnp.sqrt(-jnp.expm1(2.0 * log_a)) * (i * xf)

    def combine(lhs, rhs):
        a1, b1 = lhs
        a2, b2 = rhs
        return a1 * a2, a2 * b1 + b2

    _, h = lax.associative_scan(combine, (a, u), axis=1)
    return h.astype(x.dtype)


def spatial_gating(u, v, ln_g, ln_b, w_s, b_s):
    B, S, _ = v.shape
    pos_chunk = jnp.arange(SGU_BLOCK) // CHUNK
    mask = (pos_chunk[None, :] <= pos_chunk[:, None]).astype(w_s.dtype)
    vn = layernorm(v, ln_g, ln_b)
    vb = vn.reshape(B, S // SGU_BLOCK, SGU_BLOCK, SGU_HEADS, SGU_HEAD_DIM)
    s = jnp.einsum('gij,bnjgc->bnigc', (w_s * mask[None]).astype(v.dtype), vb)
    s = s + b_s.T.astype(v.dtype)[None, None, :, :, None]
    return u * s.reshape(B, S, D_SGU)


def hierarchical_moe(h, w_grp, b_grp, w_exp, b_exp, w1, w3, w2):
    B, S, D = h.shape
    T = B * S
    xt = h.reshape(T, D)
    g_logits = (xt @ w_grp).astype(jnp.float32) + b_grp.astype(jnp.float32)
    g_prob = jax.nn.softmax(g_logits, axis=-1)
    g_sel = jnp.argmax(g_logits, axis=-1)
    p_g = jnp.take_along_axis(g_prob, g_sel[:, None], axis=1)[:, 0]
    e_logits = ((xt @ w_exp).astype(jnp.float32) + b_exp.astype(jnp.float32)).reshape(T, N_GROUPS, EXPERTS_PER_GROUP)
    e_logits = jnp.take_along_axis(e_logits, g_sel[:, None, None], axis=1)[:, 0]
    e_prob = jax.nn.softmax(e_logits, axis=-1)
    top_p, top_i = lax.top_k(e_prob, TOP_K)
    top_p = top_p / jnp.sum(top_p, axis=-1, keepdims=True)
    weights = (p_g[:, None] * top_p).reshape(-1)
    expert = (g_sel[:, None] * EXPERTS_PER_GROUP + top_i).reshape(-1).astype(jnp.int32)
    token = jnp.repeat(jnp.arange(T, dtype=jnp.int32), TOP_K)

    n_slots = T * TOP_K
    cap = (n_slots + MOE_BLOCK - 1) // MOE_BLOCK * MOE_BLOCK + N_EXPERTS * MOE_BLOCK
    n_blocks = cap // MOE_BLOCK
    order = jnp.argsort(expert)
    e_sorted = expert[order]
    counts = jnp.bincount(expert, length=N_EXPERTS)
    padded = (counts + MOE_BLOCK - 1) // MOE_BLOCK * MOE_BLOCK
    start = jnp.cumsum(counts) - counts
    pend = jnp.cumsum(padded)
    pstart = pend - padded
    dest = pstart[e_sorted] + (jnp.arange(n_slots, dtype=jnp.int32) - start[e_sorted])
    tok_buf = jnp.full((cap,), T, jnp.int32).at[dest].set(token[order])
    w_buf = jnp.zeros((cap,), jnp.float32).at[dest].set(weights[order])
    block_expert = jnp.minimum(
        jnp.searchsorted(pend, jnp.arange(n_blocks, dtype=jnp.int32) * MOE_BLOCK, side='right'),
        N_EXPERTS - 1).astype(jnp.int32)

    x_pad = jnp.concatenate([xt, jnp.zeros((1, D), xt.dtype)], axis=0)
    xs = x_pad[tok_buf].reshape(n_blocks, MOE_BLOCK, D)

    def expert_block(args):
        xb, e = args
        return (jax.nn.silu(xb @ w1[e]) * (xb @ w3[e])) @ w2[e]

    ys = lax.map(expert_block, (xs, block_expert)).reshape(cap, D)
    ys = ys * w_buf[:, None].astype(ys.dtype)
    out = jnp.zeros((T + 1, D), ys.dtype).at[tok_buf].add(ys)[:T]
    return out.reshape(B, S, D)


def setup_inputs(seed: int = 0) -> dict:
    key = jax.random.key(seed)
    ks = jax.random.split(key, 32)
    f32 = jnp.float32
    L = DEPTH
    nrm = lambda k, shape, scale: jax.random.normal(k, shape, f32) * scale
    gain = lambda k, shape: 1.0 + 0.01 * jax.random.normal(k, shape, f32)
    base = jax.random.uniform(ks[10], (L, D_LRU), f32, 0.9, 0.999) ** (1.0 / LRU_C)
    lru_lambda = jnp.log(base) - jnp.log1p(-base)
    return {
        "x": nrm(ks[0], (BATCH, SEQ, D_MODEL), 1.0),
        "c": nrm(ks[1], (BATCH, D_MODEL), 1.0),
        "ada_w": nrm(ks[2], (L, D_MODEL, 6 * D_MODEL), D_MODEL ** -0.5),
        "ada_b": nrm(ks[3], (L, 6 * D_MODEL), 0.01),
        "norm1_g": gain(ks[4], (L, D_MODEL)),
        "w_in": nrm(ks[5], (L, D_MODEL, 2 * D_MIX), D_MODEL ** -0.5),
        "conv_w": nrm(ks[6], (L, CONV_WIDTH, D_LRU), CONV_WIDTH ** -0.5),
        "conv_b": nrm(ks[7], (L, D_LRU), 0.01),
        "gate_a_w": nrm(ks[8], (L, LRU_HEADS, LRU_HEAD_DIM, LRU_HEAD_DIM), LRU_HEAD_DIM ** -0.5),
        "gate_a_b": nrm(ks[9], (L, D_LRU), 0.01),
        "gate_i_w": nrm(ks[11], (L, LRU_HEADS, LRU_HEAD_DIM, LRU_HEAD_DIM), LRU_HEAD_DIM ** -0.5),
        "gate_i_b": nrm(ks[12], (L, D_LRU), 0.01),
        "lru_lambda": lru_lambda,
        "sgu_ln_g": gain(ks[13], (L, D_SGU)),
        "sgu_ln_b": nrm(ks[14], (L, D_SGU), 0.01),
        "sgu_w": nrm(ks[15], (L, SGU_HEADS, SGU_BLOCK, SGU_BLOCK), SGU_BLOCK ** -0.5),
        "sgu_b": gain(ks[16], (L, SGU_HEADS, SGU_BLOCK)),
        "w_out": nrm(ks[17], (L, D_MIX, D_MODEL), D_MIX ** -0.5),
        "norm2_g": gain(ks[18], (L, D_MODEL)),
        "router_group_w": nrm(ks[19], (L, D_MODEL, N_GROUPS), D_MODEL ** -0.5),
        "router_group_b": nrm(ks[20], (L, N_GROUPS), 0.01),
        "router_expert_w": nrm(ks[21], (L, D_MODEL, N_EXPERTS), D_MODEL ** -0.5),
        "router_expert_b": nrm(ks[22], (L, N_EXPERTS), 0.01),
        "expert_w1": nrm(ks[23], (L, N_EXPERTS, D_MODEL, D_EXPERT), D_MODEL ** -0.5),
        "expert_w3": nrm(ks[24], (L, N_EXPERTS, D_MODEL, D_EXPERT), D_MODEL ** -0.5),
        "expert_w2": nrm(ks[25], (L, N_EXPERTS, D_EXPERT, D_MODEL), D_EXPERT ** -0.5),
        "final_g": gain(ks[26], (D_MODEL,)),
    }


def reference(x, c, ada_w, ada_b, norm1_g, w_in, conv_w, conv_b, gate_a_w, gate_a_b, gate_i_w,
              gate_i_b, lru_lambda, sgu_ln_g, sgu_ln_b, sgu_w, sgu_b, w_out, norm2_g,
              router_group_w, router_group_b, router_expert_w, router_expert_b,
              expert_w1, expert_w3, expert_w2, final_g):
    cond = jax.nn.silu(c)
    for l in range(DEPTH):
        mod = cond @ ada_w[l] + ada_b[l]
        sh1, sc1, g1, sh2, sc2, g2 = jnp.split(mod, 6, axis=-1)
        h = rmsnorm(x, norm1_g[l]) * (1.0 + sc1[:, None]) + sh1[:, None]
        z = h @ w_in[l]
        xr, gr, u, v = jnp.split(z, [D_LRU, 2 * D_LRU, 2 * D_LRU + D_SGU], axis=-1)
        xr = causal_conv(xr, conv_w[l], conv_b[l])
        y_lru = rg_lru(xr, gate_a_w[l], gate_a_b[l], gate_i_w[l], gate_i_b[l], lru_lambda[l]) * jax.nn.gelu(gr)
        y_sgu = spatial_gating(jax.nn.gelu(u), jax.nn.gelu(v), sgu_ln_g[l], sgu_ln_b[l], sgu_w[l], sgu_b[l])
        mix = jnp.concatenate([y_lru, y_sgu], axis=-1) @ w_out[l]
        x = x + g1[:, None] * mix
        h = rmsnorm(x, norm2_g[l]) * (1.0 + sc2[:, None]) + sh2[:, None]
        y = hierarchical_moe(h, router_group_w[l], router_group_b[l], router_expert_w[l], router_expert_b[l],
                             expert_w1[l], expert_w3[l], expert_w2[l])
        x = x + g2[:, None] * y
    return rmsnorm(x, final_g)
```

```cpp
#include <hip/hip_runtime.h>
#include <cstdio>
#include <cstdint>

typedef unsigned short bf16_t;
typedef short bf16x8 __attribute__((ext_vector_type(8)));
typedef float f32x4 __attribute__((ext_vector_type(4)));
typedef unsigned u32x2 __attribute__((ext_vector_type(2)));
typedef unsigned u32x4 __attribute__((ext_vector_type(4)));

constexpr int T = 32768, D = 1024, SEQ = 4096, NB = 8;
constexpr int DL = 512;
constexpr int NE = 32, DE = 512;
constexpr int LISTCAP = 65536;
constexpr int MAXTILES = 288, MAXROWS = MAXTILES * 256;
constexpr float EPS = 1e-6f;

constexpr size_t MiB = 1u << 20;
constexpr size_t OFF_CTL = 0, CTL_BYTES = 1 * MiB;
constexpr size_t OFF_MOD = 1 * MiB;
constexpr size_t OFF_TBL = 1 * MiB + 256 * 1024;
constexpr size_t OFF_TOKE = 1 * MiB + 512 * 1024;
constexpr size_t OFF_TOKW = 1 * MiB + 768 * 1024;
constexpr size_t OFF_TOKP = 2 * MiB;
constexpr size_t OFF_CARRY = 3 * MiB;
constexpr size_t OFF_WIN = 4 * MiB;
constexpr size_t OFF_WOUT = 8 * MiB;
constexpr size_t OFF_W13 = 10 * MiB;
constexpr size_t OFF_W2 = 74 * MiB;
constexpr size_t OFF_XN = 106 * MiB;
constexpr size_t OFF_Z = 170 * MiB;
constexpr size_t OFF_YMIX = 298 * MiB;
constexpr size_t OFF_X1 = 362 * MiB;
constexpr size_t OFF_ACT = 426 * MiB;
constexpr size_t OFF_LIST = 498 * MiB;
constexpr size_t OFF_ROWTOK = 506 * MiB;
constexpr size_t OFF_Y = 170 * MiB;
constexpr size_t WS_NEED = 507 * MiB;
constexpr size_t OFF_VN = OFF_X1;
constexpr size_t OFF_XC = OFF_ACT;
constexpr int CW_CNT = 8192;

__device__ __forceinline__ unsigned f2bf(float f) { unsigned u = __float_as_uint(f); return (u + 0x7fffu + ((u >> 16) & 1u)) >> 16; }
__device__ __forceinline__ float bf2f(unsigned h) { return __uint_as_float(h << 16); }
__device__ __forceinline__ unsigned pk2(float lo, float hi) { return f2bf(lo) | (f2bf(hi) << 16); }
__device__ __forceinline__ float wave_sum(float v) {
#pragma unroll
    for (int o = 1; o < 64; o <<= 1) v += __shfl_xor(v, o);
    return v;
}
__device__ __forceinline__ float gelu_tanh(float x) {
    const float u = 1.5957691216057308f * (x + 0.044715f * x * x * x);
    return x / (1.0f + __expf(-u));
}
__device__ __forceinline__ float sigmoidf(float x) { return 1.0f / (1.0f + __expf(-x)); }

__global__ void __launch_bounds__(256) k_ada(const float* c, const float* ada_w, const float* ada_b, float* mod) {
    __shared__ float sc[8][1024];
    for (int i = threadIdx.x; i < 8192; i += 256) { const float v = c[i]; sc[i >> 10][i & 1023] = v / (1.0f + expf(-v)); }
    __syncthreads();
    const int n = blockIdx.x * 256 + threadIdx.x;
    float acc[8];
#pragma unroll
    for (int b = 0; b < 8; ++b) acc[b] = 0.f;
    for (int k = 0; k < 1024; ++k) {
        const float w = ada_w[(size_t)k * 6144 + n];
#pragma unroll
        for (int b = 0; b < 8; ++b) acc[b] += sc[b][k] * w;
    }
#pragma unroll
    for (int b = 0; b < 8; ++b) mod[b * 6144 + n] = acc[b] + ada_b[n];
}

__global__ void __launch_bounds__(256) k_transpose(const float* W, bf16_t* WT, int K, int N, int blk, int rstride, int rbase, size_t w_ms, size_t wt_ms) {
    __shared__ float tile[32][33];
    W += (size_t)blockIdx.z * w_ms; WT += (size_t)blockIdx.z * wt_ms;
    const int n0 = blockIdx.x * 32, k0 = blockIdx.y * 32, tx = threadIdx.x & 31, ty = threadIdx.x >> 5;
    for (int j = ty; j < 32; j += 8) tile[j][tx] = W[(size_t)(k0 + j) * N + n0 + tx];
    __syncthreads();
    for (int j = ty; j < 32; j += 8) { const int n = n0 + j; const int row = rbase + (n / blk) * rstride + (n % blk);
        WT[(size_t)row * K + k0 + tx] = (bf16_t)f2bf(tile[tx][j]); }
}

__global__ void __launch_bounds__(256) k_xn(const float* x, const float* g, const float* mod, bf16_t* XN) {
    const int row = blockIdx.x * 4 + (threadIdx.x >> 6), lane = threadIdx.x & 63, b = row / SEQ;
    const f32x4* xr = (const f32x4*)(x + (size_t)row * D);
    f32x4 v[4]; float ss = 0.f;
#pragma unroll
    for (int j = 0; j < 4; ++j) { v[j] = xr[lane + 64 * j]; ss += v[j][0] * v[j][0] + v[j][1] * v[j][1] + v[j][2] * v[j][2] + v[j][3] * v[j][3]; }
    ss = wave_sum(ss);
    const float rs = rsqrtf(ss * (1.0f / D) + EPS);
    const float* sh = mod + b * 6144; const float* sc = sh + 1024;
#pragma unroll
    for (int j = 0; j < 4; ++j) { const int col = 4 * (lane + 64 * j);
        const f32x4 gg = *(const f32x4*)(g + col), s1 = *(const f32x4*)(sc + col), s0 = *(const f32x4*)(sh + col);
        float h[4];
#pragma unroll
        for (int q = 0; q < 4; ++q) h[q] = v[j][q] * rs * gg[q] * (1.0f + s1[q]) + s0[q];
        u32x2 o; o.x = pk2(h[0], h[1]); o.y = pk2(h[2], h[3]);
        *(u32x2*)(XN + (size_t)row * D + col) = o; }
}

template <bool DUAL, class Epi>
__device__ __forceinline__ void sg_tile(const bf16_t* A, const int* arow, const bf16_t* Bt, const bf16_t* Bt2, int K, int m0, int n0, int lane, const Epi& epi) {
    const int fr = lane & 15, fq = lane >> 4;
    const bf16_t* pa[2]; const bf16_t* pb[4]; const bf16_t* pb2[4];
#pragma unroll
    for (int mi = 0; mi < 2; ++mi) { const int r = m0 + mi * 16 + fr; const int rr = arow ? arow[r] : r; pa[mi] = A + (size_t)rr * K + 8 * fq; }
#pragma unroll
    for (int ni = 0; ni < 4; ++ni) { pb[ni] = Bt + (size_t)(n0 + ni * 16 + fr) * K + 8 * fq; pb2[ni] = DUAL ? Bt2 + (size_t)(n0 + ni * 16 + fr) * K + 8 * fq : nullptr; }
    f32x4 acc[2][4], acc2[2][4];
#pragma unroll
    for (int mi = 0; mi < 2; ++mi)
#pragma unroll
        for (int ni = 0; ni < 4; ++ni) { acc[mi][ni] = (f32x4){0.f, 0.f, 0.f, 0.f}; acc2[mi][ni] = (f32x4){0.f, 0.f, 0.f, 0.f}; }
    for (int k0 = 0; k0 < K; k0 += 32) {
        bf16x8 a[2], b[4], b2[4];
#pragma unroll
        for (int mi = 0; mi < 2; ++mi) a[mi] = *(const bf16x8*)(pa[mi] + k0);
#pragma unroll
        for (int ni = 0; ni < 4; ++ni) { b[ni] = *(const bf16x8*)(pb[ni] + k0); if (DUAL) b2[ni] = *(const bf16x8*)(pb2[ni] + k0); }
#pragma unroll
        for (int mi = 0; mi < 2; ++mi)
#pragma unroll
            for (int ni = 0; ni < 4; ++ni) {
                acc[mi][ni] = __builtin_amdgcn_mfma_f32_16x16x32_bf16(b[ni], a[mi], acc[mi][ni], 0, 0, 0);
                if (DUAL) acc2[mi][ni] = __builtin_amdgcn_mfma_f32_16x16x32_bf16(b2[ni], a[mi], acc2[mi][ni], 0, 0, 0);
            }
    }
#pragma unroll
    for (int mi = 0; mi < 2; ++mi)
#pragma unroll
        for (int ni = 0; ni < 4; ++ni) epi(m0 + mi * 16 + fr, n0 + ni * 16 + 4 * fq, acc[mi][ni], acc2[mi][ni]);
}

struct EpiInProj { bf16_t* Z;
    __device__ __forceinline__ void operator()(int row, int col, f32x4 v, f32x4) const {
        if (col >= 512) { v[0] = gelu_tanh(v[0]); v[1] = gelu_tanh(v[1]); v[2] = gelu_tanh(v[2]); v[3] = gelu_tanh(v[3]); }
        u32x2 o; o.x = pk2(v[0], v[1]); o.y = pk2(v[2], v[3]); *(u32x2*)(Z + (size_t)row * 2048 + col) = o; } };
struct EpiOutProj { const float* x; const float* mod; bf16_t* X1;
    __device__ __forceinline__ void operator()(int row, int col, f32x4 v, f32x4) const {
        const int b = row / SEQ; const f32x4 xv = *(const f32x4*)(x + (size_t)row * D + col), g1 = *(const f32x4*)(mod + b * 6144 + 2048 + col);
        u32x2 o; o.x = pk2(xv[0] + g1[0] * v[0], xv[1] + g1[1] * v[1]); o.y = pk2(xv[2] + g1[2] * v[2], xv[3] + g1[3] * v[3]);
        *(u32x2*)(X1 + (size_t)row * D + col) = o; } };
struct EpiMoe1 { bf16_t* ACT;
    __device__ __forceinline__ void operator()(int row, int col, f32x4 g, f32x4 u) const {
        float a[4];
#pragma unroll
        for (int q = 0; q < 4; ++q) a[q] = g[q] / (1.0f + __expf(-g[q])) * u[q];
        u32x2 o; o.x = pk2(a[0], a[1]); o.y = pk2(a[2], a[3]); *(u32x2*)(ACT + (size_t)row * DE + col) = o; } };
struct EpiMoe2 { bf16_t* Y;
    __device__ __forceinline__ void operator()(int row, int col, f32x4 v, f32x4) const {
        u32x2 o; o.x = pk2(v[0], v[1]); o.y = pk2(v[2], v[3]); *(u32x2*)(Y + (size_t)row * D + col) = o; } };

template <class Epi>
__global__ void __launch_bounds__(256) k_sgemm(const bf16_t* A, const bf16_t* Bt, int M, int N, int K, Epi epi) {
    const int w = blockIdx.x * 4 + (threadIdx.x >> 6), lane = threadIdx.x & 63, nN = N / 64;
    const int mt = w / nN, nt = w % nN; if (mt * 32 >= M) return;
    sg_tile<false>(A, nullptr, Bt, nullptr, K, mt * 32, nt * 64, lane, epi);
}
__global__ void __launch_bounds__(256) k_moe1(const bf16_t* H2, const int* rowtok, const int* tbl, const bf16_t* W13, EpiMoe1 epi) {
    const int w = blockIdx.x * 4 + (threadIdx.x >> 6), lane = threadIdx.x & 63;
    const int mt = w / 8, nt = w % 8, tile = mt / 8;
    if (tile >= tbl[0]) return;
    const int e = tbl[64 + tile], n0 = nt * 64, q = n0 / 128, i0 = n0 % 128;
    const bf16_t* Wg = W13 + (size_t)e * 1024 * 1024 + (size_t)(256 * q + i0) * 1024 - (size_t)n0 * 1024;
    sg_tile<true>(H2, rowtok, Wg, Wg + (size_t)128 * 1024, 1024, mt * 32, n0, lane, epi);
}
__global__ void __launch_bounds__(256) k_moe2(const bf16_t* ACT, const int* tbl, const bf16_t* W2, EpiMoe2 epi) {
    const int w = blockIdx.x * 4 + (threadIdx.x >> 6), lane = threadIdx.x & 63;
    const int mt = w / 16, nt = w % 16, tile = mt / 8;
    if (tile >= tbl[0]) return;
    const int e = tbl[64 + tile];
    sg_tile<false>(ACT, nullptr, W2 + (size_t)e * 1024 * 512, nullptr, 512, mt * 32, nt * 64, lane, epi);
}

__global__ void __launch_bounds__(256) k_lnv(const bf16_t* Z, const float* g, const float* bb, bf16_t* VN) {
    const int row = blockIdx.x * 4 + (threadIdx.x >> 6), lane = threadIdx.x & 63;
    const u32x4 raw = *(const u32x4*)(Z + (size_t)row * 2048 + 1536 + 8 * lane);
    float v[8];
#pragma unroll
    for (int q = 0; q < 4; ++q) { v[2 * q] = bf2f(raw[q] & 0xffffu); v[2 * q + 1] = bf2f(raw[q] >> 16); }
    float s = 0.f;
#pragma unroll
    for (int q = 0; q < 8; ++q) s += v[q];
    const float mu = wave_sum(s) * (1.0f / 512.0f);
    float s2 = 0.f;
#pragma unroll
    for (int q = 0; q < 8; ++q) { v[q] -= mu; s2 += v[q] * v[q]; }
    const float rstd = rsqrtf(wave_sum(s2) * (1.0f / 512.0f) + EPS);
    u32x4 o;
#pragma unroll
    for (int q = 0; q < 4; ++q) { const int c = 8 * lane + 2 * q; o[q] = pk2(v[2 * q] * rstd * g[c] + bb[c], v[2 * q + 1] * rstd * g[c + 1] + bb[c + 1]); }
    *(u32x4*)(VN + (size_t)row * 512 + 8 * lane) = o;
}
__global__ void __launch_bounds__(256) k_sgu(const bf16_t* Z, const bf16_t* VN, const float* sgu_w, const float* sgu_b, bf16_t* YMIX) {
    const int idx = blockIdx.x * 256 + threadIdx.x, t = idx >> 9, ch = idx & 511, i = t & 127, blk = t >> 7, g = ch >> 6;
    const int jmax = (i < 64) ? 64 : 128;
    float s = sgu_b[g * 128 + i];
    const float* wrow = sgu_w + ((size_t)g * 128 + i) * 128;
    for (int j = 0; j < jmax; ++j) s += wrow[j] * bf2f(VN[((size_t)blk * 128 + j) * 512 + ch]);
    YMIX[(size_t)t * D + 512 + ch] = (bf16_t)f2bf(bf2f(Z[(size_t)t * 2048 + 1024 + ch]) * s);
}
__global__ void __launch_bounds__(256) k_conv(const bf16_t* Z, const float* cw, const float* cb, float* XC) {
    const int idx = blockIdx.x * 256 + threadIdx.x, t = idx >> 9, ch = idx & 511, pos = t & (SEQ - 1);
    float acc = cb[ch];
#pragma unroll
    for (int k = 0; k < 4; ++k) { const int d = k - 3; if (pos + d >= 0) acc += cw[k * 512 + ch] * bf2f(Z[(size_t)(t + d) * 2048 + ch]); }
    XC[idx] = acc;
}
__global__ void __launch_bounds__(256) k_gates(const float* XC, const float* wa, const float* ba, const float* wi, const float* bi, const float* lam, float* A_, float* U_) {
    const int idx = blockIdx.x * 256 + threadIdx.x, t = idx >> 9, ch = idx & 511, h = ch >> 6, e = ch & 63;
    const float* xrow = XC + (size_t)t * 512 + h * 64;
    float ra = ba[ch], ri = bi[ch];
    for (int d = 0; d < 64; ++d) { const float xv = xrow[d]; ra += xv * wa[h * 4096 + d * 64 + e]; ri += xv * wi[h * 4096 + d * 64 + e]; }
    const float r = sigmoidf(ra), ig = sigmoidf(ri);
    const float sp = log1pf(expf(-lam[ch]));
    const float log_a = -8.0f * r * sp;
    A_[idx] = expf(log_a);
    U_[idx] = sqrtf(-expm1f(2.0f * log_a)) * (ig * XC[idx]);
}
__global__ void __launch_bounds__(64) k_scan(const float* A_, const float* U_, const bf16_t* Z, bf16_t* YMIX) {
    const int idx = blockIdx.x * 64 + threadIdx.x, b = idx >> 9, ch = idx & 511;
    float h = 0.f;
    for (int p0 = 0; p0 < SEQ; p0 += 8) {
        float a[8], u[8], g[8];
#pragma unroll
        for (int q = 0; q < 8; ++q) { const size_t t = (size_t)b * SEQ + p0 + q; a[q] = A_[t * 512 + ch]; u[q] = U_[t * 512 + ch]; g[q] = bf2f(Z[t * 2048 + 512 + ch]); }
#pragma unroll
        for (int q = 0; q < 8; ++q) { const size_t t = (size_t)b * SEQ + p0 + q; h = a[q] * h + u[q]; YMIX[t * D + ch] = (bf16_t)f2bf(h * g[q]); }
    }
}

__global__ void __launch_bounds__(256) k_router(const bf16_t* X1, const float* g2w, const float* mod, const float* wg, const float* bg, const float* we, const float* be,
                                                bf16_t* H2, unsigned* cnt, int* list, int* toke, float* tokw, int* tokp) {
    const int row = blockIdx.x * 4 + (threadIdx.x >> 6), lane = threadIdx.x & 63, b = row / SEQ;
    float h[16]; float ss = 0.f;
#pragma unroll
    for (int jj = 0; jj < 2; ++jj) { const u32x4 raw = *(const u32x4*)(X1 + (size_t)row * D + 512 * jj + 8 * lane);
#pragma unroll
        for (int q = 0; q < 4; ++q) { h[8 * jj + 2 * q] = bf2f(raw[q] & 0xffffu); h[8 * jj + 2 * q + 1] = bf2f(raw[q] >> 16); } }
#pragma unroll
    for (int q = 0; q < 16; ++q) ss += h[q] * h[q];
    const float rs = rsqrtf(wave_sum(ss) * (1.0f / D) + EPS);
    const float* sh = mod + b * 6144 + 3072; const float* sc = sh + 1024;
#pragma unroll
    for (int jj = 0; jj < 2; ++jj) { u32x4 o;
#pragma unroll
        for (int q = 0; q < 4; ++q) { const int c = 512 * jj + 8 * lane + 2 * q;
            const float h0 = h[8 * jj + 2 * q] * rs * g2w[c] * (1.0f + sc[c]) + sh[c], h1 = h[8 * jj + 2 * q + 1] * rs * g2w[c + 1] * (1.0f + sc[c + 1]) + sh[c + 1];
            o[q] = pk2(h0, h1); h[8 * jj + 2 * q] = bf2f(o[q] & 0xffffu); h[8 * jj + 2 * q + 1] = bf2f(o[q] >> 16); }
        *(u32x4*)(H2 + (size_t)row * D + 512 * jj + 8 * lane) = o; }
    float gl[4], el[8];
#pragma unroll
    for (int j = 0; j < 4; ++j) { float p = 0.f;
#pragma unroll
        for (int q = 0; q < 16; ++q) { const int k = 512 * (q >> 3) + 8 * lane + (q & 7); p += h[q] * wg[k * 4 + j]; }
        gl[j] = wave_sum(p) + bg[j]; }
    int gs = 0; float gmax = gl[0];
#pragma unroll
    for (int j = 1; j < 4; ++j) if (gl[j] > gmax) { gmax = gl[j]; gs = j; }
#pragma unroll
    for (int j = 0; j < 8; ++j) { float p = 0.f;
#pragma unroll
        for (int q = 0; q < 16; ++q) { const int k = 512 * (q >> 3) + 8 * lane + (q & 7); p += h[q] * we[k * 32 + gs * 8 + j]; }
        el[j] = wave_sum(p) + be[gs * 8 + j]; }
    if (lane == 0) {
        float gsum = 0.f;
#pragma unroll
        for (int j = 0; j < 4; ++j) gsum += expf(gl[j] - gmax);
        const float pg = 1.0f / gsum;
        int i1 = 0; float m1 = el[0];
#pragma unroll
        for (int j = 1; j < 8; ++j) if (el[j] > m1) { m1 = el[j]; i1 = j; }
        int i2 = -1; float m2 = -INFINITY;
#pragma unroll
        for (int j = 0; j < 8; ++j) if (j != i1 && el[j] > m2) { m2 = el[j]; i2 = j; }
        const float r = expf(m2 - m1);
        const float w1 = pg / (1.0f + r), w2 = pg * r / (1.0f + r);
        const int e1 = gs * 8 + i1, e2 = gs * 8 + i2;
        const unsigned p1 = atomicAdd(cnt + e1, 1u), p2 = atomicAdd(cnt + e2, 1u);
        list[(size_t)e1 * LISTCAP + p1] = row; list[(size_t)e2 * LISTCAP + p2] = row;
        toke[2 * row] = e1; toke[2 * row + 1] = e2; tokw[2 * row] = w1; tokw[2 * row + 1] = w2; tokp[2 * row] = (int)p1; tokp[2 * row + 1] = (int)p2;
    }
}
__global__ void k_table(const unsigned* cnt, int* tbl) {
    if (threadIdx.x == 0) { int p = 0;
        for (int e = 0; e < NE; ++e) { tbl[1 + e] = p; const int nt = ((int)cnt[e] + 255) / 256; for (int j = 0; j < nt; ++j) tbl[64 + p + j] = e; p += nt; }
        tbl[1 + NE] = p; tbl[0] = p; }
}
__global__ void __launch_bounds__(256) k_rowtok(const unsigned* cnt, const int* tbl, const int* list, int* rowtok) {
    const int p = blockIdx.x * 256 + threadIdx.x, t = p >> 8; int tok = 0;
    if (t < tbl[0]) { const int e = tbl[64 + t], pos = (t - tbl[1 + e]) * 256 + (p & 255); if (pos < (int)cnt[e]) tok = list[(size_t)e * LISTCAP + pos]; }
    rowtok[p] = tok;
}
__global__ void __launch_bounds__(256) k_combine(const bf16_t* X1, const bf16_t* Y, const float* mod, const int* tbl, const int* toke, const float* tokw, const int* tokp, const float* fg, float* out) {
    const int row = blockIdx.x * 4 + (threadIdx.x >> 6), lane = threadIdx.x & 63, b = row / SEQ;
    const int e0 = toke[2 * row], e1 = toke[2 * row + 1];
    const size_t q0 = (size_t)tbl[1 + e0] * 256 + tokp[2 * row], q1 = (size_t)tbl[1 + e1] * 256 + tokp[2 * row + 1];
    const float w0 = tokw[2 * row], w1 = tokw[2 * row + 1];
    const float* g2 = mod + b * 6144 + 5120;
    float v[16]; float ss = 0.f;
#pragma unroll
    for (int jj = 0; jj < 2; ++jj) { const int c0 = 512 * jj + 8 * lane;
        const u32x4 xr = *(const u32x4*)(X1 + (size_t)row * D + c0), ya = *(const u32x4*)(Y + q0 * D + c0), yb = *(const u32x4*)(Y + q1 * D + c0);
#pragma unroll
        for (int q = 0; q < 4; ++q) {
            const float x0 = bf2f(xr[q] & 0xffffu), x1 = bf2f(xr[q] >> 16);
            const float y0 = w0 * bf2f(ya[q] & 0xffffu) + w1 * bf2f(yb[q] & 0xffffu), y1 = w0 * bf2f(ya[q] >> 16) + w1 * bf2f(yb[q] >> 16);
            v[8 * jj + 2 * q] = x0 + g2[c0 + 2 * q] * y0; v[8 * jj + 2 * q + 1] = x1 + g2[c0 + 2 * q + 1] * y1; } }
#pragma unroll
    for (int q = 0; q < 16; ++q) ss += v[q] * v[q];
    const float rs = rsqrtf(wave_sum(ss) * (1.0f / D) + EPS);
#pragma unroll
    for (int jj = 0; jj < 2; ++jj) { const int c0 = 512 * jj + 8 * lane;
        f32x4 o0, o1;
#pragma unroll
        for (int q = 0; q < 4; ++q) { o0[q] = v[8 * jj + q] * rs * fg[c0 + q]; o1[q] = v[8 * jj + 4 + q] * rs * fg[c0 + 4 + q]; }
        *(f32x4*)(out + (size_t)row * D + c0) = o0; *(f32x4*)(out + (size_t)row * D + c0 + 4) = o1; }
}

extern "C" void kernel_launch(void* const* d_in, const int* in_sizes, int n_in, void* d_out, int out_size, void* d_ws, size_t ws_size, hipStream_t stream) {
    if (n_in != 27 || out_size != T * D || ws_size < WS_NEED) { fprintf(stderr, "kernel_launch: unexpected shapes (n_in %d out %d ws %zu)\n", n_in, out_size, ws_size); return; }
    const float* x = (const float*)d_in[0]; const float* c = (const float*)d_in[1]; const float* ada_w = (const float*)d_in[2]; const float* ada_b = (const float*)d_in[3];
    const float* norm1_g = (const float*)d_in[4]; const float* w_in = (const float*)d_in[5]; const float* conv_w = (const float*)d_in[6]; const float* conv_b = (const float*)d_in[7];
    const float* gate_a_w = (const float*)d_in[8]; const float* gate_a_b = (const float*)d_in[9]; const float* gate_i_w = (const float*)d_in[10]; const float* gate_i_b = (const float*)d_in[11];
    const float* lam = (const float*)d_in[12]; const float* sgu_ln_g = (const float*)d_in[13]; const float* sgu_ln_b = (const float*)d_in[14]; const float* sgu_w = (const float*)d_in[15];
    const float* sgu_b = (const float*)d_in[16]; const float* w_out = (const float*)d_in[17]; const float* norm2_g = (const float*)d_in[18]; const float* rg_w = (const float*)d_in[19];
    const float* rg_b = (const float*)d_in[20]; const float* re_w = (const float*)d_in[21]; const float* re_b = (const float*)d_in[22]; const float* ew1 = (const float*)d_in[23];
    const float* ew3 = (const float*)d_in[24]; const float* ew2 = (const float*)d_in[25]; const float* final_g = (const float*)d_in[26];
    char* ws = (char*)d_ws; float* out = (float*)d_out;
    unsigned* ctl = (unsigned*)(ws + OFF_CTL); float* mod = (float*)(ws + OFF_MOD); int* tbl = (int*)(ws + OFF_TBL);
    int* toke = (int*)(ws + OFF_TOKE); float* tokw = (float*)(ws + OFF_TOKW); int* tokp = (int*)(ws + OFF_TOKP);
    bf16_t* WIN = (bf16_t*)(ws + OFF_WIN); bf16_t* WOUT = (bf16_t*)(ws + OFF_WOUT); bf16_t* W13 = (bf16_t*)(ws + OFF_W13); bf16_t* W2 = (bf16_t*)(ws + OFF_W2);
    bf16_t* XN = (bf16_t*)(ws + OFF_XN); bf16_t* Z = (bf16_t*)(ws + OFF_Z); bf16_t* YMIX = (bf16_t*)(ws + OFF_YMIX); bf16_t* X1 = (bf16_t*)(ws + OFF_X1);
    bf16_t* ACT = (bf16_t*)(ws + OFF_ACT); int* list = (int*)(ws + OFF_LIST); int* rowtok = (int*)(ws + OFF_ROWTOK); bf16_t* Y = (bf16_t*)(ws + OFF_Y);
    bf16_t* VN = (bf16_t*)(ws + OFF_VN); float* XC = (float*)(ws + OFF_XC); float* A_ = out; float* U_ = out + (size_t)T * DL;
    bf16_t* H2 = XN;

    (void)hipMemsetAsync(ws + OFF_CTL, 0, CTL_BYTES, stream);
    k_ada<<<24, 256, 0, stream>>>(c, ada_w, ada_b, mod);
    k_transpose<<<dim3(2048 / 32, 1024 / 32, 1), 256, 0, stream>>>(w_in, WIN, 1024, 2048, 2048, 0, 0, 0, 0);
    k_transpose<<<dim3(1024 / 32, 1024 / 32, 1), 256, 0, stream>>>(w_out, WOUT, 1024, 1024, 1024, 0, 0, 0, 0);
    k_transpose<<<dim3(512 / 32, 1024 / 32, NE), 256, 0, stream>>>(ew1, W13, 1024, 512, 128, 256, 0, (size_t)1024 * 512, (size_t)1024 * 1024);
    k_transpose<<<dim3(512 / 32, 1024 / 32, NE), 256, 0, stream>>>(ew3, W13, 1024, 512, 128, 256, 128, (size_t)1024 * 512, (size_t)1024 * 1024);
    k_transpose<<<dim3(1024 / 32, 512 / 32, NE), 256, 0, stream>>>(ew2, W2, 512, 1024, 1024, 0, 0, (size_t)512 * 1024, (size_t)1024 * 512);
    k_xn<<<T / 4, 256, 0, stream>>>(x, norm1_g, mod, XN);
    k_sgemm<EpiInProj><<<(T / 32) * (2048 / 64) / 4, 256, 0, stream>>>(XN, WIN, T, 2048, 1024, EpiInProj{Z});
    k_lnv<<<T / 4, 256, 0, stream>>>(Z, sgu_ln_g, sgu_ln_b, VN);
    k_sgu<<<T * 512 / 256, 256, 0, stream>>>(Z, VN, sgu_w, sgu_b, YMIX);
    k_conv<<<T * 512 / 256, 256, 0, stream>>>(Z, conv_w, conv_b, XC);
    k_gates<<<T * 512 / 256, 256, 0, stream>>>(XC, gate_a_w, gate_a_b, gate_i_w, gate_i_b, lam, A_, U_);
    k_scan<<<NB * 512 / 64, 64, 0, stream>>>(A_, U_, Z, YMIX);
    k_sgemm<EpiOutProj><<<(T / 32) * (1024 / 64) / 4, 256, 0, stream>>>(YMIX, WOUT, T, 1024, 1024, EpiOutProj{x, mod, X1});
    k_router<<<T / 4, 256, 0, stream>>>(X1, norm2_g, mod, rg_w, rg_b, re_w, re_b, H2, ctl + CW_CNT, list, toke, tokw, tokp);
    k_table<<<1, 64, 0, stream>>>(ctl + CW_CNT, tbl);
    k_rowtok<<<MAXROWS / 256, 256, 0, stream>>>(ctl + CW_CNT, tbl, list, rowtok);
    k_moe1<<<(MAXROWS / 32) * 8 / 4, 256, 0, stream>>>(H2, rowtok, tbl, W13, EpiMoe1{ACT});
    k_moe2<<<(MAXROWS / 32) * 16 / 4, 256, 0, stream>>>(ACT, tbl, W2, EpiMoe2{Y});
    k_combine<<<T / 4, 256, 0, stream>>>(X1, Y, mod, tbl, toke, tokw, tokp, final_g, out);
}
```

```cpp
#include <hip/hip_runtime.h>
#include <cstdio>
#include <cstdint>

typedef unsigned short bf16_t;
typedef short bf16x8 __attribute__((ext_vector_type(8)));
typedef float f32x4 __attribute__((ext_vector_type(4)));
typedef unsigned u32x2 __attribute__((ext_vector_type(2)));
typedef unsigned u32x4 __attribute__((ext_vector_type(4)));

constexpr int T = 32768, D = 1024, SEQ = 4096, NB = 8;
constexpr int DL = 512;
constexpr int NE = 32, DE = 512;
constexpr int LISTCAP = 65536;
constexpr int MAXTILES = 288, MAXROWS = MAXTILES * 256;
constexpr float EPS = 1e-6f;

constexpr size_t MiB = 1u << 20;
constexpr size_t OFF_CTL = 0, CTL_BYTES = 1 * MiB;
constexpr size_t OFF_MOD = 1 * MiB;
constexpr size_t OFF_TBL = 1 * MiB + 256 * 1024;
constexpr size_t OFF_TOKE = 1 * MiB + 512 * 1024;
constexpr size_t OFF_TOKW = 1 * MiB + 768 * 1024;
constexpr size_t OFF_TOKP = 2 * MiB;
constexpr size_t OFF_N8SP = 1 * MiB + 256 * 1024 + 16384;
constexpr size_t OFF_GATEW = 2 * MiB + 256 * 1024;
constexpr size_t OFF_SGUW = 2 * MiB + 512 * 1024;
constexpr size_t OFF_ROUTW = 2 * MiB + 768 * 1024;
constexpr size_t OFF_CARRY = 3 * MiB;
constexpr size_t OFF_WIN = 4 * MiB;
constexpr size_t OFF_WOUT = 8 * MiB;
constexpr size_t OFF_W13 = 10 * MiB;
constexpr size_t OFF_W2 = 74 * MiB;
constexpr size_t OFF_XN = 106 * MiB;
constexpr size_t OFF_Z = 170 * MiB;
constexpr size_t OFF_YMIX = 298 * MiB;
constexpr size_t OFF_X1 = 362 * MiB;
constexpr size_t OFF_ACT = 426 * MiB;
constexpr size_t OFF_LIST = 498 * MiB;
constexpr size_t OFF_ROWTOK = 506 * MiB;
constexpr size_t OFF_Y = 170 * MiB;
constexpr size_t WS_NEED = 507 * MiB;
constexpr size_t OFF_VN = OFF_X1;
constexpr size_t OFF_XC = OFF_ACT;
constexpr int CW_BAR = 4096;
constexpr int CW_CNT = 8192, CNT_STRIDE = 64;

__device__ __forceinline__ unsigned f2bf(float f) { unsigned u = __float_as_uint(f); return (u + 0x7fffu + ((u >> 16) & 1u)) >> 16; }
__device__ __forceinline__ float bf2f(unsigned h) { return __uint_as_float(h << 16); }
__device__ __forceinline__ unsigned pk2(float lo, float hi) { return f2bf(lo) | (f2bf(hi) << 16); }
__device__ __forceinline__ float wave_sum(float v) {
#pragma unroll
    for (int o = 1; o < 64; o <<= 1) v += __shfl_xor(v, o);
    return v;
}
__device__ __forceinline__ float gelu_tanh(float x) {
    const float u = 1.5957691216057308f * (x + 0.044715f * x * x * x);
    return x / (1.0f + __expf(-u));
}
__device__ __forceinline__ float sigmoidf(float x) { return 1.0f / (1.0f + __expf(-x)); }

__global__ void __launch_bounds__(256) k_ada(const float* c, const float* ada_w, const float* ada_b, float* mod) {
    __shared__ float sc[8][1024];
    for (int i = threadIdx.x; i < 8192; i += 256) { const float v = c[i]; sc[i >> 10][i & 1023] = v / (1.0f + expf(-v)); }
    __syncthreads();
    const int n = blockIdx.x * 256 + threadIdx.x;
    float acc[8];
#pragma unroll
    for (int b = 0; b < 8; ++b) acc[b] = 0.f;
    for (int k = 0; k < 1024; ++k) {
        const float w = ada_w[(size_t)k * 6144 + n];
#pragma unroll
        for (int b = 0; b < 8; ++b) acc[b] += sc[b][k] * w;
    }
#pragma unroll
    for (int b = 0; b < 8; ++b) mod[b * 6144 + n] = acc[b] + ada_b[n];
}

__global__ void __launch_bounds__(256) k_transpose(const float* W, bf16_t* WT, int K, int N, int blk, int rstride, int rbase, size_t w_ms, size_t wt_ms) {
    __shared__ float tile[32][33];
    W += (size_t)blockIdx.z * w_ms; WT += (size_t)blockIdx.z * wt_ms;
    const int n0 = blockIdx.x * 32, k0 = blockIdx.y * 32, tx = threadIdx.x & 31, ty = threadIdx.x >> 5;
    for (int j = ty; j < 32; j += 8) tile[j][tx] = W[(size_t)(k0 + j) * N + n0 + tx];
    __syncthreads();
    for (int j = ty; j < 32; j += 8) { const int n = n0 + j; const int row = rbase + (n / blk) * rstride + (n % blk);
        WT[(size_t)row * K + k0 + tx] = (bf16_t)f2bf(tile[tx][j]); }
}

__global__ void __launch_bounds__(256) k_xn(const float* x, const float* g, const float* mod, bf16_t* XN) {
    const int row = blockIdx.x * 4 + (threadIdx.x >> 6), lane = threadIdx.x & 63, b = row / SEQ;
    const f32x4* xr = (const f32x4*)(x + (size_t)row * D);
    f32x4 v[4]; float ss = 0.f;
#pragma unroll
    for (int j = 0; j < 4; ++j) { v[j] = xr[lane + 64 * j]; ss += v[j][0] * v[j][0] + v[j][1] * v[j][1] + v[j][2] * v[j][2] + v[j][3] * v[j][3]; }
    ss = wave_sum(ss);
    const float rs = rsqrtf(ss * (1.0f / D) + EPS);
    const float* sh = mod + b * 6144; const float* sc = sh + 1024;
#pragma unroll
    for (int j = 0; j < 4; ++j) { const int col = 4 * (lane + 64 * j);
        const f32x4 gg = *(const f32x4*)(g + col), s1 = *(const f32x4*)(sc + col), s0 = *(const f32x4*)(sh + col);
        float h[4];
#pragma unroll
        for (int q = 0; q < 4; ++q) h[q] = v[j][q] * rs * gg[q] * (1.0f + s1[q]) + s0[q];
        u32x2 o; o.x = pk2(h[0], h[1]); o.y = pk2(h[2], h[3]);
        *(u32x2*)(XN + (size_t)row * D + col) = o; }
}

template <bool DUAL, class Epi>
__device__ __forceinline__ void sg_tile(const bf16_t* A, const int* arow, const bf16_t* Bt, const bf16_t* Bt2, int K, int m0, int n0, int lane, const Epi& epi) {
    const int fr = lane & 15, fq = lane >> 4;
    const bf16_t* pa[2]; const bf16_t* pb[4]; const bf16_t* pb2[4];
#pragma unroll
    for (int mi = 0; mi < 2; ++mi) { const int r = m0 + mi * 16 + fr; const int rr = arow ? arow[r] : r; pa[mi] = A + (size_t)rr * K + 8 * fq; }
#pragma unroll
    for (int ni = 0; ni < 4; ++ni) { pb[ni] = Bt + (size_t)(n0 + ni * 16 + fr) * K + 8 * fq; pb2[ni] = DUAL ? Bt2 + (size_t)(n0 + ni * 16 + fr) * K + 8 * fq : nullptr; }
    f32x4 acc[2][4], acc2[2][4];
#pragma unroll
    for (int mi = 0; mi < 2; ++mi)
#pragma unroll
        for (int ni = 0; ni < 4; ++ni) { acc[mi][ni] = (f32x4){0.f, 0.f, 0.f, 0.f}; acc2[mi][ni] = (f32x4){0.f, 0.f, 0.f, 0.f}; }
    for (int k0 = 0; k0 < K; k0 += 32) {
        bf16x8 a[2], b[4], b2[4];
#pragma unroll
        for (int mi = 0; mi < 2; ++mi) a[mi] = *(const bf16x8*)(pa[mi] + k0);
#pragma unroll
        for (int ni = 0; ni < 4; ++ni) { b[ni] = *(const bf16x8*)(pb[ni] + k0); if (DUAL) b2[ni] = *(const bf16x8*)(pb2[ni] + k0); }
#pragma unroll
        for (int mi = 0; mi < 2; ++mi)
#pragma unroll
            for (int ni = 0; ni < 4; ++ni) {
                acc[mi][ni] = __builtin_amdgcn_mfma_f32_16x16x32_bf16(b[ni], a[mi], acc[mi][ni], 0, 0, 0);
                if (DUAL) acc2[mi][ni] = __builtin_amdgcn_mfma_f32_16x16x32_bf16(b2[ni], a[mi], acc2[mi][ni], 0, 0, 0);
            }
    }
#pragma unroll
    for (int mi = 0; mi < 2; ++mi)
#pragma unroll
        for (int ni = 0; ni < 4; ++ni) epi(m0 + mi * 16 + fr, n0 + ni * 16 + 4 * fq, acc[mi][ni], acc2[mi][ni]);
}

struct EpiInProj { bf16_t* Z;
    __device__ __forceinline__ void operator()(int row, int col, f32x4 v, f32x4) const {
        if (col >= 512) { v[0] = gelu_tanh(v[0]); v[1] = gelu_tanh(v[1]); v[2] = gelu_tanh(v[2]); v[3] = gelu_tanh(v[3]); }
        u32x2 o; o.x = pk2(v[0], v[1]); o.y = pk2(v[2], v[3]); *(u32x2*)(Z + (size_t)row * 2048 + col) = o; } };
struct EpiOutProj { const float* x; const float* mod; bf16_t* X1;
    __device__ __forceinline__ void operator()(int row, int col, f32x4 v, f32x4) const {
        const int b = row / SEQ; const f32x4 xv = *(const f32x4*)(x + (size_t)row * D + col), g1 = *(const f32x4*)(mod + b * 6144 + 2048 + col);
        u32x2 o; o.x = pk2(xv[0] + g1[0] * v[0], xv[1] + g1[1] * v[1]); o.y = pk2(xv[2] + g1[2] * v[2], xv[3] + g1[3] * v[3]);
        *(u32x2*)(X1 + (size_t)row * D + col) = o; } };
struct EpiMoe1 { bf16_t* ACT;
    __device__ __forceinline__ void operator()(int row, int col, f32x4 g, f32x4 u) const {
        float a[4];
#pragma unroll
        for (int q = 0; q < 4; ++q) a[q] = g[q] / (1.0f + __expf(-g[q])) * u[q];
        u32x2 o; o.x = pk2(a[0], a[1]); o.y = pk2(a[2], a[3]); *(u32x2*)(ACT + (size_t)row * DE + col) = o; } };
struct EpiMoe2 { bf16_t* Y;
    __device__ __forceinline__ void operator()(int row, int col, f32x4 v, f32x4) const {
        u32x2 o; o.x = pk2(v[0], v[1]); o.y = pk2(v[2], v[3]); *(u32x2*)(Y + (size_t)row * D + col) = o; } };

template <class Epi>
__global__ void __launch_bounds__(256) k_sgemm(const bf16_t* A, const bf16_t* Bt, int M, int N, int K, Epi epi) {
    const int w = blockIdx.x * 4 + (threadIdx.x >> 6), lane = threadIdx.x & 63, nN = N / 64;
    const int mt = w / nN, nt = w % nN; if (mt * 32 >= M) return;
    sg_tile<false>(A, nullptr, Bt, nullptr, K, mt * 32, nt * 64, lane, epi);
}
__global__ void __launch_bounds__(256) k_moe1(const bf16_t* H2, const int* rowtok, const int* tbl, const bf16_t* W13, EpiMoe1 epi) {
    const int w = blockIdx.x * 4 + (threadIdx.x >> 6), lane = threadIdx.x & 63;
    const int mt = w / 8, nt = w % 8, tile = mt / 8;
    if (tile >= tbl[0]) return;
    const int e = tbl[64 + tile], n0 = nt * 64, q = n0 / 128, i0 = n0 % 128;
    const bf16_t* Wg = W13 + (size_t)e * 1024 * 1024 + (size_t)(256 * q + i0) * 1024 - (size_t)n0 * 1024;
    sg_tile<true>(H2, rowtok, Wg, Wg + (size_t)128 * 1024, 1024, mt * 32, n0, lane, epi);
}
__global__ void __launch_bounds__(256) k_moe2(const bf16_t* ACT, const int* tbl, const bf16_t* W2, EpiMoe2 epi) {
    const int w = blockIdx.x * 4 + (threadIdx.x >> 6), lane = threadIdx.x & 63;
    const int mt = w / 16, nt = w % 16, tile = mt / 8;
    if (tile >= tbl[0]) return;
    const int e = tbl[64 + tile];
    sg_tile<false>(ACT, nullptr, W2 + (size_t)e * 1024 * 512, nullptr, 512, mt * 32, nt * 64, lane, epi);
}

__global__ void __launch_bounds__(256) k_lnv(const bf16_t* Z, const float* g, const float* bb, bf16_t* VN) {
    const int row = blockIdx.x * 4 + (threadIdx.x >> 6), lane = threadIdx.x & 63;
    const u32x4 raw = *(const u32x4*)(Z + (size_t)row * 2048 + 1536 + 8 * lane);
    float v[8];
#pragma unroll
    for (int q = 0; q < 4; ++q) { v[2 * q] = bf2f(raw[q] & 0xffffu); v[2 * q + 1] = bf2f(raw[q] >> 16); }
    float s = 0.f;
#pragma unroll
    for (int q = 0; q < 8; ++q) s += v[q];
    const float mu = wave_sum(s) * (1.0f / 512.0f);
    float s2 = 0.f;
#pragma unroll
    for (int q = 0; q < 8; ++q) { v[q] -= mu; s2 += v[q] * v[q]; }
    const float rstd = rsqrtf(wave_sum(s2) * (1.0f / 512.0f) + EPS);
    u32x4 o;
#pragma unroll
    for (int q = 0; q < 4; ++q) { const int c = 8 * lane + 2 * q; o[q] = pk2(v[2 * q] * rstd * g[c] + bb[c], v[2 * q + 1] * rstd * g[c + 1] + bb[c + 1]); }
    *(u32x4*)(VN + (size_t)row * 512 + 8 * lane) = o;
}
__global__ void __launch_bounds__(256) k_sgu(const bf16_t* Z, const bf16_t* VN, const float* sgu_w, const float* sgu_b, bf16_t* YMIX) {
    const int idx = blockIdx.x * 256 + threadIdx.x, t = idx >> 9, ch = idx & 511, i = t & 127, blk = t >> 7, g = ch >> 6;
    const int jmax = (i < 64) ? 64 : 128;
    float s = sgu_b[g * 128 + i];
    const float* wrow = sgu_w + ((size_t)g * 128 + i) * 128;
    for (int j = 0; j < jmax; ++j) s += wrow[j] * bf2f(VN[((size_t)blk * 128 + j) * 512 + ch]);
    YMIX[(size_t)t * D + 512 + ch] = (bf16_t)f2bf(bf2f(Z[(size_t)t * 2048 + 1024 + ch]) * s);
}
__global__ void __launch_bounds__(256) k_conv(const bf16_t* Z, const float* cw, const float* cb, float* XC) {
    const int idx = blockIdx.x * 256 + threadIdx.x, t = idx >> 9, ch = idx & 511, pos = t & (SEQ - 1);
    float acc = cb[ch];
#pragma unroll
    for (int k = 0; k < 4; ++k) { const int d = k - 3; if (pos + d >= 0) acc += cw[k * 512 + ch] * bf2f(Z[(size_t)(t + d) * 2048 + ch]); }
    XC[idx] = acc;
}
__global__ void __launch_bounds__(256) k_gates(const float* XC, const float* wa, const float* ba, const float* wi, const float* bi, const float* lam, float* A_, float* U_) {
    const int idx = blockIdx.x * 256 + threadIdx.x, t = idx >> 9, ch = idx & 511, h = ch >> 6, e = ch & 63;
    const float* xrow = XC + (size_t)t * 512 + h * 64;
    float ra = ba[ch], ri = bi[ch];
    for (int d = 0; d < 64; ++d) { const float xv = xrow[d]; ra += xv * wa[h * 4096 + d * 64 + e]; ri += xv * wi[h * 4096 + d * 64 + e]; }
    const float r = sigmoidf(ra), ig = sigmoidf(ri);
    const float sp = log1pf(expf(-lam[ch]));
    const float log_a = -8.0f * r * sp;
    A_[idx] = expf(log_a);
    U_[idx] = sqrtf(-expm1f(2.0f * log_a)) * (ig * XC[idx]);
}
__global__ void __launch_bounds__(64) k_scan(const float* A_, const float* U_, const bf16_t* Z, bf16_t* YMIX) {
    const int idx = blockIdx.x * 64 + threadIdx.x, b = idx >> 9, ch = idx & 511;
    float h = 0.f;
    for (int p0 = 0; p0 < SEQ; p0 += 8) {
        float a[8], u[8], g[8];
#pragma unroll
        for (int q = 0; q < 8; ++q) { const size_t t = (size_t)b * SEQ + p0 + q; a[q] = A_[t * 512 + ch]; u[q] = U_[t * 512 + ch]; g[q] = bf2f(Z[t * 2048 + 512 + ch]); }
#pragma unroll
        for (int q = 0; q < 8; ++q) { const size_t t = (size_t)b * SEQ + p0 + q; h = a[q] * h + u[q]; YMIX[t * D + ch] = (bf16_t)f2bf(h * g[q]); }
    }
}

__global__ void __launch_bounds__(256) k_router(const bf16_t* X1, const float* g2w, const float* mod, const float* wg, const float* bg, const float* we, const float* be,
                                                bf16_t* H2, unsigned* cnt, int* list, int* toke, float* tokw, int* tokp) {
    const int row = blockIdx.x * 4 + (threadIdx.x >> 6), lane = threadIdx.x & 63, b = row / SEQ;
    float h[16]; float ss = 0.f;
#pragma unroll
    for (int jj = 0; jj < 2; ++jj) { const u32x4 raw = *(const u32x4*)(X1 + (size_t)row * D + 512 * jj + 8 * lane);
#pragma unroll
        for (int q = 0; q < 4; ++q) { h[8 * jj + 2 * q] = bf2f(raw[q] & 0xffffu); h[8 * jj + 2 * q + 1] = bf2f(raw[q] >> 16); } }
#pragma unroll
    for (int q = 0; q < 16; ++q) ss += h[q] * h[q];
    const float rs = rsqrtf(wave_sum(ss) * (1.0f / D) + EPS);
    const float* sh = mod + b * 6144 + 3072; const float* sc = sh + 1024;
#pragma unroll
    for (int jj = 0; jj < 2; ++jj) { u32x4 o;
#pragma unroll
        for (int q = 0; q < 4; ++q) { const int c = 512 * jj + 8 * lane + 2 * q;
            const float h0 = h[8 * jj + 2 * q] * rs * g2w[c] * (1.0f + sc[c]) + sh[c], h1 = h[8 * jj + 2 * q + 1] * rs * g2w[c + 1] * (1.0f + sc[c + 1]) + sh[c + 1];
            o[q] = pk2(h0, h1); h[8 * jj + 2 * q] = bf2f(o[q] & 0xffffu); h[8 * jj + 2 * q + 1] = bf2f(o[q] >> 16); }
        *(u32x4*)(H2 + (size_t)row * D + 512 * jj + 8 * lane) = o; }
    float gl[4], el[8];
#pragma unroll
    for (int j = 0; j < 4; ++j) { float p = 0.f;
#pragma unroll
        for (int q = 0; q < 16; ++q) { const int k = 512 * (q >> 3) + 8 * lane + (q & 7); p += h[q] * wg[k * 4 + j]; }
        gl[j] = wave_sum(p) + bg[j]; }
    int gs = 0; float gmax = gl[0];
#pragma unroll
    for (int j = 1; j < 4; ++j) if (gl[j] > gmax) { gmax = gl[j]; gs = j; }
#pragma unroll
    for (int j = 0; j < 8; ++j) { float p = 0.f;
#pragma unroll
        for (int q = 0; q < 16; ++q) { const int k = 512 * (q >> 3) + 8 * lane + (q & 7); p += h[q] * we[k * 32 + gs * 8 + j]; }
        el[j] = wave_sum(p) + be[gs * 8 + j]; }
    if (lane == 0) {
        float gsum = 0.f;
#pragma unroll
        for (int j = 0; j < 4; ++j) gsum += expf(gl[j] - gmax);
        const float pg = 1.0f / gsum;
        int i1 = 0; float m1 = el[0];
#pragma unroll
        for (int j = 1; j < 8; ++j) if (el[j] > m1) { m1 = el[j]; i1 = j; }
        int i2 = -1; float m2 = -INFINITY;
#pragma unroll
        for (int j = 0; j < 8; ++j) if (j != i1 && el[j] > m2) { m2 = el[j]; i2 = j; }
        const float r = expf(m2 - m1);
        const float w1 = pg / (1.0f + r), w2 = pg * r / (1.0f + r);
        const int e1 = gs * 8 + i1, e2 = gs * 8 + i2;
        const unsigned p1 = atomicAdd(cnt + CNT_STRIDE * e1, 1u), p2 = atomicAdd(cnt + CNT_STRIDE * e2, 1u);
        list[(size_t)e1 * LISTCAP + p1] = row; list[(size_t)e2 * LISTCAP + p2] = row;
        toke[2 * row] = e1; toke[2 * row + 1] = e2; tokw[2 * row] = w1; tokw[2 * row + 1] = w2; tokp[2 * row] = (int)p1; tokp[2 * row + 1] = (int)p2;
    }
}
__global__ void k_table(const unsigned* cnt, int* tbl) {
    if (threadIdx.x == 0) { int p = 0;
        for (int e = 0; e < NE; ++e) { tbl[1 + e] = p; const int nt = ((int)cnt[CNT_STRIDE * e] + 255) / 256; for (int j = 0; j < nt; ++j) tbl[64 + p + j] = e; p += nt; }
        tbl[1 + NE] = p; tbl[0] = p; }
}
__global__ void __launch_bounds__(256) k_rowtok(const unsigned* cnt, const int* tbl, const int* list, int* rowtok) {
    const int p = blockIdx.x * 256 + threadIdx.x, t = p >> 8; int tok = 0;
    if (t < tbl[0]) { const int e = tbl[64 + t], pos = (t - tbl[1 + e]) * 256 + (p & 255); if (pos < (int)cnt[CNT_STRIDE * e]) tok = list[(size_t)e * LISTCAP + pos]; }
    rowtok[p] = tok;
}
__global__ void __launch_bounds__(256) k_combine(const bf16_t* X1, const bf16_t* Y, const float* mod, const int* tbl, const int* toke, const float* tokw, const int* tokp, const float* fg, float* out) {
    const int row = blockIdx.x * 4 + (threadIdx.x >> 6), lane = threadIdx.x & 63, b = row / SEQ;
    const int e0 = toke[2 * row], e1 = toke[2 * row + 1];
    const size_t q0 = (size_t)tbl[1 + e0] * 256 + tokp[2 * row], q1 = (size_t)tbl[1 + e1] * 256 + tokp[2 * row + 1];
    const float w0 = tokw[2 * row], w1 = tokw[2 * row + 1];
    const float* g2 = mod + b * 6144 + 5120;
    float v[16]; float ss = 0.f;
#pragma unroll
    for (int jj = 0; jj < 2; ++jj) { const int c0 = 512 * jj + 8 * lane;
        const u32x4 xr = *(const u32x4*)(X1 + (size_t)row * D + c0), ya = *(const u32x4*)(Y + q0 * D + c0), yb = *(const u32x4*)(Y + q1 * D + c0);
#pragma unroll
        for (int q = 0; q < 4; ++q) {
            const float x0 = bf2f(xr[q] & 0xffffu), x1 = bf2f(xr[q] >> 16);
            const float y0 = w0 * bf2f(ya[q] & 0xffffu) + w1 * bf2f(yb[q] & 0xffffu), y1 = w0 * bf2f(ya[q] >> 16) + w1 * bf2f(yb[q] >> 16);
            v[8 * jj + 2 * q] = x0 + g2[c0 + 2 * q] * y0; v[8 * jj + 2 * q + 1] = x1 + g2[c0 + 2 * q + 1] * y1; } }
#pragma unroll
    for (int q = 0; q < 16; ++q) ss += v[q] * v[q];
    const float rs = rsqrtf(wave_sum(ss) * (1.0f / D) + EPS);
#pragma unroll
    for (int jj = 0; jj < 2; ++jj) { const int c0 = 512 * jj + 8 * lane;
        f32x4 o0, o1;
#pragma unroll
        for (int q = 0; q < 4; ++q) { o0[q] = v[8 * jj + q] * rs * fg[c0 + q]; o1[q] = v[8 * jj + 4 + q] * rs * fg[c0 + 4 + q]; }
        *(f32x4*)(out + (size_t)row * D + c0) = o0; *(f32x4*)(out + (size_t)row * D + c0 + 4) = o1; }
}

namespace pg8 {
#define PG8_LAS __attribute__((address_space(3)))
constexpr int BM = 256, BK = 64, HALF = 128, HTB = HALF * BK * 2  , STAGE_BYTES = 8 * HTB, NXCD = 8, WGM = 8;
__host__ __device__ __forceinline__ int lds_byte(int r, int c) { const int st = (r >> 4) * 2 + (c >> 5), rr = r & 15, cc = c & 31, ob = rr * 64 + cc * 2; return st * 1024 + (ob ^ (((ob >> 9) & 1) << 5)); }
__host__ __device__ __forceinline__ void stage_rc(int b, int& R, int& C) { const int st = b / 1024, sb = b % 1024, swz = sb ^ (((sb >> 9) & 1) << 5); R = (st >> 1) * 16 + swz / 64; C = (st & 1) * 32 + (swz % 64) / 2; }
__host__ __device__ __forceinline__ int perm32(int rho) { const int n = rho >> 4, i = rho & 15; return 8 * (i >> 2) + 4 * n + (i & 3); }

struct Unit { int pm, pn, e; };
struct Gemm { const bf16_t* A; const bf16_t* Bt; int K; };

struct StaticOrder {
    int nM, nN, nwg, G, c; size_t tstep;
    __device__ void init(int M, int N, int K, int G_, int c_) { nM = M / BM; nN = N / BM; nwg = nM * nN; G = G_; c = c_; tstep = (size_t)BM * K * 2; }
    __device__ bool next(int i, Unit& u) const {
        const long L = (long)i * G + c; if (L >= nwg) return false;
        int wgid = (int)L; { const int q = nwg / NXCD, r = nwg % NXCD, xcd = wgid % NXCD, off = wgid / NXCD; wgid = (xcd < r ? xcd * (q + 1) : r * (q + 1) + (xcd - r) * q) + off; }
        const int nig = WGM * nN, gid = wgid / nig, fm = gid * WGM, gsz = (nM - fm) < WGM ? (nM - fm) : WGM;
        u.pm = fm + ((wgid % nig) % gsz); u.pn = (wgid % nig) / gsz; u.e = 0; return true;
    }
    __device__ __forceinline__ size_t a_off(const Unit& u) const { return (size_t)u.pm * tstep; }
    __device__ __forceinline__ size_t b_off(const Unit& u) const { return (size_t)u.pn * tstep; }
    __device__ __forceinline__ unsigned row_off(const Unit&, int) const { return 0u; }
};
struct MoeOrder {
    int nunits, G, c, K; size_t estride;
    const PG8_LAS int* tile_e; const PG8_LAS int* p0; const PG8_LAS int* cnt; const int* list; bool gather;
    __device__ bool next(int i, Unit& u) const {
        const int L = i * G + c; if (L >= nunits) return false;
        u.pm = L >> 2; u.pn = L & 3; u.e = tile_e[u.pm]; return true;
    }
    __device__ __forceinline__ size_t a_off(const Unit& u) const { return gather ? (size_t)0 : (size_t)u.pm * BM * K * 2; }
    __device__ __forceinline__ size_t b_off(const Unit& u) const { return (size_t)u.e * estride + (size_t)u.pn * BM * K * 2; }
    __device__ __forceinline__ unsigned row_off(const Unit& u, int r) const {
        const int pos = (u.pm - p0[u.e]) * 256 + r, last = cnt[u.e] - 1;
        const int tok = list[(size_t)u.e * LISTCAP + (pos < last ? pos : last)];
        return (unsigned)tok * (unsigned)(K * 2);
    }
};

__device__ __forceinline__ unsigned cvt_pk_bf16(float lo, float hi) { unsigned r; asm volatile("v_cvt_pk_bf16_f32 %0, %1, %2" : "=v"(r) : "v"(lo), "v"(hi)); return r; }
__device__ __forceinline__ float gelu_fast(float x) {
    const float u = -2.3022082f * (x + 0.044715f * x * x * x);
    return x * __builtin_amdgcn_rcpf(1.0f + __builtin_amdgcn_exp2f(u));
}
__device__ __forceinline__ float silu_fast(float x) { return x * __builtin_amdgcn_rcpf(1.0f + __builtin_amdgcn_exp2f(-1.4426950408889634f * x)); }

struct EpiZ { static constexpr bool PERM = true; bf16_t* Z;
    __device__ __forceinline__ void operator()(const f32x4 (&acc)[2][2][4][2], const Unit& u, int wr, int wc, int fr, int fq) const {
        const int row0 = u.pm * BM + wr * 64 + fr, col0 = u.pn * BM + wc * 32 + 8 * fq; const bool act = u.pn >= 2;
#pragma unroll
        for (int ai = 0; ai < 2; ++ai)
#pragma unroll
            for (int m = 0; m < 4; ++m) { bf16_t* rowp = Z + (size_t)(row0 + ai * HALF + m * 16) * 2048 + col0;
#pragma unroll
                for (int bj = 0; bj < 2; ++bj) { f32x4 v0 = acc[ai][bj][m][0], v1 = acc[ai][bj][m][1];
                    if (act) {
#pragma unroll
                        for (int q = 0; q < 4; ++q) { v0[q] = gelu_fast(v0[q]); v1[q] = gelu_fast(v1[q]); } }
                    u32x4 w; w.x = cvt_pk_bf16(v0[0], v0[1]); w.y = cvt_pk_bf16(v0[2], v0[3]); w.z = cvt_pk_bf16(v1[0], v1[1]); w.w = cvt_pk_bf16(v1[2], v1[3]);
                    *(u32x4*)(rowp + bj * HALF) = w; } }
    }
};
struct EpiX1 { static constexpr bool PERM = true; const float* x; const float* mod; bf16_t* X1;
    __device__ __forceinline__ void operator()(const f32x4 (&acc)[2][2][4][2], const Unit& u, int wr, int wc, int fr, int fq) const {
        const int row0 = u.pm * BM + wr * 64 + fr, col0 = u.pn * BM + wc * 32 + 8 * fq; const int b = (u.pm * BM) / SEQ;
        const float* g1 = mod + b * 6144 + 2048 + col0;
        f32x4 gv[2][2];
#pragma unroll
        for (int bj = 0; bj < 2; ++bj) { gv[bj][0] = *(const f32x4*)(g1 + bj * HALF); gv[bj][1] = *(const f32x4*)(g1 + bj * HALF + 4); }
#pragma unroll
        for (int ai = 0; ai < 2; ++ai)
#pragma unroll
            for (int m = 0; m < 4; ++m) { const size_t off = (size_t)(row0 + ai * HALF + m * 16) * D + col0;
#pragma unroll
                for (int bj = 0; bj < 2; ++bj) { const f32x4 x0 = *(const f32x4*)(x + off + bj * HALF), x1 = *(const f32x4*)(x + off + bj * HALF + 4);
                    const f32x4 v0 = x0 + gv[bj][0] * acc[ai][bj][m][0], v1 = x1 + gv[bj][1] * acc[ai][bj][m][1];
                    u32x4 w; w.x = cvt_pk_bf16(v0[0], v0[1]); w.y = cvt_pk_bf16(v0[2], v0[3]); w.z = cvt_pk_bf16(v1[0], v1[1]); w.w = cvt_pk_bf16(v1[2], v1[3]);
                    *(u32x4*)(X1 + off + bj * HALF) = w; } }
    }
};
struct EpiAct { static constexpr bool PERM = true; bf16_t* ACT;
    __device__ __forceinline__ void operator()(const f32x4 (&acc)[2][2][4][2], const Unit& u, int wr, int wc, int fr, int fq) const {
        const int row0 = u.pm * BM + wr * 64 + fr, col0 = u.pn * HALF + wc * 32 + 8 * fq;
#pragma unroll
        for (int ai = 0; ai < 2; ++ai)
#pragma unroll
            for (int m = 0; m < 4; ++m) { f32x4 v0, v1;
#pragma unroll
                for (int q = 0; q < 4; ++q) { v0[q] = silu_fast(acc[ai][0][m][0][q]) * acc[ai][1][m][0][q]; v1[q] = silu_fast(acc[ai][0][m][1][q]) * acc[ai][1][m][1][q]; }
                u32x4 w; w.x = cvt_pk_bf16(v0[0], v0[1]); w.y = cvt_pk_bf16(v0[2], v0[3]); w.z = cvt_pk_bf16(v1[0], v1[1]); w.w = cvt_pk_bf16(v1[2], v1[3]);
                *(u32x4*)(ACT + (size_t)(row0 + ai * HALF + m * 16) * DE + col0) = w; }
    }
};
struct EpiY { static constexpr bool PERM = true; bf16_t* Y;
    __device__ __forceinline__ void operator()(const f32x4 (&acc)[2][2][4][2], const Unit& u, int wr, int wc, int fr, int fq) const {
        const int row0 = u.pm * BM + wr * 64 + fr, col0 = u.pn * BM + wc * 32 + 8 * fq;
#pragma unroll
        for (int ai = 0; ai < 2; ++ai)
#pragma unroll
            for (int m = 0; m < 4; ++m) { bf16_t* rowp = Y + (size_t)(row0 + ai * HALF + m * 16) * D + col0;
#pragma unroll
                for (int bj = 0; bj < 2; ++bj) { const f32x4 v0 = acc[ai][bj][m][0], v1 = acc[ai][bj][m][1];
                    u32x4 w; w.x = cvt_pk_bf16(v0[0], v0[1]); w.y = cvt_pk_bf16(v0[2], v0[3]); w.z = cvt_pk_bf16(v1[0], v1[1]); w.w = cvt_pk_bf16(v1[2], v1[3]);
                    *(u32x4*)(rowp + bj * HALF) = w; } }
    }
};

template <class Epi, class Sched, bool ALIGN_EPI, bool GATHER>
__device__ __forceinline__ void gemm_phase(PG8_LAS unsigned char* lds, const Gemm g, const Sched& S, const Epi& E) {
    const int tid = threadIdx.x, wid = __builtin_amdgcn_readfirstlane(tid >> 6), lane = tid & 63, wr = wid >> 2, wc = wid & 3, fr = lane & 15, fq = lane >> 4;
    const int K = g.K, nt = K / BK;
    unsigned voffA[2], voffB[2]; int Ra[2];
#pragma unroll
    for (int i = 0; i < 2; ++i) { int R, C; stage_rc(tid * 16 + i * 8192, R, C); const int Rb = Epi::PERM ? ((R & ~31) + perm32(R & 31)) : R;
        Ra[i] = R; voffA[i] = GATHER ? (unsigned)(C * 2) : (unsigned)(R * K + C) * 2u; voffB[i] = (unsigned)(Rb * K + C) * 2u; }
    const size_t kstep = (size_t)(BK * 2);
    const size_t hstep = (size_t)HALF * K * 2;
    const size_t hstepA = GATHER ? (size_t)0 : hstep;
    const unsigned ldsw = (unsigned)wid * 1024u;
    const int aoff = lds_byte(wr * 64 + fr, fq * 8), boff = lds_byte(wc * 32 + fr, fq * 8);
#define PG8_SA(b, h) (((b) * 2 + (h)) * HTB)
#define PG8_SB(b, h) ((4 + (b) * 2 + (h)) * HTB)
#define PG8_STAGE(bufoff, gbase, voff) do { _Pragma("unroll") for (int _i = 0; _i < 2; ++_i) \
        __builtin_amdgcn_global_load_lds((const unsigned*)((const char*)(gbase) + (voff)[_i]), (PG8_LAS unsigned*)(lds + (bufoff) + ldsw + _i * 8192), 16, 0, 0); } while (0)
#define PG8_STAGE_A(bufoff, kbase, h, GO) do { _Pragma("unroll") for (int _i = 0; _i < 2; ++_i) \
        __builtin_amdgcn_global_load_lds((const unsigned*)((const char*)(kbase) + (size_t)(h) * hstepA + (GATHER ? (GO)[h][_i] : 0u) + voffA[_i]), (PG8_LAS unsigned*)(lds + (bufoff) + ldsw + _i * 8192), 16, 0, 0); } while (0)
#define PG8_LDA(dst, b, h) do { _Pragma("unroll") for (int m = 0; m < 4; ++m) _Pragma("unroll") for (int k = 0; k < 2; ++k) dst[m][k] = *(const PG8_LAS bf16x8*)(lds + PG8_SA(b, h) + aoff + m * 2048 + k * 1024); } while (0)
#define PG8_LDB(dst, b, h) do { _Pragma("unroll") for (int n = 0; n < 2; ++n) _Pragma("unroll") for (int k = 0; k < 2; ++k) dst[n][k] = *(const PG8_LAS bf16x8*)(lds + PG8_SB(b, h) + boff + n * 2048 + k * 1024); } while (0)
#define PG8_MMA(ai, bj, At, Bt) do { __builtin_amdgcn_s_setprio(1); _Pragma("unroll") for (int m = 0; m < 4; ++m) _Pragma("unroll") for (int n = 0; n < 2; ++n) _Pragma("unroll") for (int k = 0; k < 2; ++k) \
        acc[ai][bj][m][n] = __builtin_amdgcn_mfma_f32_16x16x32_bf16(Bt[n][k], At[m][k], acc[ai][bj][m][n], 0, 0, 0); __builtin_amdgcn_s_setprio(0); } while (0)
#define PG8_WAIT_V(n) asm volatile("s_waitcnt vmcnt(" #n ")" ::: "memory")
#define PG8_WAIT_L(n) asm volatile("s_waitcnt lgkmcnt(" #n ")" ::: "memory")
#define PG8_BAR __builtin_amdgcn_s_barrier()
#define PG8_SCHED __builtin_amdgcn_sched_barrier(0)
    Unit cur, nxt; int ui = 0;
    if (!S.next(0, cur)) return;
    f32x4 acc[2][2][4][2];
#pragma unroll
    for (int a = 0; a < 2; ++a)
#pragma unroll
        for (int b = 0; b < 2; ++b)
#pragma unroll
            for (int m = 0; m < 4; ++m)
#pragma unroll
                for (int n = 0; n < 2; ++n) acc[a][b][m][n] = (f32x4){0.f, 0.f, 0.f, 0.f};
    bf16x8 At[4][2], B0[2][2], B1[2][2];
    unsigned gC[2][2], gN[2][2];
#pragma unroll
    for (int h = 0; h < 2; ++h)
#pragma unroll
        for (int i = 0; i < 2; ++i) { gC[h][i] = GATHER ? S.row_off(cur, h * HALF + Ra[i]) : 0u; gN[h][i] = gC[h][i]; }
    const char* cA = (const char*)g.A + S.a_off(cur); const char* cB = (const char*)g.Bt + S.b_off(cur);
    PG8_STAGE(PG8_SB(0, 0), cB, voffB); PG8_STAGE(PG8_SB(0, 1), cB + hstep, voffB); PG8_STAGE_A(PG8_SA(0, 0), cA, 0, gC); PG8_STAGE_A(PG8_SA(0, 1), cA, 1, gC);
    if (wr == 1) PG8_BAR;
    PG8_WAIT_V(2); PG8_BAR;
    PG8_STAGE(PG8_SB(1, 0), cB + kstep, voffB); PG8_STAGE_A(PG8_SA(1, 0), cA + kstep, 0, gC); PG8_STAGE(PG8_SB(1, 1), cB + hstep + kstep, voffB);
    PG8_WAIT_V(6); PG8_BAR;
    for (;;) {
        const bool has_next = S.next(ui + 1, nxt);
        const char* nA = has_next ? (const char*)g.A + S.a_off(nxt) : cA; const char* nB = has_next ? (const char*)g.Bt + S.b_off(nxt) : cB;
        if (GATHER) {
#pragma unroll
            for (int h = 0; h < 2; ++h)
#pragma unroll
                for (int i = 0; i < 2; ++i) gN[h][i] = has_next ? S.row_off(nxt, h * HALF + Ra[i]) : gC[h][i];
        }
        for (int t = 0; t < nt; t += 2) {
            const bool last = (t == nt - 2);
            const char* a1 = cA + (size_t)(t + 1) * kstep;
            const char* a2 = last ? nA : cA + (size_t)(t + 2) * kstep; const char* b2 = last ? nB : cB + (size_t)(t + 2) * kstep;
            const char* a3 = a2 + kstep; const char* b3 = b2 + kstep;
            unsigned g2[2][2];
#pragma unroll
            for (int h = 0; h < 2; ++h)
#pragma unroll
                for (int i = 0; i < 2; ++i) g2[h][i] = last ? gN[h][i] : gC[h][i];
            PG8_LDB(B0, 0, 0); PG8_LDB(B1, 0, 1); PG8_SCHED; PG8_LDA(At, 0, 0); PG8_STAGE_A(PG8_SA(1, 1), a1, 1, gC);
            PG8_WAIT_V(8); PG8_WAIT_L(0); PG8_BAR; PG8_MMA(0, 0, At, B0); PG8_MMA(0, 1, At, B1); PG8_BAR; PG8_SCHED;
            PG8_LDA(At, 0, 1); PG8_STAGE(PG8_SB(0, 0), b2, voffB); PG8_STAGE(PG8_SB(0, 1), b2 + hstep, voffB); PG8_STAGE_A(PG8_SA(0, 0), a2, 0, g2);
            PG8_WAIT_V(8); PG8_WAIT_L(0); PG8_BAR; PG8_MMA(1, 0, At, B0); PG8_MMA(1, 1, At, B1); PG8_BAR; PG8_SCHED;
            PG8_LDB(B0, 1, 0); PG8_LDB(B1, 1, 1); PG8_SCHED; PG8_LDA(At, 1, 0); PG8_STAGE_A(PG8_SA(0, 1), a2, 1, g2);
            PG8_WAIT_V(8); PG8_WAIT_L(0); PG8_BAR; PG8_MMA(0, 0, At, B0); PG8_MMA(0, 1, At, B1); PG8_BAR; PG8_SCHED;
            PG8_LDA(At, 1, 1); PG8_STAGE(PG8_SB(1, 0), b3, voffB); PG8_STAGE(PG8_SB(1, 1), b3 + hstep, voffB); PG8_STAGE_A(PG8_SA(1, 0), a3, 0, g2);
            PG8_WAIT_V(8); PG8_WAIT_L(0); PG8_BAR; PG8_MMA(1, 0, At, B0); PG8_MMA(1, 1, At, B1); PG8_BAR; PG8_SCHED;
        }
        if constexpr (ALIGN_EPI) { if (wr == 0) PG8_BAR; }
        E(acc, cur, wr, wc, fr, fq);
        if (!has_next) break;
#pragma unroll
        for (int a = 0; a < 2; ++a)
#pragma unroll
            for (int b = 0; b < 2; ++b)
#pragma unroll
                for (int m = 0; m < 4; ++m)
#pragma unroll
                    for (int n = 0; n < 2; ++n) acc[a][b][m][n] = (f32x4){0.f, 0.f, 0.f, 0.f};
        cur = nxt; cA = nA; cB = nB; ++ui;
#pragma unroll
        for (int h = 0; h < 2; ++h)
#pragma unroll
            for (int i = 0; i < 2; ++i) gC[h][i] = gN[h][i];
        if constexpr (ALIGN_EPI) { if (wr == 1) PG8_BAR; }
    }
    PG8_WAIT_V(0);
    if constexpr (!ALIGN_EPI) { if (wr == 0) PG8_BAR; }
    PG8_BAR;
#undef PG8_SA
#undef PG8_SB
#undef PG8_STAGE
#undef PG8_STAGE_A
#undef PG8_LDA
#undef PG8_LDB
#undef PG8_MMA
#undef PG8_WAIT_V
#undef PG8_WAIT_L
#undef PG8_BAR
#undef PG8_SCHED
}
}
#define LAS __attribute__((address_space(3)))
#define GAS __attribute__((address_space(1)))
constexpr int NWAVES = 8, NTHREADS = 512;
constexpr int LDS_BYTES = 163840;
constexpr int SCR_BYTES = 147456;
constexpr int LDSCTL_OFF = SCR_BYTES;
constexpr int TAB_OFF = LDSCTL_OFF + 512;
constexpr int TAB_CNT = 0, TAB_P0 = 32, TAB_TE = 72;
#define LDS_WAIT() asm volatile("s_waitcnt lgkmcnt(0)" ::: "memory")
#define WAVE_SYNC() do { asm volatile("s_waitcnt lgkmcnt(0)" ::: "memory"); __builtin_amdgcn_wave_barrier(); } while (0)

struct Args {
    const float* in[27]; float* out; unsigned char* ws; int ph_lo, ph_hi;
};
struct Frame {
    LAS unsigned char* lds; LAS int* tab; unsigned* ctl; unsigned char* ws;
    int tid, lane, wave, G, bid, vcu;
};
enum Phase { PH_A = 0, PH_B, PH_C, PH_D, PH_E, PH_F, PH_G, PH_H, PH_I, PH_J, PH_N };

#define XB_TMO      128
#define XB_XCNT(j)  (256  + 64 * (j))
#define XB_XSUB(j)  (1280 + 64 * (j))
#define XB_XGEN(j)  (2304 + 64 * (j))
#define XB_TOP      3328
#define XB_TOPGEN   3392
#define XCD_BAR_WORDS 3456
#define XB_SPIN_CAP (1u << 18)
__device__ __forceinline__ unsigned xb_ld(unsigned* p)              { return __hip_atomic_load(p, __ATOMIC_RELAXED, __HIP_MEMORY_SCOPE_AGENT); }
__device__ __forceinline__ unsigned xb_add(unsigned* p, unsigned v) { return __hip_atomic_fetch_add(p, v, __ATOMIC_RELAXED, __HIP_MEMORY_SCOPE_AGENT); }
__device__ __forceinline__ unsigned xb_xcc_id() { return (unsigned)__builtin_amdgcn_s_getreg((3 << 11) | 20) & 0xFu; }
#define XB_SPIN(cond, bar) do { unsigned _sp = 0; while (cond) { __builtin_amdgcn_s_sleep(1); \
    if ((++_sp & 255u) == 0u) { if (xb_ld(&(bar)[XB_TMO])) break; if (_sp > XB_SPIN_CAP) { atomicAdd(&(bar)[XB_TMO], 1u); break; } } } } while (0)
struct XcdBarrier { unsigned* bar; unsigned x; volatile LAS unsigned* st; };
__device__ __forceinline__ XcdBarrier xcd_barrier_post(unsigned* bar, volatile LAS unsigned* st) {
    XcdBarrier b; b.bar = bar; b.x = xb_xcc_id(); b.st = st;
    if (threadIdx.x == 0) (void)xb_add(&bar[XB_XCNT(b.x)], 1u);
    return b;
}
__device__ __forceinline__ void xcd_barrier_complete(unsigned* bar, unsigned x, unsigned& nloc, unsigned& nx) {
    const unsigned G = gridDim.x * gridDim.y * gridDim.z;
    unsigned sum, cnt, mine, sp = 0u;
    for (;;) {
        sum = 0u; cnt = 0u; mine = 0u;
#pragma unroll
        for (unsigned j = 0; j < 16; ++j) { const unsigned c = xb_ld(&bar[XB_XCNT(j)]); sum += c; cnt += (c > 0u) ? 1u : 0u; mine = (j == x) ? c : mine; }
        if (sum == G) break;
        __builtin_amdgcn_s_sleep(1);
        if ((++sp & 255u) == 0u) { if (xb_ld(&bar[XB_TMO])) break; if (sp > XB_SPIN_CAP) { atomicAdd(&bar[XB_TMO], 1u); break; } }
    }
    nloc = mine > 0u ? mine : 1u; nx = cnt > 0u ? cnt : 1u;
}
__device__ __forceinline__ void xcd_barrier(const XcdBarrier& b) {
    asm volatile("s_waitcnt vmcnt(0)" ::: "memory");
    __syncthreads();
    if (threadIdx.x == 0) {
        unsigned* bar = b.bar;
        __builtin_amdgcn_s_waitcnt(0);
        unsigned nloc = b.st[0], nx = b.st[1];
        if (nloc == 0u) { xcd_barrier_complete(bar, b.x, nloc, nx); b.st[0] = nloc; b.st[1] = nx; }
        const unsigned old = xb_add(&bar[XB_XSUB(b.x)], 1u);
        const unsigned gen = old / nloc;
        if (old + 1u == (gen + 1u) * nloc) {
            __builtin_amdgcn_fence(__ATOMIC_RELEASE, "agent");
            asm volatile("s_waitcnt vmcnt(0)" ::: "memory");
            const unsigned og = xb_add(&bar[XB_TOP], 1u);
            const unsigned tg = og / nx;
            if (og + 1u == (tg + 1u) * nx) xb_add(&bar[XB_TOPGEN], 1u);
            else XB_SPIN(xb_ld(&bar[XB_TOPGEN]) == tg, bar);
            __builtin_amdgcn_fence(__ATOMIC_ACQUIRE, "agent");
            xb_add(&bar[XB_XGEN(b.x)], 1u);
            asm volatile("s_waitcnt vmcnt(0)" ::: "memory");
        } else {
            XB_SPIN(xb_ld(&bar[XB_XGEN(b.x)]) == gen, bar);
            __builtin_amdgcn_fence(__ATOMIC_ACQUIRE, "agent");
            asm volatile("s_waitcnt vmcnt(0)" ::: "memory");
        }
    }
    __syncthreads();
}

__device__ __forceinline__ void build_moe_table(Frame& F) {
    __syncthreads();
    if (F.tid < 64) {
        const int c = F.tid < NE ? (int)__hip_atomic_load(F.ctl + CW_CNT + CNT_STRIDE * F.tid, __ATOMIC_RELAXED, __HIP_MEMORY_SCOPE_AGENT) : 0;
        const int nt = (c + 255) >> 8; int p = nt;
#pragma unroll
        for (int o = 1; o < 32; o <<= 1) { const int v = __shfl_up(p, o); if (F.lane >= o) p += v; }
        const int excl = p - nt;
        if (F.tid < NE) { F.tab[TAB_CNT + F.tid] = c; F.tab[TAB_P0 + F.tid] = excl; for (int j = 0; j < nt; ++j) F.tab[TAB_TE + excl + j] = F.tid; }
        if (F.tid == NE - 1) F.tab[TAB_P0 + NE] = p;
    }
    __syncthreads();
}

__device__ __forceinline__ void transpose_item(const float* W, int K, int N, bf16_t* WT, int blk, int rstride, int rbase, LAS float* scr, int item, int lane) {
    const int nblk = N / 32, kb = item / nblk, nb = item % nblk, k0 = 64 * kb, n0 = 32 * nb;
#pragma unroll 8
    for (int i = 0; i < 32; ++i) { const int kk = 2 * i + (lane >> 5); scr[kk * 33 + (lane & 31)] = W[(size_t)(k0 + kk) * N + n0 + (lane & 31)]; }
    LDS_WAIT(); asm volatile("" ::: "memory");
    const int c = lane & 7;
#pragma unroll
    for (int j = 0; j < 4; ++j) { const int nl = (lane >> 3) + 8 * j, n = n0 + nl; const LAS float* s = scr + (8 * c) * 33 + nl;
        u32x4 o; o.x = pk2(s[0 * 33], s[1 * 33]); o.y = pk2(s[2 * 33], s[3 * 33]); o.z = pk2(s[4 * 33], s[5 * 33]); o.w = pk2(s[6 * 33], s[7 * 33]);
        const int row = rbase + (n / blk) * rstride + (n % blk);
        *(u32x4*)(WT + (size_t)row * K + k0 + 8 * c) = o; }
    LDS_WAIT(); asm volatile("" ::: "memory");
}
__device__ __forceinline__ void phase_A(Frame& F, const Args& args) {
    unsigned char* ws = F.ws;
    const float* c = args.in[1]; const float* ada_w = args.in[2]; const float* ada_b = args.in[3];
    float* mod = (float*)(ws + OFF_MOD);
    for (int it = F.G - 1 - F.bid; it < 96; it += F.G) {
        LAS float* sc = (LAS float*)F.lds; LAS float* red = sc + 8192;
        for (int i = F.tid; i < 8192; i += NTHREADS) { const float v = c[i]; sc[(i & 1023) * 8 + (i >> 10)] = v / (1.0f + __expf(-v)); }
        __syncthreads();
        const int n = it * 64 + F.lane, k0 = F.wave * 128;
        float acc[8];
#pragma unroll
        for (int b = 0; b < 8; ++b) acc[b] = 0.f;
#pragma unroll 8
        for (int kk = 0; kk < 128; ++kk) { const float w = ada_w[(size_t)(k0 + kk) * 6144 + n];
            const f32x4 s0 = *(const LAS f32x4*)(sc + (k0 + kk) * 8), s1 = *(const LAS f32x4*)(sc + (k0 + kk) * 8 + 4);
#pragma unroll
            for (int b = 0; b < 4; ++b) { acc[b] += s0[b] * w; acc[4 + b] += s1[b] * w; } }
#pragma unroll
        for (int b = 0; b < 8; ++b) red[(F.wave * 8 + b) * 64 + F.lane] = acc[b];
        __syncthreads();
        { const int b = F.wave; float s = ada_b[n];
#pragma unroll
          for (int w = 0; w < 8; ++w) s += red[(w * 8 + b) * 64 + F.lane];
          mod[b * 6144 + n] = s; }
        __syncthreads();
    }
    {
        LAS float* scr = (LAS float*)(F.lds + F.wave * 8448);
        const int gw = F.vcu * NWAVES + F.wave, NGW = F.G * NWAVES;
        constexpr int I_IN = 1024, I_OUT = 512, I_EXP = 768 * NE, I_GATE = 32, NIT = I_IN + I_OUT + I_EXP + I_GATE;
        const float* w_in = args.in[5]; const float* w_out = args.in[17]; const float* ew1 = args.in[23]; const float* ew3 = args.in[24]; const float* ew2 = args.in[25];
        const float* gaw = args.in[8]; const float* giw = args.in[10];
        bf16_t* WIN = (bf16_t*)(ws + OFF_WIN); bf16_t* WOUT = (bf16_t*)(ws + OFF_WOUT); bf16_t* W13 = (bf16_t*)(ws + OFF_W13); bf16_t* W2 = (bf16_t*)(ws + OFF_W2); bf16_t* GATEW = (bf16_t*)(ws + OFF_GATEW);
        for (int it = gw; it < NIT; it += NGW) {
            int r = it;
            if (r < I_IN) { transpose_item(w_in, 1024, 2048, WIN, 2048, 0, 0, scr, r, F.lane); continue; } r -= I_IN;
            if (r < I_OUT) { transpose_item(w_out, 1024, 1024, WOUT, 1024, 0, 0, scr, r, F.lane); continue; } r -= I_OUT;
            if (r < I_EXP) { const int e = r / 768, q = r % 768;
                if (q < 256) transpose_item(ew1 + (size_t)e * 1024 * 512, 1024, 512, W13 + (size_t)e * 1024 * 1024, 128, 256, 0, scr, q, F.lane);
                else if (q < 512) transpose_item(ew3 + (size_t)e * 1024 * 512, 1024, 512, W13 + (size_t)e * 1024 * 1024, 128, 256, 128, scr, q - 256, F.lane);
                else transpose_item(ew2 + (size_t)e * 512 * 1024, 512, 1024, W2 + (size_t)e * 1024 * 512, 1024, 0, 0, scr, q - 512, F.lane);
                continue; } r -= I_EXP;
            { const int h = r >> 2, q = r & 3, gate = q >> 1;
              transpose_item((gate ? giw : gaw) + h * 4096, 64, 64, GATEW + h * 128 * 64, 64, 0, gate * 64, scr, q & 1, F.lane); }
        }
    }
    {
        const int gt = F.bid * NTHREADS + F.tid, NGT = F.G * NTHREADS;
        const float* sgu_w = args.in[15]; const float* rgw = args.in[19]; const float* rew = args.in[21]; const float* lam = args.in[12];
        bf16_t* SGUW = (bf16_t*)(ws + OFF_SGUW); bf16_t* ROUTW = (bf16_t*)(ws + OFF_ROUTW); float* N8SP = (float*)(ws + OFF_N8SP);
        for (int i = gt; i < 8 * 128 * 128; i += NGT) { const int ii = (i >> 7) & 127, j = i & 127; SGUW[i] = (bf16_t)(((j >> 6) <= (ii >> 6)) ? f2bf(sgu_w[i]) : 0u); }
        for (int i = gt; i < 48 * 1024; i += NGT) { const int n = i >> 10, k = i & 1023; const float v = n < 4 ? rgw[k * 4 + n] : (n < 36 ? rew[k * 32 + n - 4] : 0.f); ROUTW[i] = (bf16_t)f2bf(v); }
        for (int i = gt; i < 512; i += NGT) N8SP[i] = -8.0f * log1pf(expf(-lam[i]));
    }
}

__device__ __forceinline__ void phase_B(Frame& F, const Args& args) {
    const float* x = args.in[0]; const float* g = args.in[4]; const float* mod = (const float*)(F.ws + OFF_MOD); bf16_t* XN = (bf16_t*)(F.ws + OFF_XN);
    const int gw = F.bid * NWAVES + F.wave, NGW = F.G * NWAVES, lane = F.lane;
    for (int row = gw; row < T; row += NGW) {
        const int b = row / SEQ;
        const f32x4* xr = (const f32x4*)(x + (size_t)row * D);
        f32x4 v[4]; float ss = 0.f;
#pragma unroll
        for (int j = 0; j < 4; ++j) { v[j] = xr[lane + 64 * j]; ss += v[j][0] * v[j][0] + v[j][1] * v[j][1] + v[j][2] * v[j][2] + v[j][3] * v[j][3]; }
        ss = wave_sum(ss);
        const float rs = rsqrtf(ss * (1.0f / D) + EPS);
        const float* sh = mod + b * 6144; const float* sc = sh + 1024;
#pragma unroll
        for (int j = 0; j < 4; ++j) { const int col = 4 * (lane + 64 * j);
            const f32x4 gg = *(const f32x4*)(g + col), s1 = *(const f32x4*)(sc + col), s0 = *(const f32x4*)(sh + col);
            float h[4];
#pragma unroll
            for (int q = 0; q < 4; ++q) h[q] = v[j][q] * rs * gg[q] * (1.0f + s1[q]) + s0[q];
            u32x2 o; o.x = pk2(h[0], h[1]); o.y = pk2(h[2], h[3]);
            *(u32x2*)(XN + (size_t)row * D + col) = o; }
    }
}

#ifndef SGU_TR
#define SGU_TR 1
#endif
typedef short s16x4 __attribute__((ext_vector_type(4)));
typedef short v4i16_t __attribute__((ext_vector_type(4)));
constexpr int IMG_STRIDE = 1040;
__device__ __forceinline__ float bflo(unsigned w) { return __uint_as_float(w << 16); }
__device__ __forceinline__ float bfhi(unsigned w) { return __uint_as_float(w & 0xffff0000u); }
__device__ __forceinline__ void sgu_block(Frame& F, const Args& args, int blk) {
    const bf16_t* Z = (const bf16_t*)(F.ws + OFF_Z); bf16_t* YMIX = (bf16_t*)(F.ws + OFF_YMIX); const bf16_t* SGUW = (const bf16_t*)(F.ws + OFF_SGUW);
    const float* ln_g = args.in[13]; const float* ln_b = args.in[14]; const float* sgu_b = args.in[16];
    const int lane = F.lane, w = F.wave, fr = lane & 15, fq = lane >> 4; const size_t t0 = (size_t)blk * 128;
    {
        u32x4 raw[16];
#pragma unroll
        for (int r = 0; r < 16; ++r) raw[r] = *(const u32x4*)(Z + (t0 + w * 16 + r) * 2048 + 1536 + 8 * lane);
        const f32x4 g0 = *(const f32x4*)(ln_g + 8 * lane), g1 = *(const f32x4*)(ln_g + 8 * lane + 4), b0 = *(const f32x4*)(ln_b + 8 * lane), b1 = *(const f32x4*)(ln_b + 8 * lane + 4);
#pragma unroll
        for (int r = 0; r < 16; ++r) {
            float v[8];
#pragma unroll
            for (int q = 0; q < 4; ++q) { v[2 * q] = bflo(raw[r][q]); v[2 * q + 1] = bfhi(raw[r][q]); }
            float s = 0.f;
#pragma unroll
            for (int q = 0; q < 8; ++q) s += v[q];
            const float mu = wave_sum(s) * (1.0f / 512.0f);
            float s2 = 0.f;
#pragma unroll
            for (int q = 0; q < 8; ++q) { v[q] -= mu; s2 += v[q] * v[q]; }
            const float rstd = rsqrtf(wave_sum(s2) * (1.0f / 512.0f) + EPS);
            u32x4 o;
            o.x = pk2(v[0] * rstd * g0[0] + b0[0], v[1] * rstd * g0[1] + b0[1]); o.y = pk2(v[2] * rstd * g0[2] + b0[2], v[3] * rstd * g0[3] + b0[3]);
            o.z = pk2(v[4] * rstd * g1[0] + b1[0], v[5] * rstd * g1[1] + b1[1]); o.w = pk2(v[6] * rstd * g1[2] + b1[2], v[7] * rstd * g1[3] + b1[3]);
            *(LAS u32x4*)(F.lds + (w * 16 + r) * IMG_STRIDE + 16 * lane) = o;
        }
    }
    __syncthreads();
    {
        const int g = w;
        bf16x8 af[4][4];
#pragma unroll
        for (int kt = 0; kt < 4; ++kt)
#pragma unroll
            for (int ct = 0; ct < 4; ++ct) {
#if SGU_TR
                LAS unsigned char* p = F.lds + (32 * kt + 8 * fq + (fr >> 2)) * IMG_STRIDE + (g * 64 + 16 * (fr & 3) + 4 * ct) * 2;
                const s16x4 lo = __builtin_bit_cast(s16x4, __builtin_amdgcn_ds_read_tr16_b64_v4i16((LAS v4i16_t*)p));
                const s16x4 hi = __builtin_bit_cast(s16x4, __builtin_amdgcn_ds_read_tr16_b64_v4i16((LAS v4i16_t*)(p + 4 * IMG_STRIDE)));
                af[kt][ct] = (bf16x8){lo[0], lo[1], lo[2], lo[3], hi[0], hi[1], hi[2], hi[3]};
#else
                const LAS bf16_t* p = (const LAS bf16_t*)(F.lds + (32 * kt + 8 * fq) * IMG_STRIDE) + g * 64 + 16 * (fr >> 2) + 4 * ct + (fr & 3);
#pragma unroll
                for (int e = 0; e < 8; ++e) af[kt][ct][e] = (short)p[e * (IMG_STRIDE / 2)];
#endif
            }
#pragma unroll 1
        for (int it = 0; it < 8; ++it) {
            const int i0 = 16 * it;
            const bf16_t* wp = SGUW + ((size_t)(g * 128 + i0 + fr)) * 128 + 8 * fq;
            bf16x8 wf[4];
#pragma unroll
            for (int kt = 0; kt < 4; ++kt) wf[kt] = *(const bf16x8*)(wp + 32 * kt);
            f32x4 acc[4];
#pragma unroll
            for (int ct = 0; ct < 4; ++ct) acc[ct] = (f32x4){0.f, 0.f, 0.f, 0.f};
#pragma unroll
            for (int kt = 0; kt < 4; ++kt)
#pragma unroll
                for (int ct = 0; ct < 4; ++ct) acc[ct] = __builtin_amdgcn_mfma_f32_16x16x32_bf16(af[kt][ct], wf[kt], acc[ct], 0, 0, 0);
            const float bias = sgu_b[g * 128 + i0 + fr];
            const size_t t = t0 + i0 + fr;
            const u32x4 gu0 = *(const u32x4*)(Z + t * 2048 + 1024 + g * 64 + 16 * fq), gu1 = *(const u32x4*)(Z + t * 2048 + 1024 + g * 64 + 16 * fq + 8);
            u32x4 o0, o1;
            o0.x = pk2(bflo(gu0.x) * (acc[0][0] + bias), bfhi(gu0.x) * (acc[0][1] + bias)); o0.y = pk2(bflo(gu0.y) * (acc[0][2] + bias), bfhi(gu0.y) * (acc[0][3] + bias));
            o0.z = pk2(bflo(gu0.z) * (acc[1][0] + bias), bfhi(gu0.z) * (acc[1][1] + bias)); o0.w = pk2(bflo(gu0.w) * (acc[1][2] + bias), bfhi(gu0.w) * (acc[1][3] + bias));
            o1.x = pk2(bflo(gu1.x) * (acc[2][0] + bias), bfhi(gu1.x) * (acc[2][1] + bias)); o1.y = pk2(bflo(gu1.y) * (acc[2][2] + bias), bfhi(gu1.y) * (acc[2][3] + bias));
            o1.z = pk2(bflo(gu1.z) * (acc[3][0] + bias), bfhi(gu1.z) * (acc[3][1] + bias)); o1.w = pk2(bflo(gu1.w) * (acc[3][2] + bias), bfhi(gu1.w) * (acc[3][3] + bias));
            *(u32x4*)(YMIX + t * D + 512 + g * 64 + 16 * fq) = o0; *(u32x4*)(YMIX + t * D + 512 + g * 64 + 16 * fq + 8) = o1;
        }
    }
}

constexpr int XC_STRIDE = 144;
constexpr int AU_STRIDE = 68;
constexpr int LRU_WAVE_BYTES = 64 * XC_STRIDE + 2 * 16 * AU_STRIDE * 4;
__device__ __forceinline__ float sigm_fast(float x) { return __builtin_amdgcn_rcpf(1.0f + __builtin_amdgcn_exp2f(-1.4426950408889634f * x)); }
template <int PASS>
__device__ __forceinline__ void lru_block(Frame& F, const Args& args, int blk) {
    const bf16_t* Z = (const bf16_t*)(F.ws + OFF_Z); bf16_t* YMIX = (bf16_t*)(F.ws + OFF_YMIX); const bf16_t* GATEW = (const bf16_t*)(F.ws + OFF_GATEW);
    const float* N8SP = (const float*)(F.ws + OFF_N8SP); float* CA = (float*)(F.ws + OFF_CARRY); float* CH = CA + 256 * 512;
    const float* cw = args.in[6]; const float* cb = args.in[7]; const float* gab = args.in[9]; const float* gib = args.in[11];
    const int lane = F.lane, h = F.wave, fr = lane & 15, fq = lane >> 4, cg = lane & 7, run = lane >> 3; const size_t t0 = (size_t)blk * 128;
    LAS unsigned char* xcT = F.lds + h * LRU_WAVE_BYTES; LAS float* Abuf = (LAS float*)(xcT + 64 * XC_STRIDE); LAS float* Ubuf = Abuf + 16 * AU_STRIDE;
    bf16x8 gw[8][2];
#pragma unroll
    for (int et = 0; et < 8; ++et)
#pragma unroll
        for (int kt = 0; kt < 2; ++kt) gw[et][kt] = *(const bf16x8*)(GATEW + ((size_t)(h * 128 + 16 * et + fr)) * 64 + 32 * kt + 8 * fq);
    float cwv[4][8], cbv[8];
#pragma unroll
    for (int k = 0; k < 4; ++k) { const f32x4 a = *(const f32x4*)(cw + k * 512 + 64 * h + 8 * cg), b = *(const f32x4*)(cw + k * 512 + 64 * h + 8 * cg + 4);
#pragma unroll
        for (int q = 0; q < 4; ++q) { cwv[k][q] = a[q]; cwv[k][4 + q] = b[q]; } }
    { const f32x4 a = *(const f32x4*)(cb + 64 * h + 8 * cg), b = *(const f32x4*)(cb + 64 * h + 8 * cg + 4);
#pragma unroll
      for (int q = 0; q < 4; ++q) { cbv[q] = a[q]; cbv[4 + q] = b[q]; } }
    float hst = 0.f, pp = 1.f;
    if (PASS == 2) { const int b0 = blk & ~31, n = blk & 31;
        for (int k = 0; k < n; ++k) hst = CA[(size_t)(b0 + k) * 512 + 64 * h + lane] * hst + CH[(size_t)(b0 + k) * 512 + 64 * h + lane]; }
    const bool seq_start = (blk & 31) == 0;
#pragma unroll 1
    for (int hb = 0; hb < 2; ++hb) {
        const size_t tb = t0 + 64 * hb;
        {
            u32x4 xr[11];
#pragma unroll
            for (int j = 0; j < 11; ++j) { const int rel = 8 * run - 3 + j;
                const bool pad = (j < 3) && (rel < 0) && (hb == 0) && seq_start;
                const u32x4 v = *(const u32x4*)(Z + (size_t)((long)tb + (pad ? 0 : rel)) * 2048 + 64 * h + 8 * cg);
                xr[j] = pad ? (u32x4){0u, 0u, 0u, 0u} : v; }
#pragma unroll
            for (int s = 0; s < 8; ++s) { float o[8];
#pragma unroll
                for (int q = 0; q < 8; ++q) o[q] = cbv[q];
#pragma unroll
                for (int k = 0; k < 4; ++k) { const u32x4 r = xr[s + k];
#pragma unroll
                    for (int q = 0; q < 4; ++q) { o[2 * q] += cwv[k][2 * q] * bflo(r[q]); o[2 * q + 1] += cwv[k][2 * q + 1] * bfhi(r[q]); } }
                u32x4 pkd; pkd.x = pk2(o[0], o[1]); pkd.y = pk2(o[2], o[3]); pkd.z = pk2(o[4], o[5]); pkd.w = pk2(o[6], o[7]);
                *(LAS u32x4*)(xcT + (8 * run + s) * XC_STRIDE + 16 * cg) = pkd; }
        }
        WAVE_SYNC();
#pragma unroll 1
        for (int it = 0; it < 4; ++it) {
            bf16x8 xf[2];
#pragma unroll
            for (int kt = 0; kt < 2; ++kt) xf[kt] = *(const LAS bf16x8*)(xcT + (16 * it + fr) * XC_STRIDE + (32 * kt + 8 * fq) * 2);
            f32x4 acc[8];
#pragma unroll
            for (int et = 0; et < 4; ++et) { acc[et] = *(const f32x4*)(gab + 64 * h + 16 * et + 4 * fq); acc[4 + et] = *(const f32x4*)(gib + 64 * h + 16 * et + 4 * fq); }
#pragma unroll
            for (int et = 0; et < 8; ++et)
#pragma unroll
                for (int kt = 0; kt < 2; ++kt) acc[et] = __builtin_amdgcn_mfma_f32_16x16x32_bf16(gw[et][kt], xf[kt], acc[et], 0, 0, 0);
#pragma unroll
            for (int et = 0; et < 4; ++et) {
                const f32x4 sp = *(const f32x4*)(N8SP + 64 * h + 16 * et + 4 * fq);
                const u32x2 xw = *(const LAS u32x2*)(xcT + (16 * it + fr) * XC_STRIDE + (16 * et + 4 * fq) * 2);
                const float xv[4] = {bflo(xw.x), bfhi(xw.x), bflo(xw.y), bfhi(xw.y)};
                f32x4 av, uv;
#pragma unroll
                for (int r = 0; r < 4; ++r) {
                    const float rg = sigm_fast(acc[et][r]), ig = sigm_fast(acc[4 + et][r]);
                    const float la = rg * sp[r];
                    av[r] = __builtin_amdgcn_exp2f(1.4426950408889634f * la);
                    const float x2 = 2.0f * la;
                    const float om = -x2 * (1.0f + x2 * (0.5f + x2 * (0.16666667f + x2 * 0.041666668f)));
                    uv[r] = __builtin_amdgcn_sqrtf(om) * (ig * xv[r]);
                }
                *(LAS f32x4*)(Abuf + fr * AU_STRIDE + 16 * et + 4 * fq) = av; *(LAS f32x4*)(Ubuf + fr * AU_STRIDE + 16 * et + 4 * fq) = uv;
            }
            WAVE_SYNC();
            {
                float a[16], u[16];
#pragma unroll
                for (int tk = 0; tk < 16; ++tk) { a[tk] = Abuf[tk * AU_STRIDE + lane]; u[tk] = Ubuf[tk * AU_STRIDE + lane]; }
#pragma unroll
                for (int tk = 0; tk < 16; ++tk) { hst = a[tk] * hst + u[tk]; if (PASS == 1) pp *= a[tk]; else Ubuf[tk * AU_STRIDE + lane] = hst; }
            }
            if (PASS == 2) {
                WAVE_SYNC();
                const int tok = lane >> 2, cq = lane & 3; const size_t t = tb + 16 * it + tok;
                const u32x4 g0 = *(const u32x4*)(Z + t * 2048 + 512 + 64 * h + 16 * cq), g1 = *(const u32x4*)(Z + t * 2048 + 512 + 64 * h + 16 * cq + 8);
                const LAS float* hp = Ubuf + tok * AU_STRIDE + 16 * cq;
                const f32x4 h0 = *(const LAS f32x4*)(hp), h1 = *(const LAS f32x4*)(hp + 4), h2 = *(const LAS f32x4*)(hp + 8), h3 = *(const LAS f32x4*)(hp + 12);
                u32x4 o0, o1;
                o0.x = pk2(h0[0] * bflo(g0.x), h0[1] * bfhi(g0.x)); o0.y = pk2(h0[2] * bflo(g0.y), h0[3] * bfhi(g0.y));
                o0.z = pk2(h1[0] * bflo(g0.z), h1[1] * bfhi(g0.z)); o0.w = pk2(h1[2] * bflo(g0.w), h1[3] * bfhi(g0.w));
                o1.x = pk2(h2[0] * bflo(g1.x), h2[1] * bfhi(g1.x)); o1.y = pk2(h2[2] * bflo(g1.y), h2[3] * bfhi(g1.y));
                o1.z = pk2(h3[0] * bflo(g1.z), h3[1] * bfhi(g1.z)); o1.w = pk2(h3[2] * bflo(g1.w), h3[3] * bfhi(g1.w));
                *(u32x4*)(YMIX + t * D + 64 * h + 16 * cq) = o0; *(u32x4*)(YMIX + t * D + 64 * h + 16 * cq + 8) = o1;
            }
            WAVE_SYNC();
        }
    }
    if (PASS == 1) { CA[(size_t)blk * 512 + 64 * h + lane] = pp; CH[(size_t)blk * 512 + 64 * h + lane] = hst; }
}
constexpr int HT_STRIDE = 2064;
constexpr int RG_LOG_OFF = 64 * HT_STRIDE;
constexpr int RG_MISC_OFF = RG_LOG_OFF + 64 * 48 * 4;
__device__ __forceinline__ void phase_G(Frame& F, const Args& args) {
    const bf16_t* X1 = (const bf16_t*)(F.ws + OFF_X1); bf16_t* H2 = (bf16_t*)(F.ws + OFF_XN); const bf16_t* ROUTW = (const bf16_t*)(F.ws + OFF_ROUTW);
    const float* mod = (const float*)(F.ws + OFF_MOD); const float* g2w = args.in[18]; const float* bg = args.in[20]; const float* be = args.in[22];
    int* list = (int*)(F.ws + OFF_LIST); int* toke = (int*)(F.ws + OFF_TOKE); float* tokw = (float*)(F.ws + OFF_TOKW); int* tokp = (int*)(F.ws + OFF_TOKP);
    const int lane = F.lane, w = F.wave, fr = lane & 15, fq = lane >> 4;
    LAS float* LG = (LAS float*)(F.lds + RG_LOG_OFF); LAS int* hist = (LAS int*)(F.lds + RG_MISC_OFF); LAS int* base = hist + 32;
    for (int tile = F.bid; tile < T / 64; tile += F.G) {
        const int row0 = tile * 64, b = row0 / SEQ;
        const float* sh = mod + b * 6144 + 3072; const float* sc = sh + 1024;
        {
            u32x4 raw[8][2];
#pragma unroll
            for (int r = 0; r < 8; ++r)
#pragma unroll
                for (int jj = 0; jj < 2; ++jj) raw[r][jj] = *(const u32x4*)(X1 + (size_t)(row0 + 8 * w + r) * D + 512 * jj + 8 * lane);
            float gm[16], sv[16];
#pragma unroll
            for (int jj = 0; jj < 2; ++jj)
#pragma unroll
                for (int q = 0; q < 8; ++q) { const int c = 512 * jj + 8 * lane + q; gm[8 * jj + q] = g2w[c] * (1.0f + sc[c]); sv[8 * jj + q] = sh[c]; }
            if (F.tid < 32) hist[F.tid] = 0;
#pragma unroll
            for (int r = 0; r < 8; ++r) {
                float h[16]; float ss = 0.f;
#pragma unroll
                for (int jj = 0; jj < 2; ++jj)
#pragma unroll
                    for (int q = 0; q < 4; ++q) { h[8 * jj + 2 * q] = bflo(raw[r][jj][q]); h[8 * jj + 2 * q + 1] = bfhi(raw[r][jj][q]); }
#pragma unroll
                for (int q = 0; q < 16; ++q) ss += h[q] * h[q];
                const float rs = rsqrtf(wave_sum(ss) * (1.0f / D) + EPS);
#pragma unroll
                for (int jj = 0; jj < 2; ++jj) { u32x4 o;
#pragma unroll
                    for (int q = 0; q < 4; ++q) o[q] = pk2(h[8 * jj + 2 * q] * rs * gm[8 * jj + 2 * q] + sv[8 * jj + 2 * q], h[8 * jj + 2 * q + 1] * rs * gm[8 * jj + 2 * q + 1] + sv[8 * jj + 2 * q + 1]);
                    *(u32x4*)(H2 + (size_t)(row0 + 8 * w + r) * D + 512 * jj + 8 * lane) = o;
                    *(LAS u32x4*)(F.lds + (8 * w + r) * HT_STRIDE + (512 * jj + 8 * lane) * 2) = o; }
            }
        }
        __syncthreads();
        {
            const int rt = w & 3, kh = w >> 2;
            f32x4 acc[3];
#pragma unroll
            for (int ct = 0; ct < 3; ++ct) acc[ct] = (f32x4){0.f, 0.f, 0.f, 0.f};
#pragma unroll 4
            for (int kt = 0; kt < 16; ++kt) { const int k0 = 512 * kh + 32 * kt + 8 * fq;
                const bf16x8 hf = *(const LAS bf16x8*)(F.lds + (16 * rt + fr) * HT_STRIDE + k0 * 2);
#pragma unroll
                for (int ct = 0; ct < 3; ++ct) { const bf16x8 wf = *(const bf16x8*)(ROUTW + (size_t)(16 * ct + fr) * 1024 + k0);
                    acc[ct] = __builtin_amdgcn_mfma_f32_16x16x32_bf16(wf, hf, acc[ct], 0, 0, 0); } }
            if (kh == 1) {
#pragma unroll
                for (int ct = 0; ct < 3; ++ct) *(LAS f32x4*)(LG + (16 * rt + fr) * 48 + 16 * ct + 4 * fq) = acc[ct]; }
            __syncthreads();
            if (kh == 0) {
#pragma unroll
                for (int ct = 0; ct < 3; ++ct) { LAS f32x4* p = (LAS f32x4*)(LG + (16 * rt + fr) * 48 + 16 * ct + 4 * fq); *p = *p + acc[ct]; } }
            __syncthreads();
        }
        int e1 = 0, e2 = 0, l1 = 0, l2 = 0; float w1 = 0.f, w2 = 0.f;
        if (F.tid < 64) {
            const LAS float* L = LG + F.tid * 48;
            float gl[4], el[8];
#pragma unroll
            for (int j = 0; j < 4; ++j) gl[j] = L[j] + bg[j];
            int gs = 0; float gmax = gl[0];
#pragma unroll
            for (int j = 1; j < 4; ++j) if (gl[j] > gmax) { gmax = gl[j]; gs = j; }
#pragma unroll
            for (int j = 0; j < 8; ++j) el[j] = L[4 + gs * 8 + j] + be[gs * 8 + j];
            float gsum = 0.f;
#pragma unroll
            for (int j = 0; j < 4; ++j) gsum += __expf(gl[j] - gmax);
            const float pg = 1.0f / gsum;
            int i1 = 0; float m1 = el[0];
#pragma unroll
            for (int j = 1; j < 8; ++j) if (el[j] > m1) { m1 = el[j]; i1 = j; }
            int i2 = -1; float m2 = -INFINITY;
#pragma unroll
            for (int j = 0; j < 8; ++j) if (j != i1 && el[j] > m2) { m2 = el[j]; i2 = j; }
            const float r = __expf(m2 - m1);
            w1 = pg / (1.0f + r); w2 = pg * r / (1.0f + r); e1 = gs * 8 + i1; e2 = gs * 8 + i2;
            l1 = __hip_atomic_fetch_add(hist + e1, 1, __ATOMIC_RELAXED, __HIP_MEMORY_SCOPE_WORKGROUP);
            l2 = __hip_atomic_fetch_add(hist + e2, 1, __ATOMIC_RELAXED, __HIP_MEMORY_SCOPE_WORKGROUP);
        }
        __syncthreads();
        if (F.tid < 32) { const int n = hist[F.tid]; base[F.tid] = n ? (int)__hip_atomic_fetch_add(F.ctl + CW_CNT + CNT_STRIDE * F.tid, (unsigned)n, __ATOMIC_RELAXED, __HIP_MEMORY_SCOPE_AGENT) : 0; }
        __syncthreads();
        if (F.tid < 64) { const int row = row0 + F.tid, p1 = base[e1] + l1, p2 = base[e2] + l2;
            list[(size_t)e1 * LISTCAP + p1] = row; list[(size_t)e2 * LISTCAP + p2] = row;
            toke[2 * row] = e1; toke[2 * row + 1] = e2; tokw[2 * row] = w1; tokw[2 * row + 1] = w2; tokp[2 * row] = p1; tokp[2 * row + 1] = p2; }
        __syncthreads();
    }
}

__device__ __forceinline__ void phase_J(Frame& F, const Args& args) {
    const bf16_t* X1 = (const bf16_t*)(F.ws + OFF_X1); const bf16_t* Y = (const bf16_t*)(F.ws + OFF_Y); const float* mod = (const float*)(F.ws + OFF_MOD);
    const int* toke = (const int*)(F.ws + OFF_TOKE); const float* tokw = (const float*)(F.ws + OFF_TOKW); const int* tokp = (const int*)(F.ws + OFF_TOKP);
    const float* fg = args.in[26]; float* out = args.out;
    const int gw = F.bid * NWAVES + F.wave, NGW = F.G * NWAVES, lane = F.lane;
    for (int row = gw; row < T; row += NGW) {
        const int b = row / SEQ;
        const int e0 = toke[2 * row], e1 = toke[2 * row + 1];
        const size_t q0 = (size_t)F.tab[TAB_P0 + e0] * 256 + tokp[2 * row], q1 = (size_t)F.tab[TAB_P0 + e1] * 256 + tokp[2 * row + 1];
        const float w0 = tokw[2 * row], w1 = tokw[2 * row + 1];
        const float* g2 = mod + b * 6144 + 5120;
        float v[16]; float ss = 0.f;
#pragma unroll
        for (int jj = 0; jj < 2; ++jj) { const int c0 = 512 * jj + 8 * lane;
            const u32x4 xr = *(const u32x4*)(X1 + (size_t)row * D + c0), ya = *(const u32x4*)(Y + q0 * D + c0), yb = *(const u32x4*)(Y + q1 * D + c0);
            const f32x4 ga = *(const f32x4*)(g2 + c0), gb = *(const f32x4*)(g2 + c0 + 4);
#pragma unroll
            for (int q = 0; q < 4; ++q) {
                const float y0 = w0 * bflo(ya[q]) + w1 * bflo(yb[q]), y1 = w0 * bfhi(ya[q]) + w1 * bfhi(yb[q]);
                const float ge = q < 2 ? ga[2 * q] : gb[2 * q - 4], go = q < 2 ? ga[2 * q + 1] : gb[2 * q - 3];
                v[8 * jj + 2 * q] = bflo(xr[q]) + ge * y0; v[8 * jj + 2 * q + 1] = bfhi(xr[q]) + go * y1; } }
#pragma unroll
        for (int q = 0; q < 16; ++q) ss += v[q] * v[q];
        const float rs = rsqrtf(wave_sum(ss) * (1.0f / D) + EPS);
#pragma unroll
        for (int jj = 0; jj < 2; ++jj) { const int c0 = 512 * jj + 8 * lane;
            const f32x4 f0 = *(const f32x4*)(fg + c0), f1 = *(const f32x4*)(fg + c0 + 4);
            f32x4 o0, o1;
#pragma unroll
            for (int q = 0; q < 4; ++q) { o0[q] = v[8 * jj + q] * rs * f0[q]; o1[q] = v[8 * jj + 4 + q] * rs * f1[q]; }
            *(f32x4*)(out + (size_t)row * D + c0) = o0; *(f32x4*)(out + (size_t)row * D + c0 + 4) = o1; }
    }
}

__global__ void __launch_bounds__(NTHREADS, 2) mk(Args args) {
    extern __shared__ __attribute__((aligned(16))) unsigned char lds_raw[];
    Frame F;
    F.lds = (LAS unsigned char*)lds_raw; F.tab = (LAS int*)(F.lds + TAB_OFF);
    F.tid = threadIdx.x; F.lane = F.tid & 63; F.wave = __builtin_amdgcn_readfirstlane(F.tid >> 6);
    F.G = gridDim.x; F.bid = blockIdx.x; F.vcu = (F.G % 8 == 0) ? (F.bid % 8) * (F.G / 8) + F.bid / 8 : F.bid;
    F.ws = args.ws; F.ctl = (unsigned*)(args.ws + OFF_CTL);
    unsigned char* ws = args.ws;
    bf16_t* WIN = (bf16_t*)(ws + OFF_WIN); bf16_t* WOUT = (bf16_t*)(ws + OFF_WOUT); bf16_t* W13 = (bf16_t*)(ws + OFF_W13); bf16_t* W2 = (bf16_t*)(ws + OFF_W2);
    bf16_t* XN = (bf16_t*)(ws + OFF_XN); bf16_t* Z = (bf16_t*)(ws + OFF_Z); bf16_t* YMIX = (bf16_t*)(ws + OFF_YMIX); bf16_t* X1 = (bf16_t*)(ws + OFF_X1);
    bf16_t* ACT = (bf16_t*)(ws + OFF_ACT); bf16_t* Y = (bf16_t*)(ws + OFF_Y); bf16_t* H2 = XN;
    const float* mod = (const float*)(ws + OFF_MOD); const int* list = (const int*)(ws + OFF_LIST);
    const int lo = args.ph_lo, hi = args.ph_hi;
    for (int u = F.tid; u < (LDS_BYTES - LDSCTL_OFF) / 4; u += NTHREADS) ((LAS unsigned*)(F.lds + LDSCTL_OFF))[u] = 0u;
    __syncthreads();
    XcdBarrier bar; bar.bar = F.ctl + CW_BAR; bar.x = 0; bar.st = nullptr;
    if (hi - lo > 1) bar = xcd_barrier_post(F.ctl + CW_BAR, (volatile LAS unsigned*)(F.lds + LDSCTL_OFF) + 8);
#ifndef PHMASK
#define PHMASK 0x3ff
#endif
#define IN(k) (((PHMASK >> (k)) & 1) && lo <= (k) && (k) < hi)
#define SEAM(k) do { if (IN(k) && IN((k) + 1)) xcd_barrier(bar); } while (0)

    if (IN(PH_A)) phase_A(F, args);
    SEAM(PH_A);
    if (IN(PH_B)) phase_B(F, args);
    SEAM(PH_B);
    if (IN(PH_C)) {
        pg8::Gemm g{XN, WIN, 1024}; pg8::StaticOrder S; S.init(T, 2048, 1024, F.G, F.bid);
        pg8::EpiZ E{Z};
        pg8::gemm_phase<pg8::EpiZ, pg8::StaticOrder, true, false>(F.lds, g, S, E);
    }
    SEAM(PH_C);
    if (IN(PH_D)) { for (int blk = F.bid; blk < T / 128; blk += F.G) { __syncthreads(); sgu_block(F, args, blk); __syncthreads(); lru_block<1>(F, args, blk); } }
    SEAM(PH_D);
    if (IN(PH_E)) { for (int blk = F.bid; blk < T / 128; blk += F.G) { __syncthreads(); lru_block<2>(F, args, blk); } }
    SEAM(PH_E);
    if (IN(PH_F)) {
        __syncthreads();
        pg8::Gemm g{YMIX, WOUT, 1024}; pg8::StaticOrder S; S.init(T, 1024, 1024, F.G, F.bid);
        pg8::EpiX1 E{args.in[0], mod, X1};
        pg8::gemm_phase<pg8::EpiX1, pg8::StaticOrder, true, false>(F.lds, g, S, E);
    }
    SEAM(PH_F);
    if (IN(PH_G)) phase_G(F, args);
    SEAM(PH_G);
    if (IN(PH_H)) {
        build_moe_table(F);
        pg8::MoeOrder S; S.nunits = F.tab[TAB_P0 + NE] * 4; S.G = F.G; S.c = F.vcu; S.K = 1024; S.estride = (size_t)1024 * 1024 * 2;
        S.tile_e = F.tab + TAB_TE; S.p0 = F.tab + TAB_P0; S.cnt = F.tab + TAB_CNT; S.list = list; S.gather = true;
        pg8::Gemm g{H2, W13, 1024}; pg8::EpiAct E{ACT};
        pg8::gemm_phase<pg8::EpiAct, pg8::MoeOrder, true, true>(F.lds, g, S, E);
    }
    SEAM(PH_H);
    if (IN(PH_I)) {
        build_moe_table(F);
        pg8::MoeOrder S; S.nunits = F.tab[TAB_P0 + NE] * 4; S.G = F.G; S.c = F.vcu; S.K = 512; S.estride = (size_t)1024 * 512 * 2;
        S.tile_e = F.tab + TAB_TE; S.p0 = F.tab + TAB_P0; S.cnt = F.tab + TAB_CNT; S.list = list; S.gather = false;
        pg8::Gemm g{ACT, W2, 512}; pg8::EpiY E{Y};
        pg8::gemm_phase<pg8::EpiY, pg8::MoeOrder, true, false>(F.lds, g, S, E);
    }
    SEAM(PH_I);
    if (IN(PH_J)) { build_moe_table(F); phase_J(F, args); }
#undef IN
#undef SEAM
}
#ifndef FUSED
#define FUSED 1
#endif
extern "C" void kernel_launch(void* const* d_in, const int* in_sizes, int n_in, void* d_out, int out_size, void* d_ws, size_t ws_size, hipStream_t stream) {
    if (n_in != 27 || out_size != T * D || ws_size < WS_NEED) { fprintf(stderr, "kernel_launch: unexpected shapes (n_in %d out %d ws %zu)\n", n_in, out_size, ws_size); return; }
    static int grid = 0;
    if (grid == 0) {
        int dev = 0, cus = 0;
        if (hipGetDevice(&dev) != hipSuccess || hipDeviceGetAttribute(&cus, hipDeviceAttributeMultiprocessorCount, dev) != hipSuccess) { fprintf(stderr, "kernel_launch: device query failed\n"); grid = -1; return; }
        if (hipFuncSetAttribute((const void*)mk, hipFuncAttributeMaxDynamicSharedMemorySize, LDS_BYTES) != hipSuccess) { fprintf(stderr, "kernel_launch: hipFuncSetAttribute failed\n"); grid = -1; return; }
        int per_cu = 0;
        if (hipOccupancyMaxActiveBlocksPerMultiprocessor(&per_cu, (const void*)mk, NTHREADS, LDS_BYTES) != hipSuccess || per_cu < 1) fprintf(stderr, "kernel_launch: occupancy query says %d\n", per_cu);
        (void)hipGetLastError();
        grid = cus;
    }
    if (grid < 0) return;
    Args a{}; for (int i = 0; i < 27; ++i) a.in[i] = (const float*)d_in[i]; a.out = (float*)d_out; a.ws = (unsigned char*)d_ws;
#define MK(lo_, hi_) do { a.ph_lo = (lo_); a.ph_hi = (hi_); hipLaunchKernelGGL(mk, dim3(grid), dim3(NTHREADS), LDS_BYTES, stream, a); } while (0)
    (void)hipMemsetAsync((char*)d_ws + OFF_CTL, 0, CTL_BYTES, stream);
#if FUSED
    MK(0, PH_N);
#else
    for (int p = 0; p < PH_N; ++p) MK(p, p + 1);
#endif
}
```

```cpp
#include <hip/hip_runtime.h>
#include <cstdio>
#include <cstdint>

typedef unsigned short bf16_t;
typedef short bf16x8 __attribute__((ext_vector_type(8)));
typedef float f32x4 __attribute__((ext_vector_type(4)));
typedef unsigned u32x2 __attribute__((ext_vector_type(2)));
typedef unsigned u32x4 __attribute__((ext_vector_type(4)));

constexpr int T = 32768, D = 1024, SEQ = 4096, NB = 8;
constexpr int DL = 512;
constexpr int NE = 32, DE = 512;
constexpr int LISTCAP = 65536;
constexpr int MAXTILES = 288, MAXROWS = MAXTILES * 256;
constexpr float EPS = 1e-6f;

constexpr size_t MiB = 1u << 20;
constexpr size_t OFF_CTL = 0, CTL_BYTES = 1 * MiB;
constexpr size_t OFF_MOD = 1 * MiB;
constexpr size_t OFF_TBL = 1 * MiB + 256 * 1024;
constexpr size_t OFF_TOKE = 1 * MiB + 512 * 1024;
constexpr size_t OFF_TOKW = 1 * MiB + 768 * 1024;
constexpr size_t OFF_TOKP = 2 * MiB;
constexpr size_t OFF_N8SP = 1 * MiB + 256 * 1024 + 16384;
constexpr size_t OFF_GATEW = 2 * MiB + 256 * 1024;
constexpr size_t OFF_SGUW = 2 * MiB + 512 * 1024;
constexpr size_t OFF_ROUTW = 2 * MiB + 768 * 1024;
constexpr size_t OFF_CARRY = 3 * MiB;
constexpr size_t OFF_WIN = 4 * MiB;
constexpr size_t OFF_WOUT = 8 * MiB;
constexpr size_t OFF_W13 = 10 * MiB;
constexpr size_t OFF_W2 = 74 * MiB;
constexpr size_t OFF_XN = 106 * MiB;
constexpr size_t OFF_Z = 170 * MiB;
constexpr size_t OFF_YMIX = 298 * MiB;
constexpr size_t OFF_X1 = 362 * MiB;
constexpr size_t OFF_ACT = 426 * MiB;
constexpr size_t OFF_LIST = 498 * MiB;
constexpr size_t OFF_ROWTOK = 506 * MiB;
constexpr size_t OFF_Y = 170 * MiB;
constexpr size_t WS_NEED = 507 * MiB;
constexpr size_t OFF_VN = OFF_X1;
constexpr size_t OFF_XC = OFF_ACT;
constexpr int CW_BAR = 4096;
constexpr int CW_CNT = 8192, CNT_STRIDE = 64;

__device__ __forceinline__ unsigned f2bf(float f) { unsigned u = __float_as_uint(f); return (u + 0x7fffu + ((u >> 16) & 1u)) >> 16; }
__device__ __forceinline__ float bf2f(unsigned h) { return __uint_as_float(h << 16); }
__device__ __forceinline__ unsigned pk2(float lo, float hi) { return f2bf(lo) | (f2bf(hi) << 16); }
__device__ __forceinline__ float wave_sum(float v) {
#pragma unroll
    for (int o = 1; o < 64; o <<= 1) v += __shfl_xor(v, o);
    return v;
}
__device__ __forceinline__ float gelu_tanh(float x) {
    const float u = 1.5957691216057308f * (x + 0.044715f * x * x * x);
    return x / (1.0f + __expf(-u));
}
__device__ __forceinline__ float sigmoidf(float x) { return 1.0f / (1.0f + __expf(-x)); }

__global__ void __launch_bounds__(256) k_ada(const float* c, const float* ada_w, const float* ada_b, float* mod) {
    __shared__ float sc[8][1024];
    for (int i = threadIdx.x; i < 8192; i += 256) { const float v = c[i]; sc[i >> 10][i & 1023] = v / (1.0f + expf(-v)); }
    __syncthreads();
    const int n = blockIdx.x * 256 + threadIdx.x;
    float acc[8];
#pragma unroll
    for (int b = 0; b < 8; ++b) acc[b] = 0.f;
    for (int k = 0; k < 1024; ++k) {
        const float w = ada_w[(size_t)k * 6144 + n];
#pragma unroll
        for (int b = 0; b < 8; ++b) acc[b] += sc[b][k] * w;
    }
#pragma unroll
    for (int b = 0; b < 8; ++b) mod[b * 6144 + n] = acc[b] + ada_b[n];
}

__global__ void __launch_bounds__(256) k_transpose(const float* W, bf16_t* WT, int K, int N, int blk, int rstride, int rbase, size_t w_ms, size_t wt_ms) {
    __shared__ float tile[32][33];
    W += (size_t)blockIdx.z * w_ms; WT += (size_t)blockIdx.z * wt_ms;
    const int n0 = blockIdx.x * 32, k0 = blockIdx.y * 32, tx = threadIdx.x & 31, ty = threadIdx.x >> 5;
    for (int j = ty; j < 32; j += 8) tile[j][tx] = W[(size_t)(k0 + j) * N + n0 + tx];
    __syncthreads();
    for (int j = ty; j < 32; j += 8) { const int n = n0 + j; const int row = rbase + (n / blk) * rstride + (n % blk);
        WT[(size_t)row * K + k0 + tx] = (bf16_t)f2bf(tile[tx][j]); }
}

__global__ void __launch_bounds__(256) k_xn(const float* x, const float* g, const float* mod, bf16_t* XN) {
    const int row = blockIdx.x * 4 + (threadIdx.x >> 6), lane = threadIdx.x & 63, b = row / SEQ;
    const f32x4* xr = (const f32x4*)(x + (size_t)row * D);
    f32x4 v[4]; float ss = 0.f;
#pragma unroll
    for (int j = 0; j < 4; ++j) { v[j] = xr[lane + 64 * j]; ss += v[j][0] * v[j][0] + v[j][1] * v[j][1] + v[j][2] * v[j][2] + v[j][3] * v[j][3]; }
    ss = wave_sum(ss);
    const float rs = rsqrtf(ss * (1.0f / D) + EPS);
    const float* sh = mod + b * 6144; const float* sc = sh + 1024;
#pragma unroll
    for (int j = 0; j < 4; ++j) { const int col = 4 * (lane + 64 * j);
        const f32x4 gg = *(const f32x4*)(g + col), s1 = *(const f32x4*)(sc + col), s0 = *(const f32x4*)(sh + col);
        float h[4];
#pragma unroll
        for (int q = 0; q < 4; ++q) h[q] = v[j][q] * rs * gg[q] * (1.0f + s1[q]) + s0[q];
        u32x2 o; o.x = pk2(h[0], h[1]); o.y = pk2(h[2], h[3]);
        *(u32x2*)(XN + (size_t)row * D + col) = o; }
}

template <bool DUAL, class Epi>
__device__ __forceinline__ void sg_tile(const bf16_t* A, const int* arow, const bf16_t* Bt, const bf16_t* Bt2, int K, int m0, int n0, int lane, const Epi& epi) {
    const int fr = lane & 15, fq = lane >> 4;
    const bf16_t* pa[2]; const bf16_t* pb[4]; const bf16_t* pb2[4];
#pragma unroll
    for (int mi = 0; mi < 2; ++mi) { const int r = m0 + mi * 16 + fr; const int rr = arow ? arow[r] : r; pa[mi] = A + (size_t)rr * K + 8 * fq; }
#pragma unroll
    for (int ni = 0; ni < 4; ++ni) { pb[ni] = Bt + (size_t)(n0 + ni * 16 + fr) * K + 8 * fq; pb2[ni] = DUAL ? Bt2 + (size_t)(n0 + ni * 16 + fr) * K + 8 * fq : nullptr; }
    f32x4 acc[2][4], acc2[2][4];
#pragma unroll
    for (int mi = 0; mi < 2; ++mi)
#pragma unroll
        for (int ni = 0; ni < 4; ++ni) { acc[mi][ni] = (f32x4){0.f, 0.f, 0.f, 0.f}; acc2[mi][ni] = (f32x4){0.f, 0.f, 0.f, 0.f}; }
    for (int k0 = 0; k0 < K; k0 += 32) {
        bf16x8 a[2], b[4], b2[4];
#pragma unroll
        for (int mi = 0; mi < 2; ++mi) a[mi] = *(const bf16x8*)(pa[mi] + k0);
#pragma unroll
        for (int ni = 0; ni < 4; ++ni) { b[ni] = *(const bf16x8*)(pb[ni] + k0); if (DUAL) b2[ni] = *(const bf16x8*)(pb2[ni] + k0); }
#pragma unroll
        for (int mi = 0; mi < 2; ++mi)
#pragma unroll
            for (int ni = 0; ni < 4; ++ni) {
                acc[mi][ni] = __builtin_amdgcn_mfma_f32_16x16x32_bf16(b[ni], a[mi], acc[mi][ni], 0, 0, 0);
                if (DUAL) acc2[mi][ni] = __builtin_amdgcn_mfma_f32_16x16x32_bf16(b2[ni], a[mi], acc2[mi][ni], 0, 0, 0);
            }
    }
#pragma unroll
    for (int mi = 0; mi < 2; ++mi)
#pragma unroll
        for (int ni = 0; ni < 4; ++ni) epi(m0 + mi * 16 + fr, n0 + ni * 16 + 4 * fq, acc[mi][ni], acc2[mi][ni]);
}

struct EpiInProj { bf16_t* Z;
    __device__ __forceinline__ void operator()(int row, int col, f32x4 v, f32x4) const {
        if (col >= 512) { v[0] = gelu_tanh(v[0]); v[1] = gelu_tanh(v[1]); v[2] = gelu_tanh(v[2]); v[3] = gelu_tanh(v[3]); }
        u32x2 o; o.x = pk2(v[0], v[1]); o.y = pk2(v[2], v[3]); *(u32x2*)(Z + (size_t)row * 2048 + col) = o; } };
struct EpiOutProj { const float* x; const float* mod; bf16_t* X1;
    __device__ __forceinline__ void operator()(int row, int col, f32x4 v, f32x4) const {
        const int b = row / SEQ; const f32x4 xv = *(const f32x4*)(x + (size_t)row * D + col), g1 = *(const f32x4*)(mod + b * 6144 + 2048 + col);
        u32x2 o; o.x = pk2(xv[0] + g1[0] * v[0], xv[1] + g1[1] * v[1]); o.y = pk2(xv[2] + g1[2] * v[2], xv[3] + g1[3] * v[3]);
        *(u32x2*)(X1 + (size_t)row * D + col) = o; } };
struct EpiMoe1 { bf16_t* ACT;
    __device__ __forceinline__ void operator()(int row, int col, f32x4 g, f32x4 u) const {
        float a[4];
#pragma unroll
        for (int q = 0; q < 4; ++q) a[q] = g[q] / (1.0f + __expf(-g[q])) * u[q];
        u32x2 o; o.x = pk2(a[0], a[1]); o.y = pk2(a[2], a[3]); *(u32x2*)(ACT + (size_t)row * DE + col) = o; } };
struct EpiMoe2 { bf16_t* Y;
    __device__ __forceinline__ void operator()(int row, int col, f32x4 v, f32x4) const {
        u32x2 o; o.x = pk2(v[0], v[1]); o.y = pk2(v[2], v[3]); *(u32x2*)(Y + (size_t)row * D + col) = o; } };

template <class Epi>
__global__ void __launch_bounds__(256) k_sgemm(const bf16_t* A, const bf16_t* Bt, int M, int N, int K, Epi epi) {
    const int w = blockIdx.x * 4 + (threadIdx.x >> 6), lane = threadIdx.x & 63, nN = N / 64;
    const int mt = w / nN, nt = w % nN; if (mt * 32 >= M) return;
    sg_tile<false>(A, nullptr, Bt, nullptr, K, mt * 32, nt * 64, lane, epi);
}
__global__ void __launch_bounds__(256) k_moe1(const bf16_t* H2, const int* rowtok, const int* tbl, const bf16_t* W13, EpiMoe1 epi) {
    const int w = blockIdx.x * 4 + (threadIdx.x >> 6), lane = threadIdx.x & 63;
    const int mt = w / 8, nt = w % 8, tile = mt / 8;
    if (tile >= tbl[0]) return;
    const int e = tbl[64 + tile], n0 = nt * 64, q = n0 / 128, i0 = n0 % 128;
    const bf16_t* Wg = W13 + (size_t)e * 1024 * 1024 + (size_t)(256 * q + i0) * 1024 - (size_t)n0 * 1024;
    sg_tile<true>(H2, rowtok, Wg, Wg + (size_t)128 * 1024, 1024, mt * 32, n0, lane, epi);
}
__global__ void __launch_bounds__(256) k_moe2(const bf16_t* ACT, const int* tbl, const bf16_t* W2, EpiMoe2 epi) {
    const int w = blockIdx.x * 4 + (threadIdx.x >> 6), lane = threadIdx.x & 63;
    const int mt = w / 16, nt = w % 16, tile = mt / 8;
    if (tile >= tbl[0]) return;
    const int e = tbl[64 + tile];
    sg_tile<false>(ACT, nullptr, W2 + (size_t)e * 1024 * 512, nullptr, 512, mt * 32, nt * 64, lane, epi);
}

__global__ void __launch_bounds__(256) k_lnv(const bf16_t* Z, const float* g, const float* bb, bf16_t* VN) {
    const int row = blockIdx.x * 4 + (threadIdx.x >> 6), lane = threadIdx.x & 63;
    const u32x4 raw = *(const u32x4*)(Z + (size_t)row * 2048 + 1536 + 8 * lane);
    float v[8];
#pragma unroll
    for (int q = 0; q < 4; ++q) { v[2 * q] = bf2f(raw[q] & 0xffffu); v[2 * q + 1] = bf2f(raw[q] >> 16); }
    float s = 0.f;
#pragma unroll
    for (int q = 0; q < 8; ++q) s += v[q];
    const float mu = wave_sum(s) * (1.0f / 512.0f);
    float s2 = 0.f;
#pragma unroll
    for (int q = 0; q < 8; ++q) { v[q] -= mu; s2 += v[q] * v[q]; }
    const float rstd = rsqrtf(wave_sum(s2) * (1.0f / 512.0f) + EPS);
    u32x4 o;
#pragma unroll
    for (int q = 0; q < 4; ++q) { const int c = 8 * lane + 2 * q; o[q] = pk2(v[2 * q] * rstd * g[c] + bb[c], v[2 * q + 1] * rstd * g[c + 1] + bb[c + 1]); }
    *(u32x4*)(VN + (size_t)row * 512 + 8 * lane) = o;
}
__global__ void __launch_bounds__(256) k_sgu(const bf16_t* Z, const bf16_t* VN, const float* sgu_w, const float* sgu_b, bf16_t* YMIX) {
    const int idx = blockIdx.x * 256 + threadIdx.x, t = idx >> 9, ch = idx & 511, i = t & 127, blk = t >> 7, g = ch >> 6;
    const int jmax = (i < 64) ? 64 : 128;
    float s = sgu_b[g * 128 + i];
    const float* wrow = sgu_w + ((size_t)g * 128 + i) * 128;
    for (int j = 0; j < jmax; ++j) s += wrow[j] * bf2f(VN[((size_t)blk * 128 + j) * 512 + ch]);
    YMIX[(size_t)t * D + 512 + ch] = (bf16_t)f2bf(bf2f(Z[(size_t)t * 2048 + 1024 + ch]) * s);
}
__global__ void __launch_bounds__(256) k_conv(const bf16_t* Z, const float* cw, const float* cb, float* XC) {
    const int idx = blockIdx.x * 256 + threadIdx.x, t = idx >> 9, ch = idx & 511, pos = t & (SEQ - 1);
    float acc = cb[ch];
#pragma unroll
    for (int k = 0; k < 4; ++k) { const int d = k - 3; if (pos + d >= 0) acc += cw[k * 512 + ch] * bf2f(Z[(size_t)(t + d) * 2048 + ch]); }
    XC[idx] = acc;
}
__global__ void __launch_bounds__(256) k_gates(const float* XC, const float* wa, const float* ba, const float* wi, const float* bi, const float* lam, float* A_, float* U_) {
    const int idx = blockIdx.x * 256 + threadIdx.x, t = idx >> 9, ch = idx & 511, h = ch >> 6, e = ch & 63;
    const float* xrow = XC + (size_t)t * 512 + h * 64;
    float ra = ba[ch], ri = bi[ch];
    for (int d = 0; d < 64; ++d) { const float xv = xrow[d]; ra += xv * wa[h * 4096 + d * 64 + e]; ri += xv * wi[h * 4096 + d * 64 + e]; }
    const float r = sigmoidf(ra), ig = sigmoidf(ri);
    const float sp = log1pf(expf(-lam[ch]));
    const float log_a = -8.0f * r * sp;
    A_[idx] = expf(log_a);
    U_[idx] = sqrtf(-expm1f(2.0f * log_a)) * (ig * XC[idx]);
}
__global__ void __launch_bounds__(64) k_scan(const float* A_, const float* U_, const bf16_t* Z, bf16_t* YMIX) {
    const int idx = blockIdx.x * 64 + threadIdx.x, b = idx >> 9, ch = idx & 511;
    float h = 0.f;
    for (int p0 = 0; p0 < SEQ; p0 += 8) {
        float a[8], u[8], g[8];
#pragma unroll
        for (int q = 0; q < 8; ++q) { const size_t t = (size_t)b * SEQ + p0 + q; a[q] = A_[t * 512 + ch]; u[q] = U_[t * 512 + ch]; g[q] = bf2f(Z[t * 2048 + 512 + ch]); }
#pragma unroll
        for (int q = 0; q < 8; ++q) { const size_t t = (size_t)b * SEQ + p0 + q; h = a[q] * h + u[q]; YMIX[t * D + ch] = (bf16_t)f2bf(h * g[q]); }
    }
}

__global__ void __launch_bounds__(256) k_router(const bf16_t* X1, const float* g2w, const float* mod, const float* wg, const float* bg, const float* we, const float* be,
                                                bf16_t* H2, unsigned* cnt, int* list, int* toke, float* tokw, int* tokp) {
    const int row = blockIdx.x * 4 + (threadIdx.x >> 6), lane = threadIdx.x & 63, b = row / SEQ;
    float h[16]; float ss = 0.f;
#pragma unroll
    for (int jj = 0; jj < 2; ++jj) { const u32x4 raw = *(const u32x4*)(X1 + (size_t)row * D + 512 * jj + 8 * lane);
#pragma unroll
        for (int q = 0; q < 4; ++q) { h[8 * jj + 2 * q] = bf2f(raw[q] & 0xffffu); h[8 * jj + 2 * q + 1] = bf2f(raw[q] >> 16); } }
#pragma unroll
    for (int q = 0; q < 16; ++q) ss += h[q] * h[q];
    const float rs = rsqrtf(wave_sum(ss) * (1.0f / D) + EPS);
    const float* sh = mod + b * 6144 + 3072; const float* sc = sh + 1024;
#pragma unroll
    for (int jj = 0; jj < 2; ++jj) { u32x4 o;
#pragma unroll
        for (int q = 0; q < 4; ++q) { const int c = 512 * jj + 8 * lane + 2 * q;
            const float h0 = h[8 * jj + 2 * q] * rs * g2w[c] * (1.0f + sc[c]) + sh[c], h1 = h[8 * jj + 2 * q + 1] * rs * g2w[c + 1] * (1.0f + sc[c + 1]) + sh[c + 1];
            o[q] = pk2(h0, h1); h[8 * jj + 2 * q] = bf2f(o[q] & 0xffffu); h[8 * jj + 2 * q + 1] = bf2f(o[q] >> 16); }
        *(u32x4*)(H2 + (size_t)row * D + 512 * jj + 8 * lane) = o; }
    float gl[4], el[8];
#pragma unroll
    for (int j = 0; j < 4; ++j) { float p = 0.f;
#pragma unroll
        for (int q = 0; q < 16; ++q) { const int k = 512 * (q >> 3) + 8 * lane + (q & 7); p += h[q] * wg[k * 4 + j]; }
        gl[j] = wave_sum(p) + bg[j]; }
    int gs = 0; float gmax = gl[0];
#pragma unroll
    for (int j = 1; j < 4; ++j) if (gl[j] > gmax) { gmax = gl[j]; gs = j; }
#pragma unroll
    for (int j = 0; j < 8; ++j) { float p = 0.f;
#pragma unroll
        for (int q = 0; q < 16; ++q) { const int k = 512 * (q >> 3) + 8 * lane + (q & 7); p += h[q] * we[k * 32 + gs * 8 + j]; }
        el[j] = wave_sum(p) + be[gs * 8 + j]; }
    if (lane == 0) {
        float gsum = 0.f;
#pragma unroll
        for (int j = 0; j < 4; ++j) gsum += expf(gl[j] - gmax);
        const float pg = 1.0f / gsum;
        int i1 = 0; float m1 = el[0];
#pragma unroll
        for (int j = 1; j < 8; ++j) if (el[j] > m1) { m1 = el[j]; i1 = j; }
        int i2 = -1; float m2 = -INFINITY;
#pragma unroll
        for (int j = 0; j < 8; ++j) if (j != i1 && el[j] > m2) { m2 = el[j]; i2 = j; }
        const float r = expf(m2 - m1);
        const float w1 = pg / (1.0f + r), w2 = pg * r / (1.0f + r);
        const int e1 = gs * 8 + i1, e2 = gs * 8 + i2;
        const unsigned p1 = atomicAdd(cnt + CNT_STRIDE * e1, 1u), p2 = atomicAdd(cnt + CNT_STRIDE * e2, 1u);
        list[(size_t)e1 * LISTCAP + p1] = row; list[(size_t)e2 * LISTCAP + p2] = row;
        toke[2 * row] = e1; toke[2 * row + 1] = e2; tokw[2 * row] = w1; tokw[2 * row + 1] = w2; tokp[2 * row] = (int)p1; tokp[2 * row + 1] = (int)p2;
    }
}
__global__ void k_table(const unsigned* cnt, int* tbl) {
    if (threadIdx.x == 0) { int p = 0;
        for (int e = 0; e < NE; ++e) { tbl[1 + e] = p; const int nt = ((int)cnt[CNT_STRIDE * e] + 255) / 256; for (int j = 0; j < nt; ++j) tbl[64 + p + j] = e; p += nt; }
        tbl[1 + NE] = p; tbl[0] = p; }
}
__global__ void __launch_bounds__(256) k_rowtok(const unsigned* cnt, const int* tbl, const int* list, int* rowtok) {
    const int p = blockIdx.x * 256 + threadIdx.x, t = p >> 8; int tok = 0;
    if (t < tbl[0]) { const int e = tbl[64 + t], pos = (t - tbl[1 + e]) * 256 + (p & 255); if (pos < (int)cnt[CNT_STRIDE * e]) tok = list[(size_t)e * LISTCAP + pos]; }
    rowtok[p] = tok;
}
__global__ void __launch_bounds__(256) k_combine(const bf16_t* X1, const bf16_t* Y, const float* mod, const int* tbl, const int* toke, const float* tokw, const int* tokp, const float* fg, float* out) {
    const int row = blockIdx.x * 4 + (threadIdx.x >> 6), lane = threadIdx.x & 63, b = row / SEQ;
    const int e0 = toke[2 * row], e1 = toke[2 * row + 1];
    const size_t q0 = (size_t)tbl[1 + e0] * 256 + tokp[2 * row], q1 = (size_t)tbl[1 + e1] * 256 + tokp[2 * row + 1];
    const float w0 = tokw[2 * row], w1 = tokw[2 * row + 1];
    const float* g2 = mod + b * 6144 + 5120;
    float v[16]; float ss = 0.f;
#pragma unroll
    for (int jj = 0; jj < 2; ++jj) { const int c0 = 512 * jj + 8 * lane;
        const u32x4 xr = *(const u32x4*)(X1 + (size_t)row * D + c0), ya = *(const u32x4*)(Y + q0 * D + c0), yb = *(const u32x4*)(Y + q1 * D + c0);
#pragma unroll
        for (int q = 0; q < 4; ++q) {
            const float x0 = bf2f(xr[q] & 0xffffu), x1 = bf2f(xr[q] >> 16);
            const float y0 = w0 * bf2f(ya[q] & 0xffffu) + w1 * bf2f(yb[q] & 0xffffu), y1 = w0 * bf2f(ya[q] >> 16) + w1 * bf2f(yb[q] >> 16);
            v[8 * jj + 2 * q] = x0 + g2[c0 + 2 * q] * y0; v[8 * jj + 2 * q + 1] = x1 + g2[c0 + 2 * q + 1] * y1; } }
#pragma unroll
    for (int q = 0; q < 16; ++q) ss += v[q] * v[q];
    const float rs = rsqrtf(wave_sum(ss) * (1.0f / D) + EPS);
#pragma unroll
    for (int jj = 0; jj < 2; ++jj) { const int c0 = 512 * jj + 8 * lane;
        f32x4 o0, o1;
#pragma unroll
        for (int q = 0; q < 4; ++q) { o0[q] = v[8 * jj + q] * rs * fg[c0 + q]; o1[q] = v[8 * jj + 4 + q] * rs * fg[c0 + 4 + q]; }
        *(f32x4*)(out + (size_t)row * D + c0) = o0; *(f32x4*)(out + (size_t)row * D + c0 + 4) = o1; }
}

namespace pg8 {
#define PG8_LAS __attribute__((address_space(3)))
constexpr int BM = 256, BK = 64, HALF = 128, HTB = HALF * BK * 2  , STAGE_BYTES = 8 * HTB, NXCD = 8, WGM = 8;
__host__ __device__ __forceinline__ int lds_byte(int r, int c) { const int st = (r >> 4) * 2 + (c >> 5), rr = r & 15, cc = c & 31, ob = rr * 64 + cc * 2; return st * 1024 + (ob ^ (((ob >> 9) & 1) << 5)); }
__host__ __device__ __forceinline__ void stage_rc(int b, int& R, int& C) { const int st = b / 1024, sb = b % 1024, swz = sb ^ (((sb >> 9) & 1) << 5); R = (st >> 1) * 16 + swz / 64; C = (st & 1) * 32 + (swz % 64) / 2; }
__host__ __device__ __forceinline__ int perm32(int rho) { const int n = rho >> 4, i = rho & 15; return 8 * (i >> 2) + 4 * n + (i & 3); }

struct Unit { int pm, pn, e; };
struct Gemm { const void* A; const void* Bt; int Kb; };
__host__ __device__ __forceinline__ int lds_byte8(int r, int piece) { return (r >> 4) * 2048 + piece * 256 + (r & 15) * 16; }
__host__ __device__ __forceinline__ void stage_rc8(int b, int& R, int& Cb) { R = (b / 2048) * 16 + (b % 256) / 16; Cb = ((b % 2048) / 256) * 16; }
typedef int v8i32 __attribute__((ext_vector_type(8)));
typedef int v4i32 __attribute__((ext_vector_type(4)));

struct StaticOrder {
    int nM, nN, nwg, G, c; size_t tstep;
    __device__ void init(int M, int N, int Kb, int G_, int c_) { nM = M / BM; nN = N / BM; nwg = nM * nN; G = G_; c = c_; tstep = (size_t)BM * Kb; }
    __device__ bool next(int i, Unit& u) const {
        const long L = (long)i * G + c; if (L >= nwg) return false;
        int wgid = (int)L; { const int q = nwg / NXCD, r = nwg % NXCD, xcd = wgid % NXCD, off = wgid / NXCD; wgid = (xcd < r ? xcd * (q + 1) : r * (q + 1) + (xcd - r) * q) + off; }
        const int nig = WGM * nN, gid = wgid / nig, fm = gid * WGM, gsz = (nM - fm) < WGM ? (nM - fm) : WGM;
        u.pm = fm + ((wgid % nig) % gsz); u.pn = (wgid % nig) / gsz; u.e = 0; return true;
    }
    __device__ __forceinline__ size_t a_off(const Unit& u) const { return (size_t)u.pm * tstep; }
    __device__ __forceinline__ size_t b_off(const Unit& u) const { return (size_t)u.pn * tstep; }
    PG8_LAS unsigned char* tokt;
    __device__ __forceinline__ const int* tok_src(const Unit&, int) const { return nullptr; }
};
struct MoeOrder {
    int nunits, G, c, Kb; size_t estride;
    const PG8_LAS int* tile_e; const PG8_LAS int* p0; const PG8_LAS int* cnt; const int* list; bool gather;
    __device__ bool next(int i, Unit& u) const {
        const int L = i * G + c; if (L >= nunits) return false;
        u.pm = L >> 2; u.pn = L & 3; u.e = tile_e[u.pm]; return true;
    }
    __device__ __forceinline__ size_t a_off(const Unit& u) const { return gather ? (size_t)0 : (size_t)u.pm * BM * Kb; }
    __device__ __forceinline__ size_t b_off(const Unit& u) const { return (size_t)u.e * estride + (size_t)u.pn * BM * Kb; }
    PG8_LAS unsigned char* tokt;
    __device__ __forceinline__ const int* tok_src(const Unit& u, int r) const {
        const int pos = (u.pm - p0[u.e]) * 256 + r, last = cnt[u.e] - 1;
        return list + (size_t)u.e * LISTCAP + (pos < last ? pos : last);
    }
};

__device__ __forceinline__ unsigned cvt_pk_bf16(float lo, float hi) { unsigned r; asm volatile("v_cvt_pk_bf16_f32 %0, %1, %2" : "=v"(r) : "v"(lo), "v"(hi)); return r; }
__device__ __forceinline__ float gelu_fast(float x) {
    const float u = -2.3022082f * (x + 0.044715f * x * x * x);
    return x * __builtin_amdgcn_rcpf(1.0f + __builtin_amdgcn_exp2f(u));
}
__device__ __forceinline__ float silu_fast(float x) { return x * __builtin_amdgcn_rcpf(1.0f + __builtin_amdgcn_exp2f(-1.4426950408889634f * x)); }

struct EpiZ { static constexpr bool PERM = true; bf16_t* Z;
    __device__ __forceinline__ void operator()(const f32x4 (&acc)[2][2][4][2], const Unit& u, int wr, int wc, int fr, int fq) const {
        const int row0 = u.pm * BM + wr * 64 + fr, col0 = u.pn * BM + wc * 32 + 8 * fq; const bool act = u.pn >= 2;
#pragma unroll
        for (int ai = 0; ai < 2; ++ai)
#pragma unroll
            for (int m = 0; m < 4; ++m) { bf16_t* rowp = Z + (size_t)(row0 + ai * HALF + m * 16) * 2048 + col0;
#pragma unroll
                for (int bj = 0; bj < 2; ++bj) { f32x4 v0 = acc[ai][bj][m][0], v1 = acc[ai][bj][m][1];
                    if (act) {
#pragma unroll
                        for (int q = 0; q < 4; ++q) { v0[q] = gelu_fast(v0[q]); v1[q] = gelu_fast(v1[q]); } }
                    u32x4 w; w.x = cvt_pk_bf16(v0[0], v0[1]); w.y = cvt_pk_bf16(v0[2], v0[3]); w.z = cvt_pk_bf16(v1[0], v1[1]); w.w = cvt_pk_bf16(v1[2], v1[3]);
                    *(u32x4*)(rowp + bj * HALF) = w; } }
    }
};
struct EpiX1 { static constexpr bool PERM = true; const float* x; const float* mod; bf16_t* X1;
    __device__ __forceinline__ void operator()(const f32x4 (&acc)[2][2][4][2], const Unit& u, int wr, int wc, int fr, int fq) const {
        const int row0 = u.pm * BM + wr * 64 + fr, col0 = u.pn * BM + wc * 32 + 8 * fq; const int b = (u.pm * BM) / SEQ;
        const float* g1 = mod + b * 6144 + 2048 + col0;
        f32x4 gv[2][2];
#pragma unroll
        for (int bj = 0; bj < 2; ++bj) { gv[bj][0] = *(const f32x4*)(g1 + bj * HALF); gv[bj][1] = *(const f32x4*)(g1 + bj * HALF + 4); }
#pragma unroll
        for (int ai = 0; ai < 2; ++ai)
#pragma unroll
            for (int m = 0; m < 4; ++m) { const size_t off = (size_t)(row0 + ai * HALF + m * 16) * D + col0;
#pragma unroll
                for (int bj = 0; bj < 2; ++bj) { const f32x4 x0 = *(const f32x4*)(x + off + bj * HALF), x1 = *(const f32x4*)(x + off + bj * HALF + 4);
                    const f32x4 v0 = x0 + gv[bj][0] * acc[ai][bj][m][0], v1 = x1 + gv[bj][1] * acc[ai][bj][m][1];
                    u32x4 w; w.x = cvt_pk_bf16(v0[0], v0[1]); w.y = cvt_pk_bf16(v0[2], v0[3]); w.z = cvt_pk_bf16(v1[0], v1[1]); w.w = cvt_pk_bf16(v1[2], v1[3]);
                    *(u32x4*)(X1 + off + bj * HALF) = w; } }
    }
};
struct EpiAct { static constexpr bool PERM = true; bf16_t* ACT;
    __device__ __forceinline__ void operator()(const f32x4 (&acc)[2][2][4][2], const Unit& u, int wr, int wc, int fr, int fq) const {
        const int row0 = u.pm * BM + wr * 64 + fr, col0 = u.pn * HALF + wc * 32 + 8 * fq;
#pragma unroll
        for (int ai = 0; ai < 2; ++ai)
#pragma unroll
            for (int m = 0; m < 4; ++m) { f32x4 v0, v1;
#pragma unroll
                for (int q = 0; q < 4; ++q) { v0[q] = silu_fast(acc[ai][0][m][0][q]) * acc[ai][1][m][0][q]; v1[q] = silu_fast(acc[ai][0][m][1][q]) * acc[ai][1][m][1][q]; }
                u32x4 w; w.x = cvt_pk_bf16(v0[0], v0[1]); w.y = cvt_pk_bf16(v0[2], v0[3]); w.z = cvt_pk_bf16(v1[0], v1[1]); w.w = cvt_pk_bf16(v1[2], v1[3]);
                *(u32x4*)(ACT + (size_t)(row0 + ai * HALF + m * 16) * DE + col0) = w; }
    }
};
__device__ __forceinline__ unsigned pk4_fp8(float a, float b, float c, float d) {
    a = __builtin_fminf(__builtin_fmaxf(a, -448.f), 448.f); b = __builtin_fminf(__builtin_fmaxf(b, -448.f), 448.f);
    c = __builtin_fminf(__builtin_fmaxf(c, -448.f), 448.f); d = __builtin_fminf(__builtin_fmaxf(d, -448.f), 448.f);
    unsigned w = 0u; w = __builtin_amdgcn_cvt_pk_fp8_f32(a, b, w, false); w = __builtin_amdgcn_cvt_pk_fp8_f32(c, d, w, true); return w; }
struct EpiAct8 { static constexpr bool PERM = true; unsigned char* ACT; float inv, oscale;
    __device__ __forceinline__ void operator()(const f32x4 (&acc)[2][2][4][2], const Unit& u, int wr, int wc, int fr, int fq) const {
        const int row0 = u.pm * BM + wr * 64 + fr, col0 = u.pn * HALF + wc * 32 + 8 * fq; const float io = inv * oscale;
#pragma unroll
        for (int ai = 0; ai < 2; ++ai)
#pragma unroll
            for (int m = 0; m < 4; ++m) { f32x4 v0, v1;
#pragma unroll
                for (int q = 0; q < 4; ++q) { v0[q] = silu_fast(acc[ai][0][m][0][q] * inv) * (acc[ai][1][m][0][q] * io); v1[q] = silu_fast(acc[ai][0][m][1][q] * inv) * (acc[ai][1][m][1][q] * io); }
                u32x2 w; w.x = pk4_fp8(v0[0], v0[1], v0[2], v0[3]); w.y = pk4_fp8(v1[0], v1[1], v1[2], v1[3]);
                *(u32x2*)(ACT + (size_t)(row0 + ai * HALF + m * 16) * DE + col0) = w; }
    }
};
struct EpiY8 { static constexpr bool PERM = true; bf16_t* Y; float inv;
    __device__ __forceinline__ void operator()(const f32x4 (&acc)[2][2][4][2], const Unit& u, int wr, int wc, int fr, int fq) const {
        const int row0 = u.pm * BM + wr * 64 + fr, col0 = u.pn * BM + wc * 32 + 8 * fq;
#pragma unroll
        for (int ai = 0; ai < 2; ++ai)
#pragma unroll
            for (int m = 0; m < 4; ++m) { bf16_t* rowp = Y + (size_t)(row0 + ai * HALF + m * 16) * D + col0;
#pragma unroll
                for (int bj = 0; bj < 2; ++bj) { const f32x4 v0 = acc[ai][bj][m][0] * inv, v1 = acc[ai][bj][m][1] * inv;
                    u32x4 w; w.x = cvt_pk_bf16(v0[0], v0[1]); w.y = cvt_pk_bf16(v0[2], v0[3]); w.z = cvt_pk_bf16(v1[0], v1[1]); w.w = cvt_pk_bf16(v1[2], v1[3]);
                    *(u32x4*)(rowp + bj * HALF) = w; } }
    }
};
struct EpiY { static constexpr bool PERM = true; bf16_t* Y;
    __device__ __forceinline__ void operator()(const f32x4 (&acc)[2][2][4][2], const Unit& u, int wr, int wc, int fr, int fq) const {
        const int row0 = u.pm * BM + wr * 64 + fr, col0 = u.pn * BM + wc * 32 + 8 * fq;
#pragma unroll
        for (int ai = 0; ai < 2; ++ai)
#pragma unroll
            for (int m = 0; m < 4; ++m) { bf16_t* rowp = Y + (size_t)(row0 + ai * HALF + m * 16) * D + col0;
#pragma unroll
                for (int bj = 0; bj < 2; ++bj) { const f32x4 v0 = acc[ai][bj][m][0], v1 = acc[ai][bj][m][1];
                    u32x4 w; w.x = cvt_pk_bf16(v0[0], v0[1]); w.y = cvt_pk_bf16(v0[2], v0[3]); w.z = cvt_pk_bf16(v1[0], v1[1]); w.w = cvt_pk_bf16(v1[2], v1[3]);
                    *(u32x4*)(rowp + bj * HALF) = w; } }
    }
};

template <class Epi, class Sched, bool ALIGN_EPI, bool GATHER, bool FP8>
__device__ __forceinline__ void gemm_phase(PG8_LAS unsigned char* lds, const Gemm g, const Sched& S, const Epi& E) {
    const int tid = threadIdx.x, wid = __builtin_amdgcn_readfirstlane(tid >> 6), lane = tid & 63, wr = wid >> 2, wc = wid & 3, fr = lane & 15, fq = lane >> 4;
    const int Kb = g.Kb, nt = Kb / (BK * 2);
    unsigned voffA[2], voffB[2]; int Ra[2];
#pragma unroll
    for (int i = 0; i < 2; ++i) { int R, Cb; if (FP8) stage_rc8(tid * 16 + i * 8192, R, Cb); else { stage_rc(tid * 16 + i * 8192, R, Cb); Cb *= 2; }
        const int Rb = Epi::PERM ? ((R & ~31) + perm32(R & 31)) : R;
        Ra[i] = R; voffA[i] = GATHER ? (unsigned)Cb : (unsigned)(R * Kb + Cb); voffB[i] = (unsigned)(Rb * Kb + Cb); }
    const size_t kstep = (size_t)(BK * 2);
    const size_t hstep = (size_t)HALF * Kb;
    const size_t hstepA = GATHER ? (size_t)0 : hstep;
    const unsigned ldsw = (unsigned)wid * 1024u;
    const int aoff = FP8 ? lds_byte8(wr * 64 + fr, 2 * fq) : lds_byte(wr * 64 + fr, fq * 8), boff = FP8 ? lds_byte8(wc * 32 + fr, 2 * fq) : lds_byte(wc * 32 + fr, fq * 8);
#define PG8_SA(b, h) (((b) * 2 + (h)) * HTB)
#define PG8_SB(b, h) ((4 + (b) * 2 + (h)) * HTB)
#define PG8_STAGE(bufoff, gbase, voff) do { _Pragma("unroll") for (int _i = 0; _i < 2; ++_i) \
        __builtin_amdgcn_global_load_lds((const unsigned*)((const char*)(gbase) + (voff)[_i]), (PG8_LAS unsigned*)(lds + (bufoff) + ldsw + _i * 8192), 16, 0, 0); } while (0)
#define PG8_STAGE_A(bufoff, kbase, h) do { _Pragma("unroll") for (int _i = 0; _i < 2; ++_i) \
        __builtin_amdgcn_global_load_lds((const unsigned*)((const char*)(kbase) + (size_t)(h) * hstepA + (GATHER ? gC[h][_i] : 0u) + voffA[_i]), (PG8_LAS unsigned*)(lds + (bufoff) + ldsw + _i * 8192), 16, 0, 0); } while (0)
#define PG8_LD16(off) (*(const PG8_LAS v4i32*)(lds + (off)))
#define PG8_LDA(dst, b, h) do { _Pragma("unroll") for (int m = 0; m < 4; ++m) { if constexpr (FP8) dst##8[m] = __builtin_shufflevector(PG8_LD16(PG8_SA(b, h) + aoff + m * 2048), PG8_LD16(PG8_SA(b, h) + aoff + m * 2048 + 256), 0, 1, 2, 3, 4, 5, 6, 7); \
        else { _Pragma("unroll") for (int k = 0; k < 2; ++k) dst[m][k] = *(const PG8_LAS bf16x8*)(lds + PG8_SA(b, h) + aoff + m * 2048 + k * 1024); } } } while (0)
#define PG8_LDB(dst, b, h) do { _Pragma("unroll") for (int n = 0; n < 2; ++n) { if constexpr (FP8) dst##8[n] = __builtin_shufflevector(PG8_LD16(PG8_SB(b, h) + boff + n * 2048), PG8_LD16(PG8_SB(b, h) + boff + n * 2048 + 256), 0, 1, 2, 3, 4, 5, 6, 7); \
        else { _Pragma("unroll") for (int k = 0; k < 2; ++k) dst[n][k] = *(const PG8_LAS bf16x8*)(lds + PG8_SB(b, h) + boff + n * 2048 + k * 1024); } } } while (0)
#define PG8_MMA(ai, bj, At, Bt) do { __builtin_amdgcn_s_setprio(1); _Pragma("unroll") for (int m = 0; m < 4; ++m) _Pragma("unroll") for (int n = 0; n < 2; ++n) { \
        if constexpr (FP8) asm volatile("v_mfma_f32_16x16x128_f8f6f4 %0, %1, %2, %0" : "+v"(acc[ai][bj][m][n]) : "v"(Bt##8[n]), "v"(At##8[m])); \
        else { _Pragma("unroll") for (int k = 0; k < 2; ++k) acc[ai][bj][m][n] = __builtin_amdgcn_mfma_f32_16x16x32_bf16(Bt[n][k], At[m][k], acc[ai][bj][m][n], 0, 0, 0); } } \
        __builtin_amdgcn_s_setprio(0); } while (0)
#define PG8_WAIT_V(n) asm volatile("s_waitcnt vmcnt(" #n ")" ::: "memory")
#define PG8_WAIT_L(n) asm volatile("s_waitcnt lgkmcnt(" #n ")" ::: "memory")
#define PG8_BAR __builtin_amdgcn_s_barrier()
#define PG8_SCHED __builtin_amdgcn_sched_barrier(0)
    Unit cur, nxt; int ui = 0;
    if (!S.next(0, cur)) return;
    f32x4 acc[2][2][4][2];
#pragma unroll
    for (int a = 0; a < 2; ++a)
#pragma unroll
        for (int b = 0; b < 2; ++b)
#pragma unroll
            for (int m = 0; m < 4; ++m)
#pragma unroll
                for (int n = 0; n < 2; ++n) acc[a][b][m][n] = (f32x4){0.f, 0.f, 0.f, 0.f};
    bf16x8 At[4][2], B0[2][2], B1[2][2]; v8i32 At8[4], B08[2], B18[2];
#define PG8_TOK_ISSUE(u_, slot_) do { if (wid < 4) __builtin_amdgcn_global_load_lds((const unsigned*)S.tok_src(u_, tid), (PG8_LAS unsigned*)(S.tokt + (slot_) * 1024 + wid * 256), 4, 0, 0); } while (0)
#define PG8_TOK_READ(slot_) do { _Pragma("unroll") for (int h = 0; h < 2; ++h) _Pragma("unroll") for (int i = 0; i < 2; ++i) \
        gC[h][i] = *(const PG8_LAS unsigned*)(S.tokt + (slot_) * 1024 + (h * HALF + Ra[i]) * 4) * (unsigned)Kb; } while (0)
    unsigned gC[2][2];
#pragma unroll
    for (int h = 0; h < 2; ++h)
#pragma unroll
        for (int i = 0; i < 2; ++i) gC[h][i] = 0u;
    if constexpr (GATHER) { PG8_TOK_ISSUE(cur, 0); PG8_WAIT_V(0); PG8_BAR; PG8_TOK_READ(0); }
    const char* cA = (const char*)g.A + S.a_off(cur); const char* cB = (const char*)g.Bt + S.b_off(cur);
    PG8_STAGE(PG8_SB(0, 0), cB, voffB); PG8_STAGE(PG8_SB(0, 1), cB + hstep, voffB); PG8_STAGE_A(PG8_SA(0, 0), cA, 0); PG8_STAGE_A(PG8_SA(0, 1), cA, 1);
    if (wr == 1) PG8_BAR;
    PG8_WAIT_V(2); PG8_BAR;
    PG8_STAGE(PG8_SB(1, 0), cB + kstep, voffB); PG8_STAGE_A(PG8_SA(1, 0), cA + kstep, 0); PG8_STAGE(PG8_SB(1, 1), cB + hstep + kstep, voffB);
    PG8_WAIT_V(6); PG8_BAR;
    for (;;) {
        const bool has_next = S.next(ui + 1, nxt);
        const char* nA = has_next ? (const char*)g.A + S.a_off(nxt) : cA; const char* nB = has_next ? (const char*)g.Bt + S.b_off(nxt) : cB;
        if constexpr (GATHER) { if (has_next) PG8_TOK_ISSUE(nxt, (ui + 1) & 1); }
#pragma unroll 1
        for (int t = 0; t < nt; t += 2) {
            const bool last = (t == nt - 2);
            const char* a1 = cA + (size_t)(t + 1) * kstep;
            const char* a2 = last ? nA : cA + (size_t)(t + 2) * kstep; const char* b2 = last ? nB : cB + (size_t)(t + 2) * kstep;
            const char* a3 = a2 + kstep; const char* b3 = b2 + kstep;
            PG8_LDB(B0, 0, 0); PG8_LDB(B1, 0, 1); PG8_SCHED; PG8_LDA(At, 0, 0); PG8_STAGE_A(PG8_SA(1, 1), a1, 1);
            PG8_WAIT_V(8); PG8_WAIT_L(0); PG8_BAR; PG8_MMA(0, 0, At, B0); PG8_MMA(0, 1, At, B1); PG8_BAR; PG8_SCHED;
            if constexpr (GATHER) { if (last && has_next) PG8_TOK_READ((ui + 1) & 1); }
            PG8_LDA(At, 0, 1); PG8_STAGE(PG8_SB(0, 0), b2, voffB); PG8_STAGE(PG8_SB(0, 1), b2 + hstep, voffB); PG8_STAGE_A(PG8_SA(0, 0), a2, 0);
            PG8_WAIT_V(8); PG8_WAIT_L(0); PG8_BAR; PG8_MMA(1, 0, At, B0); PG8_MMA(1, 1, At, B1); PG8_BAR; PG8_SCHED;
            PG8_LDB(B0, 1, 0); PG8_LDB(B1, 1, 1); PG8_SCHED; PG8_LDA(At, 1, 0); PG8_STAGE_A(PG8_SA(0, 1), a2, 1);
            PG8_WAIT_V(8); PG8_WAIT_L(0); PG8_BAR; PG8_MMA(0, 0, At, B0); PG8_MMA(0, 1, At, B1); PG8_BAR; PG8_SCHED;
            PG8_LDA(At, 1, 1); PG8_STAGE(PG8_SB(1, 0), b3, voffB); PG8_STAGE(PG8_SB(1, 1), b3 + hstep, voffB); PG8_STAGE_A(PG8_SA(1, 0), a3, 0);
            PG8_WAIT_V(8); PG8_WAIT_L(0); PG8_BAR; PG8_MMA(1, 0, At, B0); PG8_MMA(1, 1, At, B1); PG8_BAR; PG8_SCHED;
        }
        if constexpr (ALIGN_EPI) { if (wr == 0) PG8_BAR; }
        if constexpr (FP8) asm volatile("s_nop 15\n\ts_nop 15" ::: "memory");
        E(acc, cur, wr, wc, fr, fq);
        if (!has_next) break;
#pragma unroll
        for (int a = 0; a < 2; ++a)
#pragma unroll
            for (int b = 0; b < 2; ++b)
#pragma unroll
                for (int m = 0; m < 4; ++m)
#pragma unroll
                    for (int n = 0; n < 2; ++n) acc[a][b][m][n] = (f32x4){0.f, 0.f, 0.f, 0.f};
        cur = nxt; cA = nA; cB = nB; ++ui;
        if constexpr (ALIGN_EPI) { if (wr == 1) PG8_BAR; }
    }
    PG8_WAIT_V(0);
    if constexpr (!ALIGN_EPI) { if (wr == 0) PG8_BAR; }
    PG8_BAR;
#undef PG8_SA
#undef PG8_SB
#undef PG8_STAGE
#undef PG8_STAGE_A
#undef PG8_TOK_ISSUE
#undef PG8_TOK_READ
#undef PG8_LDA
#undef PG8_LDB
#undef PG8_MMA
#undef PG8_LD16
#undef PG8_WAIT_V
#undef PG8_WAIT_L
#undef PG8_BAR
#undef PG8_SCHED
}
}
#define LAS __attribute__((address_space(3)))
#define GAS __attribute__((address_space(1)))
constexpr int NWAVES = 8, NTHREADS = 512;
constexpr int LDS_BYTES = 163840;
constexpr int SCR_BYTES = 147456;
constexpr int LDSCTL_OFF = SCR_BYTES;
constexpr int TAB_OFF = LDSCTL_OFF + 512;
constexpr int TAB_CNT = 0, TAB_P0 = 32, TAB_TE = 72;
constexpr int TOKT_OFF = TAB_OFF + 2048;
#define LDS_WAIT() asm volatile("s_waitcnt lgkmcnt(0)" ::: "memory")
#define WAVE_SYNC() do { asm volatile("s_waitcnt lgkmcnt(0)" ::: "memory"); __builtin_amdgcn_wave_barrier(); } while (0)

#ifndef MOE_FP8
#define MOE_FP8 1
#endif
constexpr float W13_SCALE = 32.f, W2_SCALE = 16.f, ACT_SCALE = 4.f;
struct Args {
    const float* in[27]; float* out; unsigned char* ws; int ph_lo, ph_hi;
};
struct Frame {
    LAS unsigned char* lds; LAS int* tab; unsigned* ctl; unsigned char* ws;
    int tid, lane, wave, G, bid, vcu;
};
enum Phase { PH_A = 0, PH_B, PH_C, PH_D, PH_E, PH_F, PH_G, PH_H, PH_I, PH_J, PH_N };

#define XB_TMO      128
#define XB_XCNT(j)  (256  + 64 * (j))
#define XB_XSUB(j)  (1280 + 64 * (j))
#define XB_XGEN(j)  (2304 + 64 * (j))
#define XB_TOP      3328
#define XB_TOPGEN   3392
#define XCD_BAR_WORDS 3456
#define XB_SPIN_CAP (1u << 18)
__device__ __forceinline__ unsigned xb_ld(unsigned* p)              { return __hip_atomic_load(p, __ATOMIC_RELAXED, __HIP_MEMORY_SCOPE_AGENT); }
__device__ __forceinline__ unsigned xb_add(unsigned* p, unsigned v) { return __hip_atomic_fetch_add(p, v, __ATOMIC_RELAXED, __HIP_MEMORY_SCOPE_AGENT); }
__device__ __forceinline__ unsigned xb_xcc_id() { return (unsigned)__builtin_amdgcn_s_getreg((3 << 11) | 20) & 0xFu; }
#define XB_SPIN(cond, bar) do { unsigned _sp = 0; while (cond) { __builtin_amdgcn_s_sleep(1); \
    if ((++_sp & 255u) == 0u) { if (xb_ld(&(bar)[XB_TMO])) break; if (_sp > XB_SPIN_CAP) { atomicAdd(&(bar)[XB_TMO], 1u); break; } } } } while (0)
struct XcdBarrier { unsigned* bar; unsigned x; volatile LAS unsigned* st; };
__device__ __forceinline__ XcdBarrier xcd_barrier_post(unsigned* bar, volatile LAS unsigned* st) {
    XcdBarrier b; b.bar = bar; b.x = xb_xcc_id(); b.st = st;
    if (threadIdx.x == 0) (void)xb_add(&bar[XB_XCNT(b.x)], 1u);
    return b;
}
__device__ __forceinline__ void xcd_barrier_complete(unsigned* bar, unsigned x, unsigned& nloc, unsigned& nx) {
    const unsigned G = gridDim.x * gridDim.y * gridDim.z;
    unsigned sum, cnt, mine, sp = 0u;
    for (;;) {
        sum = 0u; cnt = 0u; mine = 0u;
#pragma unroll
        for (unsigned j = 0; j < 16; ++j) { const unsigned c = xb_ld(&bar[XB_XCNT(j)]); sum += c; cnt += (c > 0u) ? 1u : 0u; mine = (j == x) ? c : mine; }
        if (sum == G) break;
        __builtin_amdgcn_s_sleep(1);
        if ((++sp & 255u) == 0u) { if (xb_ld(&bar[XB_TMO])) break; if (sp > XB_SPIN_CAP) { atomicAdd(&bar[XB_TMO], 1u); break; } }
    }
    nloc = mine > 0u ? mine : 1u; nx = cnt > 0u ? cnt : 1u;
}
__device__ __forceinline__ void xcd_barrier(const XcdBarrier& b) {
    asm volatile("s_waitcnt vmcnt(0)" ::: "memory");
    __syncthreads();
    if (threadIdx.x == 0) {
        unsigned* bar = b.bar;
        __builtin_amdgcn_s_waitcnt(0);
        unsigned nloc = b.st[0], nx = b.st[1];
        if (nloc == 0u) { xcd_barrier_complete(bar, b.x, nloc, nx); b.st[0] = nloc; b.st[1] = nx; }
        const unsigned old = xb_add(&bar[XB_XSUB(b.x)], 1u);
        const unsigned gen = old / nloc;
        if (old + 1u == (gen + 1u) * nloc) {
            __builtin_amdgcn_fence(__ATOMIC_RELEASE, "agent");
            asm volatile("s_waitcnt vmcnt(0)" ::: "memory");
            const unsigned og = xb_add(&bar[XB_TOP], 1u);
            const unsigned tg = og / nx;
            if (og + 1u == (tg + 1u) * nx) xb_add(&bar[XB_TOPGEN], 1u);
            else XB_SPIN(xb_ld(&bar[XB_TOPGEN]) == tg, bar);
            __builtin_amdgcn_fence(__ATOMIC_ACQUIRE, "agent");
            xb_add(&bar[XB_XGEN(b.x)], 1u);
            asm volatile("s_waitcnt vmcnt(0)" ::: "memory");
        } else {
            XB_SPIN(xb_ld(&bar[XB_XGEN(b.x)]) == gen, bar);
            __builtin_amdgcn_fence(__ATOMIC_ACQUIRE, "agent");
            asm volatile("s_waitcnt vmcnt(0)" ::: "memory");
        }
    }
    __syncthreads();
}

__device__ __forceinline__ void build_moe_table(Frame& F) {
    __syncthreads();
    if (F.tid < 64) {
        const int c = F.tid < NE ? (int)__hip_atomic_load(F.ctl + CW_CNT + CNT_STRIDE * F.tid, __ATOMIC_RELAXED, __HIP_MEMORY_SCOPE_AGENT) : 0;
        const int nt = (c + 255) >> 8; int p = nt;
#pragma unroll
        for (int o = 1; o < 32; o <<= 1) { const int v = __shfl_up(p, o); if (F.lane >= o) p += v; }
        const int excl = p - nt;
        if (F.tid < NE) { F.tab[TAB_CNT + F.tid] = c; F.tab[TAB_P0 + F.tid] = excl; for (int j = 0; j < nt; ++j) F.tab[TAB_TE + excl + j] = F.tid; }
        if (F.tid == NE - 1) F.tab[TAB_P0 + NE] = p;
    }
    __syncthreads();
}

struct TItem { const float* W; unsigned char* WT; int N, K, blk, rstride, rbase, k0, n0, fp8; float scale; };
__device__ __forceinline__ void titem_load(const TItem& d, f32x4 (&v)[8], int lane) {
#pragma unroll
    for (int i = 0; i < 8; ++i) v[i] = *(const f32x4*)(d.W + (size_t)(d.k0 + (lane >> 3) + 8 * i) * d.N + d.n0 + 4 * (lane & 7));
}
__device__ __forceinline__ void titem_store(const TItem& d, const f32x4 (&v)[8], LAS float* scr, int lane) {
#pragma unroll
    for (int i = 0; i < 8; ++i) { LAS float* q = scr + ((lane >> 3) + 8 * i) * 33 + 4 * (lane & 7); q[0] = v[i][0]; q[1] = v[i][1]; q[2] = v[i][2]; q[3] = v[i][3]; }
    LDS_WAIT(); asm volatile("" ::: "memory");
    if (d.fp8) {
        const int c = lane & 3;
#pragma unroll
        for (int j = 0; j < 2; ++j) { const int nl = (lane >> 2) + 16 * j, n = d.n0 + nl; const LAS float* s = scr + (16 * c) * 33 + nl; const float sc = d.scale;
            u32x4 o;
            o.x = pg8::pk4_fp8(s[0 * 33] * sc, s[1 * 33] * sc, s[2 * 33] * sc, s[3 * 33] * sc);
            o.y = pg8::pk4_fp8(s[4 * 33] * sc, s[5 * 33] * sc, s[6 * 33] * sc, s[7 * 33] * sc);
            o.z = pg8::pk4_fp8(s[8 * 33] * sc, s[9 * 33] * sc, s[10 * 33] * sc, s[11 * 33] * sc);
            o.w = pg8::pk4_fp8(s[12 * 33] * sc, s[13 * 33] * sc, s[14 * 33] * sc, s[15 * 33] * sc);
            const int row = d.rbase + (n / d.blk) * d.rstride + (n % d.blk);
            *(u32x4*)(d.WT + (size_t)row * d.K + d.k0 + 16 * c) = o; }
    } else {
        const int c = lane & 7;
#pragma unroll
        for (int j = 0; j < 4; ++j) { const int nl = (lane >> 3) + 8 * j, n = d.n0 + nl; const LAS float* s = scr + (8 * c) * 33 + nl;
            u32x4 o; o.x = pk2(s[0 * 33], s[1 * 33]); o.y = pk2(s[2 * 33], s[3 * 33]); o.z = pk2(s[4 * 33], s[5 * 33]); o.w = pk2(s[6 * 33], s[7 * 33]);
            const int row = d.rbase + (n / d.blk) * d.rstride + (n % d.blk);
            *(u32x4*)(d.WT + ((size_t)row * d.K + d.k0 + 8 * c) * 2) = o; }
    }
    LDS_WAIT(); asm volatile("" ::: "memory");
}
constexpr int TI_IN = 1024, TI_OUT = 512, TI_EXP = 768 * NE, TI_GATE = 32, TI_N = TI_IN + TI_OUT + TI_EXP + TI_GATE;
__device__ __forceinline__ void titem_decode(const Args& args, unsigned char* ws, int it, TItem& d) {
    int r = it, item; d.fp8 = 0; d.scale = 1.f; d.rstride = 0; d.rbase = 0;
    if (r < TI_IN) { d.W = args.in[5]; d.WT = ws + OFF_WIN; d.K = 1024; d.N = 2048; d.blk = 2048; item = r; }
    else if ((r -= TI_IN) < TI_OUT) { d.W = args.in[17]; d.WT = ws + OFF_WOUT; d.K = 1024; d.N = 1024; d.blk = 1024; item = r; }
    else if ((r -= TI_OUT) < TI_EXP) { const int e = r / 768, q = r % 768;
        if (q < 512) { d.W = (q < 256 ? args.in[23] : args.in[24]) + (size_t)e * 1024 * 512; d.K = 1024; d.N = 512; d.blk = 128; d.rstride = 256; d.rbase = q < 256 ? 0 : 128; item = q & 255;
            d.WT = ws + OFF_W13 + (size_t)e * 1024 * 1024 * (MOE_FP8 ? 1 : 2); d.scale = W13_SCALE; }
        else { d.W = args.in[25] + (size_t)e * 512 * 1024; d.K = 512; d.N = 1024; d.blk = 1024; item = q - 512; d.WT = ws + OFF_W2 + (size_t)e * 1024 * 512 * (MOE_FP8 ? 1 : 2); d.scale = W2_SCALE; }
        d.fp8 = MOE_FP8; if (!MOE_FP8) d.scale = 1.f; }
    else { r -= TI_EXP; const int h = r >> 2, q = r & 3, gate = q >> 1;
        d.W = (gate ? args.in[10] : args.in[8]) + h * 4096; d.WT = ws + OFF_GATEW + (size_t)h * 128 * 64 * 2; d.K = 64; d.N = 64; d.blk = 64; d.rbase = gate * 64; item = q & 1; }
    const int nblk = d.N / 32; d.k0 = 64 * (item / nblk); d.n0 = 32 * (item % nblk);
}
__device__ __forceinline__ void phase_A(Frame& F, const Args& args) {
    unsigned char* ws = F.ws;
    const float* c = args.in[1]; const float* ada_w = args.in[2]; const float* ada_b = args.in[3];
    float* mod = (float*)(ws + OFF_MOD);
    for (int it = F.G - 1 - F.bid; it < 96; it += F.G) {
        LAS float* sc = (LAS float*)F.lds; LAS float* red = sc + 8192;
        for (int i = F.tid; i < 8192; i += NTHREADS) { const float v = c[i]; sc[(i & 1023) * 8 + (i >> 10)] = v / (1.0f + __expf(-v)); }
        __syncthreads();
        const int n = it * 64 + F.lane, k0 = F.wave * 128;
        float acc[8];
#pragma unroll
        for (int b = 0; b < 8; ++b) acc[b] = 0.f;
#pragma unroll 8
        for (int kk = 0; kk < 128; ++kk) { const float w = ada_w[(size_t)(k0 + kk) * 6144 + n];
            const f32x4 s0 = *(const LAS f32x4*)(sc + (k0 + kk) * 8), s1 = *(const LAS f32x4*)(sc + (k0 + kk) * 8 + 4);
#pragma unroll
            for (int b = 0; b < 4; ++b) { acc[b] += s0[b] * w; acc[4 + b] += s1[b] * w; } }
#pragma unroll
        for (int b = 0; b < 8; ++b) red[(F.wave * 8 + b) * 64 + F.lane] = acc[b];
        __syncthreads();
        { const int b = F.wave; float s = ada_b[n];
#pragma unroll
          for (int w = 0; w < 8; ++w) s += red[(w * 8 + b) * 64 + F.lane];
          mod[b * 6144 + n] = s; }
        __syncthreads();
    }
    {
        LAS float* scr = (LAS float*)(F.lds + F.wave * 8448);
        const int gw = F.vcu * NWAVES + F.wave, NGW = F.G * NWAVES;
        int it = gw;
        if (it < TI_N) {
            TItem d, d2; f32x4 v[8], v2[8];
            titem_decode(args, ws, it, d); titem_load(d, v, F.lane);
            for (;;) {
                const int itn = it + NGW; const bool more = itn < TI_N;
                if (more) { titem_decode(args, ws, itn, d2); titem_load(d2, v2, F.lane); }
                titem_store(d, v, scr, F.lane);
                if (!more) break;
                d = d2; it = itn;
#pragma unroll
                for (int i = 0; i < 8; ++i) v[i] = v2[i];
            }
        }
    }
    {
        const int gt = F.bid * NTHREADS + F.tid, NGT = F.G * NTHREADS;
        const float* sgu_w = args.in[15]; const float* rgw = args.in[19]; const float* rew = args.in[21]; const float* lam = args.in[12];
        bf16_t* SGUW = (bf16_t*)(ws + OFF_SGUW); bf16_t* ROUTW = (bf16_t*)(ws + OFF_ROUTW); float* N8SP = (float*)(ws + OFF_N8SP);
        for (int i = gt; i < 8 * 128 * 128; i += NGT) { const int ii = (i >> 7) & 127, j = i & 127; SGUW[i] = (bf16_t)(((j >> 6) <= (ii >> 6)) ? f2bf(sgu_w[i]) : 0u); }
        for (int i = gt; i < 48 * 1024; i += NGT) { const int n = i >> 10, k = i & 1023; const float v = n < 4 ? rgw[k * 4 + n] : (n < 36 ? rew[k * 32 + n - 4] : 0.f); ROUTW[i] = (bf16_t)f2bf(v); }
        for (int i = gt; i < 512; i += NGT) N8SP[i] = -8.0f * log1pf(expf(-lam[i]));
    }
}

__device__ __forceinline__ void phase_B(Frame& F, const Args& args) {
    const float* x = args.in[0]; const float* g = args.in[4]; const float* mod = (const float*)(F.ws + OFF_MOD); bf16_t* XN = (bf16_t*)(F.ws + OFF_XN);
    const int gw = F.bid * NWAVES + F.wave, NGW = F.G * NWAVES, lane = F.lane;
    constexpr int RPW = 16;
    for (int item = gw; item < T / RPW; item += NGW) {
        const int row0 = item * RPW, b = row0 / SEQ;
        const float* sh = mod + b * 6144; const float* sc = sh + 1024;
        f32x4 gm[4], sv[4];
#pragma unroll
        for (int j = 0; j < 4; ++j) { const int col = 4 * (lane + 64 * j); const f32x4 gg = *(const f32x4*)(g + col), s1 = *(const f32x4*)(sc + col); sv[j] = *(const f32x4*)(sh + col); gm[j] = gg * (1.0f + s1); }
        f32x4 v[4], nv[4];
#pragma unroll
        for (int j = 0; j < 4; ++j) v[j] = ((const f32x4*)(x + (size_t)row0 * D))[lane + 64 * j];
#pragma unroll 1
        for (int r = 0; r < RPW; ++r) {
            const int row = row0 + r, nrow = (r + 1 < RPW) ? row + 1 : row;
#pragma unroll
            for (int j = 0; j < 4; ++j) nv[j] = ((const f32x4*)(x + (size_t)nrow * D))[lane + 64 * j];
            float ss = 0.f;
#pragma unroll
            for (int j = 0; j < 4; ++j) ss += v[j][0] * v[j][0] + v[j][1] * v[j][1] + v[j][2] * v[j][2] + v[j][3] * v[j][3];
            const float rs = rsqrtf(wave_sum(ss) * (1.0f / D) + EPS);
#pragma unroll
            for (int j = 0; j < 4; ++j) { const int col = 4 * (lane + 64 * j); const f32x4 h = v[j] * rs * gm[j] + sv[j];
                u32x2 o; o.x = pk2(h[0], h[1]); o.y = pk2(h[2], h[3]);
                *(u32x2*)(XN + (size_t)row * D + col) = o; v[j] = nv[j]; }
        }
    }
}

#ifndef SGU_TR
#define SGU_TR 1
#endif
typedef short s16x4 __attribute__((ext_vector_type(4)));
typedef short v4i16_t __attribute__((ext_vector_type(4)));
constexpr int IMG_STRIDE = 1040;
__device__ __forceinline__ float bflo(unsigned w) { return __uint_as_float(w << 16); }
__device__ __forceinline__ float bfhi(unsigned w) { return __uint_as_float(w & 0xffff0000u); }
__device__ __forceinline__ void sgu_block(Frame& F, const Args& args, int blk) {
    const bf16_t* Z = (const bf16_t*)(F.ws + OFF_Z); bf16_t* YMIX = (bf16_t*)(F.ws + OFF_YMIX); const bf16_t* SGUW = (const bf16_t*)(F.ws + OFF_SGUW);
    const float* ln_g = args.in[13]; const float* ln_b = args.in[14]; const float* sgu_b = args.in[16];
    const int lane = F.lane, w = F.wave, fr = lane & 15, fq = lane >> 4; const size_t t0 = (size_t)blk * 128;
    {
        u32x4 raw[16];
#pragma unroll
        for (int r = 0; r < 16; ++r) raw[r] = *(const u32x4*)(Z + (t0 + w * 16 + r) * 2048 + 1536 + 8 * lane);
        const f32x4 g0 = *(const f32x4*)(ln_g + 8 * lane), g1 = *(const f32x4*)(ln_g + 8 * lane + 4), b0 = *(const f32x4*)(ln_b + 8 * lane), b1 = *(const f32x4*)(ln_b + 8 * lane + 4);
#pragma unroll
        for (int r = 0; r < 16; ++r) {
            float v[8];
#pragma unroll
            for (int q = 0; q < 4; ++q) { v[2 * q] = bflo(raw[r][q]); v[2 * q + 1] = bfhi(raw[r][q]); }
            float s = 0.f;
#pragma unroll
            for (int q = 0; q < 8; ++q) s += v[q];
            const float mu = wave_sum(s) * (1.0f / 512.0f);
            float s2 = 0.f;
#pragma unroll
            for (int q = 0; q < 8; ++q) { v[q] -= mu; s2 += v[q] * v[q]; }
            const float rstd = rsqrtf(wave_sum(s2) * (1.0f / 512.0f) + EPS);
            u32x4 o;
            o.x = pk2(v[0] * rstd * g0[0] + b0[0], v[1] * rstd * g0[1] + b0[1]); o.y = pk2(v[2] * rstd * g0[2] + b0[2], v[3] * rstd * g0[3] + b0[3]);
            o.z = pk2(v[4] * rstd * g1[0] + b1[0], v[5] * rstd * g1[1] + b1[1]); o.w = pk2(v[6] * rstd * g1[2] + b1[2], v[7] * rstd * g1[3] + b1[3]);
            *(LAS u32x4*)(F.lds + (w * 16 + r) * IMG_STRIDE + 16 * lane) = o;
        }
    }
    __syncthreads();
    {
        const int g = w;
        bf16x8 af[4][4];
#pragma unroll
        for (int kt = 0; kt < 4; ++kt)
#pragma unroll
            for (int ct = 0; ct < 4; ++ct) {
#if SGU_TR
                LAS unsigned char* p = F.lds + (32 * kt + 8 * fq + (fr >> 2)) * IMG_STRIDE + (g * 64 + 16 * (fr & 3) + 4 * ct) * 2;
                const s16x4 lo = __builtin_bit_cast(s16x4, __builtin_amdgcn_ds_read_tr16_b64_v4i16((LAS v4i16_t*)p));
                const s16x4 hi = __builtin_bit_cast(s16x4, __builtin_amdgcn_ds_read_tr16_b64_v4i16((LAS v4i16_t*)(p + 4 * IMG_STRIDE)));
                af[kt][ct] = (bf16x8){lo[0], lo[1], lo[2], lo[3], hi[0], hi[1], hi[2], hi[3]};
#else
                const LAS bf16_t* p = (const LAS bf16_t*)(F.lds + (32 * kt + 8 * fq) * IMG_STRIDE) + g * 64 + 16 * (fr >> 2) + 4 * ct + (fr & 3);
#pragma unroll
                for (int e = 0; e < 8; ++e) af[kt][ct][e] = (short)p[e * (IMG_STRIDE / 2)];
#endif
            }
#pragma unroll 1
        for (int it = 0; it < 8; ++it) {
            const int i0 = 16 * it;
            const bf16_t* wp = SGUW + ((size_t)(g * 128 + i0 + fr)) * 128 + 8 * fq;
            bf16x8 wf[4];
#pragma unroll
            for (int kt = 0; kt < 4; ++kt) wf[kt] = *(const bf16x8*)(wp + 32 * kt);
            f32x4 acc[4];
#pragma unroll
            for (int ct = 0; ct < 4; ++ct) acc[ct] = (f32x4){0.f, 0.f, 0.f, 0.f};
#pragma unroll
            for (int kt = 0; kt < 4; ++kt)
#pragma unroll
                for (int ct = 0; ct < 4; ++ct) acc[ct] = __builtin_amdgcn_mfma_f32_16x16x32_bf16(af[kt][ct], wf[kt], acc[ct], 0, 0, 0);
            const float bias = sgu_b[g * 128 + i0 + fr];
            const size_t t = t0 + i0 + fr;
            const u32x4 gu0 = *(const u32x4*)(Z + t * 2048 + 1024 + g * 64 + 16 * fq), gu1 = *(const u32x4*)(Z + t * 2048 + 1024 + g * 64 + 16 * fq + 8);
            u32x4 o0, o1;
            o0.x = pk2(bflo(gu0.x) * (acc[0][0] + bias), bfhi(gu0.x) * (acc[0][1] + bias)); o0.y = pk2(bflo(gu0.y) * (acc[0][2] + bias), bfhi(gu0.y) * (acc[0][3] + bias));
            o0.z = pk2(bflo(gu0.z) * (acc[1][0] + bias), bfhi(gu0.z) * (acc[1][1] + bias)); o0.w = pk2(bflo(gu0.w) * (acc[1][2] + bias), bfhi(gu0.w) * (acc[1][3] + bias));
            o1.x = pk2(bflo(gu1.x) * (acc[2][0] + bias), bfhi(gu1.x) * (acc[2][1] + bias)); o1.y = pk2(bflo(gu1.y) * (acc[2][2] + bias), bfhi(gu1.y) * (acc[2][3] + bias));
            o1.z = pk2(bflo(gu1.z) * (acc[3][0] + bias), bfhi(gu1.z) * (acc[3][1] + bias)); o1.w = pk2(bflo(gu1.w) * (acc[3][2] + bias), bfhi(gu1.w) * (acc[3][3] + bias));
            *(u32x4*)(YMIX + t * D + 512 + g * 64 + 16 * fq) = o0; *(u32x4*)(YMIX + t * D + 512 + g * 64 + 16 * fq + 8) = o1;
        }
    }
}

constexpr int XC_STRIDE = 144;
constexpr int AU_STRIDE = 68;
constexpr int LRU_WAVE_BYTES = 64 * XC_STRIDE + 2 * 16 * AU_STRIDE * 4;
__device__ __forceinline__ float sigm_fast(float x) { return __builtin_amdgcn_rcpf(1.0f + __builtin_amdgcn_exp2f(-1.4426950408889634f * x)); }
template <int PASS>
__device__ __forceinline__ void lru_block(Frame& F, const Args& args, int blk) {
    const bf16_t* Z = (const bf16_t*)(F.ws + OFF_Z); bf16_t* YMIX = (bf16_t*)(F.ws + OFF_YMIX); const bf16_t* GATEW = (const bf16_t*)(F.ws + OFF_GATEW);
    const float* N8SP = (const float*)(F.ws + OFF_N8SP); float* CA = (float*)(F.ws + OFF_CARRY); float* CH = CA + 256 * 512;
    const float* cw = args.in[6]; const float* cb = args.in[7]; const float* gab = args.in[9]; const float* gib = args.in[11];
    const int lane = F.lane, h = F.wave, fr = lane & 15, fq = lane >> 4, cg = lane & 7, run = lane >> 3; const size_t t0 = (size_t)blk * 128;
    LAS unsigned char* xcT = F.lds + h * LRU_WAVE_BYTES; LAS float* Abuf = (LAS float*)(xcT + 64 * XC_STRIDE); LAS float* Ubuf = Abuf + 16 * AU_STRIDE;
    float hst = 0.f, pp = 1.f;
    if (PASS == 2) { const int b0 = blk & ~31, n = blk & 31;
        float ca[31], ch[31];
#pragma unroll
        for (int k = 0; k < 31; ++k) { const int kk = k < n ? k : 0; ca[k] = CA[(size_t)(b0 + kk) * 512 + 64 * h + lane]; ch[k] = CH[(size_t)(b0 + kk) * 512 + 64 * h + lane]; }
#pragma unroll
        for (int k = 0; k < 31; ++k) hst = k < n ? ca[k] * hst + ch[k] : hst; }
    bf16x8 gw[8][2];
#pragma unroll
    for (int et = 0; et < 8; ++et)
#pragma unroll
        for (int kt = 0; kt < 2; ++kt) gw[et][kt] = *(const bf16x8*)(GATEW + ((size_t)(h * 128 + 16 * et + fr)) * 64 + 32 * kt + 8 * fq);
    const bool seq_start = (blk & 31) == 0;
#pragma unroll 1
    for (int hb = 0; hb < 2; ++hb) {
        const size_t tb = t0 + 64 * hb;
        {
            float cwv[4][8], cbv[8];
#pragma unroll
            for (int k = 0; k < 4; ++k) { const f32x4 a = *(const f32x4*)(cw + k * 512 + 64 * h + 8 * cg), b = *(const f32x4*)(cw + k * 512 + 64 * h + 8 * cg + 4);
#pragma unroll
                for (int q = 0; q < 4; ++q) { cwv[k][q] = a[q]; cwv[k][4 + q] = b[q]; } }
            { const f32x4 a = *(const f32x4*)(cb + 64 * h + 8 * cg), b = *(const f32x4*)(cb + 64 * h + 8 * cg + 4);
#pragma unroll
              for (int q = 0; q < 4; ++q) { cbv[q] = a[q]; cbv[4 + q] = b[q]; } }
            u32x4 xr[11];
#pragma unroll
            for (int j = 0; j < 11; ++j) { const int rel = 8 * run - 3 + j;
                const bool pad = (j < 3) && (rel < 0) && (hb == 0) && seq_start;
                const u32x4 v = *(const u32x4*)(Z + (size_t)((long)tb + (pad ? 0 : rel)) * 2048 + 64 * h + 8 * cg);
                xr[j] = pad ? (u32x4){0u, 0u, 0u, 0u} : v; }
#pragma unroll
            for (int s = 0; s < 8; ++s) { float o[8];
#pragma unroll
                for (int q = 0; q < 8; ++q) o[q] = cbv[q];
#pragma unroll
                for (int k = 0; k < 4; ++k) { const u32x4 r = xr[s + k];
#pragma unroll
                    for (int q = 0; q < 4; ++q) { o[2 * q] += cwv[k][2 * q] * bflo(r[q]); o[2 * q + 1] += cwv[k][2 * q + 1] * bfhi(r[q]); } }
                u32x4 pkd; pkd.x = pk2(o[0], o[1]); pkd.y = pk2(o[2], o[3]); pkd.z = pk2(o[4], o[5]); pkd.w = pk2(o[6], o[7]);
                *(LAS u32x4*)(xcT + (8 * run + s) * XC_STRIDE + 16 * cg) = pkd; }
        }
        WAVE_SYNC();
#pragma unroll 1
        for (int it = 0; it < 4; ++it) {
            bf16x8 xf[2];
#pragma unroll
            for (int kt = 0; kt < 2; ++kt) xf[kt] = *(const LAS bf16x8*)(xcT + (16 * it + fr) * XC_STRIDE + (32 * kt + 8 * fq) * 2);
            f32x4 acc[8];
#pragma unroll
            for (int et = 0; et < 4; ++et) { acc[et] = *(const f32x4*)(gab + 64 * h + 16 * et + 4 * fq); acc[4 + et] = *(const f32x4*)(gib + 64 * h + 16 * et + 4 * fq); }
#pragma unroll
            for (int et = 0; et < 8; ++et)
#pragma unroll
                for (int kt = 0; kt < 2; ++kt) acc[et] = __builtin_amdgcn_mfma_f32_16x16x32_bf16(gw[et][kt], xf[kt], acc[et], 0, 0, 0);
#pragma unroll
            for (int et = 0; et < 4; ++et) {
                const f32x4 sp = *(const f32x4*)(N8SP + 64 * h + 16 * et + 4 * fq);
                const u32x2 xw = *(const LAS u32x2*)(xcT + (16 * it + fr) * XC_STRIDE + (16 * et + 4 * fq) * 2);
                const float xv[4] = {bflo(xw.x), bfhi(xw.x), bflo(xw.y), bfhi(xw.y)};
                f32x4 av, uv;
#pragma unroll
                for (int r = 0; r < 4; ++r) {
                    const float rg = sigm_fast(acc[et][r]), ig = sigm_fast(acc[4 + et][r]);
                    const float la = rg * sp[r];
                    av[r] = __builtin_amdgcn_exp2f(1.4426950408889634f * la);
                    const float x2 = 2.0f * la;
                    const float om = -x2 * (1.0f + x2 * (0.5f + x2 * (0.16666667f + x2 * 0.041666668f)));
                    uv[r] = __builtin_amdgcn_sqrtf(om) * (ig * xv[r]);
                }
                *(LAS f32x4*)(Abuf + fr * AU_STRIDE + 16 * et + 4 * fq) = av; *(LAS f32x4*)(Ubuf + fr * AU_STRIDE + 16 * et + 4 * fq) = uv;
            }
            WAVE_SYNC();
            {
                float a[16], u[16];
#pragma unroll
                for (int tk = 0; tk < 16; ++tk) { a[tk] = Abuf[tk * AU_STRIDE + lane]; u[tk] = Ubuf[tk * AU_STRIDE + lane]; }
#pragma unroll
                for (int tk = 0; tk < 16; ++tk) { hst = a[tk] * hst + u[tk]; if (PASS == 1) pp *= a[tk]; else Ubuf[tk * AU_STRIDE + lane] = hst; }
            }
            if (PASS == 2) {
                WAVE_SYNC();
                const int tok = lane >> 2, cq = lane & 3; const size_t t = tb + 16 * it + tok;
                const u32x4 g0 = *(const u32x4*)(Z + t * 2048 + 512 + 64 * h + 16 * cq), g1 = *(const u32x4*)(Z + t * 2048 + 512 + 64 * h + 16 * cq + 8);
                const LAS float* hp = Ubuf + tok * AU_STRIDE + 16 * cq;
                const f32x4 h0 = *(const LAS f32x4*)(hp), h1 = *(const LAS f32x4*)(hp + 4), h2 = *(const LAS f32x4*)(hp + 8), h3 = *(const LAS f32x4*)(hp + 12);
                u32x4 o0, o1;
                o0.x = pk2(h0[0] * bflo(g0.x), h0[1] * bfhi(g0.x)); o0.y = pk2(h0[2] * bflo(g0.y), h0[3] * bfhi(g0.y));
                o0.z = pk2(h1[0] * bflo(g0.z), h1[1] * bfhi(g0.z)); o0.w = pk2(h1[2] * bflo(g0.w), h1[3] * bfhi(g0.w));
                o1.x = pk2(h2[0] * bflo(g1.x), h2[1] * bfhi(g1.x)); o1.y = pk2(h2[2] * bflo(g1.y), h2[3] * bfhi(g1.y));
                o1.z = pk2(h3[0] * bflo(g1.z), h3[1] * bfhi(g1.z)); o1.w = pk2(h3[2] * bflo(g1.w), h3[3] * bfhi(g1.w));
                *(u32x4*)(YMIX + t * D + 64 * h + 16 * cq) = o0; *(u32x4*)(YMIX + t * D + 64 * h + 16 * cq + 8) = o1;
            }
            WAVE_SYNC();
        }
    }
    if (PASS == 1) { CA[(size_t)blk * 512 + 64 * h + lane] = pp; CH[(size_t)blk * 512 + 64 * h + lane] = hst; }
}
constexpr int HT_STRIDE = 2064;
constexpr int RG_W_OFF = 0, RG_H_OFF = 36 * HT_STRIDE, RG_LOG_OFF = RG_H_OFF + 32 * HT_STRIDE, RG_MISC_OFF = RG_LOG_OFF + 32 * 48 * 4;
static_assert(RG_MISC_OFF + 256 <= SCR_BYTES, "phase G LDS map");
__device__ __forceinline__ void phase_G(Frame& F, const Args& args) {
    const bf16_t* X1 = (const bf16_t*)(F.ws + OFF_X1); bf16_t* H2 = (bf16_t*)(F.ws + OFF_XN); const bf16_t* ROUTW = (const bf16_t*)(F.ws + OFF_ROUTW);
    const float* mod = (const float*)(F.ws + OFF_MOD); const float* g2w = args.in[18]; const float* bg = args.in[20]; const float* be = args.in[22];
    int* list = (int*)(F.ws + OFF_LIST); int* toke = (int*)(F.ws + OFF_TOKE); float* tokw = (float*)(F.ws + OFF_TOKW); int* tokp = (int*)(F.ws + OFF_TOKP);
    const int lane = F.lane, w = F.wave, fr = lane & 15, fq = lane >> 4;
    LAS float* LG = (LAS float*)(F.lds + RG_LOG_OFF); LAS int* hist = (LAS int*)(F.lds + RG_MISC_OFF); LAS int* base = hist + 32;
    __syncthreads();
    for (int i = F.tid; i < 36 * 128; i += NTHREADS) { const int r = i >> 7, c = i & 127; *(LAS u32x4*)(F.lds + RG_W_OFF + r * HT_STRIDE + c * 16) = *(const u32x4*)(ROUTW + (size_t)r * 1024 + c * 8); }
    for (int grp = F.bid; grp < T / 128; grp += F.G) {
        const int grow0 = grp * 128, b = grow0 / SEQ;
        const float* sh = mod + b * 6144 + 3072; const float* sc = sh + 1024;
        float gm[16], sv[16];
#pragma unroll
        for (int jj = 0; jj < 2; ++jj)
#pragma unroll
            for (int q = 0; q < 8; ++q) { const int c = 512 * jj + 8 * lane + q; gm[8 * jj + q] = g2w[c] * (1.0f + sc[c]); sv[8 * jj + q] = sh[c]; }
        if (F.tid < 32) hist[F.tid] = 0;
        u32x4 raw[4][2];
#pragma unroll
        for (int r = 0; r < 4; ++r)
#pragma unroll
            for (int jj = 0; jj < 2; ++jj) raw[r][jj] = *(const u32x4*)(X1 + (size_t)(grow0 + 4 * w + r) * D + 512 * jj + 8 * lane);
        int e1 = 0, e2 = 0, l1 = 0, l2 = 0; float w1 = 0.f, w2 = 0.f;
#pragma unroll 1
        for (int ti = 0; ti < 4; ++ti) {
            const int row0 = grow0 + 32 * ti;
#pragma unroll
            for (int r = 0; r < 4; ++r) {
                float h[16]; float ss = 0.f;
#pragma unroll
                for (int jj = 0; jj < 2; ++jj)
#pragma unroll
                    for (int q = 0; q < 4; ++q) { h[8 * jj + 2 * q] = bflo(raw[r][jj][q]); h[8 * jj + 2 * q + 1] = bfhi(raw[r][jj][q]); }
#pragma unroll
                for (int q = 0; q < 16; ++q) ss += h[q] * h[q];
                const float rs = rsqrtf(wave_sum(ss) * (1.0f / D) + EPS);
#pragma unroll
                for (int jj = 0; jj < 2; ++jj) { u32x4 o; float hv[8];
#pragma unroll
                    for (int q = 0; q < 8; ++q) hv[q] = h[8 * jj + q] * rs * gm[8 * jj + q] + sv[8 * jj + q];
#pragma unroll
                    for (int q = 0; q < 4; ++q) o[q] = pk2(hv[2 * q], hv[2 * q + 1]);
#if MOE_FP8
                    { u32x2 f; f.x = pg8::pk4_fp8(hv[0], hv[1], hv[2], hv[3]); f.y = pg8::pk4_fp8(hv[4], hv[5], hv[6], hv[7]);
                      *(u32x2*)((unsigned char*)H2 + (size_t)(row0 + 4 * w + r) * D + 512 * jj + 8 * lane) = f; }
#else
                    *(u32x4*)(H2 + (size_t)(row0 + 4 * w + r) * D + 512 * jj + 8 * lane) = o;
#endif
                    *(LAS u32x4*)(F.lds + RG_H_OFF + (4 * w + r) * HT_STRIDE + (512 * jj + 8 * lane) * 2) = o; }
            }
            if (ti < 3) {
#pragma unroll
                for (int r = 0; r < 4; ++r)
#pragma unroll
                    for (int jj = 0; jj < 2; ++jj) raw[r][jj] = *(const u32x4*)(X1 + (size_t)(row0 + 32 + 4 * w + r) * D + 512 * jj + 8 * lane);
            }
            __syncthreads();
            if (w < 6) {
                const int rt = w / 3, ct = w % 3; int wrow = 16 * ct + fr; wrow = wrow < 36 ? wrow : 35;
                const LAS unsigned char* hp = F.lds + RG_H_OFF + (16 * rt + fr) * HT_STRIDE + 16 * fq; const LAS unsigned char* wp = F.lds + RG_W_OFF + wrow * HT_STRIDE + 16 * fq;
                f32x4 acc0 = {0.f, 0.f, 0.f, 0.f}, acc1 = {0.f, 0.f, 0.f, 0.f};
#pragma unroll 8
                for (int kt = 0; kt < 32; kt += 2) {
                    acc0 = __builtin_amdgcn_mfma_f32_16x16x32_bf16(*(const LAS bf16x8*)(wp + 64 * kt), *(const LAS bf16x8*)(hp + 64 * kt), acc0, 0, 0, 0);
                    acc1 = __builtin_amdgcn_mfma_f32_16x16x32_bf16(*(const LAS bf16x8*)(wp + 64 * kt + 64), *(const LAS bf16x8*)(hp + 64 * kt + 64), acc1, 0, 0, 0); }
                *(LAS f32x4*)(LG + (16 * rt + fr) * 48 + 16 * ct + 4 * fq) = acc0 + acc1;
            }
            __syncthreads();
            if ((F.tid >> 5) == ti) {
                const LAS float* L = LG + (F.tid & 31) * 48;
                float gl[4], el[8];
#pragma unroll
                for (int j = 0; j < 4; ++j) gl[j] = L[j] + bg[j];
                int gs = 0; float gmax = gl[0];
#pragma unroll
                for (int j = 1; j < 4; ++j) if (gl[j] > gmax) { gmax = gl[j]; gs = j; }
#pragma unroll
                for (int j = 0; j < 8; ++j) el[j] = L[4 + gs * 8 + j] + be[gs * 8 + j];
                float gsum = 0.f;
#pragma unroll
                for (int j = 0; j < 4; ++j) gsum += __expf(gl[j] - gmax);
                const float pg = 1.0f / gsum;
                int i1 = 0; float m1 = el[0];
#pragma unroll
                for (int j = 1; j < 8; ++j) if (el[j] > m1) { m1 = el[j]; i1 = j; }
                int i2 = -1; float m2 = -INFINITY;
#pragma unroll
                for (int j = 0; j < 8; ++j) if (j != i1 && el[j] > m2) { m2 = el[j]; i2 = j; }
                const float r = __expf(m2 - m1);
                w1 = pg / (1.0f + r); w2 = pg * r / (1.0f + r); e1 = gs * 8 + i1; e2 = gs * 8 + i2;
                l1 = __hip_atomic_fetch_add(hist + e1, 1, __ATOMIC_RELAXED, __HIP_MEMORY_SCOPE_WORKGROUP);
                l2 = __hip_atomic_fetch_add(hist + e2, 1, __ATOMIC_RELAXED, __HIP_MEMORY_SCOPE_WORKGROUP);
            }
        }
        __syncthreads();
        if (F.tid < 32) { const int n = hist[F.tid]; base[F.tid] = n ? (int)__hip_atomic_fetch_add(F.ctl + CW_CNT + CNT_STRIDE * F.tid, (unsigned)n, __ATOMIC_RELAXED, __HIP_MEMORY_SCOPE_AGENT) : 0; }
        __syncthreads();
        if (F.tid < 128) { const int row = grow0 + F.tid, p1 = base[e1] + l1, p2 = base[e2] + l2;
            list[(size_t)e1 * LISTCAP + p1] = row; list[(size_t)e2 * LISTCAP + p2] = row;
            toke[2 * row] = e1; toke[2 * row + 1] = e2; tokw[2 * row] = w1; tokw[2 * row + 1] = w2; tokp[2 * row] = p1; tokp[2 * row + 1] = p2; }
        __syncthreads();
    }
}

__device__ __forceinline__ void phase_J(Frame& F, const Args& args) {
    const bf16_t* X1 = (const bf16_t*)(F.ws + OFF_X1); const bf16_t* Y = (const bf16_t*)(F.ws + OFF_Y); const float* mod = (const float*)(F.ws + OFF_MOD);
    const int* toke = (const int*)(F.ws + OFF_TOKE); const float* tokw = (const float*)(F.ws + OFF_TOKW); const int* tokp = (const int*)(F.ws + OFF_TOKP);
    const float* fg = args.in[26]; float* out = args.out;
    const int gw = F.bid * NWAVES + F.wave, NGW = F.G * NWAVES, lane = F.lane;
    constexpr int RPW = 16;
    for (int item = gw; item < T / RPW; item += NGW) {
        const int row0 = item * RPW, b = row0 / SEQ;
        int q0l = 0, q1l = 0; float w0l = 0.f, w1l = 0.f;
        { const int rr = row0 + (lane & 15); const int e0 = toke[2 * rr], e1 = toke[2 * rr + 1];
          q0l = F.tab[TAB_P0 + e0] * 256 + tokp[2 * rr]; q1l = F.tab[TAB_P0 + e1] * 256 + tokp[2 * rr + 1]; w0l = tokw[2 * rr]; w1l = tokw[2 * rr + 1]; }
        const float* g2 = mod + b * 6144 + 5120;
        f32x4 g2v[4], fgv[4];
#pragma unroll
        for (int jj = 0; jj < 2; ++jj)
#pragma unroll
            for (int hh = 0; hh < 2; ++hh) { const int c = 512 * jj + 8 * lane + 4 * hh; g2v[2 * jj + hh] = *(const f32x4*)(g2 + c); fgv[2 * jj + hh] = *(const f32x4*)(fg + c); }
        u32x4 xr[2], ya[2], yb[2], nxr[2], nya[2], nyb[2];
        { const size_t q0 = (size_t)__shfl(q0l, 0), q1 = (size_t)__shfl(q1l, 0);
#pragma unroll
          for (int jj = 0; jj < 2; ++jj) { const int c0 = 512 * jj + 8 * lane; xr[jj] = *(const u32x4*)(X1 + (size_t)row0 * D + c0); ya[jj] = *(const u32x4*)(Y + q0 * D + c0); yb[jj] = *(const u32x4*)(Y + q1 * D + c0); } }
#pragma unroll 1
        for (int r = 0; r < RPW; ++r) {
            const int row = row0 + r, rn = (r + 1 < RPW) ? r + 1 : r;
            { const size_t q0 = (size_t)__shfl(q0l, rn), q1 = (size_t)__shfl(q1l, rn);
#pragma unroll
              for (int jj = 0; jj < 2; ++jj) { const int c0 = 512 * jj + 8 * lane; nxr[jj] = *(const u32x4*)(X1 + (size_t)(row0 + rn) * D + c0); nya[jj] = *(const u32x4*)(Y + q0 * D + c0); nyb[jj] = *(const u32x4*)(Y + q1 * D + c0); } }
            const float w0 = __shfl(w0l, r), w1 = __shfl(w1l, r);
            float v[16]; float ss = 0.f;
#pragma unroll
            for (int jj = 0; jj < 2; ++jj)
#pragma unroll
                for (int q = 0; q < 4; ++q) {
                    const float y0 = w0 * bflo(ya[jj][q]) + w1 * bflo(yb[jj][q]), y1 = w0 * bfhi(ya[jj][q]) + w1 * bfhi(yb[jj][q]);
                    const f32x4 gg = g2v[2 * jj + (q >> 1)];
                    v[8 * jj + 2 * q] = bflo(xr[jj][q]) + gg[(2 * q) & 3] * y0; v[8 * jj + 2 * q + 1] = bfhi(xr[jj][q]) + gg[(2 * q + 1) & 3] * y1; }
#pragma unroll
            for (int q = 0; q < 16; ++q) ss += v[q] * v[q];
            const float rs = rsqrtf(wave_sum(ss) * (1.0f / D) + EPS);
#pragma unroll
            for (int jj = 0; jj < 2; ++jj) { const int c0 = 512 * jj + 8 * lane;
                f32x4 o0, o1;
#pragma unroll
                for (int q = 0; q < 4; ++q) { o0[q] = v[8 * jj + q] * rs * fgv[2 * jj][q]; o1[q] = v[8 * jj + 4 + q] * rs * fgv[2 * jj + 1][q]; }
                *(f32x4*)(out + (size_t)row * D + c0) = o0; *(f32x4*)(out + (size_t)row * D + c0 + 4) = o1;
                xr[jj] = nxr[jj]; ya[jj] = nya[jj]; yb[jj] = nyb[jj]; }
        }
    }
}

__global__ void __launch_bounds__(NTHREADS, 2) mk(Args args) {
    extern __shared__ __attribute__((aligned(16))) unsigned char lds_raw[];
    Frame F;
    F.lds = (LAS unsigned char*)lds_raw; F.tab = (LAS int*)(F.lds + TAB_OFF);
    F.tid = threadIdx.x; F.lane = F.tid & 63; F.wave = __builtin_amdgcn_readfirstlane(F.tid >> 6);
    F.G = gridDim.x; F.bid = blockIdx.x; F.vcu = (F.G % 8 == 0) ? (F.bid % 8) * (F.G / 8) + F.bid / 8 : F.bid;
    F.ws = args.ws; F.ctl = (unsigned*)(args.ws + OFF_CTL);
    unsigned char* ws = args.ws;
    bf16_t* WIN = (bf16_t*)(ws + OFF_WIN); bf16_t* WOUT = (bf16_t*)(ws + OFF_WOUT); bf16_t* W13 = (bf16_t*)(ws + OFF_W13); bf16_t* W2 = (bf16_t*)(ws + OFF_W2);
    bf16_t* XN = (bf16_t*)(ws + OFF_XN); bf16_t* Z = (bf16_t*)(ws + OFF_Z); bf16_t* YMIX = (bf16_t*)(ws + OFF_YMIX); bf16_t* X1 = (bf16_t*)(ws + OFF_X1);
    bf16_t* ACT = (bf16_t*)(ws + OFF_ACT); bf16_t* Y = (bf16_t*)(ws + OFF_Y); bf16_t* H2 = XN;
    const float* mod = (const float*)(ws + OFF_MOD); const int* list = (const int*)(ws + OFF_LIST);
    const int lo = args.ph_lo, hi = args.ph_hi;
    for (int u = F.tid; u < (LDS_BYTES - LDSCTL_OFF) / 4; u += NTHREADS) ((LAS unsigned*)(F.lds + LDSCTL_OFF))[u] = 0u;
    __syncthreads();
    XcdBarrier bar; bar.bar = F.ctl + CW_BAR; bar.x = 0; bar.st = nullptr;
    if (hi - lo > 1) bar = xcd_barrier_post(F.ctl + CW_BAR, (volatile LAS unsigned*)(F.lds + LDSCTL_OFF) + 8);
#ifndef PHMASK
#define PHMASK 0x3ff
#endif
#define IN(k) (((PHMASK >> (k)) & 1) && lo <= (k) && (k) < hi)
#define SEAM(k) do { if (IN(k) && IN((k) + 1)) xcd_barrier(bar); } while (0)

    if (IN(PH_A)) phase_A(F, args);
    SEAM(PH_A);
    if (IN(PH_B)) phase_B(F, args);
    SEAM(PH_B);
    if (IN(PH_C)) {
        pg8::Gemm g{XN, WIN, 2048}; pg8::StaticOrder S; S.tokt = F.lds; S.init(T, 2048, 2048, F.G, F.bid);
        pg8::EpiZ E{Z};
        pg8::gemm_phase<pg8::EpiZ, pg8::StaticOrder, true, false, false>(F.lds, g, S, E);
    }
    SEAM(PH_C);
    if (IN(PH_D)) { for (int blk = F.bid; blk < T / 128; blk += F.G) { __syncthreads(); sgu_block(F, args, blk); __syncthreads(); lru_block<1>(F, args, blk); } }
    SEAM(PH_D);
    if (IN(PH_E)) { for (int blk = F.bid; blk < T / 128; blk += F.G) { __syncthreads(); lru_block<2>(F, args, blk); } }
    SEAM(PH_E);
    if (IN(PH_F)) {
        __syncthreads();
        pg8::Gemm g{YMIX, WOUT, 2048}; pg8::StaticOrder S; S.tokt = F.lds; S.init(T, 1024, 2048, F.G, F.bid);
        pg8::EpiX1 E{args.in[0], mod, X1};
        pg8::gemm_phase<pg8::EpiX1, pg8::StaticOrder, true, false, false>(F.lds, g, S, E);
    }
    SEAM(PH_F);
    if (IN(PH_G)) phase_G(F, args);
    SEAM(PH_G);
    if (IN(PH_H)) {
        build_moe_table(F);
        pg8::MoeOrder S; S.nunits = F.tab[TAB_P0 + NE] * 4; S.G = F.G; S.c = F.vcu;
        S.tile_e = F.tab + TAB_TE; S.p0 = F.tab + TAB_P0; S.cnt = F.tab + TAB_CNT; S.list = list; S.gather = true; S.tokt = F.lds + TOKT_OFF;
#if MOE_FP8
        S.Kb = 1024; S.estride = (size_t)1024 * 1024;
        pg8::Gemm g{H2, W13, 1024}; pg8::EpiAct8 E{(unsigned char*)ACT, 1.0f / W13_SCALE, ACT_SCALE};
        pg8::gemm_phase<pg8::EpiAct8, pg8::MoeOrder, true, true, true>(F.lds, g, S, E);
#else
        S.Kb = 2048; S.estride = (size_t)1024 * 1024 * 2;
        pg8::Gemm g{H2, W13, 2048}; pg8::EpiAct E{ACT};
        pg8::gemm_phase<pg8::EpiAct, pg8::MoeOrder, true, true, false>(F.lds, g, S, E);
#endif
    }
    SEAM(PH_H);
    if (IN(PH_I)) {
        build_moe_table(F);
        pg8::MoeOrder S; S.nunits = F.tab[TAB_P0 + NE] * 4; S.G = F.G; S.c = F.vcu;
        S.tile_e = F.tab + TAB_TE; S.p0 = F.tab + TAB_P0; S.cnt = F.tab + TAB_CNT; S.list = list; S.gather = false; S.tokt = F.lds + TOKT_OFF;
#if MOE_FP8
        S.Kb = 512; S.estride = (size_t)1024 * 512;
        pg8::Gemm g{ACT, W2, 512}; pg8::EpiY8 E{Y, 1.0f / (W2_SCALE * ACT_SCALE)};
        pg8::gemm_phase<pg8::EpiY8, pg8::MoeOrder, true, false, true>(F.lds, g, S, E);
#else
        S.Kb = 1024; S.estride = (size_t)1024 * 512 * 2;
        pg8::Gemm g{ACT, W2, 1024}; pg8::EpiY E{Y};
        pg8::gemm_phase<pg8::EpiY, pg8::MoeOrder, true, false, false>(F.lds, g, S, E);
#endif
    }
    SEAM(PH_I);
    if (IN(PH_J)) { build_moe_table(F); phase_J(F, args); }
#undef IN
#undef SEAM
}
#ifndef FUSED
#define FUSED 1
#endif
extern "C" void kernel_launch(void* const* d_in, const int* in_sizes, int n_in, void* d_out, int out_size, void* d_ws, size_t ws_size, hipStream_t stream) {
    if (n_in != 27 || out_size != T * D || ws_size < WS_NEED) { fprintf(stderr, "kernel_launch: unexpected shapes (n_in %d out %d ws %zu)\n", n_in, out_size, ws_size); return; }
    static int grid = 0;
    if (grid == 0) {
        int dev = 0, cus = 0;
        if (hipGetDevice(&dev) != hipSuccess || hipDeviceGetAttribute(&cus, hipDeviceAttributeMultiprocessorCount, dev) != hipSuccess) { fprintf(stderr, "kernel_launch: device query failed\n"); grid = -1; return; }
        if (hipFuncSetAttribute((const void*)mk, hipFuncAttributeMaxDynamicSharedMemorySize, LDS_BYTES) != hipSuccess) { fprintf(stderr, "kernel_launch: hipFuncSetAttribute failed\n"); grid = -1; return; }
        int per_cu = 0;
        if (hipOccupancyMaxActiveBlocksPerMultiprocessor(&per_cu, (const void*)mk, NTHREADS, LDS_BYTES) != hipSuccess || per_cu < 1) fprintf(stderr, "kernel_launch: occupancy query says %d\n", per_cu);
        (void)hipGetLastError();
        grid = cus;
    }
    if (grid < 0) return;
    Args a{}; for (int i = 0; i < 27; ++i) a.in[i] = (const float*)d_in[i]; a.out = (float*)d_out; a.ws = (unsigned char*)d_ws;
#define MK(lo_, hi_) do { a.ph_lo = (lo_); a.ph_hi = (hi_); hipLaunchKernelGGL(mk, dim3(grid), dim3(NTHREADS), LDS_BYTES, stream, a); } while (0)
    (void)hipMemsetAsync((char*)d_ws + OFF_CTL, 0, CTL_BYTES, stream);
#if FUSED
    MK(0, PH_N);
#else
    for (int p = 0; p < PH_N; ++p) MK(p, p + 1);
#endif
}
```

```cpp
#include <hip/hip_runtime.h>
#include <cstdio>
#include <cstdint>

typedef unsigned short bf16_t;
typedef short bf16x8 __attribute__((ext_vector_type(8)));
typedef float f32x4 __attribute__((ext_vector_type(4)));
typedef unsigned u32x2 __attribute__((ext_vector_type(2)));
typedef unsigned u32x4 __attribute__((ext_vector_type(4)));

constexpr int T = 32768, D = 1024, SEQ = 4096, NB = 8;
constexpr int DL = 512;
constexpr int NE = 32, DE = 512;
constexpr int LISTCAP = 65536;
constexpr int MAXTILES = 288, MAXROWS = MAXTILES * 256;
constexpr float EPS = 1e-6f;

constexpr size_t MiB = 1u << 20;
constexpr size_t OFF_CTL = 0, CTL_BYTES = 48 * 1024;
constexpr size_t OFF_MOD = 1 * MiB;
constexpr size_t OFF_TBL = 1 * MiB + 256 * 1024;
constexpr size_t OFF_TOKE = 1 * MiB + 512 * 1024;
constexpr size_t OFF_TOKW = 1 * MiB + 768 * 1024;
constexpr size_t OFF_TOKP = 2 * MiB;
constexpr size_t OFF_N8SP = 1 * MiB + 256 * 1024 + 16384;
constexpr size_t OFF_GBIAS = 1 * MiB + 256 * 1024 + 32768;
constexpr size_t OFF_GATEW = 2 * MiB + 256 * 1024;
constexpr size_t OFF_SGUW = 2 * MiB + 512 * 1024;
constexpr size_t OFF_ROUTW = 2 * MiB + 768 * 1024;
constexpr size_t OFF_CARRY = 3 * MiB;
constexpr size_t OFF_WIN = 4 * MiB;
constexpr size_t OFF_WOUT = 8 * MiB;
constexpr size_t OFF_W13 = 10 * MiB;
constexpr size_t OFF_W2 = 74 * MiB;
constexpr size_t OFF_XN = 106 * MiB;
constexpr size_t OFF_Z = 170 * MiB;
constexpr size_t OFF_YMIX = 298 * MiB;
constexpr size_t OFF_X1 = 362 * MiB;
constexpr size_t OFF_ACT = 426 * MiB;
constexpr size_t OFF_LIST = 498 * MiB;
constexpr size_t OFF_ROWTOK = 506 * MiB;
constexpr size_t OFF_Y = 170 * MiB;
constexpr size_t WS_NEED = 507 * MiB;
constexpr size_t OFF_VN = OFF_X1;
constexpr size_t OFF_XC = OFF_ACT;
constexpr int CW_BAR = 4096;
constexpr int CW_CNT = 8192, CNT_STRIDE = 64;

__device__ __forceinline__ unsigned f2bf(float f) { unsigned u = __float_as_uint(f); return (u + 0x7fffu + ((u >> 16) & 1u)) >> 16; }
__device__ __forceinline__ float bf2f(unsigned h) { return __uint_as_float(h << 16); }
__device__ __forceinline__ unsigned pk2(float lo, float hi) { unsigned r; asm("v_cvt_pk_bf16_f32 %0, %1, %2" : "=v"(r) : "v"(lo), "v"(hi)); return r; }
__device__ __forceinline__ float wave_sum(float v) {
#pragma unroll
    for (int o = 1; o < 64; o <<= 1) v += __shfl_xor(v, o);
    return v;
}
__device__ __forceinline__ float gelu_tanh(float x) {
    const float u = 1.5957691216057308f * (x + 0.044715f * x * x * x);
    return x / (1.0f + __expf(-u));
}
__device__ __forceinline__ float sigmoidf(float x) { return 1.0f / (1.0f + __expf(-x)); }

__global__ void __launch_bounds__(256) k_ada(const float* c, const float* ada_w, const float* ada_b, float* mod) {
    __shared__ float sc[8][1024];
    for (int i = threadIdx.x; i < 8192; i += 256) { const float v = c[i]; sc[i >> 10][i & 1023] = v / (1.0f + expf(-v)); }
    __syncthreads();
    const int n = blockIdx.x * 256 + threadIdx.x;
    float acc[8];
#pragma unroll
    for (int b = 0; b < 8; ++b) acc[b] = 0.f;
    for (int k = 0; k < 1024; ++k) {
        const float w = ada_w[(size_t)k * 6144 + n];
#pragma unroll
        for (int b = 0; b < 8; ++b) acc[b] += sc[b][k] * w;
    }
#pragma unroll
    for (int b = 0; b < 8; ++b) mod[b * 6144 + n] = acc[b] + ada_b[n];
}

__global__ void __launch_bounds__(256) k_transpose(const float* W, bf16_t* WT, int K, int N, int blk, int rstride, int rbase, size_t w_ms, size_t wt_ms) {
    __shared__ float tile[32][33];
    W += (size_t)blockIdx.z * w_ms; WT += (size_t)blockIdx.z * wt_ms;
    const int n0 = blockIdx.x * 32, k0 = blockIdx.y * 32, tx = threadIdx.x & 31, ty = threadIdx.x >> 5;
    for (int j = ty; j < 32; j += 8) tile[j][tx] = W[(size_t)(k0 + j) * N + n0 + tx];
    __syncthreads();
    for (int j = ty; j < 32; j += 8) { const int n = n0 + j; const int row = rbase + (n / blk) * rstride + (n % blk);
        WT[(size_t)row * K + k0 + tx] = (bf16_t)f2bf(tile[tx][j]); }
}

__global__ void __launch_bounds__(256) k_xn(const float* x, const float* g, const float* mod, bf16_t* XN) {
    const int row = blockIdx.x * 4 + (threadIdx.x >> 6), lane = threadIdx.x & 63, b = row / SEQ;
    const f32x4* xr = (const f32x4*)(x + (size_t)row * D);
    f32x4 v[4]; float ss = 0.f;
#pragma unroll
    for (int j = 0; j < 4; ++j) { v[j] = xr[lane + 64 * j]; ss += v[j][0] * v[j][0] + v[j][1] * v[j][1] + v[j][2] * v[j][2] + v[j][3] * v[j][3]; }
    ss = wave_sum(ss);
    const float rs = rsqrtf(ss * (1.0f / D) + EPS);
    const float* sh = mod + b * 6144; const float* sc = sh + 1024;
#pragma unroll
    for (int j = 0; j < 4; ++j) { const int col = 4 * (lane + 64 * j);
        const f32x4 gg = *(const f32x4*)(g + col), s1 = *(const f32x4*)(sc + col), s0 = *(const f32x4*)(sh + col);
        float h[4];
#pragma unroll
        for (int q = 0; q < 4; ++q) h[q] = v[j][q] * rs * gg[q] * (1.0f + s1[q]) + s0[q];
        u32x2 o; o.x = pk2(h[0], h[1]); o.y = pk2(h[2], h[3]);
        *(u32x2*)(XN + (size_t)row * D + col) = o; }
}

template <bool DUAL, class Epi>
__device__ __forceinline__ void sg_tile(const bf16_t* A, const int* arow, const bf16_t* Bt, const bf16_t* Bt2, int K, int m0, int n0, int lane, const Epi& epi) {
    const int fr = lane & 15, fq = lane >> 4;
    const bf16_t* pa[2]; const bf16_t* pb[4]; const bf16_t* pb2[4];
#pragma unroll
    for (int mi = 0; mi < 2; ++mi) { const int r = m0 + mi * 16 + fr; const int rr = arow ? arow[r] : r; pa[mi] = A + (size_t)rr * K + 8 * fq; }
#pragma unroll
    for (int ni = 0; ni < 4; ++ni) { pb[ni] = Bt + (size_t)(n0 + ni * 16 + fr) * K + 8 * fq; pb2[ni] = DUAL ? Bt2 + (size_t)(n0 + ni * 16 + fr) * K + 8 * fq : nullptr; }
    f32x4 acc[2][4], acc2[2][4];
#pragma unroll
    for (int mi = 0; mi < 2; ++mi)
#pragma unroll
        for (int ni = 0; ni < 4; ++ni) { acc[mi][ni] = (f32x4){0.f, 0.f, 0.f, 0.f}; acc2[mi][ni] = (f32x4){0.f, 0.f, 0.f, 0.f}; }
    for (int k0 = 0; k0 < K; k0 += 32) {
        bf16x8 a[2], b[4], b2[4];
#pragma unroll
        for (int mi = 0; mi < 2; ++mi) a[mi] = *(const bf16x8*)(pa[mi] + k0);
#pragma unroll
        for (int ni = 0; ni < 4; ++ni) { b[ni] = *(const bf16x8*)(pb[ni] + k0); if (DUAL) b2[ni] = *(const bf16x8*)(pb2[ni] + k0); }
#pragma unroll
        for (int mi = 0; mi < 2; ++mi)
#pragma unroll
            for (int ni = 0; ni < 4; ++ni) {
                acc[mi][ni] = __builtin_amdgcn_mfma_f32_16x16x32_bf16(b[ni], a[mi], acc[mi][ni], 0, 0, 0);
                if (DUAL) acc2[mi][ni] = __builtin_amdgcn_mfma_f32_16x16x32_bf16(b2[ni], a[mi], acc2[mi][ni], 0, 0, 0);
            }
    }
#pragma unroll
    for (int mi = 0; mi < 2; ++mi)
#pragma unroll
        for (int ni = 0; ni < 4; ++ni) epi(m0 + mi * 16 + fr, n0 + ni * 16 + 4 * fq, acc[mi][ni], acc2[mi][ni]);
}

struct EpiInProj { bf16_t* Z;
    __device__ __forceinline__ void operator()(int row, int col, f32x4 v, f32x4) const {
        if (col >= 512) { v[0] = gelu_tanh(v[0]); v[1] = gelu_tanh(v[1]); v[2] = gelu_tanh(v[2]); v[3] = gelu_tanh(v[3]); }
        u32x2 o; o.x = pk2(v[0], v[1]); o.y = pk2(v[2], v[3]); *(u32x2*)(Z + (size_t)row * 2048 + col) = o; } };
struct EpiOutProj { const float* x; const float* mod; bf16_t* X1;
    __device__ __forceinline__ void operator()(int row, int col, f32x4 v, f32x4) const {
        const int b = row / SEQ; const f32x4 xv = *(const f32x4*)(x + (size_t)row * D + col), g1 = *(const f32x4*)(mod + b * 6144 + 2048 + col);
        u32x2 o; o.x = pk2(xv[0] + g1[0] * v[0], xv[1] + g1[1] * v[1]); o.y = pk2(xv[2] + g1[2] * v[2], xv[3] + g1[3] * v[3]);
        *(u32x2*)(X1 + (size_t)row * D + col) = o; } };
struct EpiMoe1 { bf16_t* ACT;
    __device__ __forceinline__ void operator()(int row, int col, f32x4 g, f32x4 u) const {
        float a[4];
#pragma unroll
        for (int q = 0; q < 4; ++q) a[q] = g[q] / (1.0f + __expf(-g[q])) * u[q];
        u32x2 o; o.x = pk2(a[0], a[1]); o.y = pk2(a[2], a[3]); *(u32x2*)(ACT + (size_t)row * DE + col) = o; } };
struct EpiMoe2 { bf16_t* Y;
    __device__ __forceinline__ void operator()(int row, int col, f32x4 v, f32x4) const {
        u32x2 o; o.x = pk2(v[0], v[1]); o.y = pk2(v[2], v[3]); *(u32x2*)(Y + (size_t)row * D + col) = o; } };

template <class Epi>
__global__ void __launch_bounds__(256) k_sgemm(const bf16_t* A, const bf16_t* Bt, int M, int N, int K, Epi epi) {
    const int w = blockIdx.x * 4 + (threadIdx.x >> 6), lane = threadIdx.x & 63, nN = N / 64;
    const int mt = w / nN, nt = w % nN; if (mt * 32 >= M) return;
    sg_tile<false>(A, nullptr, Bt, nullptr, K, mt * 32, nt * 64, lane, epi);
}
__global__ void __launch_bounds__(256) k_moe1(const bf16_t* H2, const int* rowtok, const int* tbl, const bf16_t* W13, EpiMoe1 epi) {
    const int w = blockIdx.x * 4 + (threadIdx.x >> 6), lane = threadIdx.x & 63;
    const int mt = w / 8, nt = w % 8, tile = mt / 8;
    if (tile >= tbl[0]) return;
    const int e = tbl[64 + tile], n0 = nt * 64, q = n0 / 128, i0 = n0 % 128;
    const bf16_t* Wg = W13 + (size_t)e * 1024 * 1024 + (size_t)(256 * q + i0) * 1024 - (size_t)n0 * 1024;
    sg_tile<true>(H2, rowtok, Wg, Wg + (size_t)128 * 1024, 1024, mt * 32, n0, lane, epi);
}
__global__ void __launch_bounds__(256) k_moe2(const bf16_t* ACT, const int* tbl, const bf16_t* W2, EpiMoe2 epi) {
    const int w = blockIdx.x * 4 + (threadIdx.x >> 6), lane = threadIdx.x & 63;
    const int mt = w / 16, nt = w % 16, tile = mt / 8;
    if (tile >= tbl[0]) return;
    const int e = tbl[64 + tile];
    sg_tile<false>(ACT, nullptr, W2 + (size_t)e * 1024 * 512, nullptr, 512, mt * 32, nt * 64, lane, epi);
}

__global__ void __launch_bounds__(256) k_lnv(const bf16_t* Z, const float* g, const float* bb, bf16_t* VN) {
    const int row = blockIdx.x * 4 + (threadIdx.x >> 6), lane = threadIdx.x & 63;
    const u32x4 raw = *(const u32x4*)(Z + (size_t)row * 2048 + 1536 + 8 * lane);
    float v[8];
#pragma unroll
    for (int q = 0; q < 4; ++q) { v[2 * q] = bf2f(raw[q] & 0xffffu); v[2 * q + 1] = bf2f(raw[q] >> 16); }
    float s = 0.f;
#pragma unroll
    for (int q = 0; q < 8; ++q) s += v[q];
    const float mu = wave_sum(s) * (1.0f / 512.0f);
    float s2 = 0.f;
#pragma unroll
    for (int q = 0; q < 8; ++q) { v[q] -= mu; s2 += v[q] * v[q]; }
    const float rstd = rsqrtf(wave_sum(s2) * (1.0f / 512.0f) + EPS);
    u32x4 o;
#pragma unroll
    for (int q = 0; q < 4; ++q) { const int c = 8 * lane + 2 * q; o[q] = pk2(v[2 * q] * rstd * g[c] + bb[c], v[2 * q + 1] * rstd * g[c + 1] + bb[c + 1]); }
    *(u32x4*)(VN + (size_t)row * 512 + 8 * lane) = o;
}
__global__ void __launch_bounds__(256) k_sgu(const bf16_t* Z, const bf16_t* VN, const float* sgu_w, const float* sgu_b, bf16_t* YMIX) {
    const int idx = blockIdx.x * 256 + threadIdx.x, t = idx >> 9, ch = idx & 511, i = t & 127, blk = t >> 7, g = ch >> 6;
    const int jmax = (i < 64) ? 64 : 128;
    float s = sgu_b[g * 128 + i];
    const float* wrow = sgu_w + ((size_t)g * 128 + i) * 128;
    for (int j = 0; j < jmax; ++j) s += wrow[j] * bf2f(VN[((size_t)blk * 128 + j) * 512 + ch]);
    YMIX[(size_t)t * D + 512 + ch] = (bf16_t)f2bf(bf2f(Z[(size_t)t * 2048 + 1024 + ch]) * s);
}
__global__ void __launch_bounds__(256) k_conv(const bf16_t* Z, const float* cw, const float* cb, float* XC) {
    const int idx = blockIdx.x * 256 + threadIdx.x, t = idx >> 9, ch = idx & 511, pos = t & (SEQ - 1);
    float acc = cb[ch];
#pragma unroll
    for (int k = 0; k < 4; ++k) { const int d = k - 3; if (pos + d >= 0) acc += cw[k * 512 + ch] * bf2f(Z[(size_t)(t + d) * 2048 + ch]); }
    XC[idx] = acc;
}
__global__ void __launch_bounds__(256) k_gates(const float* XC, const float* wa, const float* ba, const float* wi, const float* bi, const float* lam, float* A_, float* U_) {
    const int idx = blockIdx.x * 256 + threadIdx.x, t = idx >> 9, ch = idx & 511, h = ch >> 6, e = ch & 63;
    const float* xrow = XC + (size_t)t * 512 + h * 64;
    float ra = ba[ch], ri = bi[ch];
    for (int d = 0; d < 64; ++d) { const float xv = xrow[d]; ra += xv * wa[h * 4096 + d * 64 + e]; ri += xv * wi[h * 4096 + d * 64 + e]; }
    const float r = sigmoidf(ra), ig = sigmoidf(ri);
    const float sp = log1pf(expf(-lam[ch]));
    const float log_a = -8.0f * r * sp;
    A_[idx] = expf(log_a);
    U_[idx] = sqrtf(-expm1f(2.0f * log_a)) * (ig * XC[idx]);
}
__global__ void __launch_bounds__(64) k_scan(const float* A_, const float* U_, const bf16_t* Z, bf16_t* YMIX) {
    const int idx = blockIdx.x * 64 + threadIdx.x, b = idx >> 9, ch = idx & 511;
    float h = 0.f;
    for (int p0 = 0; p0 < SEQ; p0 += 8) {
        float a[8], u[8], g[8];
#pragma unroll
        for (int q = 0; q < 8; ++q) { const size_t t = (size_t)b * SEQ + p0 + q; a[q] = A_[t * 512 + ch]; u[q] = U_[t * 512 + ch]; g[q] = bf2f(Z[t * 2048 + 512 + ch]); }
#pragma unroll
        for (int q = 0; q < 8; ++q) { const size_t t = (size_t)b * SEQ + p0 + q; h = a[q] * h + u[q]; YMIX[t * D + ch] = (bf16_t)f2bf(h * g[q]); }
    }
}

__global__ void __launch_bounds__(256) k_router(const bf16_t* X1, const float* g2w, const float* mod, const float* wg, const float* bg, const float* we, const float* be,
                                                bf16_t* H2, unsigned* cnt, int* list, int* toke, float* tokw, int* tokp) {
    const int row = blockIdx.x * 4 + (threadIdx.x >> 6), lane = threadIdx.x & 63, b = row / SEQ;
    float h[16]; float ss = 0.f;
#pragma unroll
    for (int jj = 0; jj < 2; ++jj) { const u32x4 raw = *(const u32x4*)(X1 + (size_t)row * D + 512 * jj + 8 * lane);
#pragma unroll
        for (int q = 0; q < 4; ++q) { h[8 * jj + 2 * q] = bf2f(raw[q] & 0xffffu); h[8 * jj + 2 * q + 1] = bf2f(raw[q] >> 16); } }
#pragma unroll
    for (int q = 0; q < 16; ++q) ss += h[q] * h[q];
    const float rs = rsqrtf(wave_sum(ss) * (1.0f / D) + EPS);
    const float* sh = mod + b * 6144 + 3072; const float* sc = sh + 1024;
#pragma unroll
    for (int jj = 0; jj < 2; ++jj) { u32x4 o;
#pragma unroll
        for (int q = 0; q < 4; ++q) { const int c = 512 * jj + 8 * lane + 2 * q;
            const float h0 = h[8 * jj + 2 * q] * rs * g2w[c] * (1.0f + sc[c]) + sh[c], h1 = h[8 * jj + 2 * q + 1] * rs * g2w[c + 1] * (1.0f + sc[c + 1]) + sh[c + 1];
            o[q] = pk2(h0, h1); h[8 * jj + 2 * q] = bf2f(o[q] & 0xffffu); h[8 * jj + 2 * q + 1] = bf2f(o[q] >> 16); }
        *(u32x4*)(H2 + (size_t)row * D + 512 * jj + 8 * lane) = o; }
    float gl[4], el[8];
#pragma unroll
    for (int j = 0; j < 4; ++j) { float p = 0.f;
#pragma unroll
        for (int q = 0; q < 16; ++q) { const int k = 512 * (q >> 3) + 8 * lane + (q & 7); p += h[q] * wg[k * 4 + j]; }
        gl[j] = wave_sum(p) + bg[j]; }
    int gs = 0; float gmax = gl[0];
#pragma unroll
    for (int j = 1; j < 4; ++j) if (gl[j] > gmax) { gmax = gl[j]; gs = j; }
#pragma unroll
    for (int j = 0; j < 8; ++j) { float p = 0.f;
#pragma unroll
        for (int q = 0; q < 16; ++q) { const int k = 512 * (q >> 3) + 8 * lane + (q & 7); p += h[q] * we[k * 32 + gs * 8 + j]; }
        el[j] = wave_sum(p) + be[gs * 8 + j]; }
    if (lane == 0) {
        float gsum = 0.f;
#pragma unroll
        for (int j = 0; j < 4; ++j) gsum += expf(gl[j] - gmax);
        const float pg = 1.0f / gsum;
        int i1 = 0; float m1 = el[0];
#pragma unroll
        for (int j = 1; j < 8; ++j) if (el[j] > m1) { m1 = el[j]; i1 = j; }
        int i2 = -1; float m2 = -INFINITY;
#pragma unroll
        for (int j = 0; j < 8; ++j) if (j != i1 && el[j] > m2) { m2 = el[j]; i2 = j; }
        const float r = expf(m2 - m1);
        const float w1 = pg / (1.0f + r), w2 = pg * r / (1.0f + r);
        const int e1 = gs * 8 + i1, e2 = gs * 8 + i2;
        const unsigned p1 = atomicAdd(cnt + CNT_STRIDE * e1, 1u), p2 = atomicAdd(cnt + CNT_STRIDE * e2, 1u);
        list[(size_t)e1 * LISTCAP + p1] = row; list[(size_t)e2 * LISTCAP + p2] = row;
        toke[2 * row] = e1; toke[2 * row + 1] = e2; tokw[2 * row] = w1; tokw[2 * row + 1] = w2; tokp[2 * row] = (int)p1; tokp[2 * row + 1] = (int)p2;
    }
}
__global__ void k_table(const unsigned* cnt, int* tbl) {
    if (threadIdx.x == 0) { int p = 0;
        for (int e = 0; e < NE; ++e) { tbl[1 + e] = p; const int nt = ((int)cnt[CNT_STRIDE * e] + 255) / 256; for (int j = 0; j < nt; ++j) tbl[64 + p + j] = e; p += nt; }
        tbl[1 + NE] = p; tbl[0] = p; }
}
__global__ void __launch_bounds__(256) k_rowtok(const unsigned* cnt, const int* tbl, const int* list, int* rowtok) {
    const int p = blockIdx.x * 256 + threadIdx.x, t = p >> 8; int tok = 0;
    if (t < tbl[0]) { const int e = tbl[64 + t], pos = (t - tbl[1 + e]) * 256 + (p & 255); if (pos < (int)cnt[CNT_STRIDE * e]) tok = list[(size_t)e * LISTCAP + pos]; }
    rowtok[p] = tok;
}
__global__ void __launch_bounds__(256) k_combine(const bf16_t* X1, const bf16_t* Y, const float* mod, const int* tbl, const int* toke, const float* tokw, const int* tokp, const float* fg, float* out) {
    const int row = blockIdx.x * 4 + (threadIdx.x >> 6), lane = threadIdx.x & 63, b = row / SEQ;
    const int e0 = toke[2 * row], e1 = toke[2 * row + 1];
    const size_t q0 = (size_t)tbl[1 + e0] * 256 + tokp[2 * row], q1 = (size_t)tbl[1 + e1] * 256 + tokp[2 * row + 1];
    const float w0 = tokw[2 * row], w1 = tokw[2 * row + 1];
    const float* g2 = mod + b * 6144 + 5120;
    float v[16]; float ss = 0.f;
#pragma unroll
    for (int jj = 0; jj < 2; ++jj) { const int c0 = 512 * jj + 8 * lane;
        const u32x4 xr = *(const u32x4*)(X1 + (size_t)row * D + c0), ya = *(const u32x4*)(Y + q0 * D + c0), yb = *(const u32x4*)(Y + q1 * D + c0);
#pragma unroll
        for (int q = 0; q < 4; ++q) {
            const float x0 = bf2f(xr[q] & 0xffffu), x1 = bf2f(xr[q] >> 16);
            const float y0 = w0 * bf2f(ya[q] & 0xffffu) + w1 * bf2f(yb[q] & 0xffffu), y1 = w0 * bf2f(ya[q] >> 16) + w1 * bf2f(yb[q] >> 16);
            v[8 * jj + 2 * q] = x0 + g2[c0 + 2 * q] * y0; v[8 * jj + 2 * q + 1] = x1 + g2[c0 + 2 * q + 1] * y1; } }
#pragma unroll
    for (int q = 0; q < 16; ++q) ss += v[q] * v[q];
    const float rs = rsqrtf(wave_sum(ss) * (1.0f / D) + EPS);
#pragma unroll
    for (int jj = 0; jj < 2; ++jj) { const int c0 = 512 * jj + 8 * lane;
        f32x4 o0, o1;
#pragma unroll
        for (int q = 0; q < 4; ++q) { o0[q] = v[8 * jj + q] * rs * fg[c0 + q]; o1[q] = v[8 * jj + 4 + q] * rs * fg[c0 + 4 + q]; }
        *(f32x4*)(out + (size_t)row * D + c0) = o0; *(f32x4*)(out + (size_t)row * D + c0 + 4) = o1; }
}

namespace pg8 {
#define PG8_LAS __attribute__((address_space(3)))
constexpr int BM = 256, BK = 64, HALF = 128, HTB = HALF * BK * 2  , STAGE_BYTES = 8 * HTB, NXCD = 8, WGM = 8;
__host__ __device__ __forceinline__ int lds_byte(int r, int c) { const int st = (r >> 4) * 2 + (c >> 5), rr = r & 15, cc = c & 31, ob = rr * 64 + cc * 2; return st * 1024 + (ob ^ (((ob >> 9) & 1) << 5)); }
__host__ __device__ __forceinline__ void stage_rc(int b, int& R, int& C) { const int st = b / 1024, sb = b % 1024, swz = sb ^ (((sb >> 9) & 1) << 5); R = (st >> 1) * 16 + swz / 64; C = (st & 1) * 32 + (swz % 64) / 2; }
__host__ __device__ __forceinline__ int perm32(int rho) { const int n = rho >> 4, i = rho & 15; return 8 * (i >> 2) + 4 * n + (i & 3); }

struct Unit { int pm, pn, e; };
struct Gemm { const void* A; const void* Bt; int Kb; };
__host__ __device__ __forceinline__ int lds_byte8(int r, int piece) { return (r >> 4) * 2048 + piece * 256 + (r & 15) * 16; }
__host__ __device__ __forceinline__ void stage_rc8(int b, int& R, int& Cb) { R = (b / 2048) * 16 + (b % 256) / 16; Cb = ((b % 2048) / 256) * 16; }
typedef int v8i32 __attribute__((ext_vector_type(8)));
typedef int v4i32 __attribute__((ext_vector_type(4)));

struct StaticOrder {
    int nM, nN, nwg, G, c; size_t tstep;
    __device__ void init(int M, int N, int Kb, int G_, int c_) { nM = M / BM; nN = N / BM; nwg = nM * nN; G = G_; c = c_; tstep = (size_t)BM * Kb; }
    __device__ bool next(int i, Unit& u) const {
        const long L = (long)i * G + c; if (L >= nwg) return false;
        int wgid = (int)L; { const int q = nwg / NXCD, r = nwg % NXCD, xcd = wgid % NXCD, off = wgid / NXCD; wgid = (xcd < r ? xcd * (q + 1) : r * (q + 1) + (xcd - r) * q) + off; }
        const int nig = WGM * nN, gid = wgid / nig, fm = gid * WGM, gsz = (nM - fm) < WGM ? (nM - fm) : WGM;
        u.pm = fm + ((wgid % nig) % gsz); u.pn = (wgid % nig) / gsz; u.e = 0; return true;
    }
    __device__ __forceinline__ size_t a_off(const Unit& u) const { return (size_t)u.pm * tstep; }
    __device__ __forceinline__ size_t b_off(const Unit& u) const { return (size_t)u.pn * tstep; }
    PG8_LAS unsigned char* tokt;
    __device__ __forceinline__ const int* tok_src(const Unit&, int) const { return nullptr; }
};
struct SplitOrder : StaticOrder {
    int nA, upa, cls, idx, nB;
    __device__ void init2(int M, int N, int Kb, int nA_, int nB_, int upa_, int cls_, int idx_) { init(M, N, Kb, 1, 0); nA = nA_; nB = nB_; upa = upa_; cls = cls_; idx = idx_; }
    __device__ bool next(int i, Unit& u) const {
        long L; if (cls == 0) { if (i >= upa) return false; L = (long)i * nA + idx; } else { L = (long)upa * nA + (long)i * nB + idx; }
        if (L >= nwg) return false;
        int wgid = (int)L; { const int q = nwg / NXCD, r = nwg % NXCD, xcd = wgid % NXCD, off = wgid / NXCD; wgid = (xcd < r ? xcd * (q + 1) : r * (q + 1) + (xcd - r) * q) + off; }
        const int nig = WGM * nN, gid = wgid / nig, fm = gid * WGM, gsz = (nM - fm) < WGM ? (nM - fm) : WGM;
        u.pm = fm + ((wgid % nig) % gsz); u.pn = (wgid % nig) / gsz; u.e = 0; return true;
    }
};
struct MoeOrder {
    int nunits, G, c, Kb; size_t estride;
    const PG8_LAS int* tile_e; const PG8_LAS int* p0; const PG8_LAS int* cnt; const int* list; bool gather;
    __device__ bool next(int i, Unit& u) const {
        const int L = i * G + c; if (L >= nunits) return false;
        u.pm = L >> 2; u.pn = L & 3; u.e = tile_e[u.pm]; return true;
    }
    __device__ __forceinline__ size_t a_off(const Unit& u) const { return gather ? (size_t)0 : (size_t)u.pm * BM * Kb; }
    __device__ __forceinline__ size_t b_off(const Unit& u) const { return (size_t)u.e * estride + (size_t)u.pn * BM * Kb; }
    PG8_LAS unsigned char* tokt;
    __device__ __forceinline__ const int* tok_src(const Unit& u, int r) const {
        const int pos = (u.pm - p0[u.e]) * 256 + r, last = cnt[u.e] - 1;
        return list + (size_t)u.e * LISTCAP + (pos < last ? pos : last);
    }
};

__device__ __forceinline__ unsigned cvt_pk_bf16(float lo, float hi) { unsigned r; asm volatile("v_cvt_pk_bf16_f32 %0, %1, %2" : "=v"(r) : "v"(lo), "v"(hi)); return r; }
__device__ __forceinline__ float gelu_fast(float x) {
    const float u = -2.3022082f * (x + 0.044715f * x * x * x);
    return x * __builtin_amdgcn_rcpf(1.0f + __builtin_amdgcn_exp2f(u));
}
__device__ __forceinline__ float silu_fast(float x) { return x * __builtin_amdgcn_rcpf(1.0f + __builtin_amdgcn_exp2f(-1.4426950408889634f * x)); }

struct EpiZ { static constexpr bool PERM = true; bf16_t* Z;
    __device__ __forceinline__ void operator()(const f32x4 (&acc)[2][2][4][2], const Unit& u, int wr, int wc, int fr, int fq) const {
        const int row0 = u.pm * BM + wr * 64 + fr, col0 = u.pn * BM + wc * 32 + 8 * fq; const bool act = u.pn >= 2;
#pragma unroll
        for (int ai = 0; ai < 2; ++ai)
#pragma unroll
            for (int m = 0; m < 4; ++m) { bf16_t* rowp = Z + (size_t)(row0 + ai * HALF + m * 16) * 2048 + col0;
#pragma unroll
                for (int bj = 0; bj < 2; ++bj) { f32x4 v0 = acc[ai][bj][m][0], v1 = acc[ai][bj][m][1];
                    if (act) {
#pragma unroll
                        for (int q = 0; q < 4; ++q) { v0[q] = gelu_fast(v0[q]); v1[q] = gelu_fast(v1[q]); } }
                    u32x4 w; w.x = cvt_pk_bf16(v0[0], v0[1]); w.y = cvt_pk_bf16(v0[2], v0[3]); w.z = cvt_pk_bf16(v1[0], v1[1]); w.w = cvt_pk_bf16(v1[2], v1[3]);
                    *(u32x4*)(rowp + bj * HALF) = w; } }
    }
};
struct EpiX1 { static constexpr bool PERM = true; const float* x; const float* mod; bf16_t* X1;
    __device__ __forceinline__ void operator()(const f32x4 (&acc)[2][2][4][2], const Unit& u, int wr, int wc, int fr, int fq) const {
        const int row0 = u.pm * BM + wr * 64 + fr, col0 = u.pn * BM + wc * 32 + 8 * fq; const int b = (u.pm * BM) / SEQ;
        const float* g1 = mod + b * 6144 + 2048 + col0;
        f32x4 gv[2][2];
#pragma unroll
        for (int bj = 0; bj < 2; ++bj) { gv[bj][0] = *(const f32x4*)(g1 + bj * HALF); gv[bj][1] = *(const f32x4*)(g1 + bj * HALF + 4); }
#pragma unroll
        for (int ai = 0; ai < 2; ++ai)
#pragma unroll
            for (int m = 0; m < 4; ++m) { const size_t off = (size_t)(row0 + ai * HALF + m * 16) * D + col0;
#pragma unroll
                for (int bj = 0; bj < 2; ++bj) { const f32x4 x0 = *(const f32x4*)(x + off + bj * HALF), x1 = *(const f32x4*)(x + off + bj * HALF + 4);
                    const f32x4 v0 = x0 + gv[bj][0] * acc[ai][bj][m][0], v1 = x1 + gv[bj][1] * acc[ai][bj][m][1];
                    u32x4 w; w.x = cvt_pk_bf16(v0[0], v0[1]); w.y = cvt_pk_bf16(v0[2], v0[3]); w.z = cvt_pk_bf16(v1[0], v1[1]); w.w = cvt_pk_bf16(v1[2], v1[3]);
                    *(u32x4*)(X1 + off + bj * HALF) = w; } }
    }
};
struct EpiAct { static constexpr bool PERM = true; bf16_t* ACT;
    __device__ __forceinline__ void operator()(const f32x4 (&acc)[2][2][4][2], const Unit& u, int wr, int wc, int fr, int fq) const {
        const int row0 = u.pm * BM + wr * 64 + fr, col0 = u.pn * HALF + wc * 32 + 8 * fq;
#pragma unroll
        for (int ai = 0; ai < 2; ++ai)
#pragma unroll
            for (int m = 0; m < 4; ++m) { f32x4 v0, v1;
#pragma unroll
                for (int q = 0; q < 4; ++q) { v0[q] = silu_fast(acc[ai][0][m][0][q]) * acc[ai][1][m][0][q]; v1[q] = silu_fast(acc[ai][0][m][1][q]) * acc[ai][1][m][1][q]; }
                u32x4 w; w.x = cvt_pk_bf16(v0[0], v0[1]); w.y = cvt_pk_bf16(v0[2], v0[3]); w.z = cvt_pk_bf16(v1[0], v1[1]); w.w = cvt_pk_bf16(v1[2], v1[3]);
                *(u32x4*)(ACT + (size_t)(row0 + ai * HALF + m * 16) * DE + col0) = w; }
    }
};
__device__ __forceinline__ unsigned pk4_fp8(float a, float b, float c, float d) {
    a = __builtin_fminf(__builtin_fmaxf(a, -448.f), 448.f); b = __builtin_fminf(__builtin_fmaxf(b, -448.f), 448.f);
    c = __builtin_fminf(__builtin_fmaxf(c, -448.f), 448.f); d = __builtin_fminf(__builtin_fmaxf(d, -448.f), 448.f);
    unsigned w = 0u; w = __builtin_amdgcn_cvt_pk_fp8_f32(a, b, w, false); w = __builtin_amdgcn_cvt_pk_fp8_f32(c, d, w, true); return w; }
struct EpiAct8 { static constexpr bool PERM = true; unsigned char* ACT; float inv, oscale;
    __device__ __forceinline__ void operator()(const f32x4 (&acc)[2][2][4][2], const Unit& u, int wr, int wc, int fr, int fq) const {
        const int row0 = u.pm * BM + wr * 64 + fr, col0 = u.pn * HALF + wc * 32 + 8 * fq; const float io = inv * oscale;
#pragma unroll
        for (int ai = 0; ai < 2; ++ai)
#pragma unroll
            for (int m = 0; m < 4; ++m) { f32x4 v0, v1;
#pragma unroll
                for (int q = 0; q < 4; ++q) { v0[q] = silu_fast(acc[ai][0][m][0][q] * inv) * (acc[ai][1][m][0][q] * io); v1[q] = silu_fast(acc[ai][0][m][1][q] * inv) * (acc[ai][1][m][1][q] * io); }
                u32x2 w; w.x = pk4_fp8(v0[0], v0[1], v0[2], v0[3]); w.y = pk4_fp8(v1[0], v1[1], v1[2], v1[3]);
                *(u32x2*)(ACT + (size_t)(row0 + ai * HALF + m * 16) * DE + col0) = w; }
    }
};
struct EpiY8 { static constexpr bool PERM = true; unsigned char* Y; float sc;
    __device__ __forceinline__ void operator()(const f32x4 (&acc)[2][2][4][2], const Unit& u, int wr, int wc, int fr, int fq) const {
        const int row0 = u.pm * BM + wr * 64 + fr, col0 = u.pn * BM + wc * 32 + 8 * fq;
#pragma unroll
        for (int ai = 0; ai < 2; ++ai)
#pragma unroll
            for (int m = 0; m < 4; ++m) { unsigned char* rowp = Y + (size_t)(row0 + ai * HALF + m * 16) * D + col0;
#pragma unroll
                for (int bj = 0; bj < 2; ++bj) { const f32x4 v0 = acc[ai][bj][m][0] * sc, v1 = acc[ai][bj][m][1] * sc;
                    u32x2 w; w.x = pk4_fp8(v0[0], v0[1], v0[2], v0[3]); w.y = pk4_fp8(v1[0], v1[1], v1[2], v1[3]);
                    *(u32x2*)(rowp + bj * HALF) = w; } }
    }
};
struct EpiY { static constexpr bool PERM = true; bf16_t* Y;
    __device__ __forceinline__ void operator()(const f32x4 (&acc)[2][2][4][2], const Unit& u, int wr, int wc, int fr, int fq) const {
        const int row0 = u.pm * BM + wr * 64 + fr, col0 = u.pn * BM + wc * 32 + 8 * fq;
#pragma unroll
        for (int ai = 0; ai < 2; ++ai)
#pragma unroll
            for (int m = 0; m < 4; ++m) { bf16_t* rowp = Y + (size_t)(row0 + ai * HALF + m * 16) * D + col0;
#pragma unroll
                for (int bj = 0; bj < 2; ++bj) { const f32x4 v0 = acc[ai][bj][m][0], v1 = acc[ai][bj][m][1];
                    u32x4 w; w.x = cvt_pk_bf16(v0[0], v0[1]); w.y = cvt_pk_bf16(v0[2], v0[3]); w.z = cvt_pk_bf16(v1[0], v1[1]); w.w = cvt_pk_bf16(v1[2], v1[3]);
                    *(u32x4*)(rowp + bj * HALF) = w; } }
    }
};

template <class Epi, class Sched, bool ALIGN_EPI, bool GATHER, bool FP8>
__device__ __forceinline__ void gemm_phase(PG8_LAS unsigned char* lds, const Gemm g, const Sched& S, const Epi& E) {
    const int tid = threadIdx.x, wid = __builtin_amdgcn_readfirstlane(tid >> 6), lane = tid & 63, wr = wid >> 2, wc = wid & 3, fr = lane & 15, fq = lane >> 4;
    const int Kb = g.Kb, nt = Kb / (BK * 2);
    unsigned voffA[2], voffB[2]; int Ra[2];
#pragma unroll
    for (int i = 0; i < 2; ++i) { int R, Cb; if (FP8) stage_rc8(tid * 16 + i * 8192, R, Cb); else { stage_rc(tid * 16 + i * 8192, R, Cb); Cb *= 2; }
        const int Rb = Epi::PERM ? ((R & ~31) + perm32(R & 31)) : R;
        Ra[i] = R; voffA[i] = GATHER ? (unsigned)Cb : (unsigned)(R * Kb + Cb); voffB[i] = (unsigned)(Rb * Kb + Cb); }
    const size_t kstep = (size_t)(BK * 2);
    const size_t hstep = (size_t)HALF * Kb;
    const size_t hstepA = GATHER ? (size_t)0 : hstep;
    const unsigned ldsw = (unsigned)wid * 1024u;
    const int aoff = FP8 ? lds_byte8(wr * 64 + fr, 2 * fq) : lds_byte(wr * 64 + fr, fq * 8), boff = FP8 ? lds_byte8(wc * 32 + fr, 2 * fq) : lds_byte(wc * 32 + fr, fq * 8);
#define PG8_SA(b, h) (((b) * 2 + (h)) * HTB)
#define PG8_SB(b, h) ((4 + (b) * 2 + (h)) * HTB)
#define PG8_STAGE(bufoff, gbase, voff) do { _Pragma("unroll") for (int _i = 0; _i < 2; ++_i) \
        __builtin_amdgcn_global_load_lds((const unsigned*)((const char*)(gbase) + (voff)[_i]), (PG8_LAS unsigned*)(lds + (bufoff) + ldsw + _i * 8192), 16, 0, 0); } while (0)
#define PG8_STAGE_A(bufoff, kbase, h) do { _Pragma("unroll") for (int _i = 0; _i < 2; ++_i) \
        __builtin_amdgcn_global_load_lds((const unsigned*)((const char*)(kbase) + (size_t)(h) * hstepA + (GATHER ? gC[h][_i] : 0u) + voffA[_i]), (PG8_LAS unsigned*)(lds + (bufoff) + ldsw + _i * 8192), 16, 0, 0); } while (0)
#define PG8_LD16(off) (*(const PG8_LAS v4i32*)(lds + (off)))
#define PG8_LDA(dst, b, h) do { _Pragma("unroll") for (int m = 0; m < 4; ++m) { if constexpr (FP8) dst##8[m] = __builtin_shufflevector(PG8_LD16(PG8_SA(b, h) + aoff + m * 2048), PG8_LD16(PG8_SA(b, h) + aoff + m * 2048 + 256), 0, 1, 2, 3, 4, 5, 6, 7); \
        else { _Pragma("unroll") for (int k = 0; k < 2; ++k) dst[m][k] = *(const PG8_LAS bf16x8*)(lds + PG8_SA(b, h) + aoff + m * 2048 + k * 1024); } } } while (0)
#define PG8_LDB(dst, b, h) do { _Pragma("unroll") for (int n = 0; n < 2; ++n) { if constexpr (FP8) dst##8[n] = __builtin_shufflevector(PG8_LD16(PG8_SB(b, h) + boff + n * 2048), PG8_LD16(PG8_SB(b, h) + boff + n * 2048 + 256), 0, 1, 2, 3, 4, 5, 6, 7); \
        else { _Pragma("unroll") for (int k = 0; k < 2; ++k) dst[n][k] = *(const PG8_LAS bf16x8*)(lds + PG8_SB(b, h) + boff + n * 2048 + k * 1024); } } } while (0)
#define PG8_MMA(ai, bj, At, Bt, ZF) do { __builtin_amdgcn_s_setprio(1); _Pragma("unroll") for (int m = 0; m < 4; ++m) _Pragma("unroll") for (int n = 0; n < 2; ++n) { \
        if constexpr (FP8) { if constexpr (ZF) asm volatile("v_mfma_f32_16x16x128_f8f6f4 %0, %1, %2, 0" : "=v"(acc[ai][bj][m][n]) : "v"(Bt##8[n]), "v"(At##8[m])); \
                             else asm volatile("v_mfma_f32_16x16x128_f8f6f4 %0, %1, %2, %0" : "+v"(acc[ai][bj][m][n]) : "v"(Bt##8[n]), "v"(At##8[m])); } \
        else { acc[ai][bj][m][n] = __builtin_amdgcn_mfma_f32_16x16x32_bf16(Bt[n][0], At[m][0], ZF ? (f32x4){0.f, 0.f, 0.f, 0.f} : acc[ai][bj][m][n], 0, 0, 0); \
               acc[ai][bj][m][n] = __builtin_amdgcn_mfma_f32_16x16x32_bf16(Bt[n][1], At[m][1], acc[ai][bj][m][n], 0, 0, 0); } } \
        __builtin_amdgcn_s_setprio(0); } while (0)
#define PG8_WAIT_V(n) asm volatile("s_waitcnt vmcnt(" #n ")" ::: "memory")
#define PG8_WAIT_L(n) asm volatile("s_waitcnt lgkmcnt(" #n ")" ::: "memory")
#define PG8_BAR __builtin_amdgcn_s_barrier()
#define PG8_SCHED __builtin_amdgcn_sched_barrier(0)
    Unit cur, nxt; int ui = 0;
    if (!S.next(0, cur)) return;
    f32x4 acc[2][2][4][2];
    bf16x8 At[4][2], B0[2][2], B1[2][2]; v8i32 At8[4], B08[2], B18[2];
#define PG8_TOK_ISSUE(u_, slot_) do { if (wid < 4) __builtin_amdgcn_global_load_lds((const unsigned*)S.tok_src(u_, tid), (PG8_LAS unsigned*)(S.tokt + (slot_) * 1024 + wid * 256), 4, 0, 0); } while (0)
#define PG8_TOK_READ(slot_) do { _Pragma("unroll") for (int h = 0; h < 2; ++h) _Pragma("unroll") for (int i = 0; i < 2; ++i) \
        gC[h][i] = *(const PG8_LAS unsigned*)(S.tokt + (slot_) * 1024 + (h * HALF + Ra[i]) * 4) * (unsigned)Kb; } while (0)
    unsigned gC[2][2];
#pragma unroll
    for (int h = 0; h < 2; ++h)
#pragma unroll
        for (int i = 0; i < 2; ++i) gC[h][i] = 0u;
    if constexpr (GATHER) { PG8_TOK_ISSUE(cur, 0); PG8_WAIT_V(0); PG8_BAR; PG8_TOK_READ(0); }
    const char* cA = (const char*)g.A + S.a_off(cur); const char* cB = (const char*)g.Bt + S.b_off(cur);
    PG8_STAGE(PG8_SB(0, 0), cB, voffB); PG8_STAGE(PG8_SB(0, 1), cB + hstep, voffB); PG8_STAGE_A(PG8_SA(0, 0), cA, 0); PG8_STAGE_A(PG8_SA(0, 1), cA, 1);
    if (wr == 1) PG8_BAR;
    PG8_WAIT_V(2); PG8_BAR;
    PG8_STAGE(PG8_SB(1, 0), cB + kstep, voffB); PG8_STAGE_A(PG8_SA(1, 0), cA + kstep, 0); PG8_STAGE(PG8_SB(1, 1), cB + hstep + kstep, voffB);
    PG8_WAIT_V(6); PG8_BAR;
    for (;;) {
        const bool has_next = S.next(ui + 1, nxt);
        const char* nA = has_next ? (const char*)g.A + S.a_off(nxt) : cA; const char* nB = has_next ? (const char*)g.Bt + S.b_off(nxt) : cB;
        if constexpr (GATHER) { if (has_next) PG8_TOK_ISSUE(nxt, (ui + 1) & 1); }
        if constexpr (FP8) {
        { constexpr bool ZF = true; const int t = 0;
            const bool last = (t == nt - 2);
            const char* a1 = cA + (size_t)(t + 1) * kstep;
            const char* a2 = last ? nA : cA + (size_t)(t + 2) * kstep; const char* b2 = last ? nB : cB + (size_t)(t + 2) * kstep;
            const char* a3 = a2 + kstep; const char* b3 = b2 + kstep;
            PG8_LDB(B0, 0, 0); PG8_LDB(B1, 0, 1); PG8_SCHED; PG8_LDA(At, 0, 0); PG8_STAGE_A(PG8_SA(1, 1), a1, 1);
            PG8_WAIT_V(8); PG8_WAIT_L(0); PG8_BAR; PG8_MMA(0, 0, At, B0, ZF); PG8_MMA(0, 1, At, B1, ZF); PG8_BAR; PG8_SCHED;
            if constexpr (GATHER) { if (last && has_next) PG8_TOK_READ((ui + 1) & 1); }
            PG8_LDA(At, 0, 1); PG8_STAGE(PG8_SB(0, 0), b2, voffB); PG8_STAGE(PG8_SB(0, 1), b2 + hstep, voffB); PG8_STAGE_A(PG8_SA(0, 0), a2, 0);
            PG8_WAIT_V(8); PG8_WAIT_L(0); PG8_BAR; PG8_MMA(1, 0, At, B0, ZF); PG8_MMA(1, 1, At, B1, ZF); PG8_BAR; PG8_SCHED;
            PG8_LDB(B0, 1, 0); PG8_LDB(B1, 1, 1); PG8_SCHED; PG8_LDA(At, 1, 0); PG8_STAGE_A(PG8_SA(0, 1), a2, 1);
            PG8_WAIT_V(8); PG8_WAIT_L(0); PG8_BAR; PG8_MMA(0, 0, At, B0, false); PG8_MMA(0, 1, At, B1, false); PG8_BAR; PG8_SCHED;
            PG8_LDA(At, 1, 1); PG8_STAGE(PG8_SB(1, 0), b3, voffB); PG8_STAGE(PG8_SB(1, 1), b3 + hstep, voffB); PG8_STAGE_A(PG8_SA(1, 0), a3, 0);
            PG8_WAIT_V(8); PG8_WAIT_L(0); PG8_BAR; PG8_MMA(1, 0, At, B0, false); PG8_MMA(1, 1, At, B1, false); PG8_BAR; PG8_SCHED;
                }
#pragma unroll 1
        for (int t = 2; t < nt; t += 2) { constexpr bool ZF = false;
            const bool last = (t == nt - 2);
            const char* a1 = cA + (size_t)(t + 1) * kstep;
            const char* a2 = last ? nA : cA + (size_t)(t + 2) * kstep; const char* b2 = last ? nB : cB + (size_t)(t + 2) * kstep;
            const char* a3 = a2 + kstep; const char* b3 = b2 + kstep;
            PG8_LDB(B0, 0, 0); PG8_LDB(B1, 0, 1); PG8_SCHED; PG8_LDA(At, 0, 0); PG8_STAGE_A(PG8_SA(1, 1), a1, 1);
            PG8_WAIT_V(8); PG8_WAIT_L(0); PG8_BAR; PG8_MMA(0, 0, At, B0, ZF); PG8_MMA(0, 1, At, B1, ZF); PG8_BAR; PG8_SCHED;
            if constexpr (GATHER) { if (last && has_next) PG8_TOK_READ((ui + 1) & 1); }
            PG8_LDA(At, 0, 1); PG8_STAGE(PG8_SB(0, 0), b2, voffB); PG8_STAGE(PG8_SB(0, 1), b2 + hstep, voffB); PG8_STAGE_A(PG8_SA(0, 0), a2, 0);
            PG8_WAIT_V(8); PG8_WAIT_L(0); PG8_BAR; PG8_MMA(1, 0, At, B0, ZF); PG8_MMA(1, 1, At, B1, ZF); PG8_BAR; PG8_SCHED;
            PG8_LDB(B0, 1, 0); PG8_LDB(B1, 1, 1); PG8_SCHED; PG8_LDA(At, 1, 0); PG8_STAGE_A(PG8_SA(0, 1), a2, 1);
            PG8_WAIT_V(8); PG8_WAIT_L(0); PG8_BAR; PG8_MMA(0, 0, At, B0, false); PG8_MMA(0, 1, At, B1, false); PG8_BAR; PG8_SCHED;
            PG8_LDA(At, 1, 1); PG8_STAGE(PG8_SB(1, 0), b3, voffB); PG8_STAGE(PG8_SB(1, 1), b3 + hstep, voffB); PG8_STAGE_A(PG8_SA(1, 0), a3, 0);
            PG8_WAIT_V(8); PG8_WAIT_L(0); PG8_BAR; PG8_MMA(1, 0, At, B0, false); PG8_MMA(1, 1, At, B1, false); PG8_BAR; PG8_SCHED;
                }
        } else {
#pragma unroll
        for (int a = 0; a < 2; ++a)
#pragma unroll
            for (int b = 0; b < 2; ++b)
#pragma unroll
                for (int m = 0; m < 4; ++m)
#pragma unroll
                    for (int n = 0; n < 2; ++n) acc[a][b][m][n] = (f32x4){0.f, 0.f, 0.f, 0.f};
#pragma unroll 1
        for (int t = 0; t < nt; t += 2) { constexpr bool ZF = false;
            const bool last = (t == nt - 2);
            const char* a1 = cA + (size_t)(t + 1) * kstep;
            const char* a2 = last ? nA : cA + (size_t)(t + 2) * kstep; const char* b2 = last ? nB : cB + (size_t)(t + 2) * kstep;
            const char* a3 = a2 + kstep; const char* b3 = b2 + kstep;
            PG8_LDB(B0, 0, 0); PG8_LDB(B1, 0, 1); PG8_SCHED; PG8_LDA(At, 0, 0); PG8_STAGE_A(PG8_SA(1, 1), a1, 1);
            PG8_WAIT_V(8); PG8_WAIT_L(0); PG8_BAR; PG8_MMA(0, 0, At, B0, ZF); PG8_MMA(0, 1, At, B1, ZF); PG8_BAR; PG8_SCHED;
            if constexpr (GATHER) { if (last && has_next) PG8_TOK_READ((ui + 1) & 1); }
            PG8_LDA(At, 0, 1); PG8_STAGE(PG8_SB(0, 0), b2, voffB); PG8_STAGE(PG8_SB(0, 1), b2 + hstep, voffB); PG8_STAGE_A(PG8_SA(0, 0), a2, 0);
            PG8_WAIT_V(8); PG8_WAIT_L(0); PG8_BAR; PG8_MMA(1, 0, At, B0, ZF); PG8_MMA(1, 1, At, B1, ZF); PG8_BAR; PG8_SCHED;
            PG8_LDB(B0, 1, 0); PG8_LDB(B1, 1, 1); PG8_SCHED; PG8_LDA(At, 1, 0); PG8_STAGE_A(PG8_SA(0, 1), a2, 1);
            PG8_WAIT_V(8); PG8_WAIT_L(0); PG8_BAR; PG8_MMA(0, 0, At, B0, false); PG8_MMA(0, 1, At, B1, false); PG8_BAR; PG8_SCHED;
            PG8_LDA(At, 1, 1); PG8_STAGE(PG8_SB(1, 0), b3, voffB); PG8_STAGE(PG8_SB(1, 1), b3 + hstep, voffB); PG8_STAGE_A(PG8_SA(1, 0), a3, 0);
            PG8_WAIT_V(8); PG8_WAIT_L(0); PG8_BAR; PG8_MMA(1, 0, At, B0, false); PG8_MMA(1, 1, At, B1, false); PG8_BAR; PG8_SCHED;
                }
        }
        if constexpr (ALIGN_EPI) { if (wr == 0) PG8_BAR; }
        if constexpr (FP8) asm volatile("s_nop 15\n\ts_nop 15" ::: "memory");
        E(acc, cur, wr, wc, fr, fq);
        if (!has_next) break;
        cur = nxt; cA = nA; cB = nB; ++ui;
        if constexpr (ALIGN_EPI) { if (wr == 1) PG8_BAR; }
    }
    PG8_WAIT_V(0);
    if constexpr (!ALIGN_EPI) { if (wr == 0) PG8_BAR; }
    PG8_BAR;
#undef PG8_SA
#undef PG8_SB
#undef PG8_STAGE
#undef PG8_STAGE_A
#undef PG8_TOK_ISSUE
#undef PG8_TOK_READ
#undef PG8_LDA
#undef PG8_LDB
#undef PG8_MMA
#undef PG8_LD16
#undef PG8_WAIT_V
#undef PG8_WAIT_L
#undef PG8_BAR
#undef PG8_SCHED
}
}
#define LAS __attribute__((address_space(3)))
#define GAS __attribute__((address_space(1)))
constexpr int NWAVES = 8, NTHREADS = 512;
constexpr int LDS_BYTES = 163840;
constexpr int SCR_BYTES = 147456;
constexpr int LDSCTL_OFF = SCR_BYTES;
constexpr int TAB_OFF = LDSCTL_OFF + 512;
constexpr int TAB_CNT = 0, TAB_P0 = 32, TAB_TE = 72;
constexpr int TOKT_OFF = TAB_OFF + 2048;
#define LDS_WAIT() asm volatile("s_waitcnt lgkmcnt(0)" ::: "memory")
#define WAVE_SYNC() do { asm volatile("s_waitcnt lgkmcnt(0)" ::: "memory"); __builtin_amdgcn_wave_barrier(); } while (0)

#ifndef MOE_FP8
#define MOE_FP8 1
#endif
constexpr float W13_SCALE = 32.f, W2_SCALE = 16.f, ACT_SCALE = 4.f, Y_SCALE = 16.f;
struct Args {
    const float* in[27]; float* out; unsigned char* ws; int ph_lo, ph_hi;
};
struct Frame {
    LAS unsigned char* lds; LAS int* tab; unsigned* ctl; unsigned char* ws;
    int tid, lane, wave, G, bid, vcu;
};
enum Phase { PH_A = 0, PH_B, PH_C, PH_D, PH_E, PH_F, PH_G, PH_H, PH_I, PH_J, PH_N };

#define XB_TMO      128
#define XB_XCNT(j)  (256  + 64 * (j))
#define XB_XSUB(j)  (1280 + 64 * (j))
#define XB_XGEN(j)  (2304 + 64 * (j))
#define XB_TOP      3328
#define XB_TOPGEN   3392
#define XCD_BAR_WORDS 3456
#define XB_SPIN_CAP (1u << 18)
__device__ __forceinline__ unsigned xb_ld(unsigned* p)              { return __hip_atomic_load(p, __ATOMIC_RELAXED, __HIP_MEMORY_SCOPE_AGENT); }
__device__ __forceinline__ unsigned xb_add(unsigned* p, unsigned v) { return __hip_atomic_fetch_add(p, v, __ATOMIC_RELAXED, __HIP_MEMORY_SCOPE_AGENT); }
__device__ __forceinline__ unsigned xb_xcc_id() { return (unsigned)__builtin_amdgcn_s_getreg((3 << 11) | 20) & 0xFu; }
#define XB_SPIN(cond, bar) do { unsigned _sp = 0; while (cond) { __builtin_amdgcn_s_sleep(1); \
    if ((++_sp & 255u) == 0u) { if (xb_ld(&(bar)[XB_TMO])) break; if (_sp > XB_SPIN_CAP) { atomicAdd(&(bar)[XB_TMO], 1u); break; } } } } while (0)
struct XcdBarrier { unsigned* bar; unsigned x; volatile LAS unsigned* st; };
__device__ __forceinline__ XcdBarrier xcd_barrier_post(unsigned* bar, volatile LAS unsigned* st) {
    XcdBarrier b; b.bar = bar; b.x = xb_xcc_id(); b.st = st;
    if (threadIdx.x == 0) (void)xb_add(&bar[XB_XCNT(b.x)], 1u);
    return b;
}
__device__ __forceinline__ void xcd_barrier_complete(unsigned* bar, unsigned x, unsigned& nloc, unsigned& nx) {
    const unsigned G = gridDim.x * gridDim.y * gridDim.z;
    unsigned sum, cnt, mine, sp = 0u;
    for (;;) {
        sum = 0u; cnt = 0u; mine = 0u;
#pragma unroll
        for (unsigned j = 0; j < 16; ++j) { const unsigned c = xb_ld(&bar[XB_XCNT(j)]); sum += c; cnt += (c > 0u) ? 1u : 0u; mine = (j == x) ? c : mine; }
        if (sum == G) break;
        __builtin_amdgcn_s_sleep(1);
        if ((++sp & 255u) == 0u) { if (xb_ld(&bar[XB_TMO])) break; if (sp > XB_SPIN_CAP) { atomicAdd(&bar[XB_TMO], 1u); break; } }
    }
    nloc = mine > 0u ? mine : 1u; nx = cnt > 0u ? cnt : 1u;
}
__device__ __forceinline__ void xcd_barrier(const XcdBarrier& b) {
    asm volatile("s_waitcnt vmcnt(0)" ::: "memory");
    __syncthreads();
    if (threadIdx.x == 0) {
        unsigned* bar = b.bar;
        __builtin_amdgcn_s_waitcnt(0);
        unsigned nloc = b.st[0], nx = b.st[1];
        if (nloc == 0u) { xcd_barrier_complete(bar, b.x, nloc, nx); b.st[0] = nloc; b.st[1] = nx; }
        const unsigned old = xb_add(&bar[XB_XSUB(b.x)], 1u);
        const unsigned gen = old / nloc;
        if (old + 1u == (gen + 1u) * nloc) {
            __builtin_amdgcn_fence(__ATOMIC_RELEASE, "agent");
            asm volatile("s_waitcnt vmcnt(0)" ::: "memory");
            const unsigned og = xb_add(&bar[XB_TOP], 1u);
            const unsigned tg = og / nx;
            if (og + 1u == (tg + 1u) * nx) xb_add(&bar[XB_TOPGEN], 1u);
            else XB_SPIN(xb_ld(&bar[XB_TOPGEN]) == tg, bar);
            __builtin_amdgcn_fence(__ATOMIC_ACQUIRE, "agent");
            xb_add(&bar[XB_XGEN(b.x)], 1u);
            asm volatile("s_waitcnt vmcnt(0)" ::: "memory");
        } else {
            XB_SPIN(xb_ld(&bar[XB_XGEN(b.x)]) == gen, bar);
            __builtin_amdgcn_fence(__ATOMIC_ACQUIRE, "agent");
            asm volatile("s_waitcnt vmcnt(0)" ::: "memory");
        }
    }
    __syncthreads();
}

__device__ __forceinline__ void build_moe_table(Frame& F) {
    __syncthreads();
    if (F.tid < 64) {
        const int c = F.tid < NE ? (int)__hip_atomic_load(F.ctl + CW_CNT + CNT_STRIDE * F.tid, __ATOMIC_RELAXED, __HIP_MEMORY_SCOPE_AGENT) : 0;
        const int nt = (c + 255) >> 8; int p = nt;
#pragma unroll
        for (int o = 1; o < 32; o <<= 1) { const int v = __shfl_up(p, o); if (F.lane >= o) p += v; }
        const int excl = p - nt;
        if (F.tid < NE) { F.tab[TAB_CNT + F.tid] = c; F.tab[TAB_P0 + F.tid] = excl; for (int j = 0; j < nt; ++j) F.tab[TAB_TE + excl + j] = F.tid; }
        if (F.tid == NE - 1) F.tab[TAB_P0 + NE] = p;
    }
    __syncthreads();
}

struct TItem { const float* W; unsigned char* WT; int N, K, blk, rstride, rbase, k0, n0, fp8; float scale; };
__device__ __forceinline__ void titem_load(const TItem& d, f32x4 (&v)[16], int lane) {
#pragma unroll
    for (int i = 0; i < 16; ++i) v[i] = *(const f32x4*)(d.W + (size_t)(d.k0 + 16 * (lane >> 5) + i) * d.N + d.n0 + 4 * (lane & 31));
}
__device__ __forceinline__ unsigned pk4_fp8_nc(float a, float b, float c, float d) {
    unsigned w = 0u; w = __builtin_amdgcn_cvt_pk_fp8_f32(a, b, w, false); w = __builtin_amdgcn_cvt_pk_fp8_f32(c, d, w, true); return w; }
__device__ __forceinline__ void titem_store(const TItem& d, const f32x4 (&v)[16], int lane) {
#pragma unroll
    for (int q = 0; q < 4; ++q) {
        const int n = d.n0 + 4 * (lane & 31) + q, row = d.rbase + (n / d.blk) * d.rstride + (n % d.blk);
        if (d.fp8) { const float sc = d.scale; u32x4 o;
            o.x = pk4_fp8_nc(v[0][q] * sc, v[1][q] * sc, v[2][q] * sc, v[3][q] * sc); o.y = pk4_fp8_nc(v[4][q] * sc, v[5][q] * sc, v[6][q] * sc, v[7][q] * sc);
            o.z = pk4_fp8_nc(v[8][q] * sc, v[9][q] * sc, v[10][q] * sc, v[11][q] * sc); o.w = pk4_fp8_nc(v[12][q] * sc, v[13][q] * sc, v[14][q] * sc, v[15][q] * sc);
            *(u32x4*)(d.WT + (size_t)row * d.K + d.k0 + 16 * (lane >> 5)) = o;
        } else { u32x4 o0, o1;
            o0.x = pk2(v[0][q], v[1][q]); o0.y = pk2(v[2][q], v[3][q]); o0.z = pk2(v[4][q], v[5][q]); o0.w = pk2(v[6][q], v[7][q]);
            o1.x = pk2(v[8][q], v[9][q]); o1.y = pk2(v[10][q], v[11][q]); o1.z = pk2(v[12][q], v[13][q]); o1.w = pk2(v[14][q], v[15][q]);
            unsigned char* p = d.WT + ((size_t)row * d.K + d.k0 + 16 * (lane >> 5)) * 2; *(u32x4*)p = o0; *(u32x4*)(p + 16) = o1; }
    }
}
constexpr int TI_IN = 512, TI_OUT = 256, TI_EXP = 384 * NE, TI_N = TI_IN + TI_OUT + TI_EXP;
__device__ __forceinline__ void titem_decode(const Args& args, unsigned char* ws, int it, TItem& d) {
    int r = it, item; d.fp8 = 0; d.scale = 1.f; d.rstride = 0; d.rbase = 0;
    if (r < TI_IN) { d.W = args.in[5]; d.WT = ws + OFF_WIN; d.K = 1024; d.N = 2048; d.blk = 2048; item = r; }
    else if ((r -= TI_IN) < TI_OUT) { d.W = args.in[17]; d.WT = ws + OFF_WOUT; d.K = 1024; d.N = 1024; d.blk = 1024; item = r; }
    else { r -= TI_OUT; const int e = r / 384, q = r % 384;
        if (q < 256) { d.W = (q < 128 ? args.in[23] : args.in[24]) + (size_t)e * 1024 * 512; d.K = 1024; d.N = 512; d.blk = 128; d.rstride = 256; d.rbase = q < 128 ? 0 : 128; item = q & 127;
            d.WT = ws + OFF_W13 + (size_t)e * 1024 * 1024 * (MOE_FP8 ? 1 : 2); d.scale = W13_SCALE; }
        else { d.W = args.in[25] + (size_t)e * 512 * 1024; d.K = 512; d.N = 1024; d.blk = 1024; item = q - 256; d.WT = ws + OFF_W2 + (size_t)e * 1024 * 512 * (MOE_FP8 ? 1 : 2); d.scale = W2_SCALE; }
        d.fp8 = MOE_FP8; if (!MOE_FP8) d.scale = 1.f; }
    const int nkb = d.K / 32; d.k0 = 32 * (item % nkb); d.n0 = 128 * (item / nkb);
}
__device__ __forceinline__ void phase_A(Frame& F, const Args& args) {
    unsigned char* ws = F.ws;
    const float* c = args.in[1]; const float* ada_w = args.in[2]; const float* ada_b = args.in[3];
    float* mod = (float*)(ws + OFF_MOD);
    for (int it = F.G - 1 - F.bid; it < 192; it += F.G) {
        LAS float* sc = (LAS float*)F.lds; LAS float* red = sc + 8192;
        for (int i = F.tid; i < 8192; i += NTHREADS) { const float v = c[i]; sc[(i & 1023) * 8 + (i >> 10)] = v / (1.0f + __expf(-v)); }
        __syncthreads();
        const int col = F.lane & 31, ks = F.lane >> 5, n = it * 32 + col, k0 = F.wave * 128 + ks;
        float acc[8];
#pragma unroll
        for (int b = 0; b < 8; ++b) acc[b] = 0.f;
#pragma unroll 1
        for (int i0 = 0; i0 < 64; i0 += 16) {
            float wv[16];
#pragma unroll
            for (int i = 0; i < 16; ++i) wv[i] = ada_w[(size_t)(k0 + 2 * (i0 + i)) * 6144 + n];
#pragma unroll
            for (int i = 0; i < 16; ++i) { const int k = k0 + 2 * (i0 + i);
                const f32x4 s0 = *(const LAS f32x4*)(sc + k * 8), s1 = *(const LAS f32x4*)(sc + k * 8 + 4);
#pragma unroll
                for (int b = 0; b < 4; ++b) { acc[b] += s0[b] * wv[i]; acc[4 + b] += s1[b] * wv[i]; } }
        }
#pragma unroll
        for (int b = 0; b < 8; ++b) { acc[b] += __shfl_xor(acc[b], 32); if (ks == 0) red[(F.wave * 8 + b) * 32 + col] = acc[b]; }
        __syncthreads();
        if (F.tid < 256) { const int b = F.tid >> 5, cc = F.tid & 31; float s = ada_b[it * 32 + cc];
#pragma unroll
            for (int w = 0; w < 8; ++w) s += red[(w * 8 + b) * 32 + cc];
            mod[b * 6144 + it * 32 + cc] = s; }
        __syncthreads();
    }
    {
        const int gw = F.vcu * NWAVES + F.wave, NGW = F.G * NWAVES;
        const int it_end = (F.G == 256) ? TI_IN + TI_OUT : TI_N;
        int it = gw;
        if (it < it_end) {
            TItem d, d2; f32x4 v[16], v2[16];
            titem_decode(args, ws, it, d); titem_load(d, v, F.lane);
            for (;;) {
                const int itn = it + NGW; const bool more = itn < it_end;
                if (more) { titem_decode(args, ws, itn, d2); titem_load(d2, v2, F.lane); }
                titem_store(d, v, F.lane);
                if (!more) break;
                d = d2; it = itn;
#pragma unroll
                for (int i = 0; i < 16; ++i) v[i] = v2[i];
            }
        }
    }
    {
        const int gt = F.bid * NTHREADS + F.tid, NGT = F.G * NTHREADS;
        const float* sgu_w = args.in[15]; const float* rgw = args.in[19]; const float* rew = args.in[21]; const float* lam = args.in[12];
        bf16_t* SGUW = (bf16_t*)(ws + OFF_SGUW); bf16_t* ROUTW = (bf16_t*)(ws + OFF_ROUTW); float* N8SP = (float*)(ws + OFF_N8SP);
        for (int i = gt; i < 8 * 128 * 128; i += NGT) { const int ii = (i >> 7) & 127, j = i & 127; SGUW[i] = (bf16_t)(((j >> 6) <= (ii >> 6)) ? f2bf(sgu_w[i]) : 0u); }
        for (int i = gt; i < 48 * 1024; i += NGT) { const int n = i >> 10, k = i & 1023; const float v = n < 4 ? rgw[k * 4 + n] : (n < 36 ? rew[k * 32 + n - 4] : 0.f); ROUTW[i] = (bf16_t)f2bf(v); }
        for (int i = gt; i < 512; i += NGT) N8SP[i] = -8.0f * 1.4426950408889634f * log1pf(expf(-lam[i]));
        { float* GB = (float*)(ws + OFF_GBIAS); const float* gab_ = args.in[9]; const float* gib_ = args.in[11];
          for (int i = gt; i < 1024; i += NGT) GB[i] = -1.4426950408889634f * (i < 512 ? gab_[i] : gib_[i - 512]); }
        { const float* gaw = args.in[8]; const float* giw = args.in[10]; bf16_t* GATEW = (bf16_t*)(ws + OFF_GATEW);
          for (int i = gt; i < 8 * 128 * 64; i += NGT) { const int h = i >> 13, ee = (i >> 6) & 127, dd = i & 63; const float v = -1.4426950408889634f * (ee < 64 ? gaw : giw)[h * 4096 + dd * 64 + (ee & 63)]; GATEW[i] = (bf16_t)f2bf(v); } }
    }
}

__device__ __forceinline__ void convert_experts(Frame& F, const Args& args, int cidx, int ncv) {
    unsigned char* ws = F.ws;
    const int gw = cidx * NWAVES + F.wave, NGW = ncv * NWAVES;
    int it = TI_IN + TI_OUT + gw;
    if (it < TI_N) {
        TItem d, d2; f32x4 v[16], v2[16];
        titem_decode(args, ws, it, d); titem_load(d, v, F.lane);
        for (;;) {
            const int itn = it + NGW; const bool more = itn < TI_N;
            if (more) { titem_decode(args, ws, itn, d2); titem_load(d2, v2, F.lane); }
            titem_store(d, v, F.lane);
            if (!more) break;
            d = d2; it = itn;
#pragma unroll
            for (int i = 0; i < 16; ++i) v[i] = v2[i];
        }
    }
}

__device__ __forceinline__ void phase_B(Frame& F, const Args& args) {
    const float* x = args.in[0]; const float* g = args.in[4]; const float* mod = (const float*)(F.ws + OFF_MOD); bf16_t* XN = (bf16_t*)(F.ws + OFF_XN);
    const int gw = F.bid * NWAVES + F.wave, NGW = F.G * NWAVES, lane = F.lane;
    constexpr int RPW = 16;
    for (int item = gw; item < T / RPW; item += NGW) {
        const int row0 = item * RPW, b = row0 / SEQ;
        const float* sh = mod + b * 6144; const float* sc = sh + 1024;
        f32x4 gm[4], sv[4];
#pragma unroll
        for (int j = 0; j < 4; ++j) { const int col = 4 * (lane + 64 * j); const f32x4 gg = *(const f32x4*)(g + col), s1 = *(const f32x4*)(sc + col); sv[j] = *(const f32x4*)(sh + col); gm[j] = gg * (1.0f + s1); }
        f32x4 v[4], nv[4];
#pragma unroll
        for (int j = 0; j < 4; ++j) v[j] = ((const f32x4*)(x + (size_t)row0 * D))[lane + 64 * j];
#pragma unroll 1
        for (int r = 0; r < RPW; ++r) {
            const int row = row0 + r, nrow = (r + 1 < RPW) ? row + 1 : row;
#pragma unroll
            for (int j = 0; j < 4; ++j) nv[j] = ((const f32x4*)(x + (size_t)nrow * D))[lane + 64 * j];
            float ss = 0.f;
#pragma unroll
            for (int j = 0; j < 4; ++j) ss += v[j][0] * v[j][0] + v[j][1] * v[j][1] + v[j][2] * v[j][2] + v[j][3] * v[j][3];
            const float rs = rsqrtf(wave_sum(ss) * (1.0f / D) + EPS);
#pragma unroll
            for (int j = 0; j < 4; ++j) { const int col = 4 * (lane + 64 * j); const f32x4 h = v[j] * rs * gm[j] + sv[j];
                u32x2 o; o.x = pk2(h[0], h[1]); o.y = pk2(h[2], h[3]);
                *(u32x2*)(XN + (size_t)row * D + col) = o; v[j] = nv[j]; }
        }
    }
}

#ifndef SGU_TR
#define SGU_TR 1
#endif
typedef short s16x4 __attribute__((ext_vector_type(4)));
typedef short v4i16_t __attribute__((ext_vector_type(4)));
constexpr int IMG_STRIDE = 1040;
__device__ __forceinline__ float bflo(unsigned w) { return __uint_as_float(w << 16); }
__device__ __forceinline__ float bfhi(unsigned w) { return __uint_as_float(w & 0xffff0000u); }
__device__ __forceinline__ void sgu_block(Frame& F, const Args& args, int blk) {
    const bf16_t* Z = (const bf16_t*)(F.ws + OFF_Z); bf16_t* YMIX = (bf16_t*)(F.ws + OFF_YMIX); const bf16_t* SGUW = (const bf16_t*)(F.ws + OFF_SGUW);
    const float* ln_g = args.in[13]; const float* ln_b = args.in[14]; const float* sgu_b = args.in[16];
    const int lane = F.lane, w = F.wave; const size_t t0 = (size_t)blk * 128;
    {
        u32x4 raw[16];
#pragma unroll
        for (int r = 0; r < 16; ++r) raw[r] = *(const u32x4*)(Z + (t0 + w * 16 + r) * 2048 + 1536 + 8 * lane);
        const f32x4 g0 = *(const f32x4*)(ln_g + 8 * lane), g1 = *(const f32x4*)(ln_g + 8 * lane + 4), b0 = *(const f32x4*)(ln_b + 8 * lane), b1 = *(const f32x4*)(ln_b + 8 * lane + 4);
#pragma unroll
        for (int r = 0; r < 16; ++r) {
            float v[8];
#pragma unroll
            for (int q = 0; q < 4; ++q) { v[2 * q] = bflo(raw[r][q]); v[2 * q + 1] = bfhi(raw[r][q]); }
            float s = 0.f;
#pragma unroll
            for (int q = 0; q < 8; ++q) s += v[q];
            const float mu = wave_sum(s) * (1.0f / 512.0f);
            float s2 = 0.f;
#pragma unroll
            for (int q = 0; q < 8; ++q) { v[q] -= mu; s2 += v[q] * v[q]; }
            const float rstd = rsqrtf(wave_sum(s2) * (1.0f / 512.0f) + EPS);
            u32x4 o;
            o.x = pk2(v[0] * rstd * g0[0] + b0[0], v[1] * rstd * g0[1] + b0[1]); o.y = pk2(v[2] * rstd * g0[2] + b0[2], v[3] * rstd * g0[3] + b0[3]);
            o.z = pk2(v[4] * rstd * g1[0] + b1[0], v[5] * rstd * g1[1] + b1[1]); o.w = pk2(v[6] * rstd * g1[2] + b1[2], v[7] * rstd * g1[3] + b1[3]);
            *(LAS u32x4*)(F.lds + (w * 16 + r) * IMG_STRIDE + 16 * lane) = o;
        }
    }
    __syncthreads();
    {
        const int g = w;
        int fr = lane & 15, fq = lane >> 4; asm volatile("" : "+v"(fr), "+v"(fq));
        bf16x8 af[4][4];
#pragma unroll
        for (int kt = 0; kt < 4; ++kt)
#pragma unroll
            for (int ct = 0; ct < 4; ++ct) {
#if SGU_TR
                LAS unsigned char* p = F.lds + (32 * kt + 8 * fq + (fr >> 2)) * IMG_STRIDE + (g * 64 + 16 * (fr & 3) + 4 * ct) * 2;
                const s16x4 lo = __builtin_bit_cast(s16x4, __builtin_amdgcn_ds_read_tr16_b64_v4i16((LAS v4i16_t*)p));
                const s16x4 hi = __builtin_bit_cast(s16x4, __builtin_amdgcn_ds_read_tr16_b64_v4i16((LAS v4i16_t*)(p + 4 * IMG_STRIDE)));
                af[kt][ct] = (bf16x8){lo[0], lo[1], lo[2], lo[3], hi[0], hi[1], hi[2], hi[3]};
#else
                const LAS bf16_t* p = (const LAS bf16_t*)(F.lds + (32 * kt + 8 * fq) * IMG_STRIDE) + g * 64 + 16 * (fr >> 2) + 4 * ct + (fr & 3);
#pragma unroll
                for (int e = 0; e < 8; ++e) af[kt][ct][e] = (short)p[e * (IMG_STRIDE / 2)];
#endif
            }
        bf16x8 wf[4], nwf[4]; u32x4 gu0, gu1, ngu0, ngu1; float bias, nbias;
        { const bf16_t* wp = SGUW + ((size_t)(g * 128 + fr)) * 128 + 8 * fq;
#pragma unroll
          for (int kt = 0; kt < 4; ++kt) wf[kt] = *(const bf16x8*)(wp + 32 * kt);
          const size_t t = t0 + fr; gu0 = *(const u32x4*)(Z + t * 2048 + 1024 + g * 64 + 16 * fq); gu1 = *(const u32x4*)(Z + t * 2048 + 1024 + g * 64 + 16 * fq + 8); bias = sgu_b[g * 128 + fr]; }
#pragma unroll 1
        for (int it = 0; it < 8; ++it) {
            const int i0 = 16 * it, in0 = it < 7 ? i0 + 16 : i0;
            { const bf16_t* wp = SGUW + ((size_t)(g * 128 + in0 + fr)) * 128 + 8 * fq;
#pragma unroll
              for (int kt = 0; kt < 4; ++kt) nwf[kt] = *(const bf16x8*)(wp + 32 * kt);
              const size_t tn = t0 + in0 + fr; ngu0 = *(const u32x4*)(Z + tn * 2048 + 1024 + g * 64 + 16 * fq); ngu1 = *(const u32x4*)(Z + tn * 2048 + 1024 + g * 64 + 16 * fq + 8); nbias = sgu_b[g * 128 + in0 + fr]; }
            f32x4 acc[4];
#pragma unroll
            for (int ct = 0; ct < 4; ++ct) acc[ct] = (f32x4){0.f, 0.f, 0.f, 0.f};
#pragma unroll
            for (int kt = 0; kt < 4; ++kt)
#pragma unroll
                for (int ct = 0; ct < 4; ++ct) acc[ct] = __builtin_amdgcn_mfma_f32_16x16x32_bf16(af[kt][ct], wf[kt], acc[ct], 0, 0, 0);
            const size_t t = t0 + i0 + fr;
            u32x4 o0, o1;
            o0.x = pk2(bflo(gu0.x) * (acc[0][0] + bias), bfhi(gu0.x) * (acc[0][1] + bias)); o0.y = pk2(bflo(gu0.y) * (acc[0][2] + bias), bfhi(gu0.y) * (acc[0][3] + bias));
            o0.z = pk2(bflo(gu0.z) * (acc[1][0] + bias), bfhi(gu0.z) * (acc[1][1] + bias)); o0.w = pk2(bflo(gu0.w) * (acc[1][2] + bias), bfhi(gu0.w) * (acc[1][3] + bias));
            o1.x = pk2(bflo(gu1.x) * (acc[2][0] + bias), bfhi(gu1.x) * (acc[2][1] + bias)); o1.y = pk2(bflo(gu1.y) * (acc[2][2] + bias), bfhi(gu1.y) * (acc[2][3] + bias));
            o1.z = pk2(bflo(gu1.z) * (acc[3][0] + bias), bfhi(gu1.z) * (acc[3][1] + bias)); o1.w = pk2(bflo(gu1.w) * (acc[3][2] + bias), bfhi(gu1.w) * (acc[3][3] + bias));
            *(u32x4*)(YMIX + t * D + 512 + g * 64 + 16 * fq) = o0; *(u32x4*)(YMIX + t * D + 512 + g * 64 + 16 * fq + 8) = o1;
#pragma unroll
            for (int kt = 0; kt < 4; ++kt) wf[kt] = nwf[kt];
            gu0 = ngu0; gu1 = ngu1; bias = nbias;
        }
    }
}

constexpr int XC_STRIDE = 144;
constexpr int AU_STRIDE = 68;
constexpr int LRU_WAVE_BYTES = 64 * XC_STRIDE + 2 * 16 * AU_STRIDE * 4;
__device__ __forceinline__ float sigm_fast(float x) { return __builtin_amdgcn_rcpf(1.0f + __builtin_amdgcn_exp2f(-1.4426950408889634f * x)); }
template <int PASS>
__device__ __forceinline__ void lru_block(Frame& F, const Args& args, int blk) {
    const bf16_t* Z = (const bf16_t*)(F.ws + OFF_Z); bf16_t* YMIX = (bf16_t*)(F.ws + OFF_YMIX); const bf16_t* GATEW = (const bf16_t*)(F.ws + OFF_GATEW);
    const float* N8SP = (const float*)(F.ws + OFF_N8SP); float* CA = (float*)(F.ws + OFF_CARRY); float* CH = CA + 256 * 512;
    const float* cw = args.in[6]; const float* cb = args.in[7]; const float* gab = (const float*)(F.ws + OFF_GBIAS); const float* gib = gab + 512;
    const int lane = F.lane, h = F.wave, fr = lane & 15, fq = lane >> 4, cg = lane & 7, run = lane >> 3; const size_t t0 = (size_t)blk * 128;
    LAS unsigned char* xcT = F.lds + h * LRU_WAVE_BYTES; LAS float* Abuf = (LAS float*)(xcT + 64 * XC_STRIDE); LAS float* Ubuf = Abuf + 16 * AU_STRIDE;
    float hst = 0.f, pp = 1.f;
    if (PASS == 2) { const int b0 = blk & ~31, n = blk & 31;
        float ca[31], ch[31];
#pragma unroll
        for (int k = 0; k < 31; ++k) { const int kk = k < n ? k : 0; ca[k] = CA[(size_t)(b0 + kk) * 512 + 64 * h + lane]; ch[k] = CH[(size_t)(b0 + kk) * 512 + 64 * h + lane]; }
#pragma unroll
        for (int k = 0; k < 31; ++k) hst = k < n ? ca[k] * hst + ch[k] : hst; }
    bf16x8 gw[8][2];
#pragma unroll
    for (int et = 0; et < 8; ++et)
#pragma unroll
        for (int kt = 0; kt < 2; ++kt) gw[et][kt] = *(const bf16x8*)(GATEW + ((size_t)(h * 128 + 16 * et + fr)) * 64 + 32 * kt + 8 * fq);
    const bool seq_start = (blk & 31) == 0;
#pragma unroll 1
    for (int hb = 0; hb < 2; ++hb) {
        const size_t tb = t0 + 64 * hb;
        {
            float cwv[4][8], cbv[8];
#pragma unroll
            for (int k = 0; k < 4; ++k) { const f32x4 a = *(const f32x4*)(cw + k * 512 + 64 * h + 8 * cg), b = *(const f32x4*)(cw + k * 512 + 64 * h + 8 * cg + 4);
#pragma unroll
                for (int q = 0; q < 4; ++q) { cwv[k][q] = a[q]; cwv[k][4 + q] = b[q]; } }
            { const f32x4 a = *(const f32x4*)(cb + 64 * h + 8 * cg), b = *(const f32x4*)(cb + 64 * h + 8 * cg + 4);
#pragma unroll
              for (int q = 0; q < 4; ++q) { cbv[q] = a[q]; cbv[4 + q] = b[q]; } }
            u32x4 xr[11];
#pragma unroll
            for (int j = 0; j < 11; ++j) { const int rel = 8 * run - 3 + j;
                const bool pad = (j < 3) && (rel < 0) && (hb == 0) && seq_start;
                const u32x4 v = *(const u32x4*)(Z + (size_t)((long)tb + (pad ? 0 : rel)) * 2048 + 64 * h + 8 * cg);
                xr[j] = pad ? (u32x4){0u, 0u, 0u, 0u} : v; }
#pragma unroll
            for (int s = 0; s < 8; ++s) { float o[8];
#pragma unroll
                for (int q = 0; q < 8; ++q) o[q] = cbv[q];
#pragma unroll
                for (int k = 0; k < 4; ++k) { const u32x4 r = xr[s + k];
#pragma unroll
                    for (int q = 0; q < 4; ++q) { o[2 * q] += cwv[k][2 * q] * bflo(r[q]); o[2 * q + 1] += cwv[k][2 * q + 1] * bfhi(r[q]); } }
                u32x4 pkd; pkd.x = pk2(o[0], o[1]); pkd.y = pk2(o[2], o[3]); pkd.z = pk2(o[4], o[5]); pkd.w = pk2(o[6], o[7]);
                *(LAS u32x4*)(xcT + (8 * run + s) * XC_STRIDE + 16 * cg) = pkd; }
        }
        WAVE_SYNC();
        u32x4 g0 = {0u, 0u, 0u, 0u}, g1 = g0, ng0 = g0, ng1 = g0;
        if (PASS == 2) { const size_t t = tb + (lane >> 2); g0 = *(const u32x4*)(Z + t * 2048 + 512 + 64 * h + 16 * (lane & 3)); g1 = *(const u32x4*)(Z + t * 2048 + 512 + 64 * h + 16 * (lane & 3) + 8); }
#pragma unroll 1
        for (int it = 0; it < 4; ++it) {
            if (PASS == 2) { const size_t t = tb + 16 * (it < 3 ? it + 1 : it) + (lane >> 2); ng0 = *(const u32x4*)(Z + t * 2048 + 512 + 64 * h + 16 * (lane & 3)); ng1 = *(const u32x4*)(Z + t * 2048 + 512 + 64 * h + 16 * (lane & 3) + 8); }
            bf16x8 xf[2];
#pragma unroll
            for (int kt = 0; kt < 2; ++kt) xf[kt] = *(const LAS bf16x8*)(xcT + (16 * it + fr) * XC_STRIDE + (32 * kt + 8 * fq) * 2);
            int fqv = fq; asm volatile("" : "+v"(fqv));
            f32x4 acc[8];
#pragma unroll
            for (int et = 0; et < 4; ++et) { acc[et] = *(const f32x4*)(gab + 64 * h + 16 * et + 4 * fqv); acc[4 + et] = *(const f32x4*)(gib + 64 * h + 16 * et + 4 * fqv); }
#pragma unroll
            for (int et = 0; et < 8; ++et)
#pragma unroll
                for (int kt = 0; kt < 2; ++kt) acc[et] = __builtin_amdgcn_mfma_f32_16x16x32_bf16(gw[et][kt], xf[kt], acc[et], 0, 0, 0);
#pragma unroll
            for (int et = 0; et < 4; ++et) {
                const f32x4 sp = *(const f32x4*)(N8SP + 64 * h + 16 * et + 4 * fqv);
                const u32x2 xw = *(const LAS u32x2*)(xcT + (16 * it + fr) * XC_STRIDE + (16 * et + 4 * fq) * 2);
                const float xv[4] = {bflo(xw.x), bfhi(xw.x), bflo(xw.y), bfhi(xw.y)};
                f32x4 av, uv;
#pragma unroll
                for (int r = 0; r < 4; ++r) {
                    const float rg = __builtin_amdgcn_rcpf(1.0f + __builtin_amdgcn_exp2f(acc[et][r])), ig = __builtin_amdgcn_rcpf(1.0f + __builtin_amdgcn_exp2f(acc[4 + et][r]));
                    const float a = __builtin_amdgcn_exp2f(rg * sp[r]);
                    av[r] = a;
                    uv[r] = __builtin_amdgcn_sqrtf(__builtin_fmaf(-a, a, 1.0f)) * (ig * xv[r]);
                }
                *(LAS f32x4*)(Abuf + fr * AU_STRIDE + 16 * et + 4 * fq) = av; *(LAS f32x4*)(Ubuf + fr * AU_STRIDE + 16 * et + 4 * fq) = uv;
            }
            WAVE_SYNC();
            {
                float a[16], u[16];
#pragma unroll
                for (int tk = 0; tk < 16; ++tk) { a[tk] = Abuf[tk * AU_STRIDE + lane]; u[tk] = Ubuf[tk * AU_STRIDE + lane]; }
#pragma unroll
                for (int tk = 0; tk < 16; ++tk) { hst = a[tk] * hst + u[tk]; if (PASS == 1) pp *= a[tk]; else Ubuf[tk * AU_STRIDE + lane] = hst; }
            }
            if (PASS == 2) {
                WAVE_SYNC();
                const int tok = lane >> 2, cq = lane & 3; const size_t t = tb + 16 * it + tok;
                const LAS float* hp = Ubuf + tok * AU_STRIDE + 16 * cq;
                const f32x4 h0 = *(const LAS f32x4*)(hp), h1 = *(const LAS f32x4*)(hp + 4), h2 = *(const LAS f32x4*)(hp + 8), h3 = *(const LAS f32x4*)(hp + 12);
                u32x4 o0, o1;
                o0.x = pk2(h0[0] * bflo(g0.x), h0[1] * bfhi(g0.x)); o0.y = pk2(h0[2] * bflo(g0.y), h0[3] * bfhi(g0.y));
                o0.z = pk2(h1[0] * bflo(g0.z), h1[1] * bfhi(g0.z)); o0.w = pk2(h1[2] * bflo(g0.w), h1[3] * bfhi(g0.w));
                o1.x = pk2(h2[0] * bflo(g1.x), h2[1] * bfhi(g1.x)); o1.y = pk2(h2[2] * bflo(g1.y), h2[3] * bfhi(g1.y));
                o1.z = pk2(h3[0] * bflo(g1.z), h3[1] * bfhi(g1.z)); o1.w = pk2(h3[2] * bflo(g1.w), h3[3] * bfhi(g1.w));
                *(u32x4*)(YMIX + t * D + 64 * h + 16 * cq) = o0; *(u32x4*)(YMIX + t * D + 64 * h + 16 * cq + 8) = o1;
                g0 = ng0; g1 = ng1;
            }
            WAVE_SYNC();
        }
    }
    if (PASS == 1) { CA[(size_t)blk * 512 + 64 * h + lane] = pp; CH[(size_t)blk * 512 + 64 * h + lane] = hst; }
}

constexpr int HT_STRIDE = 2064;
constexpr int RG_W_OFF = 0, RG_H_OFF = 36 * HT_STRIDE, RG_LOG_OFF = RG_H_OFF + 32 * HT_STRIDE, RG_MISC_OFF = RG_LOG_OFF + 32 * 48 * 4;
static_assert(RG_MISC_OFF + 256 <= SCR_BYTES, "phase G LDS map");
__device__ __forceinline__ void phase_G(Frame& F, const Args& args) {
    const bf16_t* X1 = (const bf16_t*)(F.ws + OFF_X1); bf16_t* H2 = (bf16_t*)(F.ws + OFF_XN); const bf16_t* ROUTW = (const bf16_t*)(F.ws + OFF_ROUTW);
    const float* mod = (const float*)(F.ws + OFF_MOD); const float* g2w = args.in[18]; const float* bg = args.in[20]; const float* be = args.in[22];
    int* list = (int*)(F.ws + OFF_LIST); int* toke = (int*)(F.ws + OFF_TOKE); float* tokw = (float*)(F.ws + OFF_TOKW); int* tokp = (int*)(F.ws + OFF_TOKP);
    const int lane = F.lane, w = F.wave, fr = lane & 15, fq = lane >> 4;
    LAS float* LG = (LAS float*)(F.lds + RG_LOG_OFF); LAS int* hist = (LAS int*)(F.lds + RG_MISC_OFF); LAS int* base = hist + 32;
    __syncthreads();
    for (int i = F.tid; i < 36 * 128; i += NTHREADS) { const int r = i >> 7, c = i & 127; *(LAS u32x4*)(F.lds + RG_W_OFF + r * HT_STRIDE + c * 16) = *(const u32x4*)(ROUTW + (size_t)r * 1024 + c * 8); }
    for (int grp = F.bid; grp < T / 128; grp += F.G) {
        const int grow0 = grp * 128, b = grow0 / SEQ;
        const float* sh = mod + b * 6144 + 3072; const float* sc = sh + 1024;
        float gm[16], sv[16];
#pragma unroll
        for (int jj = 0; jj < 2; ++jj)
#pragma unroll
            for (int q = 0; q < 8; ++q) { const int c = 512 * jj + 8 * lane + q; gm[8 * jj + q] = g2w[c] * (1.0f + sc[c]); sv[8 * jj + q] = sh[c]; }
        if (F.tid < 32) hist[F.tid] = 0;
        u32x4 raw[4][2];
#pragma unroll
        for (int r = 0; r < 4; ++r)
#pragma unroll
            for (int jj = 0; jj < 2; ++jj) raw[r][jj] = *(const u32x4*)(X1 + (size_t)(grow0 + 4 * w + r) * D + 512 * jj + 8 * lane);
        int e1 = 0, e2 = 0, l1 = 0, l2 = 0; float w1 = 0.f, w2 = 0.f;
#pragma unroll 1
        for (int ti = 0; ti < 4; ++ti) {
            const int row0 = grow0 + 32 * ti;
#pragma unroll
            for (int r = 0; r < 4; ++r) {
                float h[16]; float ss = 0.f;
#pragma unroll
                for (int jj = 0; jj < 2; ++jj)
#pragma unroll
                    for (int q = 0; q < 4; ++q) { h[8 * jj + 2 * q] = bflo(raw[r][jj][q]); h[8 * jj + 2 * q + 1] = bfhi(raw[r][jj][q]); }
#pragma unroll
                for (int q = 0; q < 16; ++q) ss += h[q] * h[q];
                const float rs = rsqrtf(wave_sum(ss) * (1.0f / D) + EPS);
#pragma unroll
                for (int jj = 0; jj < 2; ++jj) { u32x4 o; float hv[8];
#pragma unroll
                    for (int q = 0; q < 8; ++q) hv[q] = h[8 * jj + q] * rs * gm[8 * jj + q] + sv[8 * jj + q];
#pragma unroll
                    for (int q = 0; q < 4; ++q) o[q] = pk2(hv[2 * q], hv[2 * q + 1]);
#if MOE_FP8
                    { u32x2 f; f.x = pg8::pk4_fp8(hv[0], hv[1], hv[2], hv[3]); f.y = pg8::pk4_fp8(hv[4], hv[5], hv[6], hv[7]);
                      *(u32x2*)((unsigned char*)H2 + (size_t)(row0 + 4 * w + r) * D + 512 * jj + 8 * lane) = f; }
#else
                    *(u32x4*)(H2 + (size_t)(row0 + 4 * w + r) * D + 512 * jj + 8 * lane) = o;
#endif
                    *(LAS u32x4*)(F.lds + RG_H_OFF + (4 * w + r) * HT_STRIDE + (512 * jj + 8 * lane) * 2) = o; }
            }
            if (ti < 3) {
#pragma unroll
                for (int r = 0; r < 4; ++r)
#pragma unroll
                    for (int jj = 0; jj < 2; ++jj) raw[r][jj] = *(const u32x4*)(X1 + (size_t)(row0 + 32 + 4 * w + r) * D + 512 * jj + 8 * lane);
            }
            __syncthreads();
            if (w < 6) {
                const int rt = w / 3, ct = w % 3; int wrow = 16 * ct + fr; wrow = wrow < 36 ? wrow : 35;
                const LAS unsigned char* hp = F.lds + RG_H_OFF + (16 * rt + fr) * HT_STRIDE + 16 * fq; const LAS unsigned char* wp = F.lds + RG_W_OFF + wrow * HT_STRIDE + 16 * fq;
                f32x4 acc0 = {0.f, 0.f, 0.f, 0.f}, acc1 = {0.f, 0.f, 0.f, 0.f};
#pragma unroll 8
                for (int kt = 0; kt < 32; kt += 2) {
                    acc0 = __builtin_amdgcn_mfma_f32_16x16x32_bf16(*(const LAS bf16x8*)(wp + 64 * kt), *(const LAS bf16x8*)(hp + 64 * kt), acc0, 0, 0, 0);
                    acc1 = __builtin_amdgcn_mfma_f32_16x16x32_bf16(*(const LAS bf16x8*)(wp + 64 * kt + 64), *(const LAS bf16x8*)(hp + 64 * kt + 64), acc1, 0, 0, 0); }
                *(LAS f32x4*)(LG + (16 * rt + fr) * 48 + 16 * ct + 4 * fq) = acc0 + acc1;
            }
            __syncthreads();
            if ((F.tid >> 5) == ti) {
                const LAS float* L = LG + (F.tid & 31) * 48;
                float gl[4], el[8];
#pragma unroll
                for (int j = 0; j < 4; ++j) gl[j] = L[j] + bg[j];
                int gs = 0; float gmax = gl[0];
#pragma unroll
                for (int j = 1; j < 4; ++j) if (gl[j] > gmax) { gmax = gl[j]; gs = j; }
#pragma unroll
                for (int j = 0; j < 8; ++j) el[j] = L[4 + gs * 8 + j] + be[gs * 8 + j];
                float gsum = 0.f;
#pragma unroll
                for (int j = 0; j < 4; ++j) gsum += __expf(gl[j] - gmax);
                const float pg = 1.0f / gsum;
                int i1 = 0; float m1 = el[0];
#pragma unroll
                for (int j = 1; j < 8; ++j) if (el[j] > m1) { m1 = el[j]; i1 = j; }
                int i2 = -1; float m2 = -INFINITY;
#pragma unroll
                for (int j = 0; j < 8; ++j) if (j != i1 && el[j] > m2) { m2 = el[j]; i2 = j; }
                const float r = __expf(m2 - m1);
                w1 = pg / (1.0f + r); w2 = pg * r / (1.0f + r); e1 = gs * 8 + i1; e2 = gs * 8 + i2;
                l1 = __hip_atomic_fetch_add(hist + e1, 1, __ATOMIC_RELAXED, __HIP_MEMORY_SCOPE_WORKGROUP);
                l2 = __hip_atomic_fetch_add(hist + e2, 1, __ATOMIC_RELAXED, __HIP_MEMORY_SCOPE_WORKGROUP);
            }
        }
        __syncthreads();
        if (F.tid < 32) { const int n = hist[F.tid]; base[F.tid] = n ? (int)__hip_atomic_fetch_add(F.ctl + CW_CNT + CNT_STRIDE * F.tid, (unsigned)n, __ATOMIC_RELAXED, __HIP_MEMORY_SCOPE_AGENT) : 0; }
        __syncthreads();
        if (F.tid < 128) { const int row = grow0 + F.tid, p1 = base[e1] + l1, p2 = base[e2] + l2;
            list[(size_t)e1 * LISTCAP + p1] = row; list[(size_t)e2 * LISTCAP + p2] = row;
            toke[2 * row] = e1; toke[2 * row + 1] = e2; tokw[2 * row] = w1; tokw[2 * row + 1] = w2; tokp[2 * row] = p1; tokp[2 * row + 1] = p2; }
        __syncthreads();
    }
}

__device__ __forceinline__ void phase_J(Frame& F, const Args& args) {
    const bf16_t* X1 = (const bf16_t*)(F.ws + OFF_X1); const bf16_t* Y = (const bf16_t*)(F.ws + OFF_Y); const float* mod = (const float*)(F.ws + OFF_MOD);
    const int* toke = (const int*)(F.ws + OFF_TOKE); const float* tokw = (const float*)(F.ws + OFF_TOKW); const int* tokp = (const int*)(F.ws + OFF_TOKP);
    const float* fg = args.in[26]; float* out = args.out;
    const int gw = F.bid * NWAVES + F.wave, NGW = F.G * NWAVES, lane = F.lane;
    constexpr int RPW = 16;
    for (int item = gw; item < T / RPW; item += NGW) {
        const int row0 = item * RPW, b = row0 / SEQ;
        int q0l = 0, q1l = 0; float w0l = 0.f, w1l = 0.f;
        { const int rr = row0 + (lane & 15); const int e0 = toke[2 * rr], e1 = toke[2 * rr + 1];
          q0l = F.tab[TAB_P0 + e0] * 256 + tokp[2 * rr]; q1l = F.tab[TAB_P0 + e1] * 256 + tokp[2 * rr + 1]; w0l = tokw[2 * rr]; w1l = tokw[2 * rr + 1]; }
        const float* g2 = mod + b * 6144 + 5120;
        f32x4 g2v[4], fgv[4];
#pragma unroll
        for (int jj = 0; jj < 2; ++jj)
#pragma unroll
            for (int hh = 0; hh < 2; ++hh) { const int c = 512 * jj + 8 * lane + 4 * hh; g2v[2 * jj + hh] = *(const f32x4*)(g2 + c); fgv[2 * jj + hh] = *(const f32x4*)(fg + c); }
#if MOE_FP8
        typedef u32x2 yvec; const unsigned char* Yb = (const unsigned char*)Y;
#define YLOAD(q_, c0_) (*(const u32x2*)(Yb + (q_) * D + (c0_)))
#define YUNPACK(v_, o_) do { const auto a0_ = __builtin_amdgcn_cvt_pk_f32_fp8((v_).x, false), a1_ = __builtin_amdgcn_cvt_pk_f32_fp8((v_).x, true), a2_ = __builtin_amdgcn_cvt_pk_f32_fp8((v_).y, false), a3_ = __builtin_amdgcn_cvt_pk_f32_fp8((v_).y, true); \
        o_[0] = a0_[0]; o_[1] = a0_[1]; o_[2] = a1_[0]; o_[3] = a1_[1]; o_[4] = a2_[0]; o_[5] = a2_[1]; o_[6] = a3_[0]; o_[7] = a3_[1]; } while (0)
        constexpr float YINV = 1.0f / Y_SCALE;
#else
        typedef u32x4 yvec;
#define YLOAD(q_, c0_) (*(const u32x4*)(Y + (q_) * D + (c0_)))
#define YUNPACK(v_, o_) do { _Pragma("unroll") for (int q_ = 0; q_ < 4; ++q_) { o_[2 * q_] = bflo((v_)[q_]); o_[2 * q_ + 1] = bfhi((v_)[q_]); } } while (0)
        constexpr float YINV = 1.0f;
#endif
        u32x4 xr[2], nxr[2]; yvec ya[2], yb[2], nya[2], nyb[2];
        { const size_t q0 = (size_t)__shfl(q0l, 0), q1 = (size_t)__shfl(q1l, 0);
#pragma unroll
          for (int jj = 0; jj < 2; ++jj) { const int c0 = 512 * jj + 8 * lane; xr[jj] = *(const u32x4*)(X1 + (size_t)row0 * D + c0); ya[jj] = YLOAD(q0, c0); yb[jj] = YLOAD(q1, c0); } }
#pragma unroll 1
        for (int r = 0; r < RPW; ++r) {
            const int row = row0 + r, rn = (r + 1 < RPW) ? r + 1 : r;
            { const size_t q0 = (size_t)__shfl(q0l, rn), q1 = (size_t)__shfl(q1l, rn);
#pragma unroll
              for (int jj = 0; jj < 2; ++jj) { const int c0 = 512 * jj + 8 * lane; nxr[jj] = *(const u32x4*)(X1 + (size_t)(row0 + rn) * D + c0); nya[jj] = YLOAD(q0, c0); nyb[jj] = YLOAD(q1, c0); } }
            const float w0 = __shfl(w0l, r), w1 = __shfl(w1l, r);
            float v[16]; float ss = 0.f;
#pragma unroll
            for (int jj = 0; jj < 2; ++jj) { float yav[8], ybv[8]; YUNPACK(ya[jj], yav); YUNPACK(yb[jj], ybv);
#pragma unroll
                for (int q = 0; q < 4; ++q) {
                    const float y0 = (w0 * yav[2 * q] + w1 * ybv[2 * q]) * YINV, y1 = (w0 * yav[2 * q + 1] + w1 * ybv[2 * q + 1]) * YINV;
                    const f32x4 gg = g2v[2 * jj + (q >> 1)];
                    v[8 * jj + 2 * q] = bflo(xr[jj][q]) + gg[(2 * q) & 3] * y0; v[8 * jj + 2 * q + 1] = bfhi(xr[jj][q]) + gg[(2 * q + 1) & 3] * y1; } }
#pragma unroll
            for (int q = 0; q < 16; ++q) ss += v[q] * v[q];
            const float rs = rsqrtf(wave_sum(ss) * (1.0f / D) + EPS);
#pragma unroll
            for (int jj = 0; jj < 2; ++jj) { const int c0 = 512 * jj + 8 * lane;
                f32x4 o0, o1;
#pragma unroll
                for (int q = 0; q < 4; ++q) { o0[q] = v[8 * jj + q] * rs * fgv[2 * jj][q]; o1[q] = v[8 * jj + 4 + q] * rs * fgv[2 * jj + 1][q]; }
                *(f32x4*)(out + (size_t)row * D + c0) = o0; *(f32x4*)(out + (size_t)row * D + c0 + 4) = o1;
                xr[jj] = nxr[jj]; ya[jj] = nya[jj]; yb[jj] = nyb[jj]; }
        }
    }
#undef YLOAD
#undef YUNPACK
}

__global__ void __launch_bounds__(NTHREADS, 2) mk(Args args) {
    extern __shared__ __attribute__((aligned(16))) unsigned char lds_raw[];
    Frame F;
    F.lds = (LAS unsigned char*)lds_raw; F.tab = (LAS int*)(F.lds + TAB_OFF);
    F.tid = threadIdx.x; F.lane = F.tid & 63; F.wave = __builtin_amdgcn_readfirstlane(F.tid >> 6);
    F.G = gridDim.x; F.bid = blockIdx.x; F.vcu = (F.G % 8 == 0) ? (F.bid % 8) * (F.G / 8) + F.bid / 8 : F.bid;
    F.ws = args.ws; F.ctl = (unsigned*)(args.ws + OFF_CTL);
    unsigned char* ws = args.ws;
    bf16_t* WIN = (bf16_t*)(ws + OFF_WIN); bf16_t* WOUT = (bf16_t*)(ws + OFF_WOUT); bf16_t* W13 = (bf16_t*)(ws + OFF_W13); bf16_t* W2 = (bf16_t*)(ws + OFF_W2);
    bf16_t* XN = (bf16_t*)(ws + OFF_XN); bf16_t* Z = (bf16_t*)(ws + OFF_Z); bf16_t* YMIX = (bf16_t*)(ws + OFF_YMIX); bf16_t* X1 = (bf16_t*)(ws + OFF_X1);
    bf16_t* ACT = (bf16_t*)(ws + OFF_ACT); bf16_t* Y = (bf16_t*)(ws + OFF_Y); bf16_t* H2 = XN;
    const float* mod = (const float*)(ws + OFF_MOD); const int* list = (const int*)(ws + OFF_LIST);
    const int lo = args.ph_lo, hi = args.ph_hi;
    for (int u = F.tid; u < (LDS_BYTES - LDSCTL_OFF) / 4; u += NTHREADS) ((LAS unsigned*)(F.lds + LDSCTL_OFF))[u] = 0u;
    __syncthreads();
    XcdBarrier bar; bar.bar = F.ctl + CW_BAR; bar.x = 0; bar.st = nullptr;
    if (hi - lo > 1) bar = xcd_barrier_post(F.ctl + CW_BAR, (volatile LAS unsigned*)(F.lds + LDSCTL_OFF) + 8);
#ifndef PHMASK
#define PHMASK 0x3ff
#endif
#define IN(k) (((PHMASK >> (k)) & 1) && lo <= (k) && (k) < hi)
#ifdef PROBE_SPAN
#define STAMP(i) do { if (F.bid == 0 && F.tid == 0) { const unsigned long long t_ = __builtin_amdgcn_s_memrealtime(); LAS unsigned* st_ = (LAS unsigned*)(F.lds + LDSCTL_OFF) + 32 + 2 * (i); st_[0] = (unsigned)t_; st_[1] = (unsigned)(t_ >> 32); } } while (0)
#else
#define STAMP(i) do { } while (0)
#endif
#define SEAM(k) do { if (IN(k) && IN((k) + 1)) xcd_barrier(bar); STAMP((k) + 1); } while (0)

    STAMP(0);
    if (IN(PH_A)) phase_A(F, args);
    SEAM(PH_A);
    if (IN(PH_B)) phase_B(F, args);
    SEAM(PH_B);
    if (IN(PH_C)) {
        pg8::Gemm g{XN, WIN, 2048}; pg8::EpiZ E{Z};
        if (F.G == 256) {
            constexpr int NCONV = 64, UPA = 5;
            const bool conv = F.bid >= 256 - NCONV;
            if (conv) { convert_experts(F, args, F.bid - (256 - NCONV), NCONV); __syncthreads(); }
            pg8::SplitOrder S; S.tokt = F.lds; S.init2(T, 2048, 2048, 256 - NCONV, NCONV, UPA, conv ? 1 : 0, conv ? F.bid - (256 - NCONV) : F.bid);
            pg8::gemm_phase<pg8::EpiZ, pg8::SplitOrder, true, false, false>(F.lds, g, S, E);
        } else {
            pg8::StaticOrder S; S.tokt = F.lds; S.init(T, 2048, 2048, F.G, F.bid);
            pg8::gemm_phase<pg8::EpiZ, pg8::StaticOrder, true, false, false>(F.lds, g, S, E);
        }
    }
    SEAM(PH_C);
    if (IN(PH_D)) { for (int blk = F.bid; blk < T / 128; blk += F.G) { __syncthreads(); sgu_block(F, args, blk); __syncthreads(); lru_block<1>(F, args, blk); } }
    SEAM(PH_D);
    if (IN(PH_E)) { for (int blk = F.bid; blk < T / 128; blk += F.G) { __syncthreads(); lru_block<2>(F, args, blk); } }
    SEAM(PH_E);
    if (IN(PH_F)) {
        __syncthreads();
        pg8::Gemm g{YMIX, WOUT, 2048}; pg8::StaticOrder S; S.tokt = F.lds; S.init(T, 1024, 2048, F.G, F.bid);
        pg8::EpiX1 E{args.in[0], mod, X1};
        pg8::gemm_phase<pg8::EpiX1, pg8::StaticOrder, true, false, false>(F.lds, g, S, E);
    }
    SEAM(PH_F);
    if (IN(PH_G)) phase_G(F, args);
    SEAM(PH_G);
    if (IN(PH_H)) {
        build_moe_table(F);
        pg8::MoeOrder S; S.nunits = F.tab[TAB_P0 + NE] * 4; S.G = F.G; S.c = F.vcu;
        S.tile_e = F.tab + TAB_TE; S.p0 = F.tab + TAB_P0; S.cnt = F.tab + TAB_CNT; S.list = list; S.gather = true; S.tokt = F.lds + TOKT_OFF;
#if MOE_FP8
        S.Kb = 1024; S.estride = (size_t)1024 * 1024;
        pg8::Gemm g{H2, W13, 1024}; pg8::EpiAct8 E{(unsigned char*)ACT, 1.0f / W13_SCALE, ACT_SCALE};
        pg8::gemm_phase<pg8::EpiAct8, pg8::MoeOrder, true, true, true>(F.lds, g, S, E);
#else
        S.Kb = 2048; S.estride = (size_t)1024 * 1024 * 2;
        pg8::Gemm g{H2, W13, 2048}; pg8::EpiAct E{ACT};
        pg8::gemm_phase<pg8::EpiAct, pg8::MoeOrder, true, true, false>(F.lds, g, S, E);
#endif
    }
    SEAM(PH_H);
    if (IN(PH_I)) {
        build_moe_table(F);
        pg8::MoeOrder S; S.nunits = F.tab[TAB_P0 + NE] * 4; S.G = F.G; S.c = F.vcu;
        S.tile_e = F.tab + TAB_TE; S.p0 = F.tab + TAB_P0; S.cnt = F.tab + TAB_CNT; S.list = list; S.gather = false; S.tokt = F.lds + TOKT_OFF;
#if MOE_FP8
        S.Kb = 512; S.estride = (size_t)1024 * 512;
        pg8::Gemm g{ACT, W2, 512}; pg8::EpiY8 E{(unsigned char*)Y, Y_SCALE / (W2_SCALE * ACT_SCALE)};
        pg8::gemm_phase<pg8::EpiY8, pg8::MoeOrder, true, false, true>(F.lds, g, S, E);
#else
        S.Kb = 1024; S.estride = (size_t)1024 * 512 * 2;
        pg8::Gemm g{ACT, W2, 1024}; pg8::EpiY E{Y};
        pg8::gemm_phase<pg8::EpiY, pg8::MoeOrder, true, false, false>(F.lds, g, S, E);
#endif
    }
    SEAM(PH_I);
    if (IN(PH_J)) { build_moe_table(F); phase_J(F, args); }
#ifdef PROBE_SPAN
    STAMP(PH_N);
    if (F.bid == 0 && F.tid == 0) { LAS unsigned* st_ = (LAS unsigned*)(F.lds + LDSCTL_OFF) + 32;
        const unsigned long long a_ = ((unsigned long long)st_[2 * PROBE_SPAN + 1] << 32) | st_[2 * PROBE_SPAN], b_ = ((unsigned long long)st_[2 * PROBE_SPAN + 3] << 32) | st_[2 * PROBE_SPAN + 2];
        const unsigned long long t0_ = __builtin_amdgcn_s_memrealtime(), dt_ = (b_ - a_) * PROBE_MULT;
        while (__builtin_amdgcn_s_memrealtime() - t0_ < dt_) __builtin_amdgcn_s_sleep(8); }
#endif
#undef IN
#undef SEAM
}
#ifndef FUSED
#define FUSED 1
#endif
extern "C" void kernel_launch(void* const* d_in, const int* in_sizes, int n_in, void* d_out, int out_size, void* d_ws, size_t ws_size, hipStream_t stream) {
    if (n_in != 27 || out_size != T * D || ws_size < WS_NEED) { fprintf(stderr, "kernel_launch: unexpected shapes (n_in %d out %d ws %zu)\n", n_in, out_size, ws_size); return; }
    static int grid = 0;
    if (grid == 0) {
        int dev = 0, cus = 0;
        if (hipGetDevice(&dev) != hipSuccess || hipDeviceGetAttribute(&cus, hipDeviceAttributeMultiprocessorCount, dev) != hipSuccess) { fprintf(stderr, "kernel_launch: device query failed\n"); grid = -1; return; }
        if (hipFuncSetAttribute((const void*)mk, hipFuncAttributeMaxDynamicSharedMemorySize, LDS_BYTES) != hipSuccess) { fprintf(stderr, "kernel_launch: hipFuncSetAttribute failed\n"); grid = -1; return; }
        int per_cu = 0;
        if (hipOccupancyMaxActiveBlocksPerMultiprocessor(&per_cu, (const void*)mk, NTHREADS, LDS_BYTES) != hipSuccess || per_cu < 1) fprintf(stderr, "kernel_launch: occupancy query says %d\n", per_cu);
        (void)hipGetLastError();
        grid = cus;
    }
    if (grid < 0) return;
    Args a{}; for (int i = 0; i < 27; ++i) a.in[i] = (const float*)d_in[i]; a.out = (float*)d_out; a.ws = (unsigned char*)d_ws;
#define MK(lo_, hi_) do { a.ph_lo = (lo_); a.ph_hi = (hi_); hipLaunchKernelGGL(mk, dim3(grid), dim3(NTHREADS), LDS_BYTES, stream, a); } while (0)
    (void)hipMemsetAsync((char*)d_ws + OFF_CTL, 0, CTL_BYTES, stream);
#if FUSED
    MK(0, PH_N);
#else
    for (int p = 0; p < PH_N; ++p) MK(p, p + 1);
#endif
}
```

```cpp
#include <hip/hip_runtime.h>
#include <cstdio>
#include <cstdint>

typedef unsigned short bf16_t;
typedef short bf16x8 __attribute__((ext_vector_type(8)));
typedef float f32x4 __attribute__((ext_vector_type(4)));
typedef unsigned u32x2 __attribute__((ext_vector_type(2)));
typedef unsigned u32x4 __attribute__((ext_vector_type(4)));

constexpr int T = 32768, D = 1024, SEQ = 4096, NB = 8;
constexpr int DL = 512;
constexpr int NE = 32, DE = 512;
constexpr int LISTCAP = 65536;
constexpr int MAXTILES = 288, MAXROWS = MAXTILES * 256;
constexpr float EPS = 1e-6f;

constexpr size_t MiB = 1u << 20;
constexpr size_t OFF_CTL = 0, CTL_BYTES = 48 * 1024;
constexpr size_t OFF_MOD = 1 * MiB;
constexpr size_t OFF_TBL = 1 * MiB + 256 * 1024;
constexpr size_t OFF_TOKE = 1 * MiB + 512 * 1024;
constexpr size_t OFF_TOKW = 1 * MiB + 768 * 1024;
constexpr size_t OFF_TOKP = 2 * MiB;
constexpr size_t OFF_N8SP = 1 * MiB + 256 * 1024 + 16384;
constexpr size_t OFF_GBIAS = 1 * MiB + 256 * 1024 + 32768;
constexpr size_t OFF_GATEW = 2 * MiB + 256 * 1024;
constexpr size_t OFF_SGUW = 2 * MiB + 512 * 1024;
constexpr size_t OFF_ROUTW = 2 * MiB + 768 * 1024;
constexpr size_t OFF_CARRY = 3 * MiB;
constexpr size_t OFF_WIN = 4 * MiB;
constexpr size_t OFF_WOUT = 8 * MiB;
constexpr size_t OFF_W13 = 10 * MiB;
constexpr size_t OFF_W2 = 74 * MiB;
constexpr size_t OFF_XN = 106 * MiB;
constexpr size_t OFF_Z = 170 * MiB;
constexpr size_t OFF_YMIX = 298 * MiB;
constexpr size_t OFF_X1 = 362 * MiB;
constexpr size_t OFF_ACT = 426 * MiB;
constexpr size_t OFF_LIST = 498 * MiB;
constexpr size_t OFF_ROWTOK = 506 * MiB;
constexpr size_t OFF_Y = 170 * MiB;
constexpr size_t WS_NEED = 507 * MiB;
constexpr size_t OFF_VN = OFF_X1;
constexpr size_t OFF_XC = OFF_ACT;
constexpr int CW_BAR = 4096;
constexpr int CW_CNT = 8192, CNT_STRIDE = 64;

__device__ __forceinline__ unsigned f2bf(float f) { unsigned u = __float_as_uint(f); return (u + 0x7fffu + ((u >> 16) & 1u)) >> 16; }
__device__ __forceinline__ float bf2f(unsigned h) { return __uint_as_float(h << 16); }
__device__ __forceinline__ unsigned pk2(float lo, float hi) { unsigned r; asm("v_cvt_pk_bf16_f32 %0, %1, %2" : "=v"(r) : "v"(lo), "v"(hi)); return r; }
__device__ __forceinline__ float wave_sum(float v) {
#pragma unroll
    for (int o = 1; o < 64; o <<= 1) v += __shfl_xor(v, o);
    return v;
}
__device__ __forceinline__ float gelu_tanh(float x) {
    const float u = 1.5957691216057308f * (x + 0.044715f * x * x * x);
    return x / (1.0f + __expf(-u));
}
__device__ __forceinline__ float sigmoidf(float x) { return 1.0f / (1.0f + __expf(-x)); }

__global__ void __launch_bounds__(256) k_ada(const float* c, const float* ada_w, const float* ada_b, float* mod) {
    __shared__ float sc[8][1024];
    for (int i = threadIdx.x; i < 8192; i += 256) { const float v = c[i]; sc[i >> 10][i & 1023] = v / (1.0f + expf(-v)); }
    __syncthreads();
    const int n = blockIdx.x * 256 + threadIdx.x;
    float acc[8];
#pragma unroll
    for (int b = 0; b < 8; ++b) acc[b] = 0.f;
    for (int k = 0; k < 1024; ++k) {
        const float w = ada_w[(size_t)k * 6144 + n];
#pragma unroll
        for (int b = 0; b < 8; ++b) acc[b] += sc[b][k] * w;
    }
#pragma unroll
    for (int b = 0; b < 8; ++b) mod[b * 6144 + n] = acc[b] + ada_b[n];
}

__global__ void __launch_bounds__(256) k_transpose(const float* W, bf16_t* WT, int K, int N, int blk, int rstride, int rbase, size_t w_ms, size_t wt_ms) {
    __shared__ float tile[32][33];
    W += (size_t)blockIdx.z * w_ms; WT += (size_t)blockIdx.z * wt_ms;
    const int n0 = blockIdx.x * 32, k0 = blockIdx.y * 32, tx = threadIdx.x & 31, ty = threadIdx.x >> 5;
    for (int j = ty; j < 32; j += 8) tile[j][tx] = W[(size_t)(k0 + j) * N + n0 + tx];
    __syncthreads();
    for (int j = ty; j < 32; j += 8) { const int n = n0 + j; const int row = rbase + (n / blk) * rstride + (n % blk);
        WT[(size_t)row * K + k0 + tx] = (bf16_t)f2bf(tile[tx][j]); }
}

__global__ void __launch_bounds__(256) k_xn(const float* x, const float* g, const float* mod, bf16_t* XN) {
    const int row = blockIdx.x * 4 + (threadIdx.x >> 6), lane = threadIdx.x & 63, b = row / SEQ;
    const f32x4* xr = (const f32x4*)(x + (size_t)row * D);
    f32x4 v[4]; float ss = 0.f;
#pragma unroll
    for (int j = 0; j < 4; ++j) { v[j] = xr[lane + 64 * j]; ss += v[j][0] * v[j][0] + v[j][1] * v[j][1] + v[j][2] * v[j][2] + v[j][3] * v[j][3]; }
    ss = wave_sum(ss);
    const float rs = rsqrtf(ss * (1.0f / D) + EPS);
    const float* sh = mod + b * 6144; const float* sc = sh + 1024;
#pragma unroll
    for (int j = 0; j < 4; ++j) { const int col = 4 * (lane + 64 * j);
        const f32x4 gg = *(const f32x4*)(g + col), s1 = *(const f32x4*)(sc + col), s0 = *(const f32x4*)(sh + col);
        float h[4];
#pragma unroll
        for (int q = 0; q < 4; ++q) h[q] = v[j][q] * rs * gg[q] * (1.0f + s1[q]) + s0[q];
        u32x2 o; o.x = pk2(h[0], h[1]); o.y = pk2(h[2], h[3]);
        *(u32x2*)(XN + (size_t)row * D + col) = o; }
}

template <bool DUAL, class Epi>
__device__ __forceinline__ void sg_tile(const bf16_t* A, const int* arow, const bf16_t* Bt, const bf16_t* Bt2, int K, int m0, int n0, int lane, const Epi& epi) {
    const int fr = lane & 15, fq = lane >> 4;
    const bf16_t* pa[2]; const bf16_t* pb[4]; const bf16_t* pb2[4];
#pragma unroll
    for (int mi = 0; mi < 2; ++mi) { const int r = m0 + mi * 16 + fr; const int rr = arow ? arow[r] : r; pa[mi] = A + (size_t)rr * K + 8 * fq; }
#pragma unroll
    for (int ni = 0; ni < 4; ++ni) { pb[ni] = Bt + (size_t)(n0 + ni * 16 + fr) * K + 8 * fq; pb2[ni] = DUAL ? Bt2 + (size_t)(n0 + ni * 16 + fr) * K + 8 * fq : nullptr; }
    f32x4 acc[2][4], acc2[2][4];
#pragma unroll
    for (int mi = 0; mi < 2; ++mi)
#pragma unroll
        for (int ni = 0; ni < 4; ++ni) { acc[mi][ni] = (f32x4){0.f, 0.f, 0.f, 0.f}; acc2[mi][ni] = (f32x4){0.f, 0.f, 0.f, 0.f}; }
    for (int k0 = 0; k0 < K; k0 += 32) {
        bf16x8 a[2], b[4], b2[4];
#pragma unroll
        for (int mi = 0; mi < 2; ++mi) a[mi] = *(const bf16x8*)(pa[mi] + k0);
#pragma unroll
        for (int ni = 0; ni < 4; ++ni) { b[ni] = *(const bf16x8*)(pb[ni] + k0); if (DUAL) b2[ni] = *(const bf16x8*)(pb2[ni] + k0); }
#pragma unroll
        for (int mi = 0; mi < 2; ++mi)
#pragma unroll
            for (int ni = 0; ni < 4; ++ni) {
                acc[mi][ni] = __builtin_amdgcn_mfma_f32_16x16x32_bf16(b[ni], a[mi], acc[mi][ni], 0, 0, 0);
                if (DUAL) acc2[mi][ni] = __builtin_amdgcn_mfma_f32_16x16x32_bf16(b2[ni], a[mi], acc2[mi][ni], 0, 0, 0);
            }
    }
#pragma unroll
    for (int mi = 0; mi < 2; ++mi)
#pragma unroll
        for (int ni = 0; ni < 4; ++ni) epi(m0 + mi * 16 + fr, n0 + ni * 16 + 4 * fq, acc[mi][ni], acc2[mi][ni]);
}

struct EpiInProj { bf16_t* Z;
    __device__ __forceinline__ void operator()(int row, int col, f32x4 v, f32x4) const {
        if (col >= 512) { v[0] = gelu_tanh(v[0]); v[1] = gelu_tanh(v[1]); v[2] = gelu_tanh(v[2]); v[3] = gelu_tanh(v[3]); }
        u32x2 o; o.x = pk2(v[0], v[1]); o.y = pk2(v[2], v[3]); *(u32x2*)(Z + (size_t)row * 2048 + col) = o; } };
struct EpiOutProj { const float* x; const float* mod; bf16_t* X1;
    __device__ __forceinline__ void operator()(int row, int col, f32x4 v, f32x4) const {
        const int b = row / SEQ; const f32x4 xv = *(const f32x4*)(x + (size_t)row * D + col), g1 = *(const f32x4*)(mod + b * 6144 + 2048 + col);
        u32x2 o; o.x = pk2(xv[0] + g1[0] * v[0], xv[1] + g1[1] * v[1]); o.y = pk2(xv[2] + g1[2] * v[2], xv[3] + g1[3] * v[3]);
        *(u32x2*)(X1 + (size_t)row * D + col) = o; } };
struct EpiMoe1 { bf16_t* ACT;
    __device__ __forceinline__ void operator()(int row, int col, f32x4 g, f32x4 u) const {
        float a[4];
#pragma unroll
        for (int q = 0; q < 4; ++q) a[q] = g[q] / (1.0f + __expf(-g[q])) * u[q];
        u32x2 o; o.x = pk2(a[0], a[1]); o.y = pk2(a[2], a[3]); *(u32x2*)(ACT + (size_t)row * DE + col) = o; } };
struct EpiMoe2 { bf16_t* Y;
    __device__ __forceinline__ void operator()(int row, int col, f32x4 v, f32x4) const {
        u32x2 o; o.x = pk2(v[0], v[1]); o.y = pk2(v[2], v[3]); *(u32x2*)(Y + (size_t)row * D + col) = o; } };

template <class Epi>
__global__ void __launch_bounds__(256) k_sgemm(const bf16_t* A, const bf16_t* Bt, int M, int N, int K, Epi epi) {
    const int w = blockIdx.x * 4 + (threadIdx.x >> 6), lane = threadIdx.x & 63, nN = N / 64;
    const int mt = w / nN, nt = w % nN; if (mt * 32 >= M) return;
    sg_tile<false>(A, nullptr, Bt, nullptr, K, mt * 32, nt * 64, lane, epi);
}
__global__ void __launch_bounds__(256) k_moe1(const bf16_t* H2, const int* rowtok, const int* tbl, const bf16_t* W13, EpiMoe1 epi) {
    const int w = blockIdx.x * 4 + (threadIdx.x >> 6), lane = threadIdx.x & 63;
    const int mt = w / 8, nt = w % 8, tile = mt / 8;
    if (tile >= tbl[0]) return;
    const int e = tbl[64 + tile], n0 = nt * 64, q = n0 / 128, i0 = n0 % 128;
    const bf16_t* Wg = W13 + (size_t)e * 1024 * 1024 + (size_t)(256 * q + i0) * 1024 - (size_t)n0 * 1024;
    sg_tile<true>(H2, rowtok, Wg, Wg + (size_t)128 * 1024, 1024, mt * 32, n0, lane, epi);
}
__global__ void __launch_bounds__(256) k_moe2(const bf16_t* ACT, const int* tbl, const bf16_t* W2, EpiMoe2 epi) {
    const int w = blockIdx.x * 4 + (threadIdx.x >> 6), lane = threadIdx.x & 63;
    const int mt = w / 16, nt = w % 16, tile = mt / 8;
    if (tile >= tbl[0]) return;
    const int e = tbl[64 + tile];
    sg_tile<false>(ACT, nullptr, W2 + (size_t)e * 1024 * 512, nullptr, 512, mt * 32, nt * 64, lane, epi);
}

__global__ void __launch_bounds__(256) k_lnv(const bf16_t* Z, const float* g, const float* bb, bf16_t* VN) {
    const int row = blockIdx.x * 4 + (threadIdx.x >> 6), lane = threadIdx.x & 63;
    const u32x4 raw = *(const u32x4*)(Z + (size_t)row * 2048 + 1536 + 8 * lane);
    float v[8];
#pragma unroll
    for (int q = 0; q < 4; ++q) { v[2 * q] = bf2f(raw[q] & 0xffffu); v[2 * q + 1] = bf2f(raw[q] >> 16); }
    float s = 0.f;
#pragma unroll
    for (int q = 0; q < 8; ++q) s += v[q];
    const float mu = wave_sum(s) * (1.0f / 512.0f);
    float s2 = 0.f;
#pragma unroll
    for (int q = 0; q < 8; ++q) { v[q] -= mu; s2 += v[q] * v[q]; }
    const float rstd = rsqrtf(wave_sum(s2) * (1.0f / 512.0f) + EPS);
    u32x4 o;
#pragma unroll
    for (int q = 0; q < 4; ++q) { const int c = 8 * lane + 2 * q; o[q] = pk2(v[2 * q] * rstd * g[c] + bb[c], v[2 * q + 1] * rstd * g[c + 1] + bb[c + 1]); }
    *(u32x4*)(VN + (size_t)row * 512 + 8 * lane) = o;
}
__global__ void __launch_bounds__(256) k_sgu(const bf16_t* Z, const bf16_t* VN, const float* sgu_w, const float* sgu_b, bf16_t* YMIX) {
    const int idx = blockIdx.x * 256 + threadIdx.x, t = idx >> 9, ch = idx & 511, i = t & 127, blk = t >> 7, g = ch >> 6;
    const int jmax = (i < 64) ? 64 : 128;
    float s = sgu_b[g * 128 + i];
    const float* wrow = sgu_w + ((size_t)g * 128 + i) * 128;
    for (int j = 0; j < jmax; ++j) s += wrow[j] * bf2f(VN[((size_t)blk * 128 + j) * 512 + ch]);
    YMIX[(size_t)t * D + 512 + ch] = (bf16_t)f2bf(bf2f(Z[(size_t)t * 2048 + 1024 + ch]) * s);
}
__global__ void __launch_bounds__(256) k_conv(const bf16_t* Z, const float* cw, const float* cb, float* XC) {
    const int idx = blockIdx.x * 256 + threadIdx.x, t = idx >> 9, ch = idx & 511, pos = t & (SEQ - 1);
    float acc = cb[ch];
#pragma unroll
    for (int k = 0; k < 4; ++k) { const int d = k - 3; if (pos + d >= 0) acc += cw[k * 512 + ch] * bf2f(Z[(size_t)(t + d) * 2048 + ch]); }
    XC[idx] = acc;
}
__global__ void __launch_bounds__(256) k_gates(const float* XC, const float* wa, const float* ba, const float* wi, const float* bi, const float* lam, float* A_, float* U_) {
    const int idx = blockIdx.x * 256 + threadIdx.x, t = idx >> 9, ch = idx & 511, h = ch >> 6, e = ch & 63;
    const float* xrow = XC + (size_t)t * 512 + h * 64;
    float ra = ba[ch], ri = bi[ch];
    for (int d = 0; d < 64; ++d) { const float xv = xrow[d]; ra += xv * wa[h * 4096 + d * 64 + e]; ri += xv * wi[h * 4096 + d * 64 + e]; }
    const float r = sigmoidf(ra), ig = sigmoidf(ri);
    const float sp = log1pf(expf(-lam[ch]));
    const float log_a = -8.0f * r * sp;
    A_[idx] = expf(log_a);
    U_[idx] = sqrtf(-expm1f(2.0f * log_a)) * (ig * XC[idx]);
}
__global__ void __launch_bounds__(64) k_scan(const float* A_, const float* U_, const bf16_t* Z, bf16_t* YMIX) {
    const int idx = blockIdx.x * 64 + threadIdx.x, b = idx >> 9, ch = idx & 511;
    float h = 0.f;
    for (int p0 = 0; p0 < SEQ; p0 += 8) {
        float a[8], u[8], g[8];
#pragma unroll
        for (int q = 0; q < 8; ++q) { const size_t t = (size_t)b * SEQ + p0 + q; a[q] = A_[t * 512 + ch]; u[q] = U_[t * 512 + ch]; g[q] = bf2f(Z[t * 2048 + 512 + ch]); }
#pragma unroll
        for (int q = 0; q < 8; ++q) { const size_t t = (size_t)b * SEQ + p0 + q; h = a[q] * h + u[q]; YMIX[t * D + ch] = (bf16_t)f2bf(h * g[q]); }
    }
}

__global__ void __launch_bounds__(256) k_router(const bf16_t* X1, const float* g2w, const float* mod, const float* wg, const float* bg, const float* we, const float* be,
                                                bf16_t* H2, unsigned* cnt, int* list, int* toke, float* tokw, int* tokp) {
    const int row = blockIdx.x * 4 + (threadIdx.x >> 6), lane = threadIdx.x & 63, b = row / SEQ;
    float h[16]; float ss = 0.f;
#pragma unroll
    for (int jj = 0; jj < 2; ++jj) { const u32x4 raw = *(const u32x4*)(X1 + (size_t)row * D + 512 * jj + 8 * lane);
#pragma unroll
        for (int q = 0; q < 4; ++q) { h[8 * jj + 2 * q] = bf2f(raw[q] & 0xffffu); h[8 * jj + 2 * q + 1] = bf2f(raw[q] >> 16); } }
#pragma unroll
    for (int q = 0; q < 16; ++q) ss += h[q] * h[q];
    const float rs = rsqrtf(wave_sum(ss) * (1.0f / D) + EPS);
    const float* sh = mod + b * 6144 + 3072; const float* sc = sh + 1024;
#pragma unroll
    for (int jj = 0; jj < 2; ++jj) { u32x4 o;
#pragma unroll
        for (int q = 0; q < 4; ++q) { const int c = 512 * jj + 8 * lane + 2 * q;
            const float h0 = h[8 * jj + 2 * q] * rs * g2w[c] * (1.0f + sc[c]) + sh[c], h1 = h[8 * jj + 2 * q + 1] * rs * g2w[c + 1] * (1.0f + sc[c + 1]) + sh[c + 1];
            o[q] = pk2(h0, h1); h[8 * jj + 2 * q] = bf2f(o[q] & 0xffffu); h[8 * jj + 2 * q + 1] = bf2f(o[q] >> 16); }
        *(u32x4*)(H2 + (size_t)row * D + 512 * jj + 8 * lane) = o; }
    float gl[4], el[8];
#pragma unroll
    for (int j = 0; j < 4; ++j) { float p = 0.f;
#pragma unroll
        for (int q = 0; q < 16; ++q) { const int k = 512 * (q >> 3) + 8 * lane + (q & 7); p += h[q] * wg[k * 4 + j]; }
        gl[j] = wave_sum(p) + bg[j]; }
    int gs = 0; float gmax = gl[0];
#pragma unroll
    for (int j = 1; j < 4; ++j) if (gl[j] > gmax) { gmax = gl[j]; gs = j; }
#pragma unroll
    for (int j = 0; j < 8; ++j) { float p = 0.f;
#pragma unroll
        for (int q = 0; q < 16; ++q) { const int k = 512 * (q >> 3) + 8 * lane + (q & 7); p += h[q] * we[k * 32 + gs * 8 + j]; }
        el[j] = wave_sum(p) + be[gs * 8 + j]; }
    if (lane == 0) {
        float gsum = 0.f;
#pragma unroll
        for (int j = 0; j < 4; ++j) gsum += expf(gl[j] - gmax);
        const float pg = 1.0f / gsum;
        int i1 = 0; float m1 = el[0];
#pragma unroll
        for (int j = 1; j < 8; ++j) if (el[j] > m1) { m1 = el[j]; i1 = j; }
        int i2 = -1; float m2 = -INFINITY;
#pragma unroll
        for (int j = 0; j < 8; ++j) if (j != i1 && el[j] > m2) { m2 = el[j]; i2 = j; }
        const float r = expf(m2 - m1);
        const float w1 = pg / (1.0f + r), w2 = pg * r / (1.0f + r);
        const int e1 = gs * 8 + i1, e2 = gs * 8 + i2;
        const unsigned p1 = atomicAdd(cnt + CNT_STRIDE * e1, 1u), p2 = atomicAdd(cnt + CNT_STRIDE * e2, 1u);
        list[(size_t)e1 * LISTCAP + p1] = row; list[(size_t)e2 * LISTCAP + p2] = row;
        toke[2 * row] = e1; toke[2 * row + 1] = e2; tokw[2 * row] = w1; tokw[2 * row + 1] = w2; tokp[2 * row] = (int)p1; tokp[2 * row + 1] = (int)p2;
    }
}
__global__ void k_table(const unsigned* cnt, int* tbl) {
    if (threadIdx.x == 0) { int p = 0;
        for (int e = 0; e < NE; ++e) { tbl[1 + e] = p; const int nt = ((int)cnt[CNT_STRIDE * e] + 255) / 256; for (int j = 0; j < nt; ++j) tbl[64 + p + j] = e; p += nt; }
        tbl[1 + NE] = p; tbl[0] = p; }
}
__global__ void __launch_bounds__(256) k_rowtok(const unsigned* cnt, const int* tbl, const int* list, int* rowtok) {
    const int p = blockIdx.x * 256 + threadIdx.x, t = p >> 8; int tok = 0;
    if (t < tbl[0]) { const int e = tbl[64 + t], pos = (t - tbl[1 + e]) * 256 + (p & 255); if (pos < (int)cnt[CNT_STRIDE * e]) tok = list[(size_t)e * LISTCAP + pos]; }
    rowtok[p] = tok;
}
__global__ void __launch_bounds__(256) k_combine(const bf16_t* X1, const bf16_t* Y, const float* mod, const int* tbl, const int* toke, const float* tokw, const int* tokp, const float* fg, float* out) {
    const int row = blockIdx.x * 4 + (threadIdx.x >> 6), lane = threadIdx.x & 63, b = row / SEQ;
    const int e0 = toke[2 * row], e1 = toke[2 * row + 1];
    const size_t q0 = (size_t)tbl[1 + e0] * 256 + tokp[2 * row], q1 = (size_t)tbl[1 + e1] * 256 + tokp[2 * row + 1];
    const float w0 = tokw[2 * row], w1 = tokw[2 * row + 1];
    const float* g2 = mod + b * 6144 + 5120;
    float v[16]; float ss = 0.f;
#pragma unroll
    for (int jj = 0; jj < 2; ++jj) { const int c0 = 512 * jj + 8 * lane;
        const u32x4 xr = *(const u32x4*)(X1 + (size_t)row * D + c0), ya = *(const u32x4*)(Y + q0 * D + c0), yb = *(const u32x4*)(Y + q1 * D + c0);
#pragma unroll
        for (int q = 0; q < 4; ++q) {
            const float x0 = bf2f(xr[q] & 0xffffu), x1 = bf2f(xr[q] >> 16);
            const float y0 = w0 * bf2f(ya[q] & 0xffffu) + w1 * bf2f(yb[q] & 0xffffu), y1 = w0 * bf2f(ya[q] >> 16) + w1 * bf2f(yb[q] >> 16);
            v[8 * jj + 2 * q] = x0 + g2[c0 + 2 * q] * y0; v[8 * jj + 2 * q + 1] = x1 + g2[c0 + 2 * q + 1] * y1; } }
#pragma unroll
    for (int q = 0; q < 16; ++q) ss += v[q] * v[q];
    const float rs = rsqrtf(wave_sum(ss) * (1.0f / D) + EPS);
#pragma unroll
    for (int jj = 0; jj < 2; ++jj) { const int c0 = 512 * jj + 8 * lane;
        f32x4 o0, o1;
#pragma unroll
        for (int q = 0; q < 4; ++q) { o0[q] = v[8 * jj + q] * rs * fg[c0 + q]; o1[q] = v[8 * jj + 4 + q] * rs * fg[c0 + 4 + q]; }
        *(f32x4*)(out + (size_t)row * D + c0) = o0; *(f32x4*)(out + (size_t)row * D + c0 + 4) = o1; }
}

namespace pg8 {
#define PG8_LAS __attribute__((address_space(3)))
constexpr int BM = 256, BK = 64, HALF = 128, HTB = HALF * BK * 2  , STAGE_BYTES = 8 * HTB, NXCD = 8, WGM = 8;
__host__ __device__ __forceinline__ int lds_byte(int r, int c) { const int st = (r >> 4) * 2 + (c >> 5), rr = r & 15, cc = c & 31, ob = rr * 64 + cc * 2; return st * 1024 + (ob ^ (((ob >> 9) & 1) << 5)); }
__host__ __device__ __forceinline__ void stage_rc(int b, int& R, int& C) { const int st = b / 1024, sb = b % 1024, swz = sb ^ (((sb >> 9) & 1) << 5); R = (st >> 1) * 16 + swz / 64; C = (st & 1) * 32 + (swz % 64) / 2; }
__host__ __device__ __forceinline__ int perm32(int rho) { const int n = rho >> 4, i = rho & 15; return 8 * (i >> 2) + 4 * n + (i & 3); }

struct Unit { int pm, pn, e; };
struct Gemm { const void* A; const void* Bt; int Kb; };
__host__ __device__ __forceinline__ int swz8(int r8) { return ((r8 >> 1) & 1) | (((r8 >> 2) & 1) << 2); }
__host__ __device__ __forceinline__ int lds_byte8(int r, int piece) { return (r >> 3) * 1024 + ((r & 7) * 8 + (piece ^ swz8(r & 7))) * 16; }
__host__ __device__ __forceinline__ void stage_rc8(int b, int& R, int& Cb) { const int chunk = b >> 10, slot = (b & 1023) >> 4, r8 = slot >> 3, j = slot & 7; R = chunk * 8 + r8; Cb = (j ^ swz8(r8)) * 16; }
typedef int v8i32 __attribute__((ext_vector_type(8)));
typedef int v4i32 __attribute__((ext_vector_type(4)));

struct StaticOrder {
    int nM, nN, nwg, G, c; size_t tstep;
    __device__ void init(int M, int N, int Kb, int G_, int c_) { nM = M / BM; nN = N / BM; nwg = nM * nN; G = G_; c = c_; tstep = (size_t)BM * Kb; }
    __device__ bool next(int i, Unit& u) const {
        const long L = (long)i * G + c; if (L >= nwg) return false;
        int wgid = (int)L; { const int q = nwg / NXCD, r = nwg % NXCD, xcd = wgid % NXCD, off = wgid / NXCD; wgid = (xcd < r ? xcd * (q + 1) : r * (q + 1) + (xcd - r) * q) + off; }
        const int nig = WGM * nN, gid = wgid / nig, fm = gid * WGM, gsz = (nM - fm) < WGM ? (nM - fm) : WGM;
        u.pm = fm + ((wgid % nig) % gsz); u.pn = (wgid % nig) / gsz; u.e = 0; return true;
    }
    __device__ __forceinline__ size_t a_off(const Unit& u) const { return (size_t)u.pm * tstep; }
    __device__ __forceinline__ size_t b_off(const Unit& u) const { return (size_t)u.pn * tstep; }
    PG8_LAS unsigned char* tokt;
    __device__ __forceinline__ const int* tok_src(const Unit&, int) const { return nullptr; }
};
struct SplitOrder : StaticOrder {
    int nA, upa, cls, idx, nB;
    __device__ void init2(int M, int N, int Kb, int nA_, int nB_, int upa_, int cls_, int idx_) { init(M, N, Kb, 1, 0); nA = nA_; nB = nB_; upa = upa_; cls = cls_; idx = idx_; }
    __device__ bool next(int i, Unit& u) const {
        long L; if (cls == 0) { if (i >= upa) return false; L = (long)i * nA + idx; } else { L = (long)upa * nA + (long)i * nB + idx; }
        if (L >= nwg) return false;
        int wgid = (int)L; { const int q = nwg / NXCD, r = nwg % NXCD, xcd = wgid % NXCD, off = wgid / NXCD; wgid = (xcd < r ? xcd * (q + 1) : r * (q + 1) + (xcd - r) * q) + off; }
        const int nig = WGM * nN, gid = wgid / nig, fm = gid * WGM, gsz = (nM - fm) < WGM ? (nM - fm) : WGM;
        u.pm = fm + ((wgid % nig) % gsz); u.pn = (wgid % nig) / gsz; u.e = 0; return true;
    }
};
struct MoeOrder {
    int nunits, G, c, Kb; size_t estride;
    const PG8_LAS int* tile_e; const PG8_LAS int* p0; const PG8_LAS int* cnt; const int* list; bool gather;
    __device__ bool next(int i, Unit& u) const {
        const int L = i * G + c; if (L >= nunits) return false;
        u.pm = L >> 2; u.pn = L & 3; u.e = tile_e[u.pm]; return true;
    }
    __device__ __forceinline__ size_t a_off(const Unit& u) const { return gather ? (size_t)0 : (size_t)u.pm * BM * Kb; }
    __device__ __forceinline__ size_t b_off(const Unit& u) const { return (size_t)u.e * estride + (size_t)u.pn * BM * Kb; }
    PG8_LAS unsigned char* tokt;
    __device__ __forceinline__ const int* tok_src(const Unit& u, int r) const {
        const int pos = (u.pm - p0[u.e]) * 256 + r, last = cnt[u.e] - 1;
        return list + (size_t)u.e * LISTCAP + (pos < last ? pos : last);
    }
};

__device__ __forceinline__ unsigned cvt_pk_bf16(float lo, float hi) { unsigned r; asm volatile("v_cvt_pk_bf16_f32 %0, %1, %2" : "=v"(r) : "v"(lo), "v"(hi)); return r; }
__device__ __forceinline__ float gelu_fast(float x) {
    const float u = -2.3022082f * (x + 0.044715f * x * x * x);
    return x * __builtin_amdgcn_rcpf(1.0f + __builtin_amdgcn_exp2f(u));
}
__device__ __forceinline__ float silu_fast(float x) { return x * __builtin_amdgcn_rcpf(1.0f + __builtin_amdgcn_exp2f(-1.4426950408889634f * x)); }

struct EpiZ { static constexpr bool PERM = true; bf16_t* Z;
    __device__ __forceinline__ void operator()(const f32x4 (&acc)[2][2][4][2], const Unit& u, int wr, int wc, int fr, int fq) const {
        const int row0 = u.pm * BM + wr * 64 + fr, col0 = u.pn * BM + wc * 32 + 8 * fq; const bool act = u.pn >= 2;
#pragma unroll
        for (int ai = 0; ai < 2; ++ai)
#pragma unroll
            for (int m = 0; m < 4; ++m) { bf16_t* rowp = Z + (size_t)(row0 + ai * HALF + m * 16) * 2048 + col0;
#pragma unroll
                for (int bj = 0; bj < 2; ++bj) { f32x4 v0 = acc[ai][bj][m][0], v1 = acc[ai][bj][m][1];
                    if (act) {
#pragma unroll
                        for (int q = 0; q < 4; ++q) { v0[q] = gelu_fast(v0[q]); v1[q] = gelu_fast(v1[q]); } }
                    u32x4 w; w.x = cvt_pk_bf16(v0[0], v0[1]); w.y = cvt_pk_bf16(v0[2], v0[3]); w.z = cvt_pk_bf16(v1[0], v1[1]); w.w = cvt_pk_bf16(v1[2], v1[3]);
                    *(u32x4*)(rowp + bj * HALF) = w; } }
    }
};
struct EpiX1 { static constexpr bool PERM = true; const float* x; const float* mod; bf16_t* X1;
    __device__ __forceinline__ void operator()(const f32x4 (&acc)[2][2][4][2], const Unit& u, int wr, int wc, int fr, int fq) const {
        const int row0 = u.pm * BM + wr * 64 + fr, col0 = u.pn * BM + wc * 32 + 8 * fq; const int b = (u.pm * BM) / SEQ;
        const float* g1 = mod + b * 6144 + 2048 + col0;
        f32x4 gv[2][2];
#pragma unroll
        for (int bj = 0; bj < 2; ++bj) { gv[bj][0] = *(const f32x4*)(g1 + bj * HALF); gv[bj][1] = *(const f32x4*)(g1 + bj * HALF + 4); }
#pragma unroll
        for (int ai = 0; ai < 2; ++ai)
#pragma unroll
            for (int m = 0; m < 4; ++m) { const size_t off = (size_t)(row0 + ai * HALF + m * 16) * D + col0;
#pragma unroll
                for (int bj = 0; bj < 2; ++bj) { const f32x4 x0 = *(const f32x4*)(x + off + bj * HALF), x1 = *(const f32x4*)(x + off + bj * HALF + 4);
                    const f32x4 v0 = x0 + gv[bj][0] * acc[ai][bj][m][0], v1 = x1 + gv[bj][1] * acc[ai][bj][m][1];
                    u32x4 w; w.x = cvt_pk_bf16(v0[0], v0[1]); w.y = cvt_pk_bf16(v0[2], v0[3]); w.z = cvt_pk_bf16(v1[0], v1[1]); w.w = cvt_pk_bf16(v1[2], v1[3]);
                    *(u32x4*)(X1 + off + bj * HALF) = w; } }
    }
};
struct EpiAct { static constexpr bool PERM = true; bf16_t* ACT;
    __device__ __forceinline__ void operator()(const f32x4 (&acc)[2][2][4][2], const Unit& u, int wr, int wc, int fr, int fq) const {
        const int row0 = u.pm * BM + wr * 64 + fr, col0 = u.pn * HALF + wc * 32 + 8 * fq;
#pragma unroll
        for (int ai = 0; ai < 2; ++ai)
#pragma unroll
            for (int m = 0; m < 4; ++m) { f32x4 v0, v1;
#pragma unroll
                for (int q = 0; q < 4; ++q) { v0[q] = silu_fast(acc[ai][0][m][0][q]) * acc[ai][1][m][0][q]; v1[q] = silu_fast(acc[ai][0][m][1][q]) * acc[ai][1][m][1][q]; }
                u32x4 w; w.x = cvt_pk_bf16(v0[0], v0[1]); w.y = cvt_pk_bf16(v0[2], v0[3]); w.z = cvt_pk_bf16(v1[0], v1[1]); w.w = cvt_pk_bf16(v1[2], v1[3]);
                *(u32x4*)(ACT + (size_t)(row0 + ai * HALF + m * 16) * DE + col0) = w; }
    }
};
__device__ __forceinline__ unsigned pk4_fp8(float a, float b, float c, float d) {
    a = __builtin_fminf(__builtin_fmaxf(a, -448.f), 448.f); b = __builtin_fminf(__builtin_fmaxf(b, -448.f), 448.f);
    c = __builtin_fminf(__builtin_fmaxf(c, -448.f), 448.f); d = __builtin_fminf(__builtin_fmaxf(d, -448.f), 448.f);
    unsigned w = 0u; w = __builtin_amdgcn_cvt_pk_fp8_f32(a, b, w, false); w = __builtin_amdgcn_cvt_pk_fp8_f32(c, d, w, true); return w; }
struct EpiAct8 { static constexpr bool PERM = true; unsigned char* ACT; float inv, oscale;
    __device__ __forceinline__ void operator()(const f32x4 (&acc)[2][2][4][2], const Unit& u, int wr, int wc, int fr, int fq) const {
        const int row0 = u.pm * BM + wr * 64 + fr, col0 = u.pn * HALF + wc * 32 + 8 * fq; const float io = inv * oscale;
#pragma unroll
        for (int ai = 0; ai < 2; ++ai)
#pragma unroll
            for (int m = 0; m < 4; ++m) { f32x4 v0, v1;
#pragma unroll
                for (int q = 0; q < 4; ++q) { v0[q] = silu_fast(acc[ai][0][m][0][q] * inv) * (acc[ai][1][m][0][q] * io); v1[q] = silu_fast(acc[ai][0][m][1][q] * inv) * (acc[ai][1][m][1][q] * io); }
                u32x2 w; w.x = pk4_fp8(v0[0], v0[1], v0[2], v0[3]); w.y = pk4_fp8(v1[0], v1[1], v1[2], v1[3]);
                *(u32x2*)(ACT + (size_t)(row0 + ai * HALF + m * 16) * DE + col0) = w; }
    }
};
struct EpiY8 { static constexpr bool PERM = true; unsigned char* Y; float sc;
    __device__ __forceinline__ void operator()(const f32x4 (&acc)[2][2][4][2], const Unit& u, int wr, int wc, int fr, int fq) const {
        const int row0 = u.pm * BM + wr * 64 + fr, col0 = u.pn * BM + wc * 32 + 8 * fq;
#pragma unroll
        for (int ai = 0; ai < 2; ++ai)
#pragma unroll
            for (int m = 0; m < 4; ++m) { unsigned char* rowp = Y + (size_t)(row0 + ai * HALF + m * 16) * D + col0;
#pragma unroll
                for (int bj = 0; bj < 2; ++bj) { const f32x4 v0 = acc[ai][bj][m][0] * sc, v1 = acc[ai][bj][m][1] * sc;
                    u32x2 w; w.x = pk4_fp8(v0[0], v0[1], v0[2], v0[3]); w.y = pk4_fp8(v1[0], v1[1], v1[2], v1[3]);
                    *(u32x2*)(rowp + bj * HALF) = w; } }
    }
};
struct EpiY { static constexpr bool PERM = true; bf16_t* Y;
    __device__ __forceinline__ void operator()(const f32x4 (&acc)[2][2][4][2], const Unit& u, int wr, int wc, int fr, int fq) const {
        const int row0 = u.pm * BM + wr * 64 + fr, col0 = u.pn * BM + wc * 32 + 8 * fq;
#pragma unroll
        for (int ai = 0; ai < 2; ++ai)
#pragma unroll
            for (int m = 0; m < 4; ++m) { bf16_t* rowp = Y + (size_t)(row0 + ai * HALF + m * 16) * D + col0;
#pragma unroll
                for (int bj = 0; bj < 2; ++bj) { const f32x4 v0 = acc[ai][bj][m][0], v1 = acc[ai][bj][m][1];
                    u32x4 w; w.x = cvt_pk_bf16(v0[0], v0[1]); w.y = cvt_pk_bf16(v0[2], v0[3]); w.z = cvt_pk_bf16(v1[0], v1[1]); w.w = cvt_pk_bf16(v1[2], v1[3]);
                    *(u32x4*)(rowp + bj * HALF) = w; } }
    }
};

template <class Epi, class Sched, bool ALIGN_EPI, bool GATHER, bool FP8>
__device__ __forceinline__ void gemm_phase(PG8_LAS unsigned char* lds, const Gemm g, const Sched& S, const Epi& E) {
    const int tid = threadIdx.x, wid = __builtin_amdgcn_readfirstlane(tid >> 6), lane = tid & 63, wr = wid >> 2, wc = wid & 3, fr = lane & 15, fq = lane >> 4;
    const int Kb = g.Kb, nt = Kb / (BK * 2);
    unsigned voffA[2], voffB[2]; int Ra[2];
#pragma unroll
    for (int i = 0; i < 2; ++i) { int R, Cb; if (FP8) stage_rc8(tid * 16 + i * 8192, R, Cb); else { stage_rc(tid * 16 + i * 8192, R, Cb); Cb *= 2; }
        const int Rb = Epi::PERM ? ((R & ~31) + perm32(R & 31)) : R;
        Ra[i] = R; voffA[i] = GATHER ? (unsigned)Cb : (unsigned)(R * Kb + Cb); voffB[i] = (unsigned)(Rb * Kb + Cb); }
    const size_t kstep = (size_t)(BK * 2);
    const size_t hstep = (size_t)HALF * Kb;
    const size_t hstepA = GATHER ? (size_t)0 : hstep;
    const unsigned ldsw = (unsigned)wid * 1024u;
    const int aoff = FP8 ? lds_byte8(wr * 64 + fr, 2 * fq) : lds_byte(wr * 64 + fr, fq * 8), boff = FP8 ? lds_byte8(wc * 32 + fr, 2 * fq) : lds_byte(wc * 32 + fr, fq * 8);
    const int aoff1 = FP8 ? lds_byte8(wr * 64 + fr, 2 * fq + 1) : 0, boff1 = FP8 ? lds_byte8(wc * 32 + fr, 2 * fq + 1) : 0;
#define PG8_SA(b, h) (((b) * 2 + (h)) * HTB)
#define PG8_SB(b, h) ((4 + (b) * 2 + (h)) * HTB)
#define PG8_STAGE(bufoff, gbase, voff) do { _Pragma("unroll") for (int _i = 0; _i < 2; ++_i) \
        __builtin_amdgcn_global_load_lds((const unsigned*)((const char*)(gbase) + (voff)[_i]), (PG8_LAS unsigned*)(lds + (bufoff) + ldsw + _i * 8192), 16, 0, 0); } while (0)
#define PG8_STAGE_A(bufoff, kbase, h) do { _Pragma("unroll") for (int _i = 0; _i < 2; ++_i) \
        __builtin_amdgcn_global_load_lds((const unsigned*)((const char*)(kbase) + (size_t)(h) * hstepA + (GATHER ? gC[h][_i] : 0u) + voffA[_i]), (PG8_LAS unsigned*)(lds + (bufoff) + ldsw + _i * 8192), 16, 0, 0); } while (0)
#define PG8_LD16(off) (*(const PG8_LAS v4i32*)(lds + (off)))
#define PG8_LDA(dst, b, h) do { _Pragma("unroll") for (int m = 0; m < 4; ++m) { if constexpr (FP8) dst##8[m] = __builtin_shufflevector(PG8_LD16(PG8_SA(b, h) + aoff + m * 2048), PG8_LD16(PG8_SA(b, h) + aoff1 + m * 2048), 0, 1, 2, 3, 4, 5, 6, 7); \
        else { _Pragma("unroll") for (int k = 0; k < 2; ++k) dst[m][k] = *(const PG8_LAS bf16x8*)(lds + PG8_SA(b, h) + aoff + m * 2048 + k * 1024); } } } while (0)
#define PG8_LDB(dst, b, h) do { _Pragma("unroll") for (int n = 0; n < 2; ++n) { if constexpr (FP8) dst##8[n] = __builtin_shufflevector(PG8_LD16(PG8_SB(b, h) + boff + n * 2048), PG8_LD16(PG8_SB(b, h) + boff1 + n * 2048), 0, 1, 2, 3, 4, 5, 6, 7); \
        else { _Pragma("unroll") for (int k = 0; k < 2; ++k) dst[n][k] = *(const PG8_LAS bf16x8*)(lds + PG8_SB(b, h) + boff + n * 2048 + k * 1024); } } } while (0)
#define PG8_MMA(ai, bj, At, Bt, ZF) do { __builtin_amdgcn_s_setprio(1); _Pragma("unroll") for (int m = 0; m < 4; ++m) _Pragma("unroll") for (int n = 0; n < 2; ++n) { \
        if constexpr (FP8) { if constexpr (ZF) asm volatile("v_mfma_f32_16x16x128_f8f6f4 %0, %1, %2, 0" : "=v"(acc[ai][bj][m][n]) : "v"(Bt##8[n]), "v"(At##8[m])); \
                             else asm volatile("v_mfma_f32_16x16x128_f8f6f4 %0, %1, %2, %0" : "+v"(acc[ai][bj][m][n]) : "v"(Bt##8[n]), "v"(At##8[m])); } \
        else { acc[ai][bj][m][n] = __builtin_amdgcn_mfma_f32_16x16x32_bf16(Bt[n][0], At[m][0], ZF ? (f32x4){0.f, 0.f, 0.f, 0.f} : acc[ai][bj][m][n], 0, 0, 0); \
               acc[ai][bj][m][n] = __builtin_amdgcn_mfma_f32_16x16x32_bf16(Bt[n][1], At[m][1], acc[ai][bj][m][n], 0, 0, 0); } } \
        __builtin_amdgcn_s_setprio(0); } while (0)
#define PG8_WAIT_V(n) asm volatile("s_waitcnt vmcnt(" #n ")" ::: "memory")
#define PG8_WAIT_L(n) asm volatile("s_waitcnt lgkmcnt(" #n ")" ::: "memory")
#define PG8_BAR __builtin_amdgcn_s_barrier()
#define PG8_SCHED __builtin_amdgcn_sched_barrier(0)
    Unit cur, nxt; int ui = 0;
    if (!S.next(0, cur)) return;
    f32x4 acc[2][2][4][2];
    bf16x8 At[4][2], B0[2][2], B1[2][2]; v8i32 At8[4], B08[2], B18[2];
#define PG8_TOK_ISSUE(u_, slot_) do { if (wid < 4) __builtin_amdgcn_global_load_lds((const unsigned*)S.tok_src(u_, tid), (PG8_LAS unsigned*)(S.tokt + (slot_) * 1024 + wid * 256), 4, 0, 0); } while (0)
#define PG8_TOK_READ(slot_) do { _Pragma("unroll") for (int h = 0; h < 2; ++h) _Pragma("unroll") for (int i = 0; i < 2; ++i) \
        gC[h][i] = *(const PG8_LAS unsigned*)(S.tokt + (slot_) * 1024 + (h * HALF + Ra[i]) * 4) * (unsigned)Kb; } while (0)
    unsigned gC[2][2];
#pragma unroll
    for (int h = 0; h < 2; ++h)
#pragma unroll
        for (int i = 0; i < 2; ++i) gC[h][i] = 0u;
    if constexpr (GATHER) { PG8_TOK_ISSUE(cur, 0); PG8_WAIT_V(0); PG8_BAR; PG8_TOK_READ(0); }
    const char* cA = (const char*)g.A + S.a_off(cur); const char* cB = (const char*)g.Bt + S.b_off(cur);
    PG8_STAGE(PG8_SB(0, 0), cB, voffB); PG8_STAGE(PG8_SB(0, 1), cB + hstep, voffB); PG8_STAGE_A(PG8_SA(0, 0), cA, 0); PG8_STAGE_A(PG8_SA(0, 1), cA, 1);
    if (wr == 1) PG8_BAR;
    PG8_WAIT_V(2); PG8_BAR;
    PG8_STAGE(PG8_SB(1, 0), cB + kstep, voffB); PG8_STAGE_A(PG8_SA(1, 0), cA + kstep, 0); PG8_STAGE(PG8_SB(1, 1), cB + hstep + kstep, voffB);
    PG8_WAIT_V(6); PG8_BAR;
    for (;;) {
        const bool has_next = S.next(ui + 1, nxt);
        const char* nA = has_next ? (const char*)g.A + S.a_off(nxt) : cA; const char* nB = has_next ? (const char*)g.Bt + S.b_off(nxt) : cB;
        if constexpr (GATHER) { if (has_next) PG8_TOK_ISSUE(nxt, (ui + 1) & 1); }
        if constexpr (FP8) {
        { constexpr bool ZF = true; const int t = 0;
            const bool last = (t == nt - 2);
            const char* a1 = cA + (size_t)(t + 1) * kstep;
            const char* a2 = last ? nA : cA + (size_t)(t + 2) * kstep; const char* b2 = last ? nB : cB + (size_t)(t + 2) * kstep;
            const char* a3 = a2 + kstep; const char* b3 = b2 + kstep;
            PG8_LDB(B0, 0, 0); PG8_LDB(B1, 0, 1); PG8_SCHED; PG8_LDA(At, 0, 0); PG8_STAGE_A(PG8_SA(1, 1), a1, 1);
            PG8_WAIT_V(8); PG8_WAIT_L(0); PG8_BAR; PG8_MMA(0, 0, At, B0, ZF); PG8_MMA(0, 1, At, B1, ZF); PG8_BAR; PG8_SCHED;
            if constexpr (GATHER) { if (last && has_next) PG8_TOK_READ((ui + 1) & 1); }
            PG8_LDA(At, 0, 1); PG8_STAGE(PG8_SB(0, 0), b2, voffB); PG8_STAGE(PG8_SB(0, 1), b2 + hstep, voffB); PG8_STAGE_A(PG8_SA(0, 0), a2, 0);
            PG8_WAIT_V(8); PG8_WAIT_L(0); PG8_BAR; PG8_MMA(1, 0, At, B0, ZF); PG8_MMA(1, 1, At, B1, ZF); PG8_BAR; PG8_SCHED;
            PG8_LDB(B0, 1, 0); PG8_LDB(B1, 1, 1); PG8_SCHED; PG8_LDA(At, 1, 0); PG8_STAGE_A(PG8_SA(0, 1), a2, 1);
            PG8_WAIT_V(8); PG8_WAIT_L(0); PG8_BAR; PG8_MMA(0, 0, At, B0, false); PG8_MMA(0, 1, At, B1, false); PG8_BAR; PG8_SCHED;
            PG8_LDA(At, 1, 1); PG8_STAGE(PG8_SB(1, 0), b3, voffB); PG8_STAGE(PG8_SB(1, 1), b3 + hstep, voffB); PG8_STAGE_A(PG8_SA(1, 0), a3, 0);
            PG8_WAIT_V(8); PG8_WAIT_L(0); PG8_BAR; PG8_MMA(1, 0, At, B0, false); PG8_MMA(1, 1, At, B1, false); PG8_BAR; PG8_SCHED;
                }
#pragma unroll 1
        for (int t = 2; t < nt; t += 2) { constexpr bool ZF = false;
            const bool last = (t == nt - 2);
            const char* a1 = cA + (size_t)(t + 1) * kstep;
            const char* a2 = last ? nA : cA + (size_t)(t + 2) * kstep; const char* b2 = last ? nB : cB + (size_t)(t + 2) * kstep;
            const char* a3 = a2 + kstep; const char* b3 = b2 + kstep;
            PG8_LDB(B0, 0, 0); PG8_LDB(B1, 0, 1); PG8_SCHED; PG8_LDA(At, 0, 0); PG8_STAGE_A(PG8_SA(1, 1), a1, 1);
            PG8_WAIT_V(8); PG8_WAIT_L(0); PG8_BAR; PG8_MMA(0, 0, At, B0, ZF); PG8_MMA(0, 1, At, B1, ZF); PG8_BAR; PG8_SCHED;
            if constexpr (GATHER) { if (last && has_next) PG8_TOK_READ((ui + 1) & 1); }
            PG8_LDA(At, 0, 1); PG8_STAGE(PG8_SB(0, 0), b2, voffB); PG8_STAGE(PG8_SB(0, 1), b2 + hstep, voffB); PG8_STAGE_A(PG8_SA(0, 0), a2, 0);
            PG8_WAIT_V(8); PG8_WAIT_L(0); PG8_BAR; PG8_MMA(1, 0, At, B0, ZF); PG8_MMA(1, 1, At, B1, ZF); PG8_BAR; PG8_SCHED;
            PG8_LDB(B0, 1, 0); PG8_LDB(B1, 1, 1); PG8_SCHED; PG8_LDA(At, 1, 0); PG8_STAGE_A(PG8_SA(0, 1), a2, 1);
            PG8_WAIT_V(8); PG8_WAIT_L(0); PG8_BAR; PG8_MMA(0, 0, At, B0, false); PG8_MMA(0, 1, At, B1, false); PG8_BAR; PG8_SCHED;
            PG8_LDA(At, 1, 1); PG8_STAGE(PG8_SB(1, 0), b3, voffB); PG8_STAGE(PG8_SB(1, 1), b3 + hstep, voffB); PG8_STAGE_A(PG8_SA(1, 0), a3, 0);
            PG8_WAIT_V(8); PG8_WAIT_L(0); PG8_BAR; PG8_MMA(1, 0, At, B0, false); PG8_MMA(1, 1, At, B1, false); PG8_BAR; PG8_SCHED;
                }
        } else {
#pragma unroll
        for (int a = 0; a < 2; ++a)
#pragma unroll
            for (int b = 0; b < 2; ++b)
#pragma unroll
                for (int m = 0; m < 4; ++m)
#pragma unroll
                    for (int n = 0; n < 2; ++n) acc[a][b][m][n] = (f32x4){0.f, 0.f, 0.f, 0.f};
#pragma unroll 1
        for (int t = 0; t < nt; t += 2) { constexpr bool ZF = false;
            const bool last = (t == nt - 2);
            const char* a1 = cA + (size_t)(t + 1) * kstep;
            const char* a2 = last ? nA : cA + (size_t)(t + 2) * kstep; const char* b2 = last ? nB : cB + (size_t)(t + 2) * kstep;
            const char* a3 = a2 + kstep; const char* b3 = b2 + kstep;
            PG8_LDB(B0, 0, 0); PG8_LDB(B1, 0, 1); PG8_SCHED; PG8_LDA(At, 0, 0); PG8_STAGE_A(PG8_SA(1, 1), a1, 1);
            PG8_WAIT_V(8); PG8_WAIT_L(0); PG8_BAR; PG8_MMA(0, 0, At, B0, ZF); PG8_MMA(0, 1, At, B1, ZF); PG8_BAR; PG8_SCHED;
            if constexpr (GATHER) { if (last && has_next) PG8_TOK_READ((ui + 1) & 1); }
            PG8_LDA(At, 0, 1); PG8_STAGE(PG8_SB(0, 0), b2, voffB); PG8_STAGE(PG8_SB(0, 1), b2 + hstep, voffB); PG8_STAGE_A(PG8_SA(0, 0), a2, 0);
            PG8_WAIT_V(8); PG8_WAIT_L(0); PG8_BAR; PG8_MMA(1, 0, At, B0, ZF); PG8_MMA(1, 1, At, B1, ZF); PG8_BAR; PG8_SCHED;
            PG8_LDB(B0, 1, 0); PG8_LDB(B1, 1, 1); PG8_SCHED; PG8_LDA(At, 1, 0); PG8_STAGE_A(PG8_SA(0, 1), a2, 1);
            PG8_WAIT_V(8); PG8_WAIT_L(0); PG8_BAR; PG8_MMA(0, 0, At, B0, false); PG8_MMA(0, 1, At, B1, false); PG8_BAR; PG8_SCHED;
            PG8_LDA(At, 1, 1); PG8_STAGE(PG8_SB(1, 0), b3, voffB); PG8_STAGE(PG8_SB(1, 1), b3 + hstep, voffB); PG8_STAGE_A(PG8_SA(1, 0), a3, 0);
            PG8_WAIT_V(8); PG8_WAIT_L(0); PG8_BAR; PG8_MMA(1, 0, At, B0, false); PG8_MMA(1, 1, At, B1, false); PG8_BAR; PG8_SCHED;
                }
        }
        if constexpr (ALIGN_EPI) { if (wr == 0) PG8_BAR; }
        if constexpr (FP8) asm volatile("s_nop 15\n\ts_nop 15" ::: "memory");
        E(acc, cur, wr, wc, fr, fq);
        if (!has_next) break;
        cur = nxt; cA = nA; cB = nB; ++ui;
        if constexpr (ALIGN_EPI) { if (wr == 1) PG8_BAR; }
    }
    PG8_WAIT_V(0);
    if constexpr (!ALIGN_EPI) { if (wr == 0) PG8_BAR; }
    PG8_BAR;
#undef PG8_SA
#undef PG8_SB
#undef PG8_STAGE
#undef PG8_STAGE_A
#undef PG8_TOK_ISSUE
#undef PG8_TOK_READ
#undef PG8_LDA
#undef PG8_LDB
#undef PG8_MMA
#undef PG8_LD16
#undef PG8_WAIT_V
#undef PG8_WAIT_L
#undef PG8_BAR
#undef PG8_SCHED
}
}
#define LAS __attribute__((address_space(3)))
#define GAS __attribute__((address_space(1)))
constexpr int NWAVES = 8, NTHREADS = 512;
constexpr int LDS_BYTES = 163840;
constexpr int SCR_BYTES = 147456;
constexpr int LDSCTL_OFF = SCR_BYTES;
constexpr int TAB_OFF = LDSCTL_OFF + 512;
constexpr int TAB_CNT = 0, TAB_P0 = 32, TAB_TE = 72;
constexpr int TOKT_OFF = TAB_OFF + 2048;
#define LDS_WAIT() asm volatile("s_waitcnt lgkmcnt(0)" ::: "memory")
#define WAVE_SYNC() do { asm volatile("s_waitcnt lgkmcnt(0)" ::: "memory"); __builtin_amdgcn_wave_barrier(); } while (0)

#ifndef MOE_FP8
#define MOE_FP8 1
#endif
constexpr float W13_SCALE = 32.f, W2_SCALE = 16.f, ACT_SCALE = 4.f, Y_SCALE = 16.f;
struct Args {
    const float* in[27]; float* out; unsigned char* ws; int ph_lo, ph_hi;
};
struct Frame {
    LAS unsigned char* lds; LAS int* tab; unsigned* ctl; unsigned char* ws;
    int tid, lane, wave, G, bid, vcu;
};
enum Phase { PH_A = 0, PH_B, PH_C, PH_D, PH_E, PH_F, PH_G, PH_H, PH_I, PH_J, PH_N };

#define XB_TMO      128
#define XB_XCNT(j)  (256  + 64 * (j))
#define XB_XSUB(j)  (1280 + 64 * (j))
#define XB_XGEN(j)  (2304 + 64 * (j))
#define XB_TOP      3328
#define XB_TOPGEN   3392
#define XCD_BAR_WORDS 3456
#define XB_SPIN_CAP (1u << 18)
__device__ __forceinline__ unsigned xb_ld(unsigned* p)              { return __hip_atomic_load(p, __ATOMIC_RELAXED, __HIP_MEMORY_SCOPE_AGENT); }
__device__ __forceinline__ unsigned xb_add(unsigned* p, unsigned v) { return __hip_atomic_fetch_add(p, v, __ATOMIC_RELAXED, __HIP_MEMORY_SCOPE_AGENT); }
__device__ __forceinline__ unsigned xb_xcc_id() { return (unsigned)__builtin_amdgcn_s_getreg((3 << 11) | 20) & 0xFu; }
#define XB_SPIN(cond, bar) do { unsigned _sp = 0; while (cond) { __builtin_amdgcn_s_sleep(1); \
    if ((++_sp & 255u) == 0u) { if (xb_ld(&(bar)[XB_TMO])) break; if (_sp > XB_SPIN_CAP) { atomicAdd(&(bar)[XB_TMO], 1u); break; } } } } while (0)
struct XcdBarrier { unsigned* bar; unsigned x; volatile LAS unsigned* st; };
__device__ __forceinline__ XcdBarrier xcd_barrier_post(unsigned* bar, volatile LAS unsigned* st) {
    XcdBarrier b; b.bar = bar; b.x = xb_xcc_id(); b.st = st;
    if (threadIdx.x == 0) (void)xb_add(&bar[XB_XCNT(b.x)], 1u);
    return b;
}
__device__ __forceinline__ void xcd_barrier_complete(unsigned* bar, unsigned x, unsigned& nloc, unsigned& nx) {
    const unsigned G = gridDim.x * gridDim.y * gridDim.z;
    unsigned sum, cnt, mine, sp = 0u;
    for (;;) {
        sum = 0u; cnt = 0u; mine = 0u;
#pragma unroll
        for (unsigned j = 0; j < 16; ++j) { const unsigned c = xb_ld(&bar[XB_XCNT(j)]); sum += c; cnt += (c > 0u) ? 1u : 0u; mine = (j == x) ? c : mine; }
        if (sum == G) break;
        __builtin_amdgcn_s_sleep(1);
        if ((++sp & 255u) == 0u) { if (xb_ld(&bar[XB_TMO])) break; if (sp > XB_SPIN_CAP) { atomicAdd(&bar[XB_TMO], 1u); break; } }
    }
    nloc = mine > 0u ? mine : 1u; nx = cnt > 0u ? cnt : 1u;
}
__device__ __forceinline__ void xcd_barrier(const XcdBarrier& b) {
    asm volatile("s_waitcnt vmcnt(0)" ::: "memory");
    __syncthreads();
    if (threadIdx.x == 0) {
        unsigned* bar = b.bar;
        __builtin_amdgcn_s_waitcnt(0);
        unsigned nloc = b.st[0], nx = b.st[1];
        if (nloc == 0u) { xcd_barrier_complete(bar, b.x, nloc, nx); b.st[0] = nloc; b.st[1] = nx; }
        const unsigned old = xb_add(&bar[XB_XSUB(b.x)], 1u);
        const unsigned gen = old / nloc;
        if (old + 1u == (gen + 1u) * nloc) {
            __builtin_amdgcn_fence(__ATOMIC_RELEASE, "agent");
            asm volatile("s_waitcnt vmcnt(0)" ::: "memory");
            const unsigned og = xb_add(&bar[XB_TOP], 1u);
            const unsigned tg = og / nx;
            if (og + 1u == (tg + 1u) * nx) xb_add(&bar[XB_TOPGEN], 1u);
            else XB_SPIN(xb_ld(&bar[XB_TOPGEN]) == tg, bar);
            __builtin_amdgcn_fence(__ATOMIC_ACQUIRE, "agent");
            xb_add(&bar[XB_XGEN(b.x)], 1u);
            asm volatile("s_waitcnt vmcnt(0)" ::: "memory");
        } else {
            XB_SPIN(xb_ld(&bar[XB_XGEN(b.x)]) == gen, bar);
            __builtin_amdgcn_fence(__ATOMIC_ACQUIRE, "agent");
            asm volatile("s_waitcnt vmcnt(0)" ::: "memory");
        }
    }
    __syncthreads();
}

__device__ __forceinline__ void build_moe_table(Frame& F) {
    __syncthreads();
    if (F.tid < 64) {
        const int c = F.tid < NE ? (int)__hip_atomic_load(F.ctl + CW_CNT + CNT_STRIDE * F.tid, __ATOMIC_RELAXED, __HIP_MEMORY_SCOPE_AGENT) : 0;
        const int nt = (c + 255) >> 8; int p = nt;
#pragma unroll
        for (int o = 1; o < 32; o <<= 1) { const int v = __shfl_up(p, o); if (F.lane >= o) p += v; }
        const int excl = p - nt;
        if (F.tid < NE) { F.tab[TAB_CNT + F.tid] = c; F.tab[TAB_P0 + F.tid] = excl; for (int j = 0; j < nt; ++j) F.tab[TAB_TE + excl + j] = F.tid; }
        if (F.tid == NE - 1) F.tab[TAB_P0 + NE] = p;
    }
    __syncthreads();
}

struct TItem { const float* W; unsigned char* WT; int N, K, blk, rstride, rbase, k0, n0, fp8; float scale; };
__device__ __forceinline__ void titem_load(const TItem& d, f32x4 (&v)[16], int lane) {
#pragma unroll
    for (int i = 0; i < 16; ++i) v[i] = *(const f32x4*)(d.W + (size_t)(d.k0 + 16 * (lane >> 5) + i) * d.N + d.n0 + 4 * (lane & 31));
}
__device__ __forceinline__ unsigned pk4_fp8_nc(float a, float b, float c, float d) {
    unsigned w = 0u; w = __builtin_amdgcn_cvt_pk_fp8_f32(a, b, w, false); w = __builtin_amdgcn_cvt_pk_fp8_f32(c, d, w, true); return w; }
__device__ __forceinline__ void titem_store(const TItem& d, const f32x4 (&v)[16], int lane) {
#pragma unroll
    for (int q = 0; q < 4; ++q) {
        const int n = d.n0 + 4 * (lane & 31) + q, row = d.rbase + (n / d.blk) * d.rstride + (n % d.blk);
        if (d.fp8) { const float sc = d.scale; u32x4 o;
            o.x = pk4_fp8_nc(v[0][q] * sc, v[1][q] * sc, v[2][q] * sc, v[3][q] * sc); o.y = pk4_fp8_nc(v[4][q] * sc, v[5][q] * sc, v[6][q] * sc, v[7][q] * sc);
            o.z = pk4_fp8_nc(v[8][q] * sc, v[9][q] * sc, v[10][q] * sc, v[11][q] * sc); o.w = pk4_fp8_nc(v[12][q] * sc, v[13][q] * sc, v[14][q] * sc, v[15][q] * sc);
            *(u32x4*)(d.WT + (size_t)row * d.K + d.k0 + 16 * (lane >> 5)) = o;
        } else { u32x4 o0, o1;
            o0.x = pk2(v[0][q], v[1][q]); o0.y = pk2(v[2][q], v[3][q]); o0.z = pk2(v[4][q], v[5][q]); o0.w = pk2(v[6][q], v[7][q]);
            o1.x = pk2(v[8][q], v[9][q]); o1.y = pk2(v[10][q], v[11][q]); o1.z = pk2(v[12][q], v[13][q]); o1.w = pk2(v[14][q], v[15][q]);
            unsigned char* p = d.WT + ((size_t)row * d.K + d.k0 + 16 * (lane >> 5)) * 2; *(u32x4*)p = o0; *(u32x4*)(p + 16) = o1; }
    }
}
constexpr int TI_IN = 512, TI_OUT = 256, TI_EXP = 384 * NE, TI_N = TI_IN + TI_OUT + TI_EXP;
__device__ __forceinline__ void titem_decode(const Args& args, unsigned char* ws, int it, TItem& d) {
    int r = it, item; d.fp8 = 0; d.scale = 1.f; d.rstride = 0; d.rbase = 0;
    if (r < TI_IN) { d.W = args.in[5]; d.WT = ws + OFF_WIN; d.K = 1024; d.N = 2048; d.blk = 2048; item = r; }
    else if ((r -= TI_IN) < TI_OUT) { d.W = args.in[17]; d.WT = ws + OFF_WOUT; d.K = 1024; d.N = 1024; d.blk = 1024; item = r; }
    else { r -= TI_OUT; const int e = r / 384, q = r % 384;
        if (q < 256) { d.W = (q < 128 ? args.in[23] : args.in[24]) + (size_t)e * 1024 * 512; d.K = 1024; d.N = 512; d.blk = 128; d.rstride = 256; d.rbase = q < 128 ? 0 : 128; item = q & 127;
            d.WT = ws + OFF_W13 + (size_t)e * 1024 * 1024 * (MOE_FP8 ? 1 : 2); d.scale = W13_SCALE; }
        else { d.W = args.in[25] + (size_t)e * 512 * 1024; d.K = 512; d.N = 1024; d.blk = 1024; item = q - 256; d.WT = ws + OFF_W2 + (size_t)e * 1024 * 512 * (MOE_FP8 ? 1 : 2); d.scale = W2_SCALE; }
        d.fp8 = MOE_FP8; if (!MOE_FP8) d.scale = 1.f; }
    const int nkb = d.K / 32; d.k0 = 32 * (item % nkb); d.n0 = 128 * (item / nkb);
}
__device__ __forceinline__ void phase_A(Frame& F, const Args& args) {
    unsigned char* ws = F.ws;
    const float* c = args.in[1]; const float* ada_w = args.in[2]; const float* ada_b = args.in[3];
    float* mod = (float*)(ws + OFF_MOD);
    for (int it = F.G - 1 - F.bid; it < 192; it += F.G) {
        LAS float* sc = (LAS float*)F.lds; LAS float* red = sc + 8192;
        for (int i = F.tid; i < 8192; i += NTHREADS) { const float v = c[i]; sc[(i & 1023) * 8 + (i >> 10)] = v / (1.0f + __expf(-v)); }
        __syncthreads();
        const int col = F.lane & 31, ks = F.lane >> 5, n = it * 32 + col, k0 = F.wave * 128 + ks;
        float acc[8];
#pragma unroll
        for (int b = 0; b < 8; ++b) acc[b] = 0.f;
#pragma unroll 1
        for (int i0 = 0; i0 < 64; i0 += 16) {
            float wv[16];
#pragma unroll
            for (int i = 0; i < 16; ++i) wv[i] = ada_w[(size_t)(k0 + 2 * (i0 + i)) * 6144 + n];
#pragma unroll
            for (int i = 0; i < 16; ++i) { const int k = k0 + 2 * (i0 + i);
                const f32x4 s0 = *(const LAS f32x4*)(sc + k * 8), s1 = *(const LAS f32x4*)(sc + k * 8 + 4);
#pragma unroll
                for (int b = 0; b < 4; ++b) { acc[b] += s0[b] * wv[i]; acc[4 + b] += s1[b] * wv[i]; } }
        }
#pragma unroll
        for (int b = 0; b < 8; ++b) { acc[b] += __shfl_xor(acc[b], 32); if (ks == 0) red[(F.wave * 8 + b) * 32 + col] = acc[b]; }
        __syncthreads();
        if (F.tid < 256) { const int b = F.tid >> 5, cc = F.tid & 31; float s = ada_b[it * 32 + cc];
#pragma unroll
            for (int w = 0; w < 8; ++w) s += red[(w * 8 + b) * 32 + cc];
            mod[b * 6144 + it * 32 + cc] = s; }
        __syncthreads();
    }
    {
        const int gw = F.vcu * NWAVES + F.wave, NGW = F.G * NWAVES;
        const int it_end = (F.G == 256) ? TI_IN + TI_OUT : TI_N;
        int it = gw;
        if (it < it_end) {
            TItem d, d2; f32x4 v[16], v2[16];
            titem_decode(args, ws, it, d); titem_load(d, v, F.lane);
            for (;;) {
                const int itn = it + NGW; const bool more = itn < it_end;
                if (more) { titem_decode(args, ws, itn, d2); titem_load(d2, v2, F.lane); }
                titem_store(d, v, F.lane);
                if (!more) break;
                d = d2; it = itn;
#pragma unroll
                for (int i = 0; i < 16; ++i) v[i] = v2[i];
            }
        }
    }
    {
        const int gt = F.bid * NTHREADS + F.tid, NGT = F.G * NTHREADS;
        const float* sgu_w = args.in[15]; const float* rgw = args.in[19]; const float* rew = args.in[21]; const float* lam = args.in[12];
        bf16_t* SGUW = (bf16_t*)(ws + OFF_SGUW); bf16_t* ROUTW = (bf16_t*)(ws + OFF_ROUTW); float* N8SP = (float*)(ws + OFF_N8SP);
        for (int i = gt; i < 8 * 128 * 128; i += NGT) { const int ii = (i >> 7) & 127, j = i & 127; SGUW[i] = (bf16_t)(((j >> 6) <= (ii >> 6)) ? f2bf(sgu_w[i]) : 0u); }
        for (int i = gt; i < 48 * 1024; i += NGT) { const int n = i >> 10, k = i & 1023; const float v = n < 4 ? rgw[k * 4 + n] : (n < 36 ? rew[k * 32 + n - 4] : 0.f); ROUTW[i] = (bf16_t)f2bf(v); }
        for (int i = gt; i < 512; i += NGT) N8SP[i] = -8.0f * 1.4426950408889634f * log1pf(expf(-lam[i]));
        { float* GB = (float*)(ws + OFF_GBIAS); const float* gab_ = args.in[9]; const float* gib_ = args.in[11];
          for (int i = gt; i < 1024; i += NGT) GB[i] = -1.4426950408889634f * (i < 512 ? gab_[i] : gib_[i - 512]); }
        { const float* gaw = args.in[8]; const float* giw = args.in[10]; bf16_t* GATEW = (bf16_t*)(ws + OFF_GATEW);
          for (int i = gt; i < 8 * 128 * 64; i += NGT) { const int h = i >> 13, ee = (i >> 6) & 127, dd = i & 63; const float v = -1.4426950408889634f * (ee < 64 ? gaw : giw)[h * 4096 + dd * 64 + (ee & 63)]; GATEW[i] = (bf16_t)f2bf(v); } }
    }
}

__device__ __forceinline__ void convert_experts(Frame& F, const Args& args, int cidx, int ncv) {
    unsigned char* ws = F.ws;
    const int gw = cidx * NWAVES + F.wave, NGW = ncv * NWAVES;
    int it = TI_IN + TI_OUT + gw;
    if (it < TI_N) {
        TItem d, d2; f32x4 v[16], v2[16];
        titem_decode(args, ws, it, d); titem_load(d, v, F.lane);
        for (;;) {
            const int itn = it + NGW; const bool more = itn < TI_N;
            if (more) { titem_decode(args, ws, itn, d2); titem_load(d2, v2, F.lane); }
            titem_store(d, v, F.lane);
            if (!more) break;
            d = d2; it = itn;
#pragma unroll
            for (int i = 0; i < 16; ++i) v[i] = v2[i];
        }
    }
}

__device__ __forceinline__ void phase_B(Frame& F, const Args& args) {
    const float* x = args.in[0]; const float* g = args.in[4]; const float* mod = (const float*)(F.ws + OFF_MOD); bf16_t* XN = (bf16_t*)(F.ws + OFF_XN);
    const int gw = F.bid * NWAVES + F.wave, NGW = F.G * NWAVES, lane = F.lane;
    constexpr int RPW = 16;
    for (int item = gw; item < T / RPW; item += NGW) {
        const int row0 = item * RPW, b = row0 / SEQ;
        const float* sh = mod + b * 6144; const float* sc = sh + 1024;
        f32x4 gm[4], sv[4];
#pragma unroll
        for (int j = 0; j < 4; ++j) { const int col = 4 * (lane + 64 * j); const f32x4 gg = *(const f32x4*)(g + col), s1 = *(const f32x4*)(sc + col); sv[j] = *(const f32x4*)(sh + col); gm[j] = gg * (1.0f + s1); }
        f32x4 v[4], nv[4];
#pragma unroll
        for (int j = 0; j < 4; ++j) v[j] = ((const f32x4*)(x + (size_t)row0 * D))[lane + 64 * j];
#pragma unroll 1
        for (int r = 0; r < RPW; ++r) {
            const int row = row0 + r, nrow = (r + 1 < RPW) ? row + 1 : row;
#pragma unroll
            for (int j = 0; j < 4; ++j) nv[j] = ((const f32x4*)(x + (size_t)nrow * D))[lane + 64 * j];
            float ss = 0.f;
#pragma unroll
            for (int j = 0; j < 4; ++j) ss += v[j][0] * v[j][0] + v[j][1] * v[j][1] + v[j][2] * v[j][2] + v[j][3] * v[j][3];
            const float rs = rsqrtf(wave_sum(ss) * (1.0f / D) + EPS);
#pragma unroll
            for (int j = 0; j < 4; ++j) { const int col = 4 * (lane + 64 * j); const f32x4 h = v[j] * rs * gm[j] + sv[j];
                u32x2 o; o.x = pk2(h[0], h[1]); o.y = pk2(h[2], h[3]);
                *(u32x2*)(XN + (size_t)row * D + col) = o; v[j] = nv[j]; }
        }
    }
}

#ifndef SGU_TR
#define SGU_TR 1
#endif
typedef short s16x4 __attribute__((ext_vector_type(4)));
typedef short v4i16_t __attribute__((ext_vector_type(4)));
constexpr int IMG_STRIDE = 1040;
__device__ __forceinline__ float bflo(unsigned w) { return __uint_as_float(w << 16); }
__device__ __forceinline__ float bfhi(unsigned w) { return __uint_as_float(w & 0xffff0000u); }
__device__ __forceinline__ void sgu_block(Frame& F, const Args& args, int blk) {
    const bf16_t* Z = (const bf16_t*)(F.ws + OFF_Z); bf16_t* YMIX = (bf16_t*)(F.ws + OFF_YMIX); const bf16_t* SGUW = (const bf16_t*)(F.ws + OFF_SGUW);
    const float* ln_g = args.in[13]; const float* ln_b = args.in[14]; const float* sgu_b = args.in[16];
    const int lane = F.lane, w = F.wave; const size_t t0 = (size_t)blk * 128;
    {
        u32x4 raw[16];
#pragma unroll
        for (int r = 0; r < 16; ++r) raw[r] = *(const u32x4*)(Z + (t0 + w * 16 + r) * 2048 + 1536 + 8 * lane);
        const f32x4 g0 = *(const f32x4*)(ln_g + 8 * lane), g1 = *(const f32x4*)(ln_g + 8 * lane + 4), b0 = *(const f32x4*)(ln_b + 8 * lane), b1 = *(const f32x4*)(ln_b + 8 * lane + 4);
#pragma unroll
        for (int r = 0; r < 16; ++r) {
            float v[8];
#pragma unroll
            for (int q = 0; q < 4; ++q) { v[2 * q] = bflo(raw[r][q]); v[2 * q + 1] = bfhi(raw[r][q]); }
            float s = 0.f;
#pragma unroll
            for (int q = 0; q < 8; ++q) s += v[q];
            const float mu = wave_sum(s) * (1.0f / 512.0f);
            float s2 = 0.f;
#pragma unroll
            for (int q = 0; q < 8; ++q) { v[q] -= mu; s2 += v[q] * v[q]; }
            const float rstd = rsqrtf(wave_sum(s2) * (1.0f / 512.0f) + EPS);
            u32x4 o;
            o.x = pk2(v[0] * rstd * g0[0] + b0[0], v[1] * rstd * g0[1] + b0[1]); o.y = pk2(v[2] * rstd * g0[2] + b0[2], v[3] * rstd * g0[3] + b0[3]);
            o.z = pk2(v[4] * rstd * g1[0] + b1[0], v[5] * rstd * g1[1] + b1[1]); o.w = pk2(v[6] * rstd * g1[2] + b1[2], v[7] * rstd * g1[3] + b1[3]);
            *(LAS u32x4*)(F.lds + (w * 16 + r) * IMG_STRIDE + 16 * lane) = o;
        }
    }
    __syncthreads();
    {
        const int g = w;
        int fr = lane & 15, fq = lane >> 4; asm volatile("" : "+v"(fr), "+v"(fq));
        bf16x8 af[4][4];
#pragma unroll
        for (int kt = 0; kt < 4; ++kt)
#pragma unroll
            for (int ct = 0; ct < 4; ++ct) {
#if SGU_TR
                LAS unsigned char* p = F.lds + (32 * kt + 8 * fq + (fr >> 2)) * IMG_STRIDE + (g * 64 + 32 * (ct >> 1) + 8 * (fr & 3) + 4 * (ct & 1)) * 2;
                const s16x4 lo = __builtin_bit_cast(s16x4, __builtin_amdgcn_ds_read_tr16_b64_v4i16((LAS v4i16_t*)p));
                const s16x4 hi = __builtin_bit_cast(s16x4, __builtin_amdgcn_ds_read_tr16_b64_v4i16((LAS v4i16_t*)(p + 4 * IMG_STRIDE)));
                af[kt][ct] = (bf16x8){lo[0], lo[1], lo[2], lo[3], hi[0], hi[1], hi[2], hi[3]};
#else
                const LAS bf16_t* p = (const LAS bf16_t*)(F.lds + (32 * kt + 8 * fq) * IMG_STRIDE) + g * 64 + 16 * (fr >> 2) + 4 * ct + (fr & 3);
#pragma unroll
                for (int e = 0; e < 8; ++e) af[kt][ct][e] = (short)p[e * (IMG_STRIDE / 2)];
#endif
            }
        bf16x8 wf[4], nwf[4]; u32x4 gu0, gu1, ngu0, ngu1; float bias, nbias;
        { const bf16_t* wp = SGUW + ((size_t)(g * 128 + fr)) * 128 + 8 * fq;
#pragma unroll
          for (int kt = 0; kt < 4; ++kt) wf[kt] = *(const bf16x8*)(wp + 32 * kt);
          const size_t t = t0 + fr; gu0 = *(const u32x4*)(Z + t * 2048 + 1024 + g * 64 + 8 * fq); gu1 = *(const u32x4*)(Z + t * 2048 + 1024 + g * 64 + 32 + 8 * fq); bias = sgu_b[g * 128 + fr]; }
#pragma unroll 1
        for (int it = 0; it < 8; ++it) {
            const int i0 = 16 * it, in0 = it < 7 ? i0 + 16 : i0;
            { const bf16_t* wp = SGUW + ((size_t)(g * 128 + in0 + fr)) * 128 + 8 * fq;
#pragma unroll
              for (int kt = 0; kt < 4; ++kt) nwf[kt] = *(const bf16x8*)(wp + 32 * kt);
              const size_t tn = t0 + in0 + fr; ngu0 = *(const u32x4*)(Z + tn * 2048 + 1024 + g * 64 + 8 * fq); ngu1 = *(const u32x4*)(Z + tn * 2048 + 1024 + g * 64 + 32 + 8 * fq); nbias = sgu_b[g * 128 + in0 + fr]; }
            f32x4 acc[4];
#pragma unroll
            for (int ct = 0; ct < 4; ++ct) acc[ct] = (f32x4){0.f, 0.f, 0.f, 0.f};
#pragma unroll
            for (int kt = 0; kt < 4; ++kt)
#pragma unroll
                for (int ct = 0; ct < 4; ++ct) acc[ct] = __builtin_amdgcn_mfma_f32_16x16x32_bf16(af[kt][ct], wf[kt], acc[ct], 0, 0, 0);
            const size_t t = t0 + i0 + fr;
            u32x4 o0, o1;
            o0.x = pk2(bflo(gu0.x) * (acc[0][0] + bias), bfhi(gu0.x) * (acc[0][1] + bias)); o0.y = pk2(bflo(gu0.y) * (acc[0][2] + bias), bfhi(gu0.y) * (acc[0][3] + bias));
            o0.z = pk2(bflo(gu0.z) * (acc[1][0] + bias), bfhi(gu0.z) * (acc[1][1] + bias)); o0.w = pk2(bflo(gu0.w) * (acc[1][2] + bias), bfhi(gu0.w) * (acc[1][3] + bias));
            o1.x = pk2(bflo(gu1.x) * (acc[2][0] + bias), bfhi(gu1.x) * (acc[2][1] + bias)); o1.y = pk2(bflo(gu1.y) * (acc[2][2] + bias), bfhi(gu1.y) * (acc[2][3] + bias));
            o1.z = pk2(bflo(gu1.z) * (acc[3][0] + bias), bfhi(gu1.z) * (acc[3][1] + bias)); o1.w = pk2(bflo(gu1.w) * (acc[3][2] + bias), bfhi(gu1.w) * (acc[3][3] + bias));
            *(u32x4*)(YMIX + t * D + 512 + g * 64 + 8 * fq) = o0; *(u32x4*)(YMIX + t * D + 512 + g * 64 + 32 + 8 * fq) = o1;
#pragma unroll
            for (int kt = 0; kt < 4; ++kt) wf[kt] = nwf[kt];
            gu0 = ngu0; gu1 = ngu1; bias = nbias;
        }
    }
}

constexpr int XC_STRIDE = 144;
constexpr int AU_STRIDE = 68;
constexpr int LRU_WAVE_BYTES = 64 * XC_STRIDE + 2 * 16 * AU_STRIDE * 4;
__device__ __forceinline__ float sigm_fast(float x) { return __builtin_amdgcn_rcpf(1.0f + __builtin_amdgcn_exp2f(-1.4426950408889634f * x)); }
template <int PASS>
__device__ __forceinline__ void lru_block(Frame& F, const Args& args, int blk) {
    const bf16_t* Z = (const bf16_t*)(F.ws + OFF_Z); bf16_t* YMIX = (bf16_t*)(F.ws + OFF_YMIX); const bf16_t* GATEW = (const bf16_t*)(F.ws + OFF_GATEW);
    const float* N8SP = (const float*)(F.ws + OFF_N8SP); float* CA = (float*)(F.ws + OFF_CARRY); float* CH = CA + 256 * 512;
    const float* cw = args.in[6]; const float* cb = args.in[7]; const float* gab = (const float*)(F.ws + OFF_GBIAS); const float* gib = gab + 512;
    const int lane = F.lane, h = F.wave, fr = lane & 15, fq = lane >> 4, cg = lane & 7, run = lane >> 3; const size_t t0 = (size_t)blk * 128;
    LAS unsigned char* xcT = F.lds + h * LRU_WAVE_BYTES; LAS float* Abuf = (LAS float*)(xcT + 64 * XC_STRIDE); LAS float* Ubuf = Abuf + 16 * AU_STRIDE;
    float hst = 0.f, pp = 1.f;
    if (PASS == 2) { const int b0 = blk & ~31, n = blk & 31;
        float ca[31], ch[31];
#pragma unroll
        for (int k = 0; k < 31; ++k) { const int kk = k < n ? k : 0; ca[k] = CA[(size_t)(b0 + kk) * 512 + 64 * h + lane]; ch[k] = CH[(size_t)(b0 + kk) * 512 + 64 * h + lane]; }
#pragma unroll
        for (int k = 0; k < 31; ++k) hst = k < n ? ca[k] * hst + ch[k] : hst; }
    bf16x8 gw[8][2];
#pragma unroll
    for (int et = 0; et < 8; ++et)
#pragma unroll
        for (int kt = 0; kt < 2; ++kt) gw[et][kt] = *(const bf16x8*)(GATEW + ((size_t)(h * 128 + 16 * et + fr)) * 64 + 32 * kt + 8 * fq);
    const bool seq_start = (blk & 31) == 0;
#pragma unroll 1
    for (int hb = 0; hb < 2; ++hb) {
        const size_t tb = t0 + 64 * hb;
        {
            float cwv[4][8], cbv[8];
#pragma unroll
            for (int k = 0; k < 4; ++k) { const f32x4 a = *(const f32x4*)(cw + k * 512 + 64 * h + 8 * cg), b = *(const f32x4*)(cw + k * 512 + 64 * h + 8 * cg + 4);
#pragma unroll
                for (int q = 0; q < 4; ++q) { cwv[k][q] = a[q]; cwv[k][4 + q] = b[q]; } }
            { const f32x4 a = *(const f32x4*)(cb + 64 * h + 8 * cg), b = *(const f32x4*)(cb + 64 * h + 8 * cg + 4);
#pragma unroll
              for (int q = 0; q < 4; ++q) { cbv[q] = a[q]; cbv[4 + q] = b[q]; } }
            u32x4 xr[11];
#pragma unroll
            for (int j = 0; j < 11; ++j) { const int rel = 8 * run - 3 + j;
                const bool pad = (j < 3) && (rel < 0) && (hb == 0) && seq_start;
                const u32x4 v = *(const u32x4*)(Z + (size_t)((long)tb + (pad ? 0 : rel)) * 2048 + 64 * h + 8 * cg);
                xr[j] = pad ? (u32x4){0u, 0u, 0u, 0u} : v; }
#pragma unroll
            for (int s = 0; s < 8; ++s) { float o[8];
#pragma unroll
                for (int q = 0; q < 8; ++q) o[q] = cbv[q];
#pragma unroll
                for (int k = 0; k < 4; ++k) { const u32x4 r = xr[s + k];
#pragma unroll
                    for (int q = 0; q < 4; ++q) { o[2 * q] += cwv[k][2 * q] * bflo(r[q]); o[2 * q + 1] += cwv[k][2 * q + 1] * bfhi(r[q]); } }
                u32x4 pkd; pkd.x = pk2(o[0], o[1]); pkd.y = pk2(o[2], o[3]); pkd.z = pk2(o[4], o[5]); pkd.w = pk2(o[6], o[7]);
                *(LAS u32x4*)(xcT + (8 * run + s) * XC_STRIDE + 16 * cg) = pkd; }
        }
        WAVE_SYNC();
        u32x4 g0 = {0u, 0u, 0u, 0u}, g1 = g0, ng0 = g0, ng1 = g0;
        if (PASS == 2) { const size_t t = tb + (lane >> 2); g0 = *(const u32x4*)(Z + t * 2048 + 512 + 64 * h + 8 * (lane & 3)); g1 = *(const u32x4*)(Z + t * 2048 + 512 + 64 * h + 32 + 8 * (lane & 3)); }
#pragma unroll 1
        for (int it = 0; it < 4; ++it) {
            if (PASS == 2) { const size_t t = tb + 16 * (it < 3 ? it + 1 : it) + (lane >> 2); ng0 = *(const u32x4*)(Z + t * 2048 + 512 + 64 * h + 8 * (lane & 3)); ng1 = *(const u32x4*)(Z + t * 2048 + 512 + 64 * h + 32 + 8 * (lane & 3)); }
            bf16x8 xf[2];
#pragma unroll
            for (int kt = 0; kt < 2; ++kt) xf[kt] = *(const LAS bf16x8*)(xcT + (16 * it + fr) * XC_STRIDE + (32 * kt + 8 * fq) * 2);
            int fqv = fq; asm volatile("" : "+v"(fqv));
            f32x4 acc[8];
#pragma unroll
            for (int et = 0; et < 4; ++et) { acc[et] = *(const f32x4*)(gab + 64 * h + 16 * et + 4 * fqv); acc[4 + et] = *(const f32x4*)(gib + 64 * h + 16 * et + 4 * fqv); }
#pragma unroll
            for (int et = 0; et < 8; ++et)
#pragma unroll
                for (int kt = 0; kt < 2; ++kt) acc[et] = __builtin_amdgcn_mfma_f32_16x16x32_bf16(gw[et][kt], xf[kt], acc[et], 0, 0, 0);
#pragma unroll
            for (int et = 0; et < 4; ++et) {
                const f32x4 sp = *(const f32x4*)(N8SP + 64 * h + 16 * et + 4 * fqv);
                const u32x2 xw = *(const LAS u32x2*)(xcT + (16 * it + fr) * XC_STRIDE + (16 * et + 4 * fq) * 2);
                const float xv[4] = {bflo(xw.x), bfhi(xw.x), bflo(xw.y), bfhi(xw.y)};
                f32x4 av, uv;
#pragma unroll
                for (int r = 0; r < 4; ++r) {
                    const float rg = __builtin_amdgcn_rcpf(1.0f + __builtin_amdgcn_exp2f(acc[et][r])), ig = __builtin_amdgcn_rcpf(1.0f + __builtin_amdgcn_exp2f(acc[4 + et][r]));
                    const float a = __builtin_amdgcn_exp2f(rg * sp[r]);
                    av[r] = a;
                    uv[r] = __builtin_amdgcn_sqrtf(__builtin_fmaf(-a, a, 1.0f)) * (ig * xv[r]);
                }
                *(LAS f32x4*)(Abuf + fr * AU_STRIDE + 16 * et + 4 * fq) = av; *(LAS f32x4*)(Ubuf + fr * AU_STRIDE + 16 * et + 4 * fq) = uv;
            }
            WAVE_SYNC();
            {
                float a[16], u[16];
#pragma unroll
                for (int tk = 0; tk < 16; ++tk) { a[tk] = Abuf[tk * AU_STRIDE + lane]; u[tk] = Ubuf[tk * AU_STRIDE + lane]; }
#pragma unroll
                for (int tk = 0; tk < 16; ++tk) { hst = a[tk] * hst + u[tk]; if (PASS == 1) pp *= a[tk]; else Ubuf[tk * AU_STRIDE + lane] = hst; }
            }
            if (PASS == 2) {
                WAVE_SYNC();
                const int tok = lane >> 2, cq = lane & 3; const size_t t = tb + 16 * it + tok;
                const LAS float* hp = Ubuf + tok * AU_STRIDE + 8 * cq;
                const f32x4 h0 = *(const LAS f32x4*)(hp), h1 = *(const LAS f32x4*)(hp + 4), h2 = *(const LAS f32x4*)(hp + 32), h3 = *(const LAS f32x4*)(hp + 36);
                u32x4 o0, o1;
                o0.x = pk2(h0[0] * bflo(g0.x), h0[1] * bfhi(g0.x)); o0.y = pk2(h0[2] * bflo(g0.y), h0[3] * bfhi(g0.y));
                o0.z = pk2(h1[0] * bflo(g0.z), h1[1] * bfhi(g0.z)); o0.w = pk2(h1[2] * bflo(g0.w), h1[3] * bfhi(g0.w));
                o1.x = pk2(h2[0] * bflo(g1.x), h2[1] * bfhi(g1.x)); o1.y = pk2(h2[2] * bflo(g1.y), h2[3] * bfhi(g1.y));
                o1.z = pk2(h3[0] * bflo(g1.z), h3[1] * bfhi(g1.z)); o1.w = pk2(h3[2] * bflo(g1.w), h3[3] * bfhi(g1.w));
                *(u32x4*)(YMIX + t * D + 64 * h + 8 * cq) = o0; *(u32x4*)(YMIX + t * D + 64 * h + 32 + 8 * cq) = o1;
                g0 = ng0; g1 = ng1;
            }
            WAVE_SYNC();
        }
    }
    if (PASS == 1) { CA[(size_t)blk * 512 + 64 * h + lane] = pp; CH[(size_t)blk * 512 + 64 * h + lane] = hst; }
}

constexpr int HT_STRIDE = 2064;
constexpr int RG_W_OFF = 0, RG_H_OFF = 36 * HT_STRIDE, RG_LOG_OFF = RG_H_OFF + 32 * HT_STRIDE, RG_MISC_OFF = RG_LOG_OFF + 32 * 48 * 4;
static_assert(RG_MISC_OFF + 256 <= SCR_BYTES, "phase G LDS map");
__device__ __forceinline__ void phase_G(Frame& F, const Args& args) {
    const bf16_t* X1 = (const bf16_t*)(F.ws + OFF_X1); bf16_t* H2 = (bf16_t*)(F.ws + OFF_XN); const bf16_t* ROUTW = (const bf16_t*)(F.ws + OFF_ROUTW);
    const float* mod = (const float*)(F.ws + OFF_MOD); const float* g2w = args.in[18]; const float* bg = args.in[20]; const float* be = args.in[22];
    int* list = (int*)(F.ws + OFF_LIST); int* toke = (int*)(F.ws + OFF_TOKE); float* tokw = (float*)(F.ws + OFF_TOKW); int* tokp = (int*)(F.ws + OFF_TOKP);
    const int lane = F.lane, w = F.wave, fr = lane & 15, fq = lane >> 4;
    LAS float* LG = (LAS float*)(F.lds + RG_LOG_OFF); LAS int* hist = (LAS int*)(F.lds + RG_MISC_OFF); LAS int* base = hist + 32;
    __syncthreads();
    for (int i = F.tid; i < 36 * 128; i += NTHREADS) { const int r = i >> 7, c = i & 127; *(LAS u32x4*)(F.lds + RG_W_OFF + r * HT_STRIDE + c * 16) = *(const u32x4*)(ROUTW + (size_t)r * 1024 + c * 8); }
    for (int grp = F.bid; grp < T / 128; grp += F.G) {
        const int grow0 = grp * 128, b = grow0 / SEQ;
        const float* sh = mod + b * 6144 + 3072; const float* sc = sh + 1024;
        float gm[16], sv[16];
#pragma unroll
        for (int jj = 0; jj < 2; ++jj)
#pragma unroll
            for (int q = 0; q < 8; ++q) { const int c = 512 * jj + 8 * lane + q; gm[8 * jj + q] = g2w[c] * (1.0f + sc[c]); sv[8 * jj + q] = sh[c]; }
        if (F.tid < 32) hist[F.tid] = 0;
        u32x4 raw[4][2];
#pragma unroll
        for (int r = 0; r < 4; ++r)
#pragma unroll
            for (int jj = 0; jj < 2; ++jj) raw[r][jj] = *(const u32x4*)(X1 + (size_t)(grow0 + 4 * w + r) * D + 512 * jj + 8 * lane);
        int e1 = 0, e2 = 0, l1 = 0, l2 = 0; float w1 = 0.f, w2 = 0.f;
#pragma unroll 1
        for (int ti = 0; ti < 4; ++ti) {
            const int row0 = grow0 + 32 * ti;
#pragma unroll
            for (int r = 0; r < 4; ++r) {
                float h[16]; float ss = 0.f;
#pragma unroll
                for (int jj = 0; jj < 2; ++jj)
#pragma unroll
                    for (int q = 0; q < 4; ++q) { h[8 * jj + 2 * q] = bflo(raw[r][jj][q]); h[8 * jj + 2 * q + 1] = bfhi(raw[r][jj][q]); }
#pragma unroll
                for (int q = 0; q < 16; ++q) ss += h[q] * h[q];
                const float rs = rsqrtf(wave_sum(ss) * (1.0f / D) + EPS);
#pragma unroll
                for (int jj = 0; jj < 2; ++jj) { u32x4 o; float hv[8];
#pragma unroll
                    for (int q = 0; q < 8; ++q) hv[q] = h[8 * jj + q] * rs * gm[8 * jj + q] + sv[8 * jj + q];
#pragma unroll
                    for (int q = 0; q < 4; ++q) o[q] = pk2(hv[2 * q], hv[2 * q + 1]);
#if MOE_FP8
                    { u32x2 f; f.x = pg8::pk4_fp8(hv[0], hv[1], hv[2], hv[3]); f.y = pg8::pk4_fp8(hv[4], hv[5], hv[6], hv[7]);
                      *(u32x2*)((unsigned char*)H2 + (size_t)(row0 + 4 * w + r) * D + 512 * jj + 8 * lane) = f; }
#else
                    *(u32x4*)(H2 + (size_t)(row0 + 4 * w + r) * D + 512 * jj + 8 * lane) = o;
#endif
                    *(LAS u32x4*)(F.lds + RG_H_OFF + (4 * w + r) * HT_STRIDE + (512 * jj + 8 * lane) * 2) = o; }
            }
            if (ti < 3) {
#pragma unroll
                for (int r = 0; r < 4; ++r)
#pragma unroll
                    for (int jj = 0; jj < 2; ++jj) raw[r][jj] = *(const u32x4*)(X1 + (size_t)(row0 + 32 + 4 * w + r) * D + 512 * jj + 8 * lane);
            }
            __syncthreads();
            if (w < 6) {
                const int rt = w / 3, ct = w % 3; int wrow = 16 * ct + fr; wrow = wrow < 36 ? wrow : 35;
                const LAS unsigned char* hp = F.lds + RG_H_OFF + (16 * rt + fr) * HT_STRIDE + 16 * fq; const LAS unsigned char* wp = F.lds + RG_W_OFF + wrow * HT_STRIDE + 16 * fq;
                f32x4 acc0 = {0.f, 0.f, 0.f, 0.f}, acc1 = {0.f, 0.f, 0.f, 0.f};
#pragma unroll 8
                for (int kt = 0; kt < 32; kt += 2) {
                    acc0 = __builtin_amdgcn_mfma_f32_16x16x32_bf16(*(const LAS bf16x8*)(wp + 64 * kt), *(const LAS bf16x8*)(hp + 64 * kt), acc0, 0, 0, 0);
                    acc1 = __builtin_amdgcn_mfma_f32_16x16x32_bf16(*(const LAS bf16x8*)(wp + 64 * kt + 64), *(const LAS bf16x8*)(hp + 64 * kt + 64), acc1, 0, 0, 0); }
                *(LAS f32x4*)(LG + (16 * rt + fr) * 48 + 16 * ct + 4 * fq) = acc0 + acc1;
            }
            __syncthreads();
            if ((F.tid >> 5) == ti) {
                const LAS float* L = LG + (F.tid & 31) * 48;
                float gl[4], el[8];
#pragma unroll
                for (int j = 0; j < 4; ++j) gl[j] = L[j] + bg[j];
                int gs = 0; float gmax = gl[0];
#pragma unroll
                for (int j = 1; j < 4; ++j) if (gl[j] > gmax) { gmax = gl[j]; gs = j; }
#pragma unroll
                for (int j = 0; j < 8; ++j) el[j] = L[4 + gs * 8 + j] + be[gs * 8 + j];
                float gsum = 0.f;
#pragma unroll
                for (int j = 0; j < 4; ++j) gsum += __expf(gl[j] - gmax);
                const float pg = 1.0f / gsum;
                int i1 = 0; float m1 = el[0];
#pragma unroll
                for (int j = 1; j < 8; ++j) if (el[j] > m1) { m1 = el[j]; i1 = j; }
                int i2 = -1; float m2 = -INFINITY;
#pragma unroll
                for (int j = 0; j < 8; ++j) if (j != i1 && el[j] > m2) { m2 = el[j]; i2 = j; }
                const float r = __expf(m2 - m1);
                w1 = pg / (1.0f + r); w2 = pg * r / (1.0f + r); e1 = gs * 8 + i1; e2 = gs * 8 + i2;
                l1 = __hip_atomic_fetch_add(hist + e1, 1, __ATOMIC_RELAXED, __HIP_MEMORY_SCOPE_WORKGROUP);
                l2 = __hip_atomic_fetch_add(hist + e2, 1, __ATOMIC_RELAXED, __HIP_MEMORY_SCOPE_WORKGROUP);
            }
        }
        __syncthreads();
        if (F.tid < 32) { const int n = hist[F.tid]; base[F.tid] = n ? (int)__hip_atomic_fetch_add(F.ctl + CW_CNT + CNT_STRIDE * F.tid, (unsigned)n, __ATOMIC_RELAXED, __HIP_MEMORY_SCOPE_AGENT) : 0; }
        __syncthreads();
        if (F.tid < 128) { const int row = grow0 + F.tid, p1 = base[e1] + l1, p2 = base[e2] + l2;
            list[(size_t)e1 * LISTCAP + p1] = row; list[(size_t)e2 * LISTCAP + p2] = row;
            toke[2 * row] = e1; toke[2 * row + 1] = e2; tokw[2 * row] = w1; tokw[2 * row + 1] = w2; tokp[2 * row] = p1; tokp[2 * row + 1] = p2; }
        __syncthreads();
    }
}

__device__ __forceinline__ void phase_J(Frame& F, const Args& args) {
    const bf16_t* X1 = (const bf16_t*)(F.ws + OFF_X1); const bf16_t* Y = (const bf16_t*)(F.ws + OFF_Y); const float* mod = (const float*)(F.ws + OFF_MOD);
    const int* toke = (const int*)(F.ws + OFF_TOKE); const float* tokw = (const float*)(F.ws + OFF_TOKW); const int* tokp = (const int*)(F.ws + OFF_TOKP);
    const float* fg = args.in[26]; float* out = args.out;
    const int gw = F.bid * NWAVES + F.wave, NGW = F.G * NWAVES, lane = F.lane;
    constexpr int RPW = 16;
    for (int item = gw; item < T / RPW; item += NGW) {
        const int row0 = item * RPW, b = row0 / SEQ;
        int q0l = 0, q1l = 0; float w0l = 0.f, w1l = 0.f;
        { const int rr = row0 + (lane & 15); const int e0 = toke[2 * rr], e1 = toke[2 * rr + 1];
          q0l = F.tab[TAB_P0 + e0] * 256 + tokp[2 * rr]; q1l = F.tab[TAB_P0 + e1] * 256 + tokp[2 * rr + 1]; w0l = tokw[2 * rr]; w1l = tokw[2 * rr + 1]; }
        const float* g2 = mod + b * 6144 + 5120;
        f32x4 g2v[4], fgv[4];
#pragma unroll
        for (int jj = 0; jj < 2; ++jj)
#pragma unroll
            for (int hh = 0; hh < 2; ++hh) { const int c = 512 * jj + 8 * lane + 4 * hh; g2v[2 * jj + hh] = *(const f32x4*)(g2 + c); fgv[2 * jj + hh] = *(const f32x4*)(fg + c); }
#if MOE_FP8
        typedef u32x2 yvec; const unsigned char* Yb = (const unsigned char*)Y;
#define YLOAD(q_, c0_) (*(const u32x2*)(Yb + (q_) * D + (c0_)))
#define YUNPACK(v_, o_) do { const auto a0_ = __builtin_amdgcn_cvt_pk_f32_fp8((v_).x, false), a1_ = __builtin_amdgcn_cvt_pk_f32_fp8((v_).x, true), a2_ = __builtin_amdgcn_cvt_pk_f32_fp8((v_).y, false), a3_ = __builtin_amdgcn_cvt_pk_f32_fp8((v_).y, true); \
        o_[0] = a0_[0]; o_[1] = a0_[1]; o_[2] = a1_[0]; o_[3] = a1_[1]; o_[4] = a2_[0]; o_[5] = a2_[1]; o_[6] = a3_[0]; o_[7] = a3_[1]; } while (0)
        constexpr float YINV = 1.0f / Y_SCALE;
#else
        typedef u32x4 yvec;
#define YLOAD(q_, c0_) (*(const u32x4*)(Y + (q_) * D + (c0_)))
#define YUNPACK(v_, o_) do { _Pragma("unroll") for (int q_ = 0; q_ < 4; ++q_) { o_[2 * q_] = bflo((v_)[q_]); o_[2 * q_ + 1] = bfhi((v_)[q_]); } } while (0)
        constexpr float YINV = 1.0f;
#endif
        u32x4 xr[2], nxr[2]; yvec ya[2], yb[2], nya[2], nyb[2];
        { const size_t q0 = (size_t)__shfl(q0l, 0), q1 = (size_t)__shfl(q1l, 0);
#pragma unroll
          for (int jj = 0; jj < 2; ++jj) { const int c0 = 512 * jj + 8 * lane; xr[jj] = *(const u32x4*)(X1 + (size_t)row0 * D + c0); ya[jj] = YLOAD(q0, c0); yb[jj] = YLOAD(q1, c0); } }
#pragma unroll 1
        for (int r = 0; r < RPW; ++r) {
            const int row = row0 + r, rn = (r + 1 < RPW) ? r + 1 : r;
            { const size_t q0 = (size_t)__shfl(q0l, rn), q1 = (size_t)__shfl(q1l, rn);
#pragma unroll
              for (int jj = 0; jj < 2; ++jj) { const int c0 = 512 * jj + 8 * lane; nxr[jj] = *(const u32x4*)(X1 + (size_t)(row0 + rn) * D + c0); nya[jj] = YLOAD(q0, c0); nyb[jj] = YLOAD(q1, c0); } }
            const float w0 = __shfl(w0l, r), w1 = __shfl(w1l, r);
            float v[16]; float ss = 0.f;
#pragma unroll
            for (int jj = 0; jj < 2; ++jj) { float yav[8], ybv[8]; YUNPACK(ya[jj], yav); YUNPACK(yb[jj], ybv);
#pragma unroll
                for (int q = 0; q < 4; ++q) {
                    const float y0 = (w0 * yav[2 * q] + w1 * ybv[2 * q]) * YINV, y1 = (w0 * yav[2 * q + 1] + w1 * ybv[2 * q + 1]) * YINV;
                    const f32x4 gg = g2v[2 * jj + (q >> 1)];
                    v[8 * jj + 2 * q] = bflo(xr[jj][q]) + gg[(2 * q) & 3] * y0; v[8 * jj + 2 * q + 1] = bfhi(xr[jj][q]) + gg[(2 * q + 1) & 3] * y1; } }
#pragma unroll
            for (int q = 0; q < 16; ++q) ss += v[q] * v[q];
            const float rs = rsqrtf(wave_sum(ss) * (1.0f / D) + EPS);
#pragma unroll
            for (int jj = 0; jj < 2; ++jj) { const int c0 = 512 * jj + 8 * lane;
                f32x4 o0, o1;
#pragma unroll
                for (int q = 0; q < 4; ++q) { o0[q] = v[8 * jj + q] * rs * fgv[2 * jj][q]; o1[q] = v[8 * jj + 4 + q] * rs * fgv[2 * jj + 1][q]; }
                *(f32x4*)(out + (size_t)row * D + c0) = o0; *(f32x4*)(out + (size_t)row * D + c0 + 4) = o1;
                xr[jj] = nxr[jj]; ya[jj] = nya[jj]; yb[jj] = nyb[jj]; }
        }
    }
#undef YLOAD
#undef YUNPACK
}

__global__ void __launch_bounds__(NTHREADS, 2) mk(Args args) {
    extern __shared__ __attribute__((aligned(16))) unsigned char lds_raw[];
    Frame F;
    F.lds = (LAS unsigned char*)lds_raw; F.tab = (LAS int*)(F.lds + TAB_OFF);
    F.tid = threadIdx.x; F.lane = F.tid & 63; F.wave = __builtin_amdgcn_readfirstlane(F.tid >> 6);
    F.G = gridDim.x; F.bid = blockIdx.x; F.vcu = (F.G % 8 == 0) ? (F.bid % 8) * (F.G / 8) + F.bid / 8 : F.bid;
    F.ws = args.ws; F.ctl = (unsigned*)(args.ws + OFF_CTL);
    unsigned char* ws = args.ws;
    bf16_t* WIN = (bf16_t*)(ws + OFF_WIN); bf16_t* WOUT = (bf16_t*)(ws + OFF_WOUT); bf16_t* W13 = (bf16_t*)(ws + OFF_W13); bf16_t* W2 = (bf16_t*)(ws + OFF_W2);
    bf16_t* XN = (bf16_t*)(ws + OFF_XN); bf16_t* Z = (bf16_t*)(ws + OFF_Z); bf16_t* YMIX = (bf16_t*)(ws + OFF_YMIX); bf16_t* X1 = (bf16_t*)(ws + OFF_X1);
    bf16_t* ACT = (bf16_t*)(ws + OFF_ACT); bf16_t* Y = (bf16_t*)(ws + OFF_Y); bf16_t* H2 = XN;
    const float* mod = (const float*)(ws + OFF_MOD); const int* list = (const int*)(ws + OFF_LIST);
    const int lo = args.ph_lo, hi = args.ph_hi;
    for (int u = F.tid; u < (LDS_BYTES - LDSCTL_OFF) / 4; u += NTHREADS) ((LAS unsigned*)(F.lds + LDSCTL_OFF))[u] = 0u;
    __syncthreads();
    XcdBarrier bar; bar.bar = F.ctl + CW_BAR; bar.x = 0; bar.st = nullptr;
    if (hi - lo > 1) bar = xcd_barrier_post(F.ctl + CW_BAR, (volatile LAS unsigned*)(F.lds + LDSCTL_OFF) + 8);
#ifndef PHMASK
#define PHMASK 0x3ff
#endif
#define IN(k) (((PHMASK >> (k)) & 1) && lo <= (k) && (k) < hi)
#ifdef PROBE_SPAN
#define STAMP(i) do { if (F.bid == 0 && F.tid == 0) { const unsigned long long t_ = __builtin_amdgcn_s_memrealtime(); LAS unsigned* st_ = (LAS unsigned*)(F.lds + LDSCTL_OFF) + 32 + 2 * (i); st_[0] = (unsigned)t_; st_[1] = (unsigned)(t_ >> 32); } } while (0)
#else
#define STAMP(i) do { } while (0)
#endif
#define SEAM(k) do { if (IN(k) && IN((k) + 1)) xcd_barrier(bar); STAMP((k) + 1); } while (0)

    STAMP(0);
    if (IN(PH_A)) phase_A(F, args);
    SEAM(PH_A);
    if (IN(PH_B)) phase_B(F, args);
    SEAM(PH_B);
    if (IN(PH_C)) {
        pg8::Gemm g{XN, WIN, 2048}; pg8::EpiZ E{Z};
        if (F.G == 256) {
            constexpr int NCONV = 64, UPA = 5;
            const bool conv = F.bid >= 256 - NCONV;
            if (conv) { convert_experts(F, args, F.bid - (256 - NCONV), NCONV); __syncthreads(); }
            pg8::SplitOrder S; S.tokt = F.lds; S.init2(T, 2048, 2048, 256 - NCONV, NCONV, UPA, conv ? 1 : 0, conv ? F.bid - (256 - NCONV) : F.bid);
            pg8::gemm_phase<pg8::EpiZ, pg8::SplitOrder, true, false, false>(F.lds, g, S, E);
        } else {
            pg8::StaticOrder S; S.tokt = F.lds; S.init(T, 2048, 2048, F.G, F.bid);
            pg8::gemm_phase<pg8::EpiZ, pg8::StaticOrder, true, false, false>(F.lds, g, S, E);
        }
    }
    SEAM(PH_C);
    if (IN(PH_D)) { for (int blk = F.bid; blk < T / 128; blk += F.G) { __syncthreads(); sgu_block(F, args, blk); __syncthreads(); lru_block<1>(F, args, blk); } }
    SEAM(PH_D);
    if (IN(PH_E)) { for (int blk = F.bid; blk < T / 128; blk += F.G) { __syncthreads(); lru_block<2>(F, args, blk); } }
    SEAM(PH_E);
    if (IN(PH_F)) {
        __syncthreads();
        pg8::Gemm g{YMIX, WOUT, 2048}; pg8::StaticOrder S; S.tokt = F.lds; S.init(T, 1024, 2048, F.G, F.bid);
        pg8::EpiX1 E{args.in[0], mod, X1};
        pg8::gemm_phase<pg8::EpiX1, pg8::StaticOrder, true, false, false>(F.lds, g, S, E);
    }
    SEAM(PH_F);
    if (IN(PH_G)) phase_G(F, args);
    SEAM(PH_G);
    if (IN(PH_H)) {
        build_moe_table(F);
        pg8::MoeOrder S; S.nunits = F.tab[TAB_P0 + NE] * 4; S.G = F.G; S.c = F.vcu;
        S.tile_e = F.tab + TAB_TE; S.p0 = F.tab + TAB_P0; S.cnt = F.tab + TAB_CNT; S.list = list; S.gather = true; S.tokt = F.lds + TOKT_OFF;
#if MOE_FP8
        S.Kb = 1024; S.estride = (size_t)1024 * 1024;
        pg8::Gemm g{H2, W13, 1024}; pg8::EpiAct8 E{(unsigned char*)ACT, 1.0f / W13_SCALE, ACT_SCALE};
        pg8::gemm_phase<pg8::EpiAct8, pg8::MoeOrder, true, true, true>(F.lds, g, S, E);
#else
        S.Kb = 2048; S.estride = (size_t)1024 * 1024 * 2;
        pg8::Gemm g{H2, W13, 2048}; pg8::EpiAct E{ACT};
        pg8::gemm_phase<pg8::EpiAct, pg8::MoeOrder, true, true, false>(F.lds, g, S, E);
#endif
    }
    SEAM(PH_H);
    if (IN(PH_I)) {
        build_moe_table(F);
        pg8::MoeOrder S; S.nunits = F.tab[TAB_P0 + NE] * 4; S.G = F.G; S.c = F.vcu;
        S.tile_e = F.tab + TAB_TE; S.p0 = F.tab + TAB_P0; S.cnt = F.tab + TAB_CNT; S.list = list; S.gather = false; S.tokt = F.lds + TOKT_OFF;
#if MOE_FP8
        S.Kb = 512; S.estride = (size_t)1024 * 512;
        pg8::Gemm g{ACT, W2, 512}; pg8::EpiY8 E{(unsigned char*)Y, Y_SCALE / (W2_SCALE * ACT_SCALE)};
        pg8::gemm_phase<pg8::EpiY8, pg8::MoeOrder, true, false, true>(F.lds, g, S, E);
#else
        S.Kb = 1024; S.estride = (size_t)1024 * 512 * 2;
        pg8::Gemm g{ACT, W2, 1024}; pg8::EpiY E{Y};
        pg8::gemm_phase<pg8::EpiY, pg8::MoeOrder, true, false, false>(F.lds, g, S, E);
#endif
    }
    SEAM(PH_I);
    if (IN(PH_J)) { build_moe_table(F); phase_J(F, args); }
#ifdef PROBE_SPAN
    STAMP(PH_N);
    if (F.bid == 0 && F.tid == 0) { LAS unsigned* st_ = (LAS unsigned*)(F.lds + LDSCTL_OFF) + 32;
        const unsigned long long a_ = ((unsigned long long)st_[2 * PROBE_SPAN + 1] << 32) | st_[2 * PROBE_SPAN], b_ = ((unsigned long long)st_[2 * PROBE_SPAN + 3] << 32) | st_[2 * PROBE_SPAN + 2];
        const unsigned long long t0_ = __builtin_amdgcn_s_memrealtime(), dt_ = (b_ - a_) * PROBE_MULT;
        while (__builtin_amdgcn_s_memrealtime() - t0_ < dt_) __builtin_amdgcn_s_sleep(8); }
#endif
#undef IN
#undef SEAM
}
#ifndef FUSED
#define FUSED 1
#endif
extern "C" void kernel_launch(void* const* d_in, const int* in_sizes, int n_in, void* d_out, int out_size, void* d_ws, size_t ws_size, hipStream_t stream) {
    if (n_in != 27 || out_size != T * D || ws_size < WS_NEED) { fprintf(stderr, "kernel_launch: unexpected shapes (n_in %d out %d ws %zu)\n", n_in, out_size, ws_size); return; }
    static int grid = 0;
    if (grid == 0) {
        int dev = 0, cus = 0;
        if (hipGetDevice(&dev) != hipSuccess || hipDeviceGetAttribute(&cus, hipDeviceAttributeMultiprocessorCount, dev) != hipSuccess) { fprintf(stderr, "kernel_launch: device query failed\n"); grid = -1; return; }
        if (hipFuncSetAttribute((const void*)mk, hipFuncAttributeMaxDynamicSharedMemorySize, LDS_BYTES) != hipSuccess) { fprintf(stderr, "kernel_launch: hipFuncSetAttribute failed\n"); grid = -1; return; }
        int per_cu = 0;
        if (hipOccupancyMaxActiveBlocksPerMultiprocessor(&per_cu, (const void*)mk, NTHREADS, LDS_BYTES) != hipSuccess || per_cu < 1) fprintf(stderr, "kernel_launch: occupancy query says %d\n", per_cu);
        (void)hipGetLastError();
        grid = cus;
    }
    if (grid < 0) return;
    Args a{}; for (int i = 0; i < 27; ++i) a.in[i] = (const float*)d_in[i]; a.out = (float*)d_out; a.ws = (unsigned char*)d_ws;
#define MK(lo_, hi_) do { a.ph_lo = (lo_); a.ph_hi = (hi_); hipLaunchKernelGGL(mk, dim3(grid), dim3(NTHREADS), LDS_BYTES, stream, a); } while (0)
    (void)hipMemsetAsync((char*)d_ws + OFF_CTL, 0, CTL_BYTES, stream);
#if FUSED
    MK(0, PH_N);
#else
    for (int p = 0; p < PH_N; ++p) MK(p, p + 1);
#endif
}
```

```cpp
#include <hip/hip_runtime.h>
#include <cstdio>
#include <cstdint>

typedef unsigned short bf16_t;
typedef short bf16x8 __attribute__((ext_vector_type(8)));
typedef float f32x4 __attribute__((ext_vector_type(4)));
typedef unsigned u32x2 __attribute__((ext_vector_type(2)));
typedef unsigned u32x4 __attribute__((ext_vector_type(4)));

constexpr int T = 32768, D = 1024, SEQ = 4096, NB = 8;
constexpr int DL = 512;
constexpr int NE = 32, DE = 512;
constexpr int LISTCAP = 65536;
constexpr int MAXTILES = 288, MAXROWS = MAXTILES * 256;
constexpr float EPS = 1e-6f;

constexpr size_t MiB = 1u << 20;
constexpr size_t OFF_CTL = 0, CTL_BYTES = 48 * 1024;
constexpr size_t OFF_MOD = 1 * MiB;
constexpr size_t OFF_TBL = 1 * MiB + 256 * 1024;
constexpr size_t OFF_TOKE = 1 * MiB + 512 * 1024;
constexpr size_t OFF_TOKW = 1 * MiB + 768 * 1024;
constexpr size_t OFF_TOKP = 2 * MiB;
constexpr size_t OFF_N8SP = 1 * MiB + 256 * 1024 + 16384;
constexpr size_t OFF_GBIAS = 1 * MiB + 256 * 1024 + 32768;
constexpr size_t OFF_GATEW = 2 * MiB + 256 * 1024;
constexpr size_t OFF_SGUW = 2 * MiB + 512 * 1024;
constexpr size_t OFF_ROUTW = 2 * MiB + 768 * 1024;
constexpr size_t OFF_CARRY = 3 * MiB;
constexpr size_t OFF_WIN = 4 * MiB;
constexpr size_t OFF_WOUT = 8 * MiB;
constexpr size_t OFF_W13 = 10 * MiB;
constexpr size_t OFF_W2 = 74 * MiB;
constexpr size_t OFF_XN = 106 * MiB;
constexpr size_t OFF_Z = 170 * MiB;
constexpr size_t OFF_YMIX = 298 * MiB;
constexpr size_t OFF_X1 = 362 * MiB;
constexpr size_t OFF_ACT = 426 * MiB;
constexpr size_t OFF_LIST = 498 * MiB;
constexpr size_t OFF_ROWTOK = 506 * MiB;
constexpr size_t OFF_Y = 170 * MiB;
constexpr size_t WS_NEED = 507 * MiB;
constexpr size_t OFF_VN = OFF_X1;
constexpr size_t OFF_XC = OFF_ACT;
constexpr int CW_BAR = 4096;
constexpr int CW_CNT = 8192, CNT_STRIDE = 64;

__device__ __forceinline__ unsigned f2bf(float f) { unsigned u = __float_as_uint(f); return (u + 0x7fffu + ((u >> 16) & 1u)) >> 16; }
__device__ __forceinline__ float bf2f(unsigned h) { return __uint_as_float(h << 16); }
__device__ __forceinline__ unsigned pk2(float lo, float hi) { unsigned r; asm("v_cvt_pk_bf16_f32 %0, %1, %2" : "=v"(r) : "v"(lo), "v"(hi)); return r; }
__device__ __forceinline__ float wave_sum(float v) {
#pragma unroll
    for (int o = 1; o < 64; o <<= 1) v += __shfl_xor(v, o);
    return v;
}
__device__ __forceinline__ float gelu_tanh(float x) {
    const float u = 1.5957691216057308f * (x + 0.044715f * x * x * x);
    return x / (1.0f + __expf(-u));
}
__device__ __forceinline__ float sigmoidf(float x) { return 1.0f / (1.0f + __expf(-x)); }

__global__ void __launch_bounds__(256) k_ada(const float* c, const float* ada_w, const float* ada_b, float* mod) {
    __shared__ float sc[8][1024];
    for (int i = threadIdx.x; i < 8192; i += 256) { const float v = c[i]; sc[i >> 10][i & 1023] = v / (1.0f + expf(-v)); }
    __syncthreads();
    const int n = blockIdx.x * 256 + threadIdx.x;
    float acc[8];
#pragma unroll
    for (int b = 0; b < 8; ++b) acc[b] = 0.f;
    for (int k = 0; k < 1024; ++k) {
        const float w = ada_w[(size_t)k * 6144 + n];
#pragma unroll
        for (int b = 0; b < 8; ++b) acc[b] += sc[b][k] * w;
    }
#pragma unroll
    for (int b = 0; b < 8; ++b) mod[b * 6144 + n] = acc[b] + ada_b[n];
}

__global__ void __launch_bounds__(256) k_transpose(const float* W, bf16_t* WT, int K, int N, int blk, int rstride, int rbase, size_t w_ms, size_t wt_ms) {
    __shared__ float tile[32][33];
    W += (size_t)blockIdx.z * w_ms; WT += (size_t)blockIdx.z * wt_ms;
    const int n0 = blockIdx.x * 32, k0 = blockIdx.y * 32, tx = threadIdx.x & 31, ty = threadIdx.x >> 5;
    for (int j = ty; j < 32; j += 8) tile[j][tx] = W[(size_t)(k0 + j) * N + n0 + tx];
    __syncthreads();
    for (int j = ty; j < 32; j += 8) { const int n = n0 + j; const int row = rbase + (n / blk) * rstride + (n % blk);
        WT[(size_t)row * K + k0 + tx] = (bf16_t)f2bf(tile[tx][j]); }
}

__global__ void __launch_bounds__(256) k_xn(const float* x, const float* g, const float* mod, bf16_t* XN) {
    const int row = blockIdx.x * 4 + (threadIdx.x >> 6), lane = threadIdx.x & 63, b = row / SEQ;
    const f32x4* xr = (const f32x4*)(x + (size_t)row * D);
    f32x4 v[4]; float ss = 0.f;
#pragma unroll
    for (int j = 0; j < 4; ++j) { v[j] = xr[lane + 64 * j]; ss += v[j][0] * v[j][0] + v[j][1] * v[j][1] + v[j][2] * v[j][2] + v[j][3] * v[j][3]; }
    ss = wave_sum(ss);
    const float rs = rsqrtf(ss * (1.0f / D) + EPS);
    const float* sh = mod + b * 6144; const float* sc = sh + 1024;
#pragma unroll
    for (int j = 0; j < 4; ++j) { const int col = 4 * (lane + 64 * j);
        const f32x4 gg = *(const f32x4*)(g + col), s1 = *(const f32x4*)(sc + col), s0 = *(const f32x4*)(sh + col);
        float h[4];
#pragma unroll
        for (int q = 0; q < 4; ++q) h[q] = v[j][q] * rs * gg[q] * (1.0f + s1[q]) + s0[q];
        u32x2 o; o.x = pk2(h[0], h[1]); o.y = pk2(h[2], h[3]);
        *(u32x2*)(XN + (size_t)row * D + col) = o; }
}

template <bool DUAL, class Epi>
__device__ __forceinline__ void sg_tile(const bf16_t* A, const int* arow, const bf16_t* Bt, const bf16_t* Bt2, int K, int m0, int n0, int lane, const Epi& epi) {
    const int fr = lane & 15, fq = lane >> 4;
    const bf16_t* pa[2]; const bf16_t* pb[4]; const bf16_t* pb2[4];
#pragma unroll
    for (int mi = 0; mi < 2; ++mi) { const int r = m0 + mi * 16 + fr; const int rr = arow ? arow[r] : r; pa[mi] = A + (size_t)rr * K + 8 * fq; }
#pragma unroll
    for (int ni = 0; ni < 4; ++ni) { pb[ni] = Bt + (size_t)(n0 + ni * 16 + fr) * K + 8 * fq; pb2[ni] = DUAL ? Bt2 + (size_t)(n0 + ni * 16 + fr) * K + 8 * fq : nullptr; }
    f32x4 acc[2][4], acc2[2][4];
#pragma unroll
    for (int mi = 0; mi < 2; ++mi)
#pragma unroll
        for (int ni = 0; ni < 4; ++ni) { acc[mi][ni] = (f32x4){0.f, 0.f, 0.f, 0.f}; acc2[mi][ni] = (f32x4){0.f, 0.f, 0.f, 0.f}; }
    for (int k0 = 0; k0 < K; k0 += 32) {
        bf16x8 a[2], b[4], b2[4];
#pragma unroll
        for (int mi = 0; mi < 2; ++mi) a[mi] = *(const bf16x8*)(pa[mi] + k0);
#pragma unroll
        for (int ni = 0; ni < 4; ++ni) { b[ni] = *(const bf16x8*)(pb[ni] + k0); if (DUAL) b2[ni] = *(const bf16x8*)(pb2[ni] + k0); }
#pragma unroll
        for (int mi = 0; mi < 2; ++mi)
#pragma unroll
            for (int ni = 0; ni < 4; ++ni) {
                acc[mi][ni] = __builtin_amdgcn_mfma_f32_16x16x32_bf16(b[ni], a[mi], acc[mi][ni], 0, 0, 0);
                if (DUAL) acc2[mi][ni] = __builtin_amdgcn_mfma_f32_16x16x32_bf16(b2[ni], a[mi], acc2[mi][ni], 0, 0, 0);
            }
    }
#pragma unroll
    for (int mi = 0; mi < 2; ++mi)
#pragma unroll
        for (int ni = 0; ni < 4; ++ni) epi(m0 + mi * 16 + fr, n0 + ni * 16 + 4 * fq, acc[mi][ni], acc2[mi][ni]);
}

struct EpiInProj { bf16_t* Z;
    __device__ __forceinline__ void operator()(int row, int col, f32x4 v, f32x4) const {
        if (col >= 512) { v[0] = gelu_tanh(v[0]); v[1] = gelu_tanh(v[1]); v[2] = gelu_tanh(v[2]); v[3] = gelu_tanh(v[3]); }
        u32x2 o; o.x = pk2(v[0], v[1]); o.y = pk2(v[2], v[3]); *(u32x2*)(Z + (size_t)row * 2048 + col) = o; } };
struct EpiOutProj { const float* x; const float* mod; bf16_t* X1;
    __device__ __forceinline__ void operator()(int row, int col, f32x4 v, f32x4) const {
        const int b = row / SEQ; const f32x4 xv = *(const f32x4*)(x + (size_t)row * D + col), g1 = *(const f32x4*)(mod + b * 6144 + 2048 + col);
        u32x2 o; o.x = pk2(xv[0] + g1[0] * v[0], xv[1] + g1[1] * v[1]); o.y = pk2(xv[2] + g1[2] * v[2], xv[3] + g1[3] * v[3]);
        *(u32x2*)(X1 + (size_t)row * D + col) = o; } };
struct EpiMoe1 { bf16_t* ACT;
    __device__ __forceinline__ void operator()(int row, int col, f32x4 g, f32x4 u) const {
        float a[4];
#pragma unroll
        for (int q = 0; q < 4; ++q) a[q] = g[q] / (1.0f + __expf(-g[q])) * u[q];
        u32x2 o; o.x = pk2(a[0], a[1]); o.y = pk2(a[2], a[3]); *(u32x2*)(ACT + (size_t)row * DE + col) = o; } };
struct EpiMoe2 { bf16_t* Y;
    __device__ __forceinline__ void operator()(int row, int col, f32x4 v, f32x4) const {
        u32x2 o; o.x = pk2(v[0], v[1]); o.y = pk2(v[2], v[3]); *(u32x2*)(Y + (size_t)row * D + col) = o; } };

template <class Epi>
__global__ void __launch_bounds__(256) k_sgemm(const bf16_t* A, const bf16_t* Bt, int M, int N, int K, Epi epi) {
    const int w = blockIdx.x * 4 + (threadIdx.x >> 6), lane = threadIdx.x & 63, nN = N / 64;
    const int mt = w / nN, nt = w % nN; if (mt * 32 >= M) return;
    sg_tile<false>(A, nullptr, Bt, nullptr, K, mt * 32, nt * 64, lane, epi);
}
__global__ void __launch_bounds__(256) k_moe1(const bf16_t* H2, const int* rowtok, const int* tbl, const bf16_t* W13, EpiMoe1 epi) {
    const int w = blockIdx.x * 4 + (threadIdx.x >> 6), lane = threadIdx.x & 63;
    const int mt = w / 8, nt = w % 8, tile = mt / 8;
    if (tile >= tbl[0]) return;
    const int e = tbl[64 + tile], n0 = nt * 64, q = n0 / 128, i0 = n0 % 128;
    const bf16_t* Wg = W13 + (size_t)e * 1024 * 1024 + (size_t)(256 * q + i0) * 1024 - (size_t)n0 * 1024;
    sg_tile<true>(H2, rowtok, Wg, Wg + (size_t)128 * 1024, 1024, mt * 32, n0, lane, epi);
}
__global__ void __launch_bounds__(256) k_moe2(const bf16_t* ACT, const int* tbl, const bf16_t* W2, EpiMoe2 epi) {
    const int w = blockIdx.x * 4 + (threadIdx.x >> 6), lane = threadIdx.x & 63;
    const int mt = w / 16, nt = w % 16, tile = mt / 8;
    if (tile >= tbl[0]) return;
    const int e = tbl[64 + tile];
    sg_tile<false>(ACT, nullptr, W2 + (size_t)e * 1024 * 512, nullptr, 512, mt * 32, nt * 64, lane, epi);
}

__global__ void __launch_bounds__(256) k_lnv(const bf16_t* Z, const float* g, const float* bb, bf16_t* VN) {
    const int row = blockIdx.x * 4 + (threadIdx.x >> 6), lane = threadIdx.x & 63;
    const u32x4 raw = *(const u32x4*)(Z + (size_t)row * 2048 + 1536 + 8 * lane);
    float v[8];
#pragma unroll
    for (int q = 0; q < 4; ++q) { v[2 * q] = bf2f(raw[q] & 0xffffu); v[2 * q + 1] = bf2f(raw[q] >> 16); }
    float s = 0.f;
#pragma unroll
    for (int q = 0; q < 8; ++q) s += v[q];
    const float mu = wave_sum(s) * (1.0f / 512.0f);
    float s2 = 0.f;
#pragma unroll
    for (int q = 0; q < 8; ++q) { v[q] -= mu; s2 += v[q] * v[q]; }
    const float rstd = rsqrtf(wave_sum(s2) * (1.0f / 512.0f) + EPS);
    u32x4 o;
#pragma unroll
    for (int q = 0; q < 4; ++q) { const int c = 8 * lane + 2 * q; o[q] = pk2(v[2 * q] * rstd * g[c] + bb[c], v[2 * q + 1] * rstd * g[c + 1] + bb[c + 1]); }
    *(u32x4*)(VN + (size_t)row * 512 + 8 * lane) = o;
}
__global__ void __launch_bounds__(256) k_sgu(const bf16_t* Z, const bf16_t* VN, const float* sgu_w, const float* sgu_b, bf16_t* YMIX) {
    const int idx = blockIdx.x * 256 + threadIdx.x, t = idx >> 9, ch = idx & 511, i = t & 127, blk = t >> 7, g = ch >> 6;
    const int jmax = (i < 64) ? 64 : 128;
    float s = sgu_b[g * 128 + i];
    const float* wrow = sgu_w + ((size_t)g * 128 + i) * 128;
    for (int j = 0; j < jmax; ++j) s += wrow[j] * bf2f(VN[((size_t)blk * 128 + j) * 512 + ch]);
    YMIX[(size_t)t * D + 512 + ch] = (bf16_t)f2bf(bf2f(Z[(size_t)t * 2048 + 1024 + ch]) * s);
}
__global__ void __launch_bounds__(256) k_conv(const bf16_t* Z, const float* cw, const float* cb, float* XC) {
    const int idx = blockIdx.x * 256 + threadIdx.x, t = idx >> 9, ch = idx & 511, pos = t & (SEQ - 1);
    float acc = cb[ch];
#pragma unroll
    for (int k = 0; k < 4; ++k) { const int d = k - 3; if (pos + d >= 0) acc += cw[k * 512 + ch] * bf2f(Z[(size_t)(t + d) * 2048 + ch]); }
    XC[idx] = acc;
}
__global__ void __launch_bounds__(256) k_gates(const float* XC, const float* wa, const float* ba, const float* wi, const float* bi, const float* lam, float* A_, float* U_) {
    const int idx = blockIdx.x * 256 + threadIdx.x, t = idx >> 9, ch = idx & 511, h = ch >> 6, e = ch & 63;
    const float* xrow = XC + (size_t)t * 512 + h * 64;
    float ra = ba[ch], ri = bi[ch];
    for (int d = 0; d < 64; ++d) { const float xv = xrow[d]; ra += xv * wa[h * 4096 + d * 64 + e]; ri += xv * wi[h * 4096 + d * 64 + e]; }
    const float r = sigmoidf(ra), ig = sigmoidf(ri);
    const float sp = log1pf(expf(-lam[ch]));
    const float log_a = -8.0f * r * sp;
    A_[idx] = expf(log_a);
    U_[idx] = sqrtf(-expm1f(2.0f * log_a)) * (ig * XC[idx]);
}
__global__ void __launch_bounds__(64) k_scan(const float* A_, const float* U_, const bf16_t* Z, bf16_t* YMIX) {
    const int idx = blockIdx.x * 64 + threadIdx.x, b = idx >> 9, ch = idx & 511;
    float h = 0.f;
    for (int p0 = 0; p0 < SEQ; p0 += 8) {
        float a[8], u[8], g[8];
#pragma unroll
        for (int q = 0; q < 8; ++q) { const size_t t = (size_t)b * SEQ + p0 + q; a[q] = A_[t * 512 + ch]; u[q] = U_[t * 512 + ch]; g[q] = bf2f(Z[t * 2048 + 512 + ch]); }
#pragma unroll
        for (int q = 0; q < 8; ++q) { const size_t t = (size_t)b * SEQ + p0 + q; h = a[q] * h + u[q]; YMIX[t * D + ch] = (bf16_t)f2bf(h * g[q]); }
    }
}

__global__ void __launch_bounds__(256) k_router(const bf16_t* X1, const float* g2w, const float* mod, const float* wg, const float* bg, const float* we, const float* be,
                                                bf16_t* H2, unsigned* cnt, int* list, int* toke, float* tokw, int* tokp) {
    const int row = blockIdx.x * 4 + (threadIdx.x >> 6), lane = threadIdx.x & 63, b = row / SEQ;
    float h[16]; float ss = 0.f;
#pragma unroll
    for (int jj = 0; jj < 2; ++jj) { const u32x4 raw = *(const u32x4*)(X1 + (size_t)row * D + 512 * jj + 8 * lane);
#pragma unroll
        for (int q = 0; q < 4; ++q) { h[8 * jj + 2 * q] = bf2f(raw[q] & 0xffffu); h[8 * jj + 2 * q + 1] = bf2f(raw[q] >> 16); } }
#pragma unroll
    for (int q = 0; q < 16; ++q) ss += h[q] * h[q];
    const float rs = rsqrtf(wave_sum(ss) * (1.0f / D) + EPS);
    const float* sh = mod + b * 6144 + 3072; const float* sc = sh + 1024;
#pragma unroll
    for (int jj = 0; jj < 2; ++jj) { u32x4 o;
#pragma unroll
        for (int q = 0; q < 4; ++q) { const int c = 512 * jj + 8 * lane + 2 * q;
            const float h0 = h[8 * jj + 2 * q] * rs * g2w[c] * (1.0f + sc[c]) + sh[c], h1 = h[8 * jj + 2 * q + 1] * rs * g2w[c + 1] * (1.0f + sc[c + 1]) + sh[c + 1];
            o[q] = pk2(h0, h1); h[8 * jj + 2 * q] = bf2f(o[q] & 0xffffu); h[8 * jj + 2 * q + 1] = bf2f(o[q] >> 16); }
        *(u32x4*)(H2 + (size_t)row * D + 512 * jj + 8 * lane) = o; }
    float gl[4], el[8];
#pragma unroll
    for (int j = 0; j < 4; ++j) { float p = 0.f;
#pragma unroll
        for (int q = 0; q < 16; ++q) { const int k = 512 * (q >> 3) + 8 * lane + (q & 7); p += h[q] * wg[k * 4 + j]; }
        gl[j] = wave_sum(p) + bg[j]; }
    int gs = 0; float gmax = gl[0];
#pragma unroll
    for (int j = 1; j < 4; ++j) if (gl[j] > gmax) { gmax = gl[j]; gs = j; }
#pragma unroll
    for (int j = 0; j < 8; ++j) { float p = 0.f;
#pragma unroll
        for (int q = 0; q < 16; ++q) { const int k = 512 * (q >> 3) + 8 * lane + (q & 7); p += h[q] * we[k * 32 + gs * 8 + j]; }
        el[j] = wave_sum(p) + be[gs * 8 + j]; }
    if (lane == 0) {
        float gsum = 0.f;
#pragma unroll
        for (int j = 0; j < 4; ++j) gsum += expf(gl[j] - gmax);
        const float pg = 1.0f / gsum;
        int i1 = 0; float m1 = el[0];
#pragma unroll
        for (int j = 1; j < 8; ++j) if (el[j] > m1) { m1 = el[j]; i1 = j; }
        int i2 = -1; float m2 = -INFINITY;
#pragma unroll
        for (int j = 0; j < 8; ++j) if (j != i1 && el[j] > m2) { m2 = el[j]; i2 = j; }
        const float r = expf(m2 - m1);
        const float w1 = pg / (1.0f + r), w2 = pg * r / (1.0f + r);
        const int e1 = gs * 8 + i1, e2 = gs * 8 + i2;
        const unsigned p1 = atomicAdd(cnt + CNT_STRIDE * e1, 1u), p2 = atomicAdd(cnt + CNT_STRIDE * e2, 1u);
        list[(size_t)e1 * LISTCAP + p1] = row; list[(size_t)e2 * LISTCAP + p2] = row;
        toke[2 * row] = e1; toke[2 * row + 1] = e2; tokw[2 * row] = w1; tokw[2 * row + 1] = w2; tokp[2 * row] = (int)p1; tokp[2 * row + 1] = (int)p2;
    }
}
__global__ void k_table(const unsigned* cnt, int* tbl) {
    if (threadIdx.x == 0) { int p = 0;
        for (int e = 0; e < NE; ++e) { tbl[1 + e] = p; const int nt = ((int)cnt[CNT_STRIDE * e] + 255) / 256; for (int j = 0; j < nt; ++j) tbl[64 + p + j] = e; p += nt; }
        tbl[1 + NE] = p; tbl[0] = p; }
}
__global__ void __launch_bounds__(256) k_rowtok(const unsigned* cnt, const int* tbl, const int* list, int* rowtok) {
    const int p = blockIdx.x * 256 + threadIdx.x, t = p >> 8; int tok = 0;
    if (t < tbl[0]) { const int e = tbl[64 + t], pos = (t - tbl[1 + e]) * 256 + (p & 255); if (pos < (int)cnt[CNT_STRIDE * e]) tok = list[(size_t)e * LISTCAP + pos]; }
    rowtok[p] = tok;
}
__global__ void __launch_bounds__(256) k_combine(const bf16_t* X1, const bf16_t* Y, const float* mod, const int* tbl, const int* toke, const float* tokw, const int* tokp, const float* fg, float* out) {
    const int row = blockIdx.x * 4 + (threadIdx.x >> 6), lane = threadIdx.x & 63, b = row / SEQ;
    const int e0 = toke[2 * row], e1 = toke[2 * row + 1];
    const size_t q0 = (size_t)tbl[1 + e0] * 256 + tokp[2 * row], q1 = (size_t)tbl[1 + e1] * 256 + tokp[2 * row + 1];
    const float w0 = tokw[2 * row], w1 = tokw[2 * row + 1];
    const float* g2 = mod + b * 6144 + 5120;
    float v[16]; float ss = 0.f;
#pragma unroll
    for (int jj = 0; jj < 2; ++jj) { const int c0 = 512 * jj + 8 * lane;
        const u32x4 xr = *(const u32x4*)(X1 + (size_t)row * D + c0), ya = *(const u32x4*)(Y + q0 * D + c0), yb = *(const u32x4*)(Y + q1 * D + c0);
#pragma unroll
        for (int q = 0; q < 4; ++q) {
            const float x0 = bf2f(xr[q] & 0xffffu), x1 = bf2f(xr[q] >> 16);
            const float y0 = w0 * bf2f(ya[q] & 0xffffu) + w1 * bf2f(yb[q] & 0xffffu), y1 = w0 * bf2f(ya[q] >> 16) + w1 * bf2f(yb[q] >> 16);
            v[8 * jj + 2 * q] = x0 + g2[c0 + 2 * q] * y0; v[8 * jj + 2 * q + 1] = x1 + g2[c0 + 2 * q + 1] * y1; } }
#pragma unroll
    for (int q = 0; q < 16; ++q) ss += v[q] * v[q];
    const float rs = rsqrtf(wave_sum(ss) * (1.0f / D) + EPS);
#pragma unroll
    for (int jj = 0; jj < 2; ++jj) { const int c0 = 512 * jj + 8 * lane;
        f32x4 o0, o1;
#pragma unroll
        for (int q = 0; q < 4; ++q) { o0[q] = v[8 * jj + q] * rs * fg[c0 + q]; o1[q] = v[8 * jj + 4 + q] * rs * fg[c0 + 4 + q]; }
        *(f32x4*)(out + (size_t)row * D + c0) = o0; *(f32x4*)(out + (size_t)row * D + c0 + 4) = o1; }
}

namespace pg8 {
#define PG8_LAS __attribute__((address_space(3)))
constexpr int BM = 256, BK = 64, HALF = 128, HTB = HALF * BK * 2  , STAGE_BYTES = 8 * HTB, NXCD = 8, WGM = 8;
__host__ __device__ __forceinline__ int lds_byte(int r, int c) { const int st = (r >> 4) * 2 + (c >> 5), rr = r & 15, cc = c & 31, ob = rr * 64 + cc * 2; return st * 1024 + (ob ^ (((ob >> 9) & 1) << 5)); }
__host__ __device__ __forceinline__ void stage_rc(int b, int& R, int& C) { const int st = b / 1024, sb = b % 1024, swz = sb ^ (((sb >> 9) & 1) << 5); R = (st >> 1) * 16 + swz / 64; C = (st & 1) * 32 + (swz % 64) / 2; }
__host__ __device__ __forceinline__ int perm32(int rho) { const int n = rho >> 4, i = rho & 15; return 8 * (i >> 2) + 4 * n + (i & 3); }

struct Unit { int pm, pn, e; };
struct Gemm { const void* A; const void* Bt; int Kb; };
__host__ __device__ __forceinline__ int swz8(int r8) { return ((r8 >> 1) & 1) | (((r8 >> 2) & 1) << 2); }
__host__ __device__ __forceinline__ int lds_byte8(int r, int piece) { return (r >> 3) * 1024 + ((r & 7) * 8 + (piece ^ swz8(r & 7))) * 16; }
__host__ __device__ __forceinline__ void stage_rc8(int b, int& R, int& Cb) { const int chunk = b >> 10, slot = (b & 1023) >> 4, r8 = slot >> 3, j = slot & 7; R = chunk * 8 + r8; Cb = (j ^ swz8(r8)) * 16; }
typedef int v8i32 __attribute__((ext_vector_type(8)));
typedef int v4i32 __attribute__((ext_vector_type(4)));

struct StaticOrder {
    int nM, nN, nwg, G, c; size_t tstep;
    __device__ void init(int M, int N, int Kb, int G_, int c_) { nM = M / BM; nN = N / BM; nwg = nM * nN; G = G_; c = c_; tstep = (size_t)BM * Kb; }
    __device__ bool next(int i, Unit& u) const {
        const long L = (long)i * G + c; if (L >= nwg) return false;
        int wgid = (int)L; { const int q = nwg / NXCD, r = nwg % NXCD, xcd = wgid % NXCD, off = wgid / NXCD; wgid = (xcd < r ? xcd * (q + 1) : r * (q + 1) + (xcd - r) * q) + off; }
        const int nig = WGM * nN, gid = wgid / nig, fm = gid * WGM, gsz = (nM - fm) < WGM ? (nM - fm) : WGM;
        u.pm = fm + ((wgid % nig) % gsz); u.pn = (wgid % nig) / gsz; u.e = 0; return true;
    }
    __device__ __forceinline__ size_t a_off(const Unit& u) const { return (size_t)u.pm * tstep; }
    __device__ __forceinline__ size_t b_off(const Unit& u) const { return (size_t)u.pn * tstep; }
    PG8_LAS unsigned char* tokt;
    __device__ __forceinline__ const int* tok_src(const Unit&, int) const { return nullptr; }
};
struct SplitOrder : StaticOrder {
    int nA, upa, cls, idx, nB;
    __device__ void init2(int M, int N, int Kb, int nA_, int nB_, int upa_, int cls_, int idx_) { init(M, N, Kb, 1, 0); nA = nA_; nB = nB_; upa = upa_; cls = cls_; idx = idx_; }
    __device__ bool next(int i, Unit& u) const {
        long L; if (cls == 0) { if (i >= upa) return false; L = (long)i * nA + idx; } else { L = (long)upa * nA + (long)i * nB + idx; }
        if (L >= nwg) return false;
        int wgid = (int)L; { const int q = nwg / NXCD, r = nwg % NXCD, xcd = wgid % NXCD, off = wgid / NXCD; wgid = (xcd < r ? xcd * (q + 1) : r * (q + 1) + (xcd - r) * q) + off; }
        const int nig = WGM * nN, gid = wgid / nig, fm = gid * WGM, gsz = (nM - fm) < WGM ? (nM - fm) : WGM;
        u.pm = fm + ((wgid % nig) % gsz); u.pn = (wgid % nig) / gsz; u.e = 0; return true;
    }
};
struct MoeOrder {
    int nunits, G, c, Kb; size_t estride;
    const PG8_LAS int* tile_e; const PG8_LAS int* p0; const PG8_LAS int* cnt; const int* list; bool gather;
    __device__ bool next(int i, Unit& u) const {
        const int L = i * G + c; if (L >= nunits) return false;
        u.pm = L >> 2; u.pn = L & 3; u.e = tile_e[u.pm]; return true;
    }
    __device__ __forceinline__ size_t a_off(const Unit& u) const { return gather ? (size_t)0 : (size_t)u.pm * BM * Kb; }
    __device__ __forceinline__ size_t b_off(const Unit& u) const { return (size_t)u.e * estride + (size_t)u.pn * BM * Kb; }
    PG8_LAS unsigned char* tokt;
    __device__ __forceinline__ const int* tok_src(const Unit& u, int r) const {
        const int pos = (u.pm - p0[u.e]) * 256 + r, last = cnt[u.e] - 1;
        return list + (size_t)u.e * LISTCAP + (pos < last ? pos : last);
    }
};

__device__ __forceinline__ unsigned cvt_pk_bf16(float lo, float hi) { unsigned r; asm volatile("v_cvt_pk_bf16_f32 %0, %1, %2" : "=v"(r) : "v"(lo), "v"(hi)); return r; }
__device__ __forceinline__ float gelu_fast(float x) {
    const float u = -2.3022082f * (x + 0.044715f * x * x * x);
    return x * __builtin_amdgcn_rcpf(1.0f + __builtin_amdgcn_exp2f(u));
}
__device__ __forceinline__ float silu_fast(float x) { return x * __builtin_amdgcn_rcpf(1.0f + __builtin_amdgcn_exp2f(-1.4426950408889634f * x)); }

struct EpiZ { static constexpr bool PERM = true; bf16_t* Z;
    __device__ __forceinline__ void operator()(const f32x4 (&acc)[2][2][4][2], const Unit& u, int wr, int wc, int fr, int fq) const {
        const int row0 = u.pm * BM + wr * 64 + fr, col0 = u.pn * BM + wc * 32 + 8 * fq; const bool act = u.pn >= 2;
#pragma unroll
        for (int ai = 0; ai < 2; ++ai)
#pragma unroll
            for (int m = 0; m < 4; ++m) { bf16_t* rowp = Z + (size_t)(row0 + ai * HALF + m * 16) * 2048 + col0;
#pragma unroll
                for (int bj = 0; bj < 2; ++bj) { f32x4 v0 = acc[ai][bj][m][0], v1 = acc[ai][bj][m][1];
                    if (act) {
#pragma unroll
                        for (int q = 0; q < 4; ++q) { v0[q] = gelu_fast(v0[q]); v1[q] = gelu_fast(v1[q]); } }
                    u32x4 w; w.x = cvt_pk_bf16(v0[0], v0[1]); w.y = cvt_pk_bf16(v0[2], v0[3]); w.z = cvt_pk_bf16(v1[0], v1[1]); w.w = cvt_pk_bf16(v1[2], v1[3]);
                    *(u32x4*)(rowp + bj * HALF) = w; } }
    }
};
struct EpiX1 { static constexpr bool PERM = true; const float* x; const float* mod; bf16_t* X1;
    __device__ __forceinline__ void operator()(const f32x4 (&acc)[2][2][4][2], const Unit& u, int wr, int wc, int fr, int fq) const {
        const int row0 = u.pm * BM + wr * 64 + fr, col0 = u.pn * BM + wc * 32 + 8 * fq; const int b = (u.pm * BM) / SEQ;
        const float* g1 = mod + b * 6144 + 2048 + col0;
        f32x4 gv[2][2];
#pragma unroll
        for (int bj = 0; bj < 2; ++bj) { gv[bj][0] = *(const f32x4*)(g1 + bj * HALF); gv[bj][1] = *(const f32x4*)(g1 + bj * HALF + 4); }
#pragma unroll
        for (int ai = 0; ai < 2; ++ai)
#pragma unroll
            for (int m = 0; m < 4; ++m) { const size_t off = (size_t)(row0 + ai * HALF + m * 16) * D + col0;
#pragma unroll
                for (int bj = 0; bj < 2; ++bj) { const f32x4 x0 = *(const f32x4*)(x + off + bj * HALF), x1 = *(const f32x4*)(x + off + bj * HALF + 4);
                    const f32x4 v0 = x0 + gv[bj][0] * acc[ai][bj][m][0], v1 = x1 + gv[bj][1] * acc[ai][bj][m][1];
                    u32x4 w; w.x = cvt_pk_bf16(v0[0], v0[1]); w.y = cvt_pk_bf16(v0[2], v0[3]); w.z = cvt_pk_bf16(v1[0], v1[1]); w.w = cvt_pk_bf16(v1[2], v1[3]);
                    *(u32x4*)(X1 + off + bj * HALF) = w; } }
    }
};
struct EpiAct { static constexpr bool PERM = true; bf16_t* ACT;
    __device__ __forceinline__ void operator()(const f32x4 (&acc)[2][2][4][2], const Unit& u, int wr, int wc, int fr, int fq) const {
        const int row0 = u.pm * BM + wr * 64 + fr, col0 = u.pn * HALF + wc * 32 + 8 * fq;
#pragma unroll
        for (int ai = 0; ai < 2; ++ai)
#pragma unroll
            for (int m = 0; m < 4; ++m) { f32x4 v0, v1;
#pragma unroll
                for (int q = 0; q < 4; ++q) { v0[q] = silu_fast(acc[ai][0][m][0][q]) * acc[ai][1][m][0][q]; v1[q] = silu_fast(acc[ai][0][m][1][q]) * acc[ai][1][m][1][q]; }
                u32x4 w; w.x = cvt_pk_bf16(v0[0], v0[1]); w.y = cvt_pk_bf16(v0[2], v0[3]); w.z = cvt_pk_bf16(v1[0], v1[1]); w.w = cvt_pk_bf16(v1[2], v1[3]);
                *(u32x4*)(ACT + (size_t)(row0 + ai * HALF + m * 16) * DE + col0) = w; }
    }
};
__device__ __forceinline__ unsigned pk4_fp8(float a, float b, float c, float d) {
    a = __builtin_fminf(__builtin_fmaxf(a, -448.f), 448.f); b = __builtin_fminf(__builtin_fmaxf(b, -448.f), 448.f);
    c = __builtin_fminf(__builtin_fmaxf(c, -448.f), 448.f); d = __builtin_fminf(__builtin_fmaxf(d, -448.f), 448.f);
    unsigned w = 0u; w = __builtin_amdgcn_cvt_pk_fp8_f32(a, b, w, false); w = __builtin_amdgcn_cvt_pk_fp8_f32(c, d, w, true); return w; }
struct EpiAct8 { static constexpr bool PERM = true; unsigned char* ACT; float inv, oscale;
    __device__ __forceinline__ void operator()(const f32x4 (&acc)[2][2][4][2], const Unit& u, int wr, int wc, int fr, int fq) const {
        const int row0 = u.pm * BM + wr * 64 + fr, col0 = u.pn * HALF + wc * 32 + 8 * fq; const float io = inv * oscale;
#pragma unroll
        for (int ai = 0; ai < 2; ++ai)
#pragma unroll
            for (int m = 0; m < 4; ++m) { f32x4 v0, v1;
#pragma unroll
                for (int q = 0; q < 4; ++q) { v0[q] = silu_fast(acc[ai][0][m][0][q] * inv) * (acc[ai][1][m][0][q] * io); v1[q] = silu_fast(acc[ai][0][m][1][q] * inv) * (acc[ai][1][m][1][q] * io); }
                u32x2 w; w.x = pk4_fp8(v0[0], v0[1], v0[2], v0[3]); w.y = pk4_fp8(v1[0], v1[1], v1[2], v1[3]);
                *(u32x2*)(ACT + (size_t)(row0 + ai * HALF + m * 16) * DE + col0) = w; }
    }
};
struct EpiY8 { static constexpr bool PERM = true; unsigned char* Y; float sc;
    __device__ __forceinline__ void operator()(const f32x4 (&acc)[2][2][4][2], const Unit& u, int wr, int wc, int fr, int fq) const {
        const int row0 = u.pm * BM + wr * 64 + fr, col0 = u.pn * BM + wc * 32 + 8 * fq;
#pragma unroll
        for (int ai = 0; ai < 2; ++ai)
#pragma unroll
            for (int m = 0; m < 4; ++m) { unsigned char* rowp = Y + (size_t)(row0 + ai * HALF + m * 16) * D + col0;
#pragma unroll
                for (int bj = 0; bj < 2; ++bj) { const f32x4 v0 = acc[ai][bj][m][0] * sc, v1 = acc[ai][bj][m][1] * sc;
                    u32x2 w; w.x = pk4_fp8(v0[0], v0[1], v0[2], v0[3]); w.y = pk4_fp8(v1[0], v1[1], v1[2], v1[3]);
                    *(u32x2*)(rowp + bj * HALF) = w; } }
    }
};
struct EpiY { static constexpr bool PERM = true; bf16_t* Y;
    __device__ __forceinline__ void operator()(const f32x4 (&acc)[2][2][4][2], const Unit& u, int wr, int wc, int fr, int fq) const {
        const int row0 = u.pm * BM + wr * 64 + fr, col0 = u.pn * BM + wc * 32 + 8 * fq;
#pragma unroll
        for (int ai = 0; ai < 2; ++ai)
#pragma unroll
            for (int m = 0; m < 4; ++m) { bf16_t* rowp = Y + (size_t)(row0 + ai * HALF + m * 16) * D + col0;
#pragma unroll
                for (int bj = 0; bj < 2; ++bj) { const f32x4 v0 = acc[ai][bj][m][0], v1 = acc[ai][bj][m][1];
                    u32x4 w; w.x = cvt_pk_bf16(v0[0], v0[1]); w.y = cvt_pk_bf16(v0[2], v0[3]); w.z = cvt_pk_bf16(v1[0], v1[1]); w.w = cvt_pk_bf16(v1[2], v1[3]);
                    *(u32x4*)(rowp + bj * HALF) = w; } }
    }
};

template <class Epi, class Sched, bool ALIGN_EPI, bool GATHER, bool FP8>
__device__ __forceinline__ void gemm_phase(PG8_LAS unsigned char* lds, const Gemm g, const Sched& S, const Epi& E) {
    const int tid = threadIdx.x, wid = __builtin_amdgcn_readfirstlane(tid >> 6), lane = tid & 63, wr = wid >> 2, wc = wid & 3, fr = lane & 15, fq = lane >> 4;
    const int Kb = g.Kb, nt = Kb / (BK * 2);
    unsigned voffA[2], voffB[2]; int Ra[2];
#pragma unroll
    for (int i = 0; i < 2; ++i) { int R, Cb; if (FP8) stage_rc8(tid * 16 + i * 8192, R, Cb); else { stage_rc(tid * 16 + i * 8192, R, Cb); Cb *= 2; }
        const int Rb = Epi::PERM ? ((R & ~31) + perm32(R & 31)) : R;
        Ra[i] = R; voffA[i] = GATHER ? (unsigned)Cb : (unsigned)(R * Kb + Cb); voffB[i] = (unsigned)(Rb * Kb + Cb); }
    const size_t kstep = (size_t)(BK * 2);
    const size_t hstep = (size_t)HALF * Kb;
    const size_t hstepA = GATHER ? (size_t)0 : hstep;
    const unsigned ldsw = (unsigned)wid * 1024u;
    const int aoff = FP8 ? lds_byte8(wr * 64 + fr, 2 * fq) : lds_byte(wr * 64 + fr, fq * 8), boff = FP8 ? lds_byte8(wc * 32 + fr, 2 * fq) : lds_byte(wc * 32 + fr, fq * 8);
    const int aoff1 = FP8 ? lds_byte8(wr * 64 + fr, 2 * fq + 1) : 0, boff1 = FP8 ? lds_byte8(wc * 32 + fr, 2 * fq + 1) : 0;
#define PG8_SA(b, h) (((b) * 2 + (h)) * HTB)
#define PG8_SB(b, h) ((4 + (b) * 2 + (h)) * HTB)
#define PG8_STAGE(bufoff, gbase, voff) do { _Pragma("unroll") for (int _i = 0; _i < 2; ++_i) \
        __builtin_amdgcn_global_load_lds((const unsigned*)((const char*)(gbase) + (voff)[_i]), (PG8_LAS unsigned*)(lds + (bufoff) + ldsw + _i * 8192), 16, 0, 0); } while (0)
#define PG8_STAGE_A(bufoff, kbase, h) do { _Pragma("unroll") for (int _i = 0; _i < 2; ++_i) \
        __builtin_amdgcn_global_load_lds((const unsigned*)((const char*)(kbase) + (size_t)(h) * hstepA + (GATHER ? gC[h][_i] : 0u) + voffA[_i]), (PG8_LAS unsigned*)(lds + (bufoff) + ldsw + _i * 8192), 16, 0, 0); } while (0)
#define PG8_LD16(off) (*(const PG8_LAS v4i32*)(lds + (off)))
#define PG8_LDA(dst, b, h) do { _Pragma("unroll") for (int m = 0; m < 4; ++m) { if constexpr (FP8) dst##8[m] = __builtin_shufflevector(PG8_LD16(PG8_SA(b, h) + aoff + m * 2048), PG8_LD16(PG8_SA(b, h) + aoff1 + m * 2048), 0, 1, 2, 3, 4, 5, 6, 7); \
        else { _Pragma("unroll") for (int k = 0; k < 2; ++k) dst[m][k] = *(const PG8_LAS bf16x8*)(lds + PG8_SA(b, h) + aoff + m * 2048 + k * 1024); } } } while (0)
#define PG8_LDB(dst, b, h) do { _Pragma("unroll") for (int n = 0; n < 2; ++n) { if constexpr (FP8) dst##8[n] = __builtin_shufflevector(PG8_LD16(PG8_SB(b, h) + boff + n * 2048), PG8_LD16(PG8_SB(b, h) + boff1 + n * 2048), 0, 1, 2, 3, 4, 5, 6, 7); \
        else { _Pragma("unroll") for (int k = 0; k < 2; ++k) dst[n][k] = *(const PG8_LAS bf16x8*)(lds + PG8_SB(b, h) + boff + n * 2048 + k * 1024); } } } while (0)
#define PG8_MMA(ai, bj, At, Bt, ZF) do { __builtin_amdgcn_s_setprio(1); _Pragma("unroll") for (int m = 0; m < 4; ++m) _Pragma("unroll") for (int n = 0; n < 2; ++n) { \
        if constexpr (FP8) { if constexpr (ZF) asm volatile("v_mfma_f32_16x16x128_f8f6f4 %0, %1, %2, 0" : "=v"(acc[ai][bj][m][n]) : "v"(Bt##8[n]), "v"(At##8[m])); \
                             else asm volatile("v_mfma_f32_16x16x128_f8f6f4 %0, %1, %2, %0" : "+v"(acc[ai][bj][m][n]) : "v"(Bt##8[n]), "v"(At##8[m])); } \
        else { acc[ai][bj][m][n] = __builtin_amdgcn_mfma_f32_16x16x32_bf16(Bt[n][0], At[m][0], ZF ? (f32x4){0.f, 0.f, 0.f, 0.f} : acc[ai][bj][m][n], 0, 0, 0); \
               acc[ai][bj][m][n] = __builtin_amdgcn_mfma_f32_16x16x32_bf16(Bt[n][1], At[m][1], acc[ai][bj][m][n], 0, 0, 0); } } \
        __builtin_amdgcn_s_setprio(0); } while (0)
#define PG8_WAIT_V(n) asm volatile("s_waitcnt vmcnt(" #n ")" ::: "memory")
#define PG8_WAIT_L(n) asm volatile("s_waitcnt lgkmcnt(" #n ")" ::: "memory")
#define PG8_BAR __builtin_amdgcn_s_barrier()
#define PG8_SCHED __builtin_amdgcn_sched_barrier(0)
    Unit cur, nxt; int ui = 0;
    if (!S.next(0, cur)) return;
    f32x4 acc[2][2][4][2];
    bf16x8 At[4][2], B0[2][2], B1[2][2]; v8i32 At8[4], B08[2], B18[2];
#define PG8_TOK_ISSUE(u_, slot_) do { if (wid < 4) __builtin_amdgcn_global_load_lds((const unsigned*)S.tok_src(u_, tid), (PG8_LAS unsigned*)(S.tokt + (slot_) * 1024 + wid * 256), 4, 0, 0); } while (0)
#define PG8_TOK_READ(slot_) do { _Pragma("unroll") for (int h = 0; h < 2; ++h) _Pragma("unroll") for (int i = 0; i < 2; ++i) \
        gC[h][i] = *(const PG8_LAS unsigned*)(S.tokt + (slot_) * 1024 + (h * HALF + Ra[i]) * 4) * (unsigned)Kb; } while (0)
    unsigned gC[2][2];
#pragma unroll
    for (int h = 0; h < 2; ++h)
#pragma unroll
        for (int i = 0; i < 2; ++i) gC[h][i] = 0u;
    if constexpr (GATHER) { PG8_TOK_ISSUE(cur, 0); PG8_WAIT_V(0); PG8_BAR; PG8_TOK_READ(0); }
    const char* cA = (const char*)g.A + S.a_off(cur); const char* cB = (const char*)g.Bt + S.b_off(cur);
    PG8_STAGE(PG8_SB(0, 0), cB, voffB); PG8_STAGE(PG8_SB(0, 1), cB + hstep, voffB); PG8_STAGE_A(PG8_SA(0, 0), cA, 0); PG8_STAGE_A(PG8_SA(0, 1), cA, 1);
    if (wr == 1) PG8_BAR;
    PG8_WAIT_V(2); PG8_BAR;
    PG8_STAGE(PG8_SB(1, 0), cB + kstep, voffB); PG8_STAGE_A(PG8_SA(1, 0), cA + kstep, 0); PG8_STAGE(PG8_SB(1, 1), cB + hstep + kstep, voffB);
    PG8_WAIT_V(6); PG8_BAR;
    for (;;) {
        const bool has_next = S.next(ui + 1, nxt);
        const char* nA = has_next ? (const char*)g.A + S.a_off(nxt) : cA; const char* nB = has_next ? (const char*)g.Bt + S.b_off(nxt) : cB;
        if constexpr (GATHER) { if (has_next) PG8_TOK_ISSUE(nxt, (ui + 1) & 1); }
        if constexpr (FP8) {
        { constexpr bool ZF = true; const int t = 0;
            const bool last = (t == nt - 2);
            const char* a1 = cA + (size_t)(t + 1) * kstep;
            const char* a2 = last ? nA : cA + (size_t)(t + 2) * kstep; const char* b2 = last ? nB : cB + (size_t)(t + 2) * kstep;
            const char* a3 = a2 + kstep; const char* b3 = b2 + kstep;
            PG8_LDB(B0, 0, 0); PG8_LDB(B1, 0, 1); PG8_SCHED; PG8_LDA(At, 0, 0); PG8_STAGE_A(PG8_SA(1, 1), a1, 1);
            PG8_WAIT_V(8); PG8_WAIT_L(0); PG8_BAR; PG8_MMA(0, 0, At, B0, ZF); PG8_MMA(0, 1, At, B1, ZF); PG8_BAR; PG8_SCHED;
            if constexpr (GATHER) { if (last && has_next) PG8_TOK_READ((ui + 1) & 1); }
            PG8_LDA(At, 0, 1); PG8_STAGE(PG8_SB(0, 0), b2, voffB); PG8_STAGE(PG8_SB(0, 1), b2 + hstep, voffB); PG8_STAGE_A(PG8_SA(0, 0), a2, 0);
            PG8_WAIT_V(8); PG8_WAIT_L(0); PG8_BAR; PG8_MMA(1, 0, At, B0, ZF); PG8_MMA(1, 1, At, B1, ZF); PG8_BAR; PG8_SCHED;
            PG8_LDB(B0, 1, 0); PG8_LDB(B1, 1, 1); PG8_SCHED; PG8_LDA(At, 1, 0); PG8_STAGE_A(PG8_SA(0, 1), a2, 1);
            PG8_WAIT_V(8); PG8_WAIT_L(0); PG8_BAR; PG8_MMA(0, 0, At, B0, false); PG8_MMA(0, 1, At, B1, false); PG8_BAR; PG8_SCHED;
            PG8_LDA(At, 1, 1); PG8_STAGE(PG8_SB(1, 0), b3, voffB); PG8_STAGE(PG8_SB(1, 1), b3 + hstep, voffB); PG8_STAGE_A(PG8_SA(1, 0), a3, 0);
            PG8_WAIT_V(8); PG8_WAIT_L(0); PG8_BAR; PG8_MMA(1, 0, At, B0, false); PG8_MMA(1, 1, At, B1, false); PG8_BAR; PG8_SCHED;
                }
#pragma unroll 1
        for (int t = 2; t < nt; t += 2) { constexpr bool ZF = false;
            const bool last = (t == nt - 2);
            const char* a1 = cA + (size_t)(t + 1) * kstep;
            const char* a2 = last ? nA : cA + (size_t)(t + 2) * kstep; const char* b2 = last ? nB : cB + (size_t)(t + 2) * kstep;
            const char* a3 = a2 + kstep; const char* b3 = b2 + kstep;
            PG8_LDB(B0, 0, 0); PG8_LDB(B1, 0, 1); PG8_SCHED; PG8_LDA(At, 0, 0); PG8_STAGE_A(PG8_SA(1, 1), a1, 1);
            PG8_WAIT_V(8); PG8_WAIT_L(0); PG8_BAR; PG8_MMA(0, 0, At, B0, ZF); PG8_MMA(0, 1, At, B1, ZF); PG8_BAR; PG8_SCHED;
            if constexpr (GATHER) { if (last && has_next) PG8_TOK_READ((ui + 1) & 1); }
            PG8_LDA(At, 0, 1); PG8_STAGE(PG8_SB(0, 0), b2, voffB); PG8_STAGE(PG8_SB(0, 1), b2 + hstep, voffB); PG8_STAGE_A(PG8_SA(0, 0), a2, 0);
            PG8_WAIT_V(8); PG8_WAIT_L(0); PG8_BAR; PG8_MMA(1, 0, At, B0, ZF); PG8_MMA(1, 1, At, B1, ZF); PG8_BAR; PG8_SCHED;
            PG8_LDB(B0, 1, 0); PG8_LDB(B1, 1, 1); PG8_SCHED; PG8_LDA(At, 1, 0); PG8_STAGE_A(PG8_SA(0, 1), a2, 1);
            PG8_WAIT_V(8); PG8_WAIT_L(0); PG8_BAR; PG8_MMA(0, 0, At, B0, false); PG8_MMA(0, 1, At, B1, false); PG8_BAR; PG8_SCHED;
            PG8_LDA(At, 1, 1); PG8_STAGE(PG8_SB(1, 0), b3, voffB); PG8_STAGE(PG8_SB(1, 1), b3 + hstep, voffB); PG8_STAGE_A(PG8_SA(1, 0), a3, 0);
            PG8_WAIT_V(8); PG8_WAIT_L(0); PG8_BAR; PG8_MMA(1, 0, At, B0, false); PG8_MMA(1, 1, At, B1, false); PG8_BAR; PG8_SCHED;
                }
        } else {
#pragma unroll
        for (int a = 0; a < 2; ++a)
#pragma unroll
            for (int b = 0; b < 2; ++b)
#pragma unroll
                for (int m = 0; m < 4; ++m)
#pragma unroll
                    for (int n = 0; n < 2; ++n) acc[a][b][m][n] = (f32x4){0.f, 0.f, 0.f, 0.f};
#pragma unroll 1
        for (int t = 0; t < nt; t += 2) { constexpr bool ZF = false;
            const bool last = (t == nt - 2);
            const char* a1 = cA + (size_t)(t + 1) * kstep;
            const char* a2 = last ? nA : cA + (size_t)(t + 2) * kstep; const char* b2 = last ? nB : cB + (size_t)(t + 2) * kstep;
            const char* a3 = a2 + kstep; const char* b3 = b2 + kstep;
            PG8_LDB(B0, 0, 0); PG8_LDB(B1, 0, 1); PG8_SCHED; PG8_LDA(At, 0, 0); PG8_STAGE_A(PG8_SA(1, 1), a1, 1);
            PG8_WAIT_V(8); PG8_WAIT_L(0); PG8_BAR; PG8_MMA(0, 0, At, B0, ZF); PG8_MMA(0, 1, At, B1, ZF); PG8_BAR; PG8_SCHED;
            if constexpr (GATHER) { if (last && has_next) PG8_TOK_READ((ui + 1) & 1); }
            PG8_LDA(At, 0, 1); PG8_STAGE(PG8_SB(0, 0), b2, voffB); PG8_STAGE(PG8_SB(0, 1), b2 + hstep, voffB); PG8_STAGE_A(PG8_SA(0, 0), a2, 0);
            PG8_WAIT_V(8); PG8_WAIT_L(0); PG8_BAR; PG8_MMA(1, 0, At, B0, ZF); PG8_MMA(1, 1, At, B1, ZF); PG8_BAR; PG8_SCHED;
            PG8_LDB(B0, 1, 0); PG8_LDB(B1, 1, 1); PG8_SCHED; PG8_LDA(At, 1, 0); PG8_STAGE_A(PG8_SA(0, 1), a2, 1);
            PG8_WAIT_V(8); PG8_WAIT_L(0); PG8_BAR; PG8_MMA(0, 0, At, B0, false); PG8_MMA(0, 1, At, B1, false); PG8_BAR; PG8_SCHED;
            PG8_LDA(At, 1, 1); PG8_STAGE(PG8_SB(1, 0), b3, voffB); PG8_STAGE(PG8_SB(1, 1), b3 + hstep, voffB); PG8_STAGE_A(PG8_SA(1, 0), a3, 0);
            PG8_WAIT_V(8); PG8_WAIT_L(0); PG8_BAR; PG8_MMA(1, 0, At, B0, false); PG8_MMA(1, 1, At, B1, false); PG8_BAR; PG8_SCHED;
                }
        }
        if constexpr (ALIGN_EPI) { if (wr == 0) PG8_BAR; }
        if constexpr (FP8) asm volatile("s_nop 15\n\ts_nop 15" ::: "memory");
        E(acc, cur, wr, wc, fr, fq);
        if (!has_next) break;
        cur = nxt; cA = nA; cB = nB; ++ui;
        if constexpr (ALIGN_EPI) { if (wr == 1) PG8_BAR; }
    }
    PG8_WAIT_V(0);
    if constexpr (!ALIGN_EPI) { if (wr == 0) PG8_BAR; }
    PG8_BAR;
#undef PG8_SA
#undef PG8_SB
#undef PG8_STAGE
#undef PG8_STAGE_A
#undef PG8_TOK_ISSUE
#undef PG8_TOK_READ
#undef PG8_LDA
#undef PG8_LDB
#undef PG8_MMA
#undef PG8_LD16
#undef PG8_WAIT_V
#undef PG8_WAIT_L
#undef PG8_BAR
#undef PG8_SCHED
}
}
#define LAS __attribute__((address_space(3)))
#define GAS __attribute__((address_space(1)))
constexpr int NWAVES = 8, NTHREADS = 512;
constexpr int LDS_BYTES = 163840;
constexpr int SCR_BYTES = 147456;
constexpr int LDSCTL_OFF = SCR_BYTES;
constexpr int TAB_OFF = LDSCTL_OFF + 512;
constexpr int TAB_CNT = 0, TAB_P0 = 32, TAB_TE = 72;
constexpr int TOKT_OFF = TAB_OFF + 2048;
#define LDS_WAIT() asm volatile("s_waitcnt lgkmcnt(0)" ::: "memory")
#define WAVE_SYNC() do { asm volatile("s_waitcnt lgkmcnt(0)" ::: "memory"); __builtin_amdgcn_wave_barrier(); } while (0)

#ifndef MOE_FP8
#define MOE_FP8 1
#endif
constexpr float W13_SCALE = 32.f, W2_SCALE = 16.f, ACT_SCALE = 4.f, Y_SCALE = 16.f;
struct Args {
    const float* in[27]; float* out; unsigned char* ws; int ph_lo, ph_hi;
};
struct Frame {
    LAS unsigned char* lds; LAS int* tab; unsigned* ctl; unsigned char* ws;
    int tid, lane, wave, G, bid, vcu;
};
enum Phase { PH_A = 0, PH_B, PH_C, PH_D, PH_E, PH_F, PH_G, PH_H, PH_I, PH_J, PH_N };

#define XB_TMO      128
#define XB_XCNT(j)  (256  + 64 * (j))
#define XB_XSUB(j)  (1280 + 64 * (j))
#define XB_XGEN(j)  (2304 + 64 * (j))
#define XB_TOP      3328
#define XB_TOPGEN   3392
#define XCD_BAR_WORDS 3456
#define XB_SPIN_CAP (1u << 18)
__device__ __forceinline__ unsigned xb_ld(unsigned* p)              { return __hip_atomic_load(p, __ATOMIC_RELAXED, __HIP_MEMORY_SCOPE_AGENT); }
__device__ __forceinline__ unsigned xb_add(unsigned* p, unsigned v) { return __hip_atomic_fetch_add(p, v, __ATOMIC_RELAXED, __HIP_MEMORY_SCOPE_AGENT); }
__device__ __forceinline__ unsigned xb_xcc_id() { return (unsigned)__builtin_amdgcn_s_getreg((3 << 11) | 20) & 0xFu; }
#define XB_SPIN(cond, bar) do { unsigned _sp = 0; while (cond) { __builtin_amdgcn_s_sleep(1); \
    if ((++_sp & 255u) == 0u) { if (xb_ld(&(bar)[XB_TMO])) break; if (_sp > XB_SPIN_CAP) { atomicAdd(&(bar)[XB_TMO], 1u); break; } } } } while (0)
struct XcdBarrier { unsigned* bar; unsigned x; volatile LAS unsigned* st; };
__device__ __forceinline__ XcdBarrier xcd_barrier_post(unsigned* bar, volatile LAS unsigned* st) {
    XcdBarrier b; b.bar = bar; b.x = xb_xcc_id(); b.st = st;
    if (threadIdx.x == 0) (void)xb_add(&bar[XB_XCNT(b.x)], 1u);
    return b;
}
__device__ __forceinline__ void xcd_barrier_complete(unsigned* bar, unsigned x, unsigned& nloc, unsigned& nx) {
    const unsigned G = gridDim.x * gridDim.y * gridDim.z;
    unsigned sum, cnt, mine, sp = 0u;
    for (;;) {
        sum = 0u; cnt = 0u; mine = 0u;
#pragma unroll
        for (unsigned j = 0; j < 16; ++j) { const unsigned c = xb_ld(&bar[XB_XCNT(j)]); sum += c; cnt += (c > 0u) ? 1u : 0u; mine = (j == x) ? c : mine; }
        if (sum == G) break;
        __builtin_amdgcn_s_sleep(1);
        if ((++sp & 255u) == 0u) { if (xb_ld(&bar[XB_TMO])) break; if (sp > XB_SPIN_CAP) { atomicAdd(&bar[XB_TMO], 1u); break; } }
    }
    nloc = mine > 0u ? mine : 1u; nx = cnt > 0u ? cnt : 1u;
}
__device__ __forceinline__ void xcd_barrier(const XcdBarrier& b) {
    asm volatile("s_waitcnt vmcnt(0)" ::: "memory");
    __syncthreads();
    if (threadIdx.x == 0) {
        unsigned* bar = b.bar;
        __builtin_amdgcn_s_waitcnt(0);
        unsigned nloc = b.st[0], nx = b.st[1];
        if (nloc == 0u) { xcd_barrier_complete(bar, b.x, nloc, nx); b.st[0] = nloc; b.st[1] = nx; }
        const unsigned old = xb_add(&bar[XB_XSUB(b.x)], 1u);
        const unsigned gen = old / nloc;
        if (old + 1u == (gen + 1u) * nloc) {
            __builtin_amdgcn_fence(__ATOMIC_RELEASE, "agent");
            asm volatile("s_waitcnt vmcnt(0)" ::: "memory");
            const unsigned og = xb_add(&bar[XB_TOP], 1u);
            const unsigned tg = og / nx;
            if (og + 1u == (tg + 1u) * nx) xb_add(&bar[XB_TOPGEN], 1u);
            else XB_SPIN(xb_ld(&bar[XB_TOPGEN]) == tg, bar);
            __builtin_amdgcn_fence(__ATOMIC_ACQUIRE, "agent");
            xb_add(&bar[XB_XGEN(b.x)], 1u);
            asm volatile("s_waitcnt vmcnt(0)" ::: "memory");
        } else {
            XB_SPIN(xb_ld(&bar[XB_XGEN(b.x)]) == gen, bar);
            __builtin_amdgcn_fence(__ATOMIC_ACQUIRE, "agent");
            asm volatile("s_waitcnt vmcnt(0)" ::: "memory");
        }
    }
    __syncthreads();
}

__device__ __forceinline__ void build_moe_table(Frame& F) {
    __syncthreads();
    if (F.tid < 64) {
        const int c = F.tid < NE ? (int)__hip_atomic_load(F.ctl + CW_CNT + CNT_STRIDE * F.tid, __ATOMIC_RELAXED, __HIP_MEMORY_SCOPE_AGENT) : 0;
        const int nt = (c + 255) >> 8; int p = nt;
#pragma unroll
        for (int o = 1; o < 32; o <<= 1) { const int v = __shfl_up(p, o); if (F.lane >= o) p += v; }
        const int excl = p - nt;
        if (F.tid < NE) { F.tab[TAB_CNT + F.tid] = c; F.tab[TAB_P0 + F.tid] = excl; for (int j = 0; j < nt; ++j) F.tab[TAB_TE + excl + j] = F.tid; }
        if (F.tid == NE - 1) F.tab[TAB_P0 + NE] = p;
    }
    __syncthreads();
}

struct TItem { const float* W; unsigned char* WT; int N, K, blk, rstride, rbase, k0, n0, fp8; float scale; };
__device__ __forceinline__ void titem_load(const TItem& d, f32x4 (&v)[16], int lane) {
#pragma unroll
    for (int i = 0; i < 16; ++i) v[i] = *(const f32x4*)(d.W + (size_t)(d.k0 + 16 * (lane >> 5) + i) * d.N + d.n0 + 4 * (lane & 31));
}
__device__ __forceinline__ unsigned pk4_fp8_nc(float a, float b, float c, float d) {
    unsigned w = 0u; w = __builtin_amdgcn_cvt_pk_fp8_f32(a, b, w, false); w = __builtin_amdgcn_cvt_pk_fp8_f32(c, d, w, true); return w; }
__device__ __forceinline__ void titem_store(const TItem& d, const f32x4 (&v)[16], int lane) {
#pragma unroll
    for (int q = 0; q < 4; ++q) {
        const int n = d.n0 + 4 * (lane & 31) + q, row = d.rbase + (n / d.blk) * d.rstride + (n % d.blk);
        if (d.fp8) { const float sc = d.scale; u32x4 o;
            o.x = pk4_fp8_nc(v[0][q] * sc, v[1][q] * sc, v[2][q] * sc, v[3][q] * sc); o.y = pk4_fp8_nc(v[4][q] * sc, v[5][q] * sc, v[6][q] * sc, v[7][q] * sc);
            o.z = pk4_fp8_nc(v[8][q] * sc, v[9][q] * sc, v[10][q] * sc, v[11][q] * sc); o.w = pk4_fp8_nc(v[12][q] * sc, v[13][q] * sc, v[14][q] * sc, v[15][q] * sc);
            *(u32x4*)(d.WT + (size_t)row * d.K + d.k0 + 16 * (lane >> 5)) = o;
        } else { u32x4 o0, o1;
            o0.x = pk2(v[0][q], v[1][q]); o0.y = pk2(v[2][q], v[3][q]); o0.z = pk2(v[4][q], v[5][q]); o0.w = pk2(v[6][q], v[7][q]);
            o1.x = pk2(v[8][q], v[9][q]); o1.y = pk2(v[10][q], v[11][q]); o1.z = pk2(v[12][q], v[13][q]); o1.w = pk2(v[14][q], v[15][q]);
            unsigned char* p = d.WT + ((size_t)row * d.K + d.k0 + 16 * (lane >> 5)) * 2; *(u32x4*)p = o0; *(u32x4*)(p + 16) = o1; }
    }
}
#ifndef CONV_PRE
#define CONV_PRE 1
#endif
constexpr int TI_IN = 512, TI_OUT = 256, TI_EXP = 384 * NE, TI_N = TI_IN + TI_OUT + TI_EXP;
__device__ __forceinline__ void titem_decode(const Args& args, unsigned char* ws, int it, TItem& d) {
    int r = it, item; d.fp8 = 0; d.scale = 1.f; d.rstride = 0; d.rbase = 0;
    if (r < TI_IN) { d.W = args.in[5]; d.WT = ws + OFF_WIN; d.K = 1024; d.N = 2048; d.blk = 2048; item = r; }
    else if ((r -= TI_IN) < TI_OUT) { d.W = args.in[17]; d.WT = ws + OFF_WOUT; d.K = 1024; d.N = 1024; d.blk = 1024; item = r; }
    else { r -= TI_OUT; const int e = r / 384, q = r % 384;
        if (q < 256) { d.W = (q < 128 ? args.in[23] : args.in[24]) + (size_t)e * 1024 * 512; d.K = 1024; d.N = 512; d.blk = 128; d.rstride = 256; d.rbase = q < 128 ? 0 : 128; item = q & 127;
            d.WT = ws + OFF_W13 + (size_t)e * 1024 * 1024 * (MOE_FP8 ? 1 : 2); d.scale = W13_SCALE; }
        else { d.W = args.in[25] + (size_t)e * 512 * 1024; d.K = 512; d.N = 1024; d.blk = 1024; item = q - 256; d.WT = ws + OFF_W2 + (size_t)e * 1024 * 512 * (MOE_FP8 ? 1 : 2); d.scale = W2_SCALE; }
        d.fp8 = MOE_FP8; if (!MOE_FP8) d.scale = 1.f; }
    const int nkb = d.K / 32; d.k0 = 32 * (item % nkb); d.n0 = 128 * (item / nkb);
}
__device__ __forceinline__ void phase_A(Frame& F, const Args& args) {
    unsigned char* ws = F.ws;
    const float* c = args.in[1]; const float* ada_w = args.in[2]; const float* ada_b = args.in[3];
    float* mod = (float*)(ws + OFF_MOD);
    for (int it = F.G - 1 - F.bid; it < 192; it += F.G) {
        LAS float* sc = (LAS float*)F.lds; LAS float* red = sc + 8192;
        for (int i = F.tid; i < 8192; i += NTHREADS) { const float v = c[i]; sc[(i & 1023) * 8 + (i >> 10)] = v / (1.0f + __expf(-v)); }
        __syncthreads();
        const int col = F.lane & 31, ks = F.lane >> 5, n = it * 32 + col, k0 = F.wave * 128 + ks;
        float acc[8];
#pragma unroll
        for (int b = 0; b < 8; ++b) acc[b] = 0.f;
#pragma unroll 1
        for (int i0 = 0; i0 < 64; i0 += 16) {
            float wv[16];
#pragma unroll
            for (int i = 0; i < 16; ++i) wv[i] = ada_w[(size_t)(k0 + 2 * (i0 + i)) * 6144 + n];
#pragma unroll
            for (int i = 0; i < 16; ++i) { const int k = k0 + 2 * (i0 + i);
                const f32x4 s0 = *(const LAS f32x4*)(sc + k * 8), s1 = *(const LAS f32x4*)(sc + k * 8 + 4);
#pragma unroll
                for (int b = 0; b < 4; ++b) { acc[b] += s0[b] * wv[i]; acc[4 + b] += s1[b] * wv[i]; } }
        }
#pragma unroll
        for (int b = 0; b < 8; ++b) { acc[b] += __shfl_xor(acc[b], 32); if (ks == 0) red[(F.wave * 8 + b) * 32 + col] = acc[b]; }
        __syncthreads();
        if (F.tid < 256) { const int b = F.tid >> 5, cc = F.tid & 31; float s = ada_b[it * 32 + cc];
#pragma unroll
            for (int w = 0; w < 8; ++w) s += red[(w * 8 + b) * 32 + cc];
            mod[b * 6144 + it * 32 + cc] = s; }
        __syncthreads();
    }
    {
        const int gw = F.vcu * NWAVES + F.wave, NGW = F.G * NWAVES;
        const int it_end = (F.G == 256) ? TI_IN + TI_OUT : TI_N;
        int it = gw;
        if (it < it_end) {
            TItem d, d2; f32x4 v[16], v2[16];
            titem_decode(args, ws, it, d); titem_load(d, v, F.lane);
            for (;;) {
                const int itn = it + NGW; const bool more = itn < it_end;
                if (more) { titem_decode(args, ws, itn, d2); titem_load(d2, v2, F.lane); }
                titem_store(d, v, F.lane);
                if (!more) break;
                d = d2; it = itn;
#pragma unroll
                for (int i = 0; i < 16; ++i) v[i] = v2[i];
            }
        }
    }
    {
        const int gt = F.bid * NTHREADS + F.tid, NGT = F.G * NTHREADS;
        const float* sgu_w = args.in[15]; const float* rgw = args.in[19]; const float* rew = args.in[21]; const float* lam = args.in[12];
        bf16_t* SGUW = (bf16_t*)(ws + OFF_SGUW); bf16_t* ROUTW = (bf16_t*)(ws + OFF_ROUTW); float* N8SP = (float*)(ws + OFF_N8SP);
        for (int i = gt; i < 8 * 128 * 128; i += NGT) { const int ii = (i >> 7) & 127, j = i & 127; SGUW[i] = (bf16_t)(((j >> 6) <= (ii >> 6)) ? f2bf(sgu_w[i]) : 0u); }
        for (int i = gt; i < 48 * 1024; i += NGT) { const int n = i >> 10, k = i & 1023; const float v = n < 4 ? rgw[k * 4 + n] : (n < 36 ? rew[k * 32 + n - 4] : 0.f); ROUTW[i] = (bf16_t)f2bf(v); }
        for (int i = gt; i < 512; i += NGT) N8SP[i] = -8.0f * 1.4426950408889634f * log1pf(expf(-lam[i]));
        { float* GB = (float*)(ws + OFF_GBIAS); const float* gab_ = args.in[9]; const float* gib_ = args.in[11];
          for (int i = gt; i < 1024; i += NGT) GB[i] = -1.4426950408889634f * (i < 512 ? gab_[i] : gib_[i - 512]); }
        { const float* gaw = args.in[8]; const float* giw = args.in[10]; bf16_t* GATEW = (bf16_t*)(ws + OFF_GATEW);
          for (int i = gt; i < 8 * 128 * 64; i += NGT) { const int h = i >> 13, ee = (i >> 6) & 127, dd = i & 63; const float v = -1.4426950408889634f * (ee < 64 ? gaw : giw)[h * 4096 + dd * 64 + (ee & 63)]; GATEW[i] = (bf16_t)f2bf(v); } }
    }
}

__device__ __forceinline__ void convert_experts(Frame& F, const Args& args, int gw, int NGW, int first, int count) {
    unsigned char* ws = F.ws;
    int it = first + gw; const int it_end = first + count;
    if (it < it_end) {
        TItem d, d2; f32x4 v[16], v2[16];
        titem_decode(args, ws, TI_IN + TI_OUT + it, d); titem_load(d, v, F.lane);
        for (;;) {
            const int itn = it + NGW; const bool more = itn < it_end;
            if (more) { titem_decode(args, ws, TI_IN + TI_OUT + itn, d2); titem_load(d2, v2, F.lane); }
            titem_store(d, v, F.lane);
            if (!more) break;
            d = d2; it = itn;
#pragma unroll
            for (int i = 0; i < 16; ++i) v[i] = v2[i];
        }
    }
}

__device__ __forceinline__ void phase_B(Frame& F, const Args& args) {
    const float* x = args.in[0]; const float* g = args.in[4]; const float* mod = (const float*)(F.ws + OFF_MOD); bf16_t* XN = (bf16_t*)(F.ws + OFF_XN);
    const int gw = F.bid * NWAVES + F.wave, NGW = F.G * NWAVES, lane = F.lane;
    constexpr int RPW = 16;
    for (int item = gw; item < T / RPW; item += NGW) {
        const int row0 = item * RPW, b = row0 / SEQ;
        const float* sh = mod + b * 6144; const float* sc = sh + 1024;
        f32x4 gm[4], sv[4];
#pragma unroll
        for (int j = 0; j < 4; ++j) { const int col = 4 * (lane + 64 * j); const f32x4 gg = *(const f32x4*)(g + col), s1 = *(const f32x4*)(sc + col); sv[j] = *(const f32x4*)(sh + col); gm[j] = gg * (1.0f + s1); }
        f32x4 v[4], nv[4];
#pragma unroll
        for (int j = 0; j < 4; ++j) v[j] = ((const f32x4*)(x + (size_t)row0 * D))[lane + 64 * j];
#pragma unroll 1
        for (int r = 0; r < RPW; ++r) {
            const int row = row0 + r, nrow = (r + 1 < RPW) ? row + 1 : row;
#pragma unroll
            for (int j = 0; j < 4; ++j) nv[j] = ((const f32x4*)(x + (size_t)nrow * D))[lane + 64 * j];
            float ss = 0.f;
#pragma unroll
            for (int j = 0; j < 4; ++j) ss += v[j][0] * v[j][0] + v[j][1] * v[j][1] + v[j][2] * v[j][2] + v[j][3] * v[j][3];
            const float rs = rsqrtf(wave_sum(ss) * (1.0f / D) + EPS);
#pragma unroll
            for (int j = 0; j < 4; ++j) { const int col = 4 * (lane + 64 * j); const f32x4 h = v[j] * rs * gm[j] + sv[j];
                u32x2 o; o.x = pk2(h[0], h[1]); o.y = pk2(h[2], h[3]);
                *(u32x2*)(XN + (size_t)row * D + col) = o; v[j] = nv[j]; }
        }
    }
}

#ifndef SGU_TR
#define SGU_TR 1
#endif
typedef short s16x4 __attribute__((ext_vector_type(4)));
typedef short v4i16_t __attribute__((ext_vector_type(4)));
constexpr int IMG_STRIDE = 1040;
__device__ __forceinline__ float bflo(unsigned w) { return __uint_as_float(w << 16); }
__device__ __forceinline__ float bfhi(unsigned w) { return __uint_as_float(w & 0xffff0000u); }
__device__ __forceinline__ void sgu_block(Frame& F, const Args& args, int blk) {
    const bf16_t* Z = (const bf16_t*)(F.ws + OFF_Z); bf16_t* YMIX = (bf16_t*)(F.ws + OFF_YMIX); const bf16_t* SGUW = (const bf16_t*)(F.ws + OFF_SGUW);
    const float* ln_g = args.in[13]; const float* ln_b = args.in[14]; const float* sgu_b = args.in[16];
    const int lane = F.lane, w = F.wave; const size_t t0 = (size_t)blk * 128;
    {
        u32x4 raw[16];
#pragma unroll
        for (int r = 0; r < 16; ++r) raw[r] = *(const u32x4*)(Z + (t0 + w * 16 + r) * 2048 + 1536 + 8 * lane);
        const f32x4 g0 = *(const f32x4*)(ln_g + 8 * lane), g1 = *(const f32x4*)(ln_g + 8 * lane + 4), b0 = *(const f32x4*)(ln_b + 8 * lane), b1 = *(const f32x4*)(ln_b + 8 * lane + 4);
#pragma unroll
        for (int r = 0; r < 16; ++r) {
            float v[8];
#pragma unroll
            for (int q = 0; q < 4; ++q) { v[2 * q] = bflo(raw[r][q]); v[2 * q + 1] = bfhi(raw[r][q]); }
            float s = 0.f;
#pragma unroll
            for (int q = 0; q < 8; ++q) s += v[q];
            const float mu = wave_sum(s) * (1.0f / 512.0f);
            float s2 = 0.f;
#pragma unroll
            for (int q = 0; q < 8; ++q) { v[q] -= mu; s2 += v[q] * v[q]; }
            const float rstd = rsqrtf(wave_sum(s2) * (1.0f / 512.0f) + EPS);
            u32x4 o;
            o.x = pk2(v[0] * rstd * g0[0] + b0[0], v[1] * rstd * g0[1] + b0[1]); o.y = pk2(v[2] * rstd * g0[2] + b0[2], v[3] * rstd * g0[3] + b0[3]);
            o.z = pk2(v[4] * rstd * g1[0] + b1[0], v[5] * rstd * g1[1] + b1[1]); o.w = pk2(v[6] * rstd * g1[2] + b1[2], v[7] * rstd * g1[3] + b1[3]);
            *(LAS u32x4*)(F.lds + (w * 16 + r) * IMG_STRIDE + 16 * lane) = o;
        }
    }
    __syncthreads();
    {
        const int g = w;
        int fr = lane & 15, fq = lane >> 4; asm volatile("" : "+v"(fr), "+v"(fq));
        bf16x8 af[4][4];
#pragma unroll
        for (int kt = 0; kt < 4; ++kt)
#pragma unroll
            for (int ct = 0; ct < 4; ++ct) {
#if SGU_TR
                LAS unsigned char* p = F.lds + (32 * kt + 8 * fq + (fr >> 2)) * IMG_STRIDE + (g * 64 + 32 * (ct >> 1) + 8 * (fr & 3) + 4 * (ct & 1)) * 2;
                const s16x4 lo = __builtin_bit_cast(s16x4, __builtin_amdgcn_ds_read_tr16_b64_v4i16((LAS v4i16_t*)p));
                const s16x4 hi = __builtin_bit_cast(s16x4, __builtin_amdgcn_ds_read_tr16_b64_v4i16((LAS v4i16_t*)(p + 4 * IMG_STRIDE)));
                af[kt][ct] = (bf16x8){lo[0], lo[1], lo[2], lo[3], hi[0], hi[1], hi[2], hi[3]};
#else
                const LAS bf16_t* p = (const LAS bf16_t*)(F.lds + (32 * kt + 8 * fq) * IMG_STRIDE) + g * 64 + 16 * (fr >> 2) + 4 * ct + (fr & 3);
#pragma unroll
                for (int e = 0; e < 8; ++e) af[kt][ct][e] = (short)p[e * (IMG_STRIDE / 2)];
#endif
            }
        bf16x8 wf[4], nwf[4]; u32x4 gu0, gu1, ngu0, ngu1; float bias, nbias;
        { const bf16_t* wp = SGUW + ((size_t)(g * 128 + fr)) * 128 + 8 * fq;
#pragma unroll
          for (int kt = 0; kt < 4; ++kt) wf[kt] = *(const bf16x8*)(wp + 32 * kt);
          const size_t t = t0 + fr; gu0 = *(const u32x4*)(Z + t * 2048 + 1024 + g * 64 + 8 * fq); gu1 = *(const u32x4*)(Z + t * 2048 + 1024 + g * 64 + 32 + 8 * fq); bias = sgu_b[g * 128 + fr]; }
#pragma unroll 1
        for (int it = 0; it < 8; ++it) {
            const int i0 = 16 * it, in0 = it < 7 ? i0 + 16 : i0;
            { const bf16_t* wp = SGUW + ((size_t)(g * 128 + in0 + fr)) * 128 + 8 * fq;
#pragma unroll
              for (int kt = 0; kt < 4; ++kt) nwf[kt] = *(const bf16x8*)(wp + 32 * kt);
              const size_t tn = t0 + in0 + fr; ngu0 = *(const u32x4*)(Z + tn * 2048 + 1024 + g * 64 + 8 * fq); ngu1 = *(const u32x4*)(Z + tn * 2048 + 1024 + g * 64 + 32 + 8 * fq); nbias = sgu_b[g * 128 + in0 + fr]; }
            f32x4 acc[4];
#pragma unroll
            for (int ct = 0; ct < 4; ++ct) acc[ct] = (f32x4){0.f, 0.f, 0.f, 0.f};
#pragma unroll
            for (int kt = 0; kt < 4; ++kt)
#pragma unroll
                for (int ct = 0; ct < 4; ++ct) acc[ct] = __builtin_amdgcn_mfma_f32_16x16x32_bf16(af[kt][ct], wf[kt], acc[ct], 0, 0, 0);
            const size_t t = t0 + i0 + fr;
            u32x4 o0, o1;
            o0.x = pk2(bflo(gu0.x) * (acc[0][0] + bias), bfhi(gu0.x) * (acc[0][1] + bias)); o0.y = pk2(bflo(gu0.y) * (acc[0][2] + bias), bfhi(gu0.y) * (acc[0][3] + bias));
            o0.z = pk2(bflo(gu0.z) * (acc[1][0] + bias), bfhi(gu0.z) * (acc[1][1] + bias)); o0.w = pk2(bflo(gu0.w) * (acc[1][2] + bias), bfhi(gu0.w) * (acc[1][3] + bias));
            o1.x = pk2(bflo(gu1.x) * (acc[2][0] + bias), bfhi(gu1.x) * (acc[2][1] + bias)); o1.y = pk2(bflo(gu1.y) * (acc[2][2] + bias), bfhi(gu1.y) * (acc[2][3] + bias));
            o1.z = pk2(bflo(gu1.z) * (acc[3][0] + bias), bfhi(gu1.z) * (acc[3][1] + bias)); o1.w = pk2(bflo(gu1.w) * (acc[3][2] + bias), bfhi(gu1.w) * (acc[3][3] + bias));
            *(u32x4*)(YMIX + t * D + 512 + g * 64 + 8 * fq) = o0; *(u32x4*)(YMIX + t * D + 512 + g * 64 + 32 + 8 * fq) = o1;
#pragma unroll
            for (int kt = 0; kt < 4; ++kt) wf[kt] = nwf[kt];
            gu0 = ngu0; gu1 = ngu1; bias = nbias;
        }
    }
}

constexpr int XC_STRIDE = 144;
constexpr int AU_STRIDE = 68;
constexpr int LRU_WAVE_BYTES = 64 * XC_STRIDE + 2 * 16 * AU_STRIDE * 4;
__device__ __forceinline__ float sigm_fast(float x) { return __builtin_amdgcn_rcpf(1.0f + __builtin_amdgcn_exp2f(-1.4426950408889634f * x)); }
template <int PASS>
__device__ __forceinline__ void lru_block(Frame& F, const Args& args, int blk) {
    const bf16_t* Z = (const bf16_t*)(F.ws + OFF_Z); bf16_t* YMIX = (bf16_t*)(F.ws + OFF_YMIX); const bf16_t* GATEW = (const bf16_t*)(F.ws + OFF_GATEW);
    const float* N8SP = (const float*)(F.ws + OFF_N8SP); float* CA = (float*)(F.ws + OFF_CARRY); float* CH = CA + 256 * 512;
    const float* cw = args.in[6]; const float* cb = args.in[7]; const float* gab = (const float*)(F.ws + OFF_GBIAS); const float* gib = gab + 512;
    const int lane = F.lane, h = F.wave, fr = lane & 15, fq = lane >> 4, cg = lane & 7, run = lane >> 3; const size_t t0 = (size_t)blk * 128;
    LAS unsigned char* xcT = F.lds + h * LRU_WAVE_BYTES; LAS float* Abuf = (LAS float*)(xcT + 64 * XC_STRIDE); LAS float* Ubuf = Abuf + 16 * AU_STRIDE;
    float hst = 0.f, pp = 1.f;
    if (PASS == 2) { const int b0 = blk & ~31, n = blk & 31;
        float ca[31], ch[31];
#pragma unroll
        for (int k = 0; k < 31; ++k) { const int kk = k < n ? k : 0; ca[k] = CA[(size_t)(b0 + kk) * 512 + 64 * h + lane]; ch[k] = CH[(size_t)(b0 + kk) * 512 + 64 * h + lane]; }
#pragma unroll
        for (int k = 0; k < 31; ++k) hst = k < n ? ca[k] * hst + ch[k] : hst; }
    bf16x8 gw[8][2];
#pragma unroll
    for (int et = 0; et < 8; ++et)
#pragma unroll
        for (int kt = 0; kt < 2; ++kt) gw[et][kt] = *(const bf16x8*)(GATEW + ((size_t)(h * 128 + 16 * et + fr)) * 64 + 32 * kt + 8 * fq);
    const bool seq_start = (blk & 31) == 0;
#pragma unroll 1
    for (int hb = 0; hb < 2; ++hb) {
        const size_t tb = t0 + 64 * hb;
        {
            float cwv[4][8], cbv[8];
#pragma unroll
            for (int k = 0; k < 4; ++k) { const f32x4 a = *(const f32x4*)(cw + k * 512 + 64 * h + 8 * cg), b = *(const f32x4*)(cw + k * 512 + 64 * h + 8 * cg + 4);
#pragma unroll
                for (int q = 0; q < 4; ++q) { cwv[k][q] = a[q]; cwv[k][4 + q] = b[q]; } }
            { const f32x4 a = *(const f32x4*)(cb + 64 * h + 8 * cg), b = *(const f32x4*)(cb + 64 * h + 8 * cg + 4);
#pragma unroll
              for (int q = 0; q < 4; ++q) { cbv[q] = a[q]; cbv[4 + q] = b[q]; } }
            u32x4 xr[11];
#pragma unroll
            for (int j = 0; j < 11; ++j) { const int rel = 8 * run - 3 + j;
                const bool pad = (j < 3) && (rel < 0) && (hb == 0) && seq_start;
                const u32x4 v = *(const u32x4*)(Z + (size_t)((long)tb + (pad ? 0 : rel)) * 2048 + 64 * h + 8 * cg);
                xr[j] = pad ? (u32x4){0u, 0u, 0u, 0u} : v; }
#pragma unroll
            for (int s = 0; s < 8; ++s) { float o[8];
#pragma unroll
                for (int q = 0; q < 8; ++q) o[q] = cbv[q];
#pragma unroll
                for (int k = 0; k < 4; ++k) { const u32x4 r = xr[s + k];
#pragma unroll
                    for (int q = 0; q < 4; ++q) { o[2 * q] += cwv[k][2 * q] * bflo(r[q]); o[2 * q + 1] += cwv[k][2 * q + 1] * bfhi(r[q]); } }
                u32x4 pkd; pkd.x = pk2(o[0], o[1]); pkd.y = pk2(o[2], o[3]); pkd.z = pk2(o[4], o[5]); pkd.w = pk2(o[6], o[7]);
                *(LAS u32x4*)(xcT + (8 * run + s) * XC_STRIDE + 16 * cg) = pkd; }
        }
        WAVE_SYNC();
        u32x4 g0 = {0u, 0u, 0u, 0u}, g1 = g0, ng0 = g0, ng1 = g0;
        if (PASS == 2) { const size_t t = tb + (lane >> 2); g0 = *(const u32x4*)(Z + t * 2048 + 512 + 64 * h + 8 * (lane & 3)); g1 = *(const u32x4*)(Z + t * 2048 + 512 + 64 * h + 32 + 8 * (lane & 3)); }
#pragma unroll 1
        for (int it = 0; it < 4; ++it) {
            if (PASS == 2) { const size_t t = tb + 16 * (it < 3 ? it + 1 : it) + (lane >> 2); ng0 = *(const u32x4*)(Z + t * 2048 + 512 + 64 * h + 8 * (lane & 3)); ng1 = *(const u32x4*)(Z + t * 2048 + 512 + 64 * h + 32 + 8 * (lane & 3)); }
            bf16x8 xf[2];
#pragma unroll
            for (int kt = 0; kt < 2; ++kt) xf[kt] = *(const LAS bf16x8*)(xcT + (16 * it + fr) * XC_STRIDE + (32 * kt + 8 * fq) * 2);
            int fqv = fq; asm volatile("" : "+v"(fqv));
            f32x4 acc[8];
#pragma unroll
            for (int et = 0; et < 4; ++et) { acc[et] = *(const f32x4*)(gab + 64 * h + 16 * et + 4 * fqv); acc[4 + et] = *(const f32x4*)(gib + 64 * h + 16 * et + 4 * fqv); }
#pragma unroll
            for (int et = 0; et < 8; ++et)
#pragma unroll
                for (int kt = 0; kt < 2; ++kt) acc[et] = __builtin_amdgcn_mfma_f32_16x16x32_bf16(gw[et][kt], xf[kt], acc[et], 0, 0, 0);
#pragma unroll
            for (int et = 0; et < 4; ++et) {
                const f32x4 sp = *(const f32x4*)(N8SP + 64 * h + 16 * et + 4 * fqv);
                const u32x2 xw = *(const LAS u32x2*)(xcT + (16 * it + fr) * XC_STRIDE + (16 * et + 4 * fq) * 2);
                const float xv[4] = {bflo(xw.x), bfhi(xw.x), bflo(xw.y), bfhi(xw.y)};
                f32x4 av, uv;
#pragma unroll
                for (int r = 0; r < 4; ++r) {
                    const float rg = __builtin_amdgcn_rcpf(1.0f + __builtin_amdgcn_exp2f(acc[et][r])), ig = __builtin_amdgcn_rcpf(1.0f + __builtin_amdgcn_exp2f(acc[4 + et][r]));
                    const float a = __builtin_amdgcn_exp2f(rg * sp[r]);
                    av[r] = a;
                    uv[r] = __builtin_amdgcn_sqrtf(__builtin_fmaf(-a, a, 1.0f)) * (ig * xv[r]);
                }
                *(LAS f32x4*)(Abuf + fr * AU_STRIDE + 16 * et + 4 * fq) = av; *(LAS f32x4*)(Ubuf + fr * AU_STRIDE + 16 * et + 4 * fq) = uv;
            }
            WAVE_SYNC();
            {
                float a[16], u[16];
#pragma unroll
                for (int tk = 0; tk < 16; ++tk) { a[tk] = Abuf[tk * AU_STRIDE + lane]; u[tk] = Ubuf[tk * AU_STRIDE + lane]; }
#pragma unroll
                for (int tk = 0; tk < 16; ++tk) { hst = a[tk] * hst + u[tk]; if (PASS == 1) pp *= a[tk]; else Ubuf[tk * AU_STRIDE + lane] = hst; }
            }
            if (PASS == 2) {
                WAVE_SYNC();
                const int tok = lane >> 2, cq = lane & 3; const size_t t = tb + 16 * it + tok;
                const LAS float* hp = Ubuf + tok * AU_STRIDE + 8 * cq;
                const f32x4 h0 = *(const LAS f32x4*)(hp), h1 = *(const LAS f32x4*)(hp + 4), h2 = *(const LAS f32x4*)(hp + 32), h3 = *(const LAS f32x4*)(hp + 36);
                u32x4 o0, o1;
                o0.x = pk2(h0[0] * bflo(g0.x), h0[1] * bfhi(g0.x)); o0.y = pk2(h0[2] * bflo(g0.y), h0[3] * bfhi(g0.y));
                o0.z = pk2(h1[0] * bflo(g0.z), h1[1] * bfhi(g0.z)); o0.w = pk2(h1[2] * bflo(g0.w), h1[3] * bfhi(g0.w));
                o1.x = pk2(h2[0] * bflo(g1.x), h2[1] * bfhi(g1.x)); o1.y = pk2(h2[2] * bflo(g1.y), h2[3] * bfhi(g1.y));
                o1.z = pk2(h3[0] * bflo(g1.z), h3[1] * bfhi(g1.z)); o1.w = pk2(h3[2] * bflo(g1.w), h3[3] * bfhi(g1.w));
                *(u32x4*)(YMIX + t * D + 64 * h + 8 * cq) = o0; *(u32x4*)(YMIX + t * D + 64 * h + 32 + 8 * cq) = o1;
                g0 = ng0; g1 = ng1;
            }
            WAVE_SYNC();
        }
    }
    if (PASS == 1) { CA[(size_t)blk * 512 + 64 * h + lane] = pp; CH[(size_t)blk * 512 + 64 * h + lane] = hst; }
}

constexpr int HT_STRIDE = 2064;
constexpr int RG_W_OFF = 0, RG_H_OFF = 36 * HT_STRIDE, RG_LOG_OFF = RG_H_OFF + 32 * HT_STRIDE, RG_MISC_OFF = RG_LOG_OFF + 32 * 48 * 4;
static_assert(RG_MISC_OFF + 256 <= SCR_BYTES, "phase G LDS map");
__device__ __forceinline__ void phase_G(Frame& F, const Args& args) {
    const bf16_t* X1 = (const bf16_t*)(F.ws + OFF_X1); bf16_t* H2 = (bf16_t*)(F.ws + OFF_XN); const bf16_t* ROUTW = (const bf16_t*)(F.ws + OFF_ROUTW);
    const float* mod = (const float*)(F.ws + OFF_MOD); const float* g2w = args.in[18]; const float* bg = args.in[20]; const float* be = args.in[22];
    int* list = (int*)(F.ws + OFF_LIST); int* toke = (int*)(F.ws + OFF_TOKE); float* tokw = (float*)(F.ws + OFF_TOKW); int* tokp = (int*)(F.ws + OFF_TOKP);
    const int lane = F.lane, w = F.wave, fr = lane & 15, fq = lane >> 4;
    LAS float* LG = (LAS float*)(F.lds + RG_LOG_OFF); LAS int* hist = (LAS int*)(F.lds + RG_MISC_OFF); LAS int* base = hist + 32;
    __syncthreads();
    for (int i = F.tid; i < 36 * 128; i += NTHREADS) { const int r = i >> 7, c = i & 127; *(LAS u32x4*)(F.lds + RG_W_OFF + r * HT_STRIDE + c * 16) = *(const u32x4*)(ROUTW + (size_t)r * 1024 + c * 8); }
    for (int grp = F.bid; grp < T / 128; grp += F.G) {
        const int grow0 = grp * 128, b = grow0 / SEQ;
        const float* sh = mod + b * 6144 + 3072; const float* sc = sh + 1024;
        float gm[16], sv[16];
#pragma unroll
        for (int jj = 0; jj < 2; ++jj)
#pragma unroll
            for (int q = 0; q < 8; ++q) { const int c = 512 * jj + 8 * lane + q; gm[8 * jj + q] = g2w[c] * (1.0f + sc[c]); sv[8 * jj + q] = sh[c]; }
        if (F.tid < 32) hist[F.tid] = 0;
        u32x4 raw[4][2];
#pragma unroll
        for (int r = 0; r < 4; ++r)
#pragma unroll
            for (int jj = 0; jj < 2; ++jj) raw[r][jj] = *(const u32x4*)(X1 + (size_t)(grow0 + 4 * w + r) * D + 512 * jj + 8 * lane);
        int e1 = 0, e2 = 0, l1 = 0, l2 = 0; float w1 = 0.f, w2 = 0.f;
#pragma unroll 1
        for (int ti = 0; ti < 4; ++ti) {
            const int row0 = grow0 + 32 * ti;
#pragma unroll
            for (int r = 0; r < 4; ++r) {
                float h[16]; float ss = 0.f;
#pragma unroll
                for (int jj = 0; jj < 2; ++jj)
#pragma unroll
                    for (int q = 0; q < 4; ++q) { h[8 * jj + 2 * q] = bflo(raw[r][jj][q]); h[8 * jj + 2 * q + 1] = bfhi(raw[r][jj][q]); }
#pragma unroll
                for (int q = 0; q < 16; ++q) ss += h[q] * h[q];
                const float rs = rsqrtf(wave_sum(ss) * (1.0f / D) + EPS);
#pragma unroll
                for (int jj = 0; jj < 2; ++jj) { u32x4 o; float hv[8];
#pragma unroll
                    for (int q = 0; q < 8; ++q) hv[q] = h[8 * jj + q] * rs * gm[8 * jj + q] + sv[8 * jj + q];
#pragma unroll
                    for (int q = 0; q < 4; ++q) o[q] = pk2(hv[2 * q], hv[2 * q + 1]);
#if MOE_FP8
                    { u32x2 f; f.x = pg8::pk4_fp8(hv[0], hv[1], hv[2], hv[3]); f.y = pg8::pk4_fp8(hv[4], hv[5], hv[6], hv[7]);
                      *(u32x2*)((unsigned char*)H2 + (size_t)(row0 + 4 * w + r) * D + 512 * jj + 8 * lane) = f; }
#else
                    *(u32x4*)(H2 + (size_t)(row0 + 4 * w + r) * D + 512 * jj + 8 * lane) = o;
#endif
                    *(LAS u32x4*)(F.lds + RG_H_OFF + (4 * w + r) * HT_STRIDE + (512 * jj + 8 * lane) * 2) = o; }
            }
            if (ti < 3) {
#pragma unroll
                for (int r = 0; r < 4; ++r)
#pragma unroll
                    for (int jj = 0; jj < 2; ++jj) raw[r][jj] = *(const u32x4*)(X1 + (size_t)(row0 + 32 + 4 * w + r) * D + 512 * jj + 8 * lane);
            }
            __syncthreads();
            if (w < 6) {
                const int rt = w / 3, ct = w % 3; int wrow = 16 * ct + fr; wrow = wrow < 36 ? wrow : 35;
                const LAS unsigned char* hp = F.lds + RG_H_OFF + (16 * rt + fr) * HT_STRIDE + 16 * fq; const LAS unsigned char* wp = F.lds + RG_W_OFF + wrow * HT_STRIDE + 16 * fq;
                f32x4 acc0 = {0.f, 0.f, 0.f, 0.f}, acc1 = {0.f, 0.f, 0.f, 0.f};
#pragma unroll 8
                for (int kt = 0; kt < 32; kt += 2) {
                    acc0 = __builtin_amdgcn_mfma_f32_16x16x32_bf16(*(const LAS bf16x8*)(wp + 64 * kt), *(const LAS bf16x8*)(hp + 64 * kt), acc0, 0, 0, 0);
                    acc1 = __builtin_amdgcn_mfma_f32_16x16x32_bf16(*(const LAS bf16x8*)(wp + 64 * kt + 64), *(const LAS bf16x8*)(hp + 64 * kt + 64), acc1, 0, 0, 0); }
                *(LAS f32x4*)(LG + (16 * rt + fr) * 48 + 16 * ct + 4 * fq) = acc0 + acc1;
            }
            __syncthreads();
            if ((F.tid >> 5) == ti) {
                const LAS float* L = LG + (F.tid & 31) * 48;
                float gl[4], el[8];
#pragma unroll
                for (int j = 0; j < 4; ++j) gl[j] = L[j] + bg[j];
                int gs = 0; float gmax = gl[0];
#pragma unroll
                for (int j = 1; j < 4; ++j) if (gl[j] > gmax) { gmax = gl[j]; gs = j; }
#pragma unroll
                for (int j = 0; j < 8; ++j) el[j] = L[4 + gs * 8 + j] + be[gs * 8 + j];
                float gsum = 0.f;
#pragma unroll
                for (int j = 0; j < 4; ++j) gsum += __expf(gl[j] - gmax);
                const float pg = 1.0f / gsum;
                int i1 = 0; float m1 = el[0];
#pragma unroll
                for (int j = 1; j < 8; ++j) if (el[j] > m1) { m1 = el[j]; i1 = j; }
                int i2 = -1; float m2 = -INFINITY;
#pragma unroll
                for (int j = 0; j < 8; ++j) if (j != i1 && el[j] > m2) { m2 = el[j]; i2 = j; }
                const float r = __expf(m2 - m1);
                w1 = pg / (1.0f + r); w2 = pg * r / (1.0f + r); e1 = gs * 8 + i1; e2 = gs * 8 + i2;
                l1 = __hip_atomic_fetch_add(hist + e1, 1, __ATOMIC_RELAXED, __HIP_MEMORY_SCOPE_WORKGROUP);
                l2 = __hip_atomic_fetch_add(hist + e2, 1, __ATOMIC_RELAXED, __HIP_MEMORY_SCOPE_WORKGROUP);
            }
        }
        __syncthreads();
        if (F.tid < 32) { const int n = hist[F.tid]; base[F.tid] = n ? (int)__hip_atomic_fetch_add(F.ctl + CW_CNT + CNT_STRIDE * F.tid, (unsigned)n, __ATOMIC_RELAXED, __HIP_MEMORY_SCOPE_AGENT) : 0; }
        __syncthreads();
        if (F.tid < 128) { const int row = grow0 + F.tid, p1 = base[e1] + l1, p2 = base[e2] + l2;
            list[(size_t)e1 * LISTCAP + p1] = row; list[(size_t)e2 * LISTCAP + p2] = row;
            toke[2 * row] = e1; toke[2 * row + 1] = e2; tokw[2 * row] = w1; tokw[2 * row + 1] = w2; tokp[2 * row] = p1; tokp[2 * row + 1] = p2; }
        __syncthreads();
    }
}

__device__ __forceinline__ void phase_J(Frame& F, const Args& args) {
    const bf16_t* X1 = (const bf16_t*)(F.ws + OFF_X1); const bf16_t* Y = (const bf16_t*)(F.ws + OFF_Y); const float* mod = (const float*)(F.ws + OFF_MOD);
    const int* toke = (const int*)(F.ws + OFF_TOKE); const float* tokw = (const float*)(F.ws + OFF_TOKW); const int* tokp = (const int*)(F.ws + OFF_TOKP);
    const float* fg = args.in[26]; float* out = args.out;
    const int gw = F.bid * NWAVES + F.wave, NGW = F.G * NWAVES, lane = F.lane;
    constexpr int RPW = 16;
    for (int item = gw; item < T / RPW; item += NGW) {
        const int row0 = item * RPW, b = row0 / SEQ;
        int q0l = 0, q1l = 0; float w0l = 0.f, w1l = 0.f;
        { const int rr = row0 + (lane & 15); const int e0 = toke[2 * rr], e1 = toke[2 * rr + 1];
          q0l = F.tab[TAB_P0 + e0] * 256 + tokp[2 * rr]; q1l = F.tab[TAB_P0 + e1] * 256 + tokp[2 * rr + 1]; w0l = tokw[2 * rr]; w1l = tokw[2 * rr + 1]; }
        const float* g2 = mod + b * 6144 + 5120;
        f32x4 g2v[4], fgv[4];
#pragma unroll
        for (int jj = 0; jj < 2; ++jj)
#pragma unroll
            for (int hh = 0; hh < 2; ++hh) { const int c = 512 * jj + 8 * lane + 4 * hh; g2v[2 * jj + hh] = *(const f32x4*)(g2 + c); fgv[2 * jj + hh] = *(const f32x4*)(fg + c); }
#if MOE_FP8
        typedef u32x2 yvec; const unsigned char* Yb = (const unsigned char*)Y;
#define YLOAD(q_, c0_) (*(const u32x2*)(Yb + (q_) * D + (c0_)))
#define YUNPACK(v_, o_) do { const auto a0_ = __builtin_amdgcn_cvt_pk_f32_fp8((v_).x, false), a1_ = __builtin_amdgcn_cvt_pk_f32_fp8((v_).x, true), a2_ = __builtin_amdgcn_cvt_pk_f32_fp8((v_).y, false), a3_ = __builtin_amdgcn_cvt_pk_f32_fp8((v_).y, true); \
        o_[0] = a0_[0]; o_[1] = a0_[1]; o_[2] = a1_[0]; o_[3] = a1_[1]; o_[4] = a2_[0]; o_[5] = a2_[1]; o_[6] = a3_[0]; o_[7] = a3_[1]; } while (0)
        constexpr float YINV = 1.0f / Y_SCALE;
#else
        typedef u32x4 yvec;
#define YLOAD(q_, c0_) (*(const u32x4*)(Y + (q_) * D + (c0_)))
#define YUNPACK(v_, o_) do { _Pragma("unroll") for (int q_ = 0; q_ < 4; ++q_) { o_[2 * q_] = bflo((v_)[q_]); o_[2 * q_ + 1] = bfhi((v_)[q_]); } } while (0)
        constexpr float YINV = 1.0f;
#endif
        u32x4 xr[2], nxr[2]; yvec ya[2], yb[2], nya[2], nyb[2];
        { const size_t q0 = (size_t)__shfl(q0l, 0), q1 = (size_t)__shfl(q1l, 0);
#pragma unroll
          for (int jj = 0; jj < 2; ++jj) { const int c0 = 512 * jj + 8 * lane; xr[jj] = *(const u32x4*)(X1 + (size_t)row0 * D + c0); ya[jj] = YLOAD(q0, c0); yb[jj] = YLOAD(q1, c0); } }
#pragma unroll 1
        for (int r = 0; r < RPW; ++r) {
            const int row = row0 + r, rn = (r + 1 < RPW) ? r + 1 : r;
            { const size_t q0 = (size_t)__shfl(q0l, rn), q1 = (size_t)__shfl(q1l, rn);
#pragma unroll
              for (int jj = 0; jj < 2; ++jj) { const int c0 = 512 * jj + 8 * lane; nxr[jj] = *(const u32x4*)(X1 + (size_t)(row0 + rn) * D + c0); nya[jj] = YLOAD(q0, c0); nyb[jj] = YLOAD(q1, c0); } }
            const float w0 = __shfl(w0l, r), w1 = __shfl(w1l, r);
            float v[16]; float ss = 0.f;
#pragma unroll
            for (int jj = 0; jj < 2; ++jj) { float yav[8], ybv[8]; YUNPACK(ya[jj], yav); YUNPACK(yb[jj], ybv);
#pragma unroll
                for (int q = 0; q < 4; ++q) {
                    const float y0 = (w0 * yav[2 * q] + w1 * ybv[2 * q]) * YINV, y1 = (w0 * yav[2 * q + 1] + w1 * ybv[2 * q + 1]) * YINV;
                    const f32x4 gg = g2v[2 * jj + (q >> 1)];
                    v[8 * jj + 2 * q] = bflo(xr[jj][q]) + gg[(2 * q) & 3] * y0; v[8 * jj + 2 * q + 1] = bfhi(xr[jj][q]) + gg[(2 * q + 1) & 3] * y1; } }
#pragma unroll
            for (int q = 0; q < 16; ++q) ss += v[q] * v[q];
            const float rs = rsqrtf(wave_sum(ss) * (1.0f / D) + EPS);
#pragma unroll
            for (int jj = 0; jj < 2; ++jj) { const int c0 = 512 * jj + 8 * lane;
                f32x4 o0, o1;
#pragma unroll
                for (int q = 0; q < 4; ++q) { o0[q] = v[8 * jj + q] * rs * fgv[2 * jj][q]; o1[q] = v[8 * jj + 4 + q] * rs * fgv[2 * jj + 1][q]; }
                *(f32x4*)(out + (size_t)row * D + c0) = o0; *(f32x4*)(out + (size_t)row * D + c0 + 4) = o1;
                xr[jj] = nxr[jj]; ya[jj] = nya[jj]; yb[jj] = nyb[jj]; }
        }
    }
#undef YLOAD
#undef YUNPACK
}

__global__ void __launch_bounds__(NTHREADS, 2) mk(Args args) {
    extern __shared__ __attribute__((aligned(16))) unsigned char lds_raw[];
    Frame F;
    F.lds = (LAS unsigned char*)lds_raw; F.tab = (LAS int*)(F.lds + TAB_OFF);
    F.tid = threadIdx.x; F.lane = F.tid & 63; F.wave = __builtin_amdgcn_readfirstlane(F.tid >> 6);
    F.G = gridDim.x; F.bid = blockIdx.x; F.vcu = (F.G % 8 == 0) ? (F.bid % 8) * (F.G / 8) + F.bid / 8 : F.bid;
    F.ws = args.ws; F.ctl = (unsigned*)(args.ws + OFF_CTL);
    unsigned char* ws = args.ws;
    bf16_t* WIN = (bf16_t*)(ws + OFF_WIN); bf16_t* WOUT = (bf16_t*)(ws + OFF_WOUT); bf16_t* W13 = (bf16_t*)(ws + OFF_W13); bf16_t* W2 = (bf16_t*)(ws + OFF_W2);
    bf16_t* XN = (bf16_t*)(ws + OFF_XN); bf16_t* Z = (bf16_t*)(ws + OFF_Z); bf16_t* YMIX = (bf16_t*)(ws + OFF_YMIX); bf16_t* X1 = (bf16_t*)(ws + OFF_X1);
    bf16_t* ACT = (bf16_t*)(ws + OFF_ACT); bf16_t* Y = (bf16_t*)(ws + OFF_Y); bf16_t* H2 = XN;
    const float* mod = (const float*)(ws + OFF_MOD); const int* list = (const int*)(ws + OFF_LIST);
    const int lo = args.ph_lo, hi = args.ph_hi;
    for (int u = F.tid; u < (LDS_BYTES - LDSCTL_OFF) / 4; u += NTHREADS) ((LAS unsigned*)(F.lds + LDSCTL_OFF))[u] = 0u;
    __syncthreads();
    XcdBarrier bar; bar.bar = F.ctl + CW_BAR; bar.x = 0; bar.st = nullptr;
    if (hi - lo > 1) bar = xcd_barrier_post(F.ctl + CW_BAR, (volatile LAS unsigned*)(F.lds + LDSCTL_OFF) + 8);
#ifndef PHMASK
#define PHMASK 0x3ff
#endif
#define IN(k) (((PHMASK >> (k)) & 1) && lo <= (k) && (k) < hi)
#ifdef PROBE_SPAN
#define STAMP(i) do { if (F.bid == 0 && F.tid == 0) { const unsigned long long t_ = __builtin_amdgcn_s_memrealtime(); LAS unsigned* st_ = (LAS unsigned*)(F.lds + LDSCTL_OFF) + 32 + 2 * (i); st_[0] = (unsigned)t_; st_[1] = (unsigned)(t_ >> 32); } } while (0)
#else
#define STAMP(i) do { } while (0)
#endif
#define SEAM(k) do { if (IN(k) && IN((k) + 1)) xcd_barrier(bar); STAMP((k) + 1); } while (0)

    STAMP(0);
    if (IN(PH_A)) phase_A(F, args);
    SEAM(PH_A);
    if (IN(PH_B)) phase_B(F, args);
    SEAM(PH_B);
    if (IN(PH_C)) {
        pg8::Gemm g{XN, WIN, 2048}; pg8::EpiZ E{Z};
        if (F.G == 256) {
            constexpr int NCONV = 64, UPA = 5;
            constexpr int CSHARE = (256 - NCONV) * NWAVES * CONV_PRE;
            const bool conv = F.bid >= 256 - NCONV;
            if (conv) convert_experts(F, args, (F.bid - (256 - NCONV)) * NWAVES + F.wave, NCONV * NWAVES, CSHARE, TI_EXP - CSHARE);
            else if (CONV_PRE > 0) convert_experts(F, args, F.bid * NWAVES + F.wave, (256 - NCONV) * NWAVES, 0, CSHARE);
            __syncthreads();
            pg8::SplitOrder S; S.tokt = F.lds; S.init2(T, 2048, 2048, 256 - NCONV, NCONV, UPA, conv ? 1 : 0, conv ? F.bid - (256 - NCONV) : F.bid);
            pg8::gemm_phase<pg8::EpiZ, pg8::SplitOrder, true, false, false>(F.lds, g, S, E);
        } else {
            pg8::StaticOrder S; S.tokt = F.lds; S.init(T, 2048, 2048, F.G, F.bid);
            pg8::gemm_phase<pg8::EpiZ, pg8::StaticOrder, true, false, false>(F.lds, g, S, E);
        }
    }
    SEAM(PH_C);
    if (IN(PH_D)) { for (int blk = F.bid; blk < T / 128; blk += F.G) { __syncthreads(); sgu_block(F, args, blk); __syncthreads(); lru_block<1>(F, args, blk); } }
    SEAM(PH_D);
    if (IN(PH_E)) { for (int blk = F.bid; blk < T / 128; blk += F.G) { __syncthreads(); lru_block<2>(F, args, blk); } }
    SEAM(PH_E);
    if (IN(PH_F)) {
        __syncthreads();
        pg8::Gemm g{YMIX, WOUT, 2048}; pg8::StaticOrder S; S.tokt = F.lds; S.init(T, 1024, 2048, F.G, F.bid);
        pg8::EpiX1 E{args.in[0], mod, X1};
        pg8::gemm_phase<pg8::EpiX1, pg8::StaticOrder, true, false, false>(F.lds, g, S, E);
    }
    SEAM(PH_F);
    if (IN(PH_G)) phase_G(F, args);
    SEAM(PH_G);
    if (IN(PH_H)) {
        build_moe_table(F);
        pg8::MoeOrder S; S.nunits = F.tab[TAB_P0 + NE] * 4; S.G = F.G; S.c = F.vcu;
        S.tile_e = F.tab + TAB_TE; S.p0 = F.tab + TAB_P0; S.cnt = F.tab + TAB_CNT; S.list = list; S.gather = true; S.tokt = F.lds + TOKT_OFF;
#if MOE_FP8
        S.Kb = 1024; S.estride = (size_t)1024 * 1024;
        pg8::Gemm g{H2, W13, 1024}; pg8::EpiAct8 E{(unsigned char*)ACT, 1.0f / W13_SCALE, ACT_SCALE};
        pg8::gemm_phase<pg8::EpiAct8, pg8::MoeOrder, true, true, true>(F.lds, g, S, E);
#else
        S.Kb = 2048; S.estride = (size_t)1024 * 1024 * 2;
        pg8::Gemm g{H2, W13, 2048}; pg8::EpiAct E{ACT};
        pg8::gemm_phase<pg8::EpiAct, pg8::MoeOrder, true, true, false>(F.lds, g, S, E);
#endif
    }
    SEAM(PH_H);
    if (IN(PH_I)) {
        build_moe_table(F);
        pg8::MoeOrder S; S.nunits = F.tab[TAB_P0 + NE] * 4; S.G = F.G; S.c = F.vcu;
        S.tile_e = F.tab + TAB_TE; S.p0 = F.tab + TAB_P0; S.cnt = F.tab + TAB_CNT; S.list = list; S.gather = false; S.tokt = F.lds + TOKT_OFF;
#if MOE_FP8
        S.Kb = 512; S.estride = (size_t)1024 * 512;
        pg8::Gemm g{ACT, W2, 512}; pg8::EpiY8 E{(unsigned char*)Y, Y_SCALE / (W2_SCALE * ACT_SCALE)};
        pg8::gemm_phase<pg8::EpiY8, pg8::MoeOrder, true, false, true>(F.lds, g, S, E);
#else
        S.Kb = 1024; S.estride = (size_t)1024 * 512 * 2;
        pg8::Gemm g{ACT, W2, 1024}; pg8::EpiY E{Y};
        pg8::gemm_phase<pg8::EpiY, pg8::MoeOrder, true, false, false>(F.lds, g, S, E);
#endif
    }
    SEAM(PH_I);
    if (IN(PH_J)) { build_moe_table(F); phase_J(F, args); }
#ifdef PROBE_SPAN
    STAMP(PH_N);
    if (F.bid == 0 && F.tid == 0) { LAS unsigned* st_ = (LAS unsigned*)(F.lds + LDSCTL_OFF) + 32;
        const unsigned long long a_ = ((unsigned long long)st_[2 * PROBE_SPAN + 1] << 32) | st_[2 * PROBE_SPAN], b_ = ((unsigned long long)st_[2 * PROBE_SPAN + 3] << 32) | st_[2 * PROBE_SPAN + 2];
        const unsigned long long t0_ = __builtin_amdgcn_s_memrealtime(), dt_ = (b_ - a_) * PROBE_MULT;
        while (__builtin_amdgcn_s_memrealtime() - t0_ < dt_) __builtin_amdgcn_s_sleep(8); }
#endif
#undef IN
#undef SEAM
}
#ifndef FUSED
#define FUSED 1
#endif
extern "C" void kernel_launch(void* const* d_in, const int* in_sizes, int n_in, void* d_out, int out_size, void* d_ws, size_t ws_size, hipStream_t stream) {
    if (n_in != 27 || out_size != T * D || ws_size < WS_NEED) { fprintf(stderr, "kernel_launch: unexpected shapes (n_in %d out %d ws %zu)\n", n_in, out_size, ws_size); return; }
    static int grid = 0;
    if (grid == 0) {
        int dev = 0, cus = 0;
        if (hipGetDevice(&dev) != hipSuccess || hipDeviceGetAttribute(&cus, hipDeviceAttributeMultiprocessorCount, dev) != hipSuccess) { fprintf(stderr, "kernel_launch: device query failed\n"); grid = -1; return; }
        if (hipFuncSetAttribute((const void*)mk, hipFuncAttributeMaxDynamicSharedMemorySize, LDS_BYTES) != hipSuccess) { fprintf(stderr, "kernel_launch: hipFuncSetAttribute failed\n"); grid = -1; return; }
        int per_cu = 0;
        if (hipOccupancyMaxActiveBlocksPerMultiprocessor(&per_cu, (const void*)mk, NTHREADS, LDS_BYTES) != hipSuccess || per_cu < 1) fprintf(stderr, "kernel_launch: occupancy query says %d\n", per_cu);
        (void)hipGetLastError();
        grid = cus;
    }
    if (grid < 0) return;
    Args a{}; for (int i = 0; i < 27; ++i) a.in[i] = (const float*)d_in[i]; a.out = (float*)d_out; a.ws = (unsigned char*)d_ws;
#define MK(lo_, hi_) do { a.ph_lo = (lo_); a.ph_hi = (hi_); hipLaunchKernelGGL(mk, dim3(grid), dim3(NTHREADS), LDS_BYTES, stream, a); } while (0)
    (void)hipMemsetAsync((char*)d_ws + OFF_CTL, 0, CTL_BYTES, stream);
#if FUSED
    MK(0, PH_N);
#else
    for (int p = 0; p < PH_N; ++p) MK(p, p + 1);
#endif
}
```

```cpp
#include <hip/hip_runtime.h>
#include <cstdio>
#include <cstdint>

typedef unsigned short bf16_t;
typedef short bf16x8 __attribute__((ext_vector_type(8)));
typedef float f32x4 __attribute__((ext_vector_type(4)));
typedef unsigned u32x2 __attribute__((ext_vector_type(2)));
typedef unsigned u32x4 __attribute__((ext_vector_type(4)));

constexpr int T = 32768, D = 1024, SEQ = 4096, NB = 8;
constexpr int DL = 512;
constexpr int NE = 32, DE = 512;
constexpr int LISTCAP = 65536;
constexpr int MAXTILES = 288, MAXROWS = MAXTILES * 256;
constexpr float EPS = 1e-6f;

constexpr size_t MiB = 1u << 20;
constexpr size_t OFF_CTL = 0, CTL_BYTES = 48 * 1024;
constexpr size_t OFF_MOD = 1 * MiB;
constexpr size_t OFF_TBL = 1 * MiB + 256 * 1024;
constexpr size_t OFF_TOKE = 1 * MiB + 512 * 1024;
constexpr size_t OFF_TOKW = 1 * MiB + 768 * 1024;
constexpr size_t OFF_TOKP = 2 * MiB;
constexpr size_t OFF_N8SP = 1 * MiB + 256 * 1024 + 16384;
constexpr size_t OFF_GBIAS = 1 * MiB + 256 * 1024 + 32768;
constexpr size_t OFF_GATEW = 2 * MiB + 256 * 1024;
constexpr size_t OFF_SGUW = 2 * MiB + 512 * 1024;
constexpr size_t OFF_ROUTW = 2 * MiB + 768 * 1024;
constexpr size_t OFF_CARRY = 3 * MiB;
constexpr size_t OFF_WIN = 4 * MiB;
constexpr size_t OFF_WOUT = 8 * MiB;
constexpr size_t OFF_W13 = 10 * MiB;
constexpr size_t OFF_W2 = 74 * MiB;
constexpr size_t OFF_XN = 106 * MiB;
constexpr size_t OFF_Z = 170 * MiB;
constexpr size_t OFF_YMIX = 298 * MiB;
constexpr size_t OFF_X1 = 362 * MiB;
constexpr size_t OFF_ACT = 426 * MiB;
constexpr size_t OFF_LIST = 498 * MiB;
constexpr size_t OFF_ROWTOK = 506 * MiB;
constexpr size_t OFF_Y = 170 * MiB;
constexpr size_t WS_NEED = 507 * MiB;
constexpr size_t OFF_VN = OFF_X1;
constexpr size_t OFF_XC = OFF_ACT;
constexpr int CW_BAR = 4096;
constexpr int CW_CNT = 8192, CNT_STRIDE = 64;

__device__ __forceinline__ unsigned f2bf(float f) { unsigned u = __float_as_uint(f); return (u + 0x7fffu + ((u >> 16) & 1u)) >> 16; }
__device__ __forceinline__ float bf2f(unsigned h) { return __uint_as_float(h << 16); }
__device__ __forceinline__ unsigned pk2(float lo, float hi) { unsigned r; asm("v_cvt_pk_bf16_f32 %0, %1, %2" : "=v"(r) : "v"(lo), "v"(hi)); return r; }
__device__ __forceinline__ float wave_sum(float v) {
#pragma unroll
    for (int o = 1; o < 64; o <<= 1) v += __shfl_xor(v, o);
    return v;
}
__device__ __forceinline__ float gelu_tanh(float x) {
    const float u = 1.5957691216057308f * (x + 0.044715f * x * x * x);
    return x / (1.0f + __expf(-u));
}
__device__ __forceinline__ float sigmoidf(float x) { return 1.0f / (1.0f + __expf(-x)); }

__global__ void __launch_bounds__(256) k_ada(const float* c, const float* ada_w, const float* ada_b, float* mod) {
    __shared__ float sc[8][1024];
    for (int i = threadIdx.x; i < 8192; i += 256) { const float v = c[i]; sc[i >> 10][i & 1023] = v / (1.0f + expf(-v)); }
    __syncthreads();
    const int n = blockIdx.x * 256 + threadIdx.x;
    float acc[8];
#pragma unroll
    for (int b = 0; b < 8; ++b) acc[b] = 0.f;
    for (int k = 0; k < 1024; ++k) {
        const float w = ada_w[(size_t)k * 6144 + n];
#pragma unroll
        for (int b = 0; b < 8; ++b) acc[b] += sc[b][k] * w;
    }
#pragma unroll
    for (int b = 0; b < 8; ++b) mod[b * 6144 + n] = acc[b] + ada_b[n];
}

__global__ void __launch_bounds__(256) k_transpose(const float* W, bf16_t* WT, int K, int N, int blk, int rstride, int rbase, size_t w_ms, size_t wt_ms) {
    __shared__ float tile[32][33];
    W += (size_t)blockIdx.z * w_ms; WT += (size_t)blockIdx.z * wt_ms;
    const int n0 = blockIdx.x * 32, k0 = blockIdx.y * 32, tx = threadIdx.x & 31, ty = threadIdx.x >> 5;
    for (int j = ty; j < 32; j += 8) tile[j][tx] = W[(size_t)(k0 + j) * N + n0 + tx];
    __syncthreads();
    for (int j = ty; j < 32; j += 8) { const int n = n0 + j; const int row = rbase + (n / blk) * rstride + (n % blk);
        WT[(size_t)row * K + k0 + tx] = (bf16_t)f2bf(tile[tx][j]); }
}

__global__ void __launch_bounds__(256) k_xn(const float* x, const float* g, const float* mod, bf16_t* XN) {
    const int row = blockIdx.x * 4 + (threadIdx.x >> 6), lane = threadIdx.x & 63, b = row / SEQ;
    const f32x4* xr = (const f32x4*)(x + (size_t)row * D);
    f32x4 v[4]; float ss = 0.f;
#pragma unroll
    for (int j = 0; j < 4; ++j) { v[j] = xr[lane + 64 * j]; ss += v[j][0] * v[j][0] + v[j][1] * v[j][1] + v[j][2] * v[j][2] + v[j][3] * v[j][3]; }
    ss = wave_sum(ss);
    const float rs = rsqrtf(ss * (1.0f / D) + EPS);
    const float* sh = mod + b * 6144; const float* sc = sh + 1024;
#pragma unroll
    for (int j = 0; j < 4; ++j) { const int col = 4 * (lane + 64 * j);
        const f32x4 gg = *(const f32x4*)(g + col), s1 = *(const f32x4*)(sc + col), s0 = *(const f32x4*)(sh + col);
        float h[4];
#pragma unroll
        for (int q = 0; q < 4; ++q) h[q] = v[j][q] * rs * gg[q] * (1.0f + s1[q]) + s0[q];
        u32x2 o; o.x = pk2(h[0], h[1]); o.y = pk2(h[2], h[3]);
        *(u32x2*)(XN + (size_t)row * D + col) = o; }
}

template <bool DUAL, class Epi>
__device__ __forceinline__ void sg_tile(const bf16_t* A, const int* arow, const bf16_t* Bt, const bf16_t* Bt2, int K, int m0, int n0, int lane, const Epi& epi) {
    const int fr = lane & 15, fq = lane >> 4;
    const bf16_t* pa[2]; const bf16_t* pb[4]; const bf16_t* pb2[4];
#pragma unroll
    for (int mi = 0; mi < 2; ++mi) { const int r = m0 + mi * 16 + fr; const int rr = arow ? arow[r] : r; pa[mi] = A + (size_t)rr * K + 8 * fq; }
#pragma unroll
    for (int ni = 0; ni < 4; ++ni) { pb[ni] = Bt + (size_t)(n0 + ni * 16 + fr) * K + 8 * fq; pb2[ni] = DUAL ? Bt2 + (size_t)(n0 + ni * 16 + fr) * K + 8 * fq : nullptr; }
    f32x4 acc[2][4], acc2[2][4];
#pragma unroll
    for (int mi = 0; mi < 2; ++mi)
#pragma unroll
        for (int ni = 0; ni < 4; ++ni) { acc[mi][ni] = (f32x4){0.f, 0.f, 0.f, 0.f}; acc2[mi][ni] = (f32x4){0.f, 0.f, 0.f, 0.f}; }
    for (int k0 = 0; k0 < K; k0 += 32) {
        bf16x8 a[2], b[4], b2[4];
#pragma unroll
        for (int mi = 0; mi < 2; ++mi) a[mi] = *(const bf16x8*)(pa[mi] + k0);
#pragma unroll
        for (int ni = 0; ni < 4; ++ni) { b[ni] = *(const bf16x8*)(pb[ni] + k0); if (DUAL) b2[ni] = *(const bf16x8*)(pb2[ni] + k0); }
#pragma unroll
        for (int mi = 0; mi < 2; ++mi)
#pragma unroll
            for (int ni = 0; ni < 4; ++ni) {
                acc[mi][ni] = __builtin_amdgcn_mfma_f32_16x16x32_bf16(b[ni], a[mi], acc[mi][ni], 0, 0, 0);
                if (DUAL) acc2[mi][ni] = __builtin_amdgcn_mfma_f32_16x16x32_bf16(b2[ni], a[mi], acc2[mi][ni], 0, 0, 0);
            }
    }
#pragma unroll
    for (int mi = 0; mi < 2; ++mi)
#pragma unroll
        for (int ni = 0; ni < 4; ++ni) epi(m0 + mi * 16 + fr, n0 + ni * 16 + 4 * fq, acc[mi][ni], acc2[mi][ni]);
}

struct EpiInProj { bf16_t* Z;
    __device__ __forceinline__ void operator()(int row, int col, f32x4 v, f32x4) const {
        if (col >= 512) { v[0] = gelu_tanh(v[0]); v[1] = gelu_tanh(v[1]); v[2] = gelu_tanh(v[2]); v[3] = gelu_tanh(v[3]); }
        u32x2 o; o.x = pk2(v[0], v[1]); o.y = pk2(v[2], v[3]); *(u32x2*)(Z + (size_t)row * 2048 + col) = o; } };
struct EpiOutProj { const float* x; const float* mod; bf16_t* X1;
    __device__ __forceinline__ void operator()(int row, int col, f32x4 v, f32x4) const {
        const int b = row / SEQ; const f32x4 xv = *(const f32x4*)(x + (size_t)row * D + col), g1 = *(const f32x4*)(mod + b * 6144 + 2048 + col);
        u32x2 o; o.x = pk2(xv[0] + g1[0] * v[0], xv[1] + g1[1] * v[1]); o.y = pk2(xv[2] + g1[2] * v[2], xv[3] + g1[3] * v[3]);
        *(u32x2*)(X1 + (size_t)row * D + col) = o; } };
struct EpiMoe1 { bf16_t* ACT;
    __device__ __forceinline__ void operator()(int row, int col, f32x4 g, f32x4 u) const {
        float a[4];
#pragma unroll
        for (int q = 0; q < 4; ++q) a[q] = g[q] / (1.0f + __expf(-g[q])) * u[q];
        u32x2 o; o.x = pk2(a[0], a[1]); o.y = pk2(a[2], a[3]); *(u32x2*)(ACT + (size_t)row * DE + col) = o; } };
struct EpiMoe2 { bf16_t* Y;
    __device__ __forceinline__ void operator()(int row, int col, f32x4 v, f32x4) const {
        u32x2 o; o.x = pk2(v[0], v[1]); o.y = pk2(v[2], v[3]); *(u32x2*)(Y + (size_t)row * D + col) = o; } };

template <class Epi>
__global__ void __launch_bounds__(256) k_sgemm(const bf16_t* A, const bf16_t* Bt, int M, int N, int K, Epi epi) {
    const int w = blockIdx.x * 4 + (threadIdx.x >> 6), lane = threadIdx.x & 63, nN = N / 64;
    const int mt = w / nN, nt = w % nN; if (mt * 32 >= M) return;
    sg_tile<false>(A, nullptr, Bt, nullptr, K, mt * 32, nt * 64, lane, epi);
}
__global__ void __launch_bounds__(256) k_moe1(const bf16_t* H2, const int* rowtok, const int* tbl, const bf16_t* W13, EpiMoe1 epi) {
    const int w = blockIdx.x * 4 + (threadIdx.x >> 6), lane = threadIdx.x & 63;
    const int mt = w / 8, nt = w % 8, tile = mt / 8;
    if (tile >= tbl[0]) return;
    const int e = tbl[64 + tile], n0 = nt * 64, q = n0 / 128, i0 = n0 % 128;
    const bf16_t* Wg = W13 + (size_t)e * 1024 * 1024 + (size_t)(256 * q + i0) * 1024 - (size_t)n0 * 1024;
    sg_tile<true>(H2, rowtok, Wg, Wg + (size_t)128 * 1024, 1024, mt * 32, n0, lane, epi);
}
__global__ void __launch_bounds__(256) k_moe2(const bf16_t* ACT, const int* tbl, const bf16_t* W2, EpiMoe2 epi) {
    const int w = blockIdx.x * 4 + (threadIdx.x >> 6), lane = threadIdx.x & 63;
    const int mt = w / 16, nt = w % 16, tile = mt / 8;
    if (tile >= tbl[0]) return;
    const int e = tbl[64 + tile];
    sg_tile<false>(ACT, nullptr, W2 + (size_t)e * 1024 * 512, nullptr, 512, mt * 32, nt * 64, lane, epi);
}

__global__ void __launch_bounds__(256) k_lnv(const bf16_t* Z, const float* g, const float* bb, bf16_t* VN) {
    const int row = blockIdx.x * 4 + (threadIdx.x >> 6), lane = threadIdx.x & 63;
    const u32x4 raw = *(const u32x4*)(Z + (size_t)row * 2048 + 1536 + 8 * lane);
    float v[8];
#pragma unroll
    for (int q = 0; q < 4; ++q) { v[2 * q] = bf2f(raw[q] & 0xffffu); v[2 * q + 1] = bf2f(raw[q] >> 16); }
    float s = 0.f;
#pragma unroll
    for (int q = 0; q < 8; ++q) s += v[q];
    const float mu = wave_sum(s) * (1.0f / 512.0f);
    float s2 = 0.f;
#pragma unroll
    for (int q = 0; q < 8; ++q) { v[q] -= mu; s2 += v[q] * v[q]; }
    const float rstd = rsqrtf(wave_sum(s2) * (1.0f / 512.0f) + EPS);
    u32x4 o;
#pragma unroll
    for (int q = 0; q < 4; ++q) { const int c = 8 * lane + 2 * q; o[q] = pk2(v[2 * q] * rstd * g[c] + bb[c], v[2 * q + 1] * rstd * g[c + 1] + bb[c + 1]); }
    *(u32x4*)(VN + (size_t)row * 512 + 8 * lane) = o;
}
__global__ void __launch_bounds__(256) k_sgu(const bf16_t* Z, const bf16_t* VN, const float* sgu_w, const float* sgu_b, bf16_t* YMIX) {
    const int idx = blockIdx.x * 256 + threadIdx.x, t = idx >> 9, ch = idx & 511, i = t & 127, blk = t >> 7, g = ch >> 6;
    const int jmax = (i < 64) ? 64 : 128;
    float s = sgu_b[g * 128 + i];
    const float* wrow = sgu_w + ((size_t)g * 128 + i) * 128;
    for (int j = 0; j < jmax; ++j) s += wrow[j] * bf2f(VN[((size_t)blk * 128 + j) * 512 + ch]);
    YMIX[(size_t)t * D + 512 + ch] = (bf16_t)f2bf(bf2f(Z[(size_t)t * 2048 + 1024 + ch]) * s);
}
__global__ void __launch_bounds__(256) k_conv(const bf16_t* Z, const float* cw, const float* cb, float* XC) {
    const int idx = blockIdx.x * 256 + threadIdx.x, t = idx >> 9, ch = idx & 511, pos = t & (SEQ - 1);
    float acc = cb[ch];
#pragma unroll
    for (int k = 0; k < 4; ++k) { const int d = k - 3; if (pos + d >= 0) acc += cw[k * 512 + ch] * bf2f(Z[(size_t)(t + d) * 2048 + ch]); }
    XC[idx] = acc;
}
__global__ void __launch_bounds__(256) k_gates(const float* XC, const float* wa, const float* ba, const float* wi, const float* bi, const float* lam, float* A_, float* U_) {
    const int idx = blockIdx.x * 256 + threadIdx.x, t = idx >> 9, ch = idx & 511, h = ch >> 6, e = ch & 63;
    const float* xrow = XC + (size_t)t * 512 + h * 64;
    float ra = ba[ch], ri = bi[ch];
    for (int d = 0; d < 64; ++d) { const float xv = xrow[d]; ra += xv * wa[h * 4096 + d * 64 + e]; ri += xv * wi[h * 4096 + d * 64 + e]; }
    const float r = sigmoidf(ra), ig = sigmoidf(ri);
    const float sp = log1pf(expf(-lam[ch]));
    const float log_a = -8.0f * r * sp;
    A_[idx] = expf(log_a);
    U_[idx] = sqrtf(-expm1f(2.0f * log_a)) * (ig * XC[idx]);
}
__global__ void __launch_bounds__(64) k_scan(const float* A_, const float* U_, const bf16_t* Z, bf16_t* YMIX) {
    const int idx = blockIdx.x * 64 + threadIdx.x, b = idx >> 9, ch = idx & 511;
    float h = 0.f;
    for (int p0 = 0; p0 < SEQ; p0 += 8) {
        float a[8], u[8], g[8];
#pragma unroll
        for (int q = 0; q < 8; ++q) { const size_t t = (size_t)b * SEQ + p0 + q; a[q] = A_[t * 512 + ch]; u[q] = U_[t * 512 + ch]; g[q] = bf2f(Z[t * 2048 + 512 + ch]); }
#pragma unroll
        for (int q = 0; q < 8; ++q) { const size_t t = (size_t)b * SEQ + p0 + q; h = a[q] * h + u[q]; YMIX[t * D + ch] = (bf16_t)f2bf(h * g[q]); }
    }
}

__global__ void __launch_bounds__(256) k_router(const bf16_t* X1, const float* g2w, const float* mod, const float* wg, const float* bg, const float* we, const float* be,
                                                bf16_t* H2, unsigned* cnt, int* list, int* toke, float* tokw, int* tokp) {
    const int row = blockIdx.x * 4 + (threadIdx.x >> 6), lane = threadIdx.x & 63, b = row / SEQ;
    float h[16]; float ss = 0.f;
#pragma unroll
    for (int jj = 0; jj < 2; ++jj) { const u32x4 raw = *(const u32x4*)(X1 + (size_t)row * D + 512 * jj + 8 * lane);
#pragma unroll
        for (int q = 0; q < 4; ++q) { h[8 * jj + 2 * q] = bf2f(raw[q] & 0xffffu); h[8 * jj + 2 * q + 1] = bf2f(raw[q] >> 16); } }
#pragma unroll
    for (int q = 0; q < 16; ++q) ss += h[q] * h[q];
    const float rs = rsqrtf(wave_sum(ss) * (1.0f / D) + EPS);
    const float* sh = mod + b * 6144 + 3072; const float* sc = sh + 1024;
#pragma unroll
    for (int jj = 0; jj < 2; ++jj) { u32x4 o;
#pragma unroll
        for (int q = 0; q < 4; ++q) { const int c = 512 * jj + 8 * lane + 2 * q;
            const float h0 = h[8 * jj + 2 * q] * rs * g2w[c] * (1.0f + sc[c]) + sh[c], h1 = h[8 * jj + 2 * q + 1] * rs * g2w[c + 1] * (1.0f + sc[c + 1]) + sh[c + 1];
            o[q] = pk2(h0, h1); h[8 * jj + 2 * q] = bf2f(o[q] & 0xffffu); h[8 * jj + 2 * q + 1] = bf2f(o[q] >> 16); }
        *(u32x4*)(H2 + (size_t)row * D + 512 * jj + 8 * lane) = o; }
    float gl[4], el[8];
#pragma unroll
    for (int j = 0; j < 4; ++j) { float p = 0.f;
#pragma unroll
        for (int q = 0; q < 16; ++q) { const int k = 512 * (q >> 3) + 8 * lane + (q & 7); p += h[q] * wg[k * 4 + j]; }
        gl[j] = wave_sum(p) + bg[j]; }
    int gs = 0; float gmax = gl[0];
#pragma unroll
    for (int j = 1; j < 4; ++j) if (gl[j] > gmax) { gmax = gl[j]; gs = j; }
#pragma unroll
    for (int j = 0; j < 8; ++j) { float p = 0.f;
#pragma unroll
        for (int q = 0; q < 16; ++q) { const int k = 512 * (q >> 3) + 8 * lane + (q & 7); p += h[q] * we[k * 32 + gs * 8 + j]; }
        el[j] = wave_sum(p) + be[gs * 8 + j]; }
    if (lane == 0) {
        float gsum = 0.f;
#pragma unroll
        for (int j = 0; j < 4; ++j) gsum += expf(gl[j] - gmax);
        const float pg = 1.0f / gsum;
        int i1 = 0; float m1 = el[0];
#pragma unroll
        for (int j = 1; j < 8; ++j) if (el[j] > m1) { m1 = el[j]; i1 = j; }
        int i2 = -1; float m2 = -INFINITY;
#pragma unroll
        for (int j = 0; j < 8; ++j) if (j != i1 && el[j] > m2) { m2 = el[j]; i2 = j; }
        const float r = expf(m2 - m1);
        const float w1 = pg / (1.0f + r), w2 = pg * r / (1.0f + r);
        const int e1 = gs * 8 + i1, e2 = gs * 8 + i2;
        const unsigned p1 = atomicAdd(cnt + CNT_STRIDE * e1, 1u), p2 = atomicAdd(cnt + CNT_STRIDE * e2, 1u);
        list[(size_t)e1 * LISTCAP + p1] = row; list[(size_t)e2 * LISTCAP + p2] = row;
        toke[2 * row] = e1; toke[2 * row + 1] = e2; tokw[2 * row] = w1; tokw[2 * row + 1] = w2; tokp[2 * row] = (int)p1; tokp[2 * row + 1] = (int)p2;
    }
}
__global__ void k_table(const unsigned* cnt, int* tbl) {
    if (threadIdx.x == 0) { int p = 0;
        for (int e = 0; e < NE; ++e) { tbl[1 + e] = p; const int nt = ((int)cnt[CNT_STRIDE * e] + 255) / 256; for (int j = 0; j < nt; ++j) tbl[64 + p + j] = e; p += nt; }
        tbl[1 + NE] = p; tbl[0] = p; }
}
__global__ void __launch_bounds__(256) k_rowtok(const unsigned* cnt, const int* tbl, const int* list, int* rowtok) {
    const int p = blockIdx.x * 256 + threadIdx.x, t = p >> 8; int tok = 0;
    if (t < tbl[0]) { const int e = tbl[64 + t], pos = (t - tbl[1 + e]) * 256 + (p & 255); if (pos < (int)cnt[CNT_STRIDE * e]) tok = list[(size_t)e * LISTCAP + pos]; }
    rowtok[p] = tok;
}
__global__ void __launch_bounds__(256) k_combine(const bf16_t* X1, const bf16_t* Y, const float* mod, const int* tbl, const int* toke, const float* tokw, const int* tokp, const float* fg, float* out) {
    const int row = blockIdx.x * 4 + (threadIdx.x >> 6), lane = threadIdx.x & 63, b = row / SEQ;
    const int e0 = toke[2 * row], e1 = toke[2 * row + 1];
    const size_t q0 = (size_t)tbl[1 + e0] * 256 + tokp[2 * row], q1 = (size_t)tbl[1 + e1] * 256 + tokp[2 * row + 1];
    const float w0 = tokw[2 * row], w1 = tokw[2 * row + 1];
    const float* g2 = mod + b * 6144 + 5120;
    float v[16]; float ss = 0.f;
#pragma unroll
    for (int jj = 0; jj < 2; ++jj) { const int c0 = 512 * jj + 8 * lane;
        const u32x4 xr = *(const u32x4*)(X1 + (size_t)row * D + c0), ya = *(const u32x4*)(Y + q0 * D + c0), yb = *(const u32x4*)(Y + q1 * D + c0);
#pragma unroll
        for (int q = 0; q < 4; ++q) {
            const float x0 = bf2f(xr[q] & 0xffffu), x1 = bf2f(xr[q] >> 16);
            const float y0 = w0 * bf2f(ya[q] & 0xffffu) + w1 * bf2f(yb[q] & 0xffffu), y1 = w0 * bf2f(ya[q] >> 16) + w1 * bf2f(yb[q] >> 16);
            v[8 * jj + 2 * q] = x0 + g2[c0 + 2 * q] * y0; v[8 * jj + 2 * q + 1] = x1 + g2[c0 + 2 * q + 1] * y1; } }
#pragma unroll
    for (int q = 0; q < 16; ++q) ss += v[q] * v[q];
    const float rs = rsqrtf(wave_sum(ss) * (1.0f / D) + EPS);
#pragma unroll
    for (int jj = 0; jj < 2; ++jj) { const int c0 = 512 * jj + 8 * lane;
        f32x4 o0, o1;
#pragma unroll
        for (int q = 0; q < 4; ++q) { o0[q] = v[8 * jj + q] * rs * fg[c0 + q]; o1[q] = v[8 * jj + 4 + q] * rs * fg[c0 + 4 + q]; }
        *(f32x4*)(out + (size_t)row * D + c0) = o0; *(f32x4*)(out + (size_t)row * D + c0 + 4) = o1; }
}

namespace pg8 {
#define PG8_LAS __attribute__((address_space(3)))
constexpr int BM = 256, BK = 64, HALF = 128, HTB = HALF * BK * 2  , STAGE_BYTES = 8 * HTB, NXCD = 8, WGM = 8;
__host__ __device__ __forceinline__ int lds_byte(int r, int c) { const int st = (r >> 4) * 2 + (c >> 5), rr = r & 15, cc = c & 31, ob = rr * 64 + cc * 2; return st * 1024 + (ob ^ (((ob >> 9) & 1) << 5)); }
__host__ __device__ __forceinline__ void stage_rc(int b, int& R, int& C) { const int st = b / 1024, sb = b % 1024, swz = sb ^ (((sb >> 9) & 1) << 5); R = (st >> 1) * 16 + swz / 64; C = (st & 1) * 32 + (swz % 64) / 2; }
__host__ __device__ __forceinline__ int perm32(int rho) { const int n = rho >> 4, i = rho & 15; return 8 * (i >> 2) + 4 * n + (i & 3); }

struct Unit { int pm, pn, e; };
struct Gemm { const void* A; const void* Bt; int Kb; };
__host__ __device__ __forceinline__ int swz8(int r8) { return ((r8 >> 1) & 1) | (((r8 >> 2) & 1) << 2); }
__host__ __device__ __forceinline__ int lds_byte8(int r, int piece) { return (r >> 3) * 1024 + ((r & 7) * 8 + (piece ^ swz8(r & 7))) * 16; }
__host__ __device__ __forceinline__ void stage_rc8(int b, int& R, int& Cb) { const int chunk = b >> 10, slot = (b & 1023) >> 4, r8 = slot >> 3, j = slot & 7; R = chunk * 8 + r8; Cb = (j ^ swz8(r8)) * 16; }
typedef int v8i32 __attribute__((ext_vector_type(8)));
typedef int v4i32 __attribute__((ext_vector_type(4)));

struct StaticOrder {
    int nM, nN, nwg, G, c; size_t tstep;
    __device__ void init(int M, int N, int Kb, int G_, int c_) { nM = M / BM; nN = N / BM; nwg = nM * nN; G = G_; c = c_; tstep = (size_t)BM * Kb; }
    __device__ bool next(int i, Unit& u) const {
        const long L = (long)i * G + c; if (L >= nwg) return false;
        int wgid = (int)L; { const int q = nwg / NXCD, r = nwg % NXCD, xcd = wgid % NXCD, off = wgid / NXCD; wgid = (xcd < r ? xcd * (q + 1) : r * (q + 1) + (xcd - r) * q) + off; }
        const int nig = WGM * nN, gid = wgid / nig, fm = gid * WGM, gsz = (nM - fm) < WGM ? (nM - fm) : WGM;
        u.pm = fm + ((wgid % nig) % gsz); u.pn = (wgid % nig) / gsz; u.e = 0; return true;
    }
    __device__ __forceinline__ size_t a_off(const Unit& u) const { return (size_t)u.pm * tstep; }
    __device__ __forceinline__ size_t b_off(const Unit& u) const { return (size_t)u.pn * tstep; }
    PG8_LAS unsigned char* tokt;
    __device__ __forceinline__ const int* tok_src(const Unit&, int) const { return nullptr; }
};
struct SplitOrder : StaticOrder {
    int nA, upa, cls, idx, nB;
    __device__ void init2(int M, int N, int Kb, int nA_, int nB_, int upa_, int cls_, int idx_) { init(M, N, Kb, 1, 0); nA = nA_; nB = nB_; upa = upa_; cls = cls_; idx = idx_; }
    __device__ bool next(int i, Unit& u) const {
        long L; if (cls == 0) { if (i >= upa) return false; L = (long)i * nA + idx; } else { L = (long)upa * nA + (long)i * nB + idx; }
        if (L >= nwg) return false;
        int wgid = (int)L; { const int q = nwg / NXCD, r = nwg % NXCD, xcd = wgid % NXCD, off = wgid / NXCD; wgid = (xcd < r ? xcd * (q + 1) : r * (q + 1) + (xcd - r) * q) + off; }
        const int nig = WGM * nN, gid = wgid / nig, fm = gid * WGM, gsz = (nM - fm) < WGM ? (nM - fm) : WGM;
        u.pm = fm + ((wgid % nig) % gsz); u.pn = (wgid % nig) / gsz; u.e = 0; return true;
    }
};
struct MoeOrder {
    int nunits, G, c, Kb; size_t estride;
    const PG8_LAS int* tile_e; const PG8_LAS int* p0; const PG8_LAS int* cnt; const int* list; bool gather;
    __device__ bool next(int i, Unit& u) const {
        const int L = i * G + c; if (L >= nunits) return false;
        u.pm = L >> 2; u.pn = L & 3; u.e = tile_e[u.pm]; return true;
    }
    __device__ __forceinline__ size_t a_off(const Unit& u) const { return gather ? (size_t)0 : (size_t)u.pm * BM * Kb; }
    __device__ __forceinline__ size_t b_off(const Unit& u) const { return (size_t)u.e * estride + (size_t)u.pn * BM * Kb; }
    PG8_LAS unsigned char* tokt;
    __device__ __forceinline__ const int* tok_src(const Unit& u, int r) const {
        const int pos = (u.pm - p0[u.e]) * 256 + r, last = cnt[u.e] - 1;
        return list + (size_t)u.e * LISTCAP + (pos < last ? pos : last);
    }
};

__device__ __forceinline__ unsigned cvt_pk_bf16(float lo, float hi) { unsigned r; asm volatile("v_cvt_pk_bf16_f32 %0, %1, %2" : "=v"(r) : "v"(lo), "v"(hi)); return r; }
__device__ __forceinline__ float gelu_fast(float x) {
    const float u = -2.3022082f * (x + 0.044715f * x * x * x);
    return x * __builtin_amdgcn_rcpf(1.0f + __builtin_amdgcn_exp2f(u));
}
__device__ __forceinline__ float silu_fast(float x) { return x * __builtin_amdgcn_rcpf(1.0f + __builtin_amdgcn_exp2f(-1.4426950408889634f * x)); }

struct EpiZ { static constexpr bool PERM = true; bf16_t* Z;
    __device__ __forceinline__ void operator()(const f32x4 (&acc)[2][2][4][2], const Unit& u, int wr, int wc, int fr, int fq) const {
        const int row0 = u.pm * BM + wr * 64 + fr, col0 = u.pn * BM + wc * 32 + 8 * fq; const bool act = u.pn >= 2;
#pragma unroll
        for (int ai = 0; ai < 2; ++ai)
#pragma unroll
            for (int m = 0; m < 4; ++m) { bf16_t* rowp = Z + (size_t)(row0 + ai * HALF + m * 16) * 2048 + col0;
#pragma unroll
                for (int bj = 0; bj < 2; ++bj) { f32x4 v0 = acc[ai][bj][m][0], v1 = acc[ai][bj][m][1];
                    if (act) {
#pragma unroll
                        for (int q = 0; q < 4; ++q) { v0[q] = gelu_fast(v0[q]); v1[q] = gelu_fast(v1[q]); } }
                    u32x4 w; w.x = cvt_pk_bf16(v0[0], v0[1]); w.y = cvt_pk_bf16(v0[2], v0[3]); w.z = cvt_pk_bf16(v1[0], v1[1]); w.w = cvt_pk_bf16(v1[2], v1[3]);
                    *(u32x4*)(rowp + bj * HALF) = w; } }
    }
};
struct EpiX1 { static constexpr bool PERM = true; const float* x; const float* mod; bf16_t* X1;
    __device__ __forceinline__ void operator()(const f32x4 (&acc)[2][2][4][2], const Unit& u, int wr, int wc, int fr, int fq) const {
        const int row0 = u.pm * BM + wr * 64 + fr, col0 = u.pn * BM + wc * 32 + 8 * fq; const int b = (u.pm * BM) / SEQ;
        const float* g1 = mod + b * 6144 + 2048 + col0;
        f32x4 gv[2][2];
#pragma unroll
        for (int bj = 0; bj < 2; ++bj) { gv[bj][0] = *(const f32x4*)(g1 + bj * HALF); gv[bj][1] = *(const f32x4*)(g1 + bj * HALF + 4); }
#pragma unroll
        for (int ai = 0; ai < 2; ++ai)
#pragma unroll
            for (int m = 0; m < 4; ++m) { const size_t off = (size_t)(row0 + ai * HALF + m * 16) * D + col0;
#pragma unroll
                for (int bj = 0; bj < 2; ++bj) { const f32x4 x0 = *(const f32x4*)(x + off + bj * HALF), x1 = *(const f32x4*)(x + off + bj * HALF + 4);
                    const f32x4 v0 = x0 + gv[bj][0] * acc[ai][bj][m][0], v1 = x1 + gv[bj][1] * acc[ai][bj][m][1];
                    u32x4 w; w.x = cvt_pk_bf16(v0[0], v0[1]); w.y = cvt_pk_bf16(v0[2], v0[3]); w.z = cvt_pk_bf16(v1[0], v1[1]); w.w = cvt_pk_bf16(v1[2], v1[3]);
                    *(u32x4*)(X1 + off + bj * HALF) = w; } }
    }
};
struct EpiAct { static constexpr bool PERM = true; bf16_t* ACT;
    __device__ __forceinline__ void operator()(const f32x4 (&acc)[2][2][4][2], const Unit& u, int wr, int wc, int fr, int fq) const {
        const int row0 = u.pm * BM + wr * 64 + fr, col0 = u.pn * HALF + wc * 32 + 8 * fq;
#pragma unroll
        for (int ai = 0; ai < 2; ++ai)
#pragma unroll
            for (int m = 0; m < 4; ++m) { f32x4 v0, v1;
#pragma unroll
                for (int q = 0; q < 4; ++q) { v0[q] = silu_fast(acc[ai][0][m][0][q]) * acc[ai][1][m][0][q]; v1[q] = silu_fast(acc[ai][0][m][1][q]) * acc[ai][1][m][1][q]; }
                u32x4 w; w.x = cvt_pk_bf16(v0[0], v0[1]); w.y = cvt_pk_bf16(v0[2], v0[3]); w.z = cvt_pk_bf16(v1[0], v1[1]); w.w = cvt_pk_bf16(v1[2], v1[3]);
                *(u32x4*)(ACT + (size_t)(row0 + ai * HALF + m * 16) * DE + col0) = w; }
    }
};
__device__ __forceinline__ unsigned pk4_fp8(float a, float b, float c, float d) {
    a = __builtin_fminf(__builtin_fmaxf(a, -448.f), 448.f); b = __builtin_fminf(__builtin_fmaxf(b, -448.f), 448.f);
    c = __builtin_fminf(__builtin_fmaxf(c, -448.f), 448.f); d = __builtin_fminf(__builtin_fmaxf(d, -448.f), 448.f);
    unsigned w = 0u; w = __builtin_amdgcn_cvt_pk_fp8_f32(a, b, w, false); w = __builtin_amdgcn_cvt_pk_fp8_f32(c, d, w, true); return w; }
struct EpiAct8 { static constexpr bool PERM = true; unsigned char* ACT; float inv, oscale;
    __device__ __forceinline__ void operator()(const f32x4 (&acc)[2][2][4][2], const Unit& u, int wr, int wc, int fr, int fq) const {
        const int row0 = u.pm * BM + wr * 64 + fr, col0 = u.pn * HALF + wc * 32 + 8 * fq; const float io = inv * oscale;
#pragma unroll
        for (int ai = 0; ai < 2; ++ai)
#pragma unroll
            for (int m = 0; m < 4; ++m) { f32x4 v0, v1;
#pragma unroll
                for (int q = 0; q < 4; ++q) { v0[q] = silu_fast(acc[ai][0][m][0][q] * inv) * (acc[ai][1][m][0][q] * io); v1[q] = silu_fast(acc[ai][0][m][1][q] * inv) * (acc[ai][1][m][1][q] * io); }
                u32x2 w; w.x = pk4_fp8(v0[0], v0[1], v0[2], v0[3]); w.y = pk4_fp8(v1[0], v1[1], v1[2], v1[3]);
                *(u32x2*)(ACT + (size_t)(row0 + ai * HALF + m * 16) * DE + col0) = w; }
    }
};
struct EpiY8 { static constexpr bool PERM = true; unsigned char* Y; float sc;
    __device__ __forceinline__ void operator()(const f32x4 (&acc)[2][2][4][2], const Unit& u, int wr, int wc, int fr, int fq) const {
        const int row0 = u.pm * BM + wr * 64 + fr, col0 = u.pn * BM + wc * 32 + 8 * fq;
#pragma unroll
        for (int ai = 0; ai < 2; ++ai)
#pragma unroll
            for (int m = 0; m < 4; ++m) { unsigned char* rowp = Y + (size_t)(row0 + ai * HALF + m * 16) * D + col0;
#pragma unroll
                for (int bj = 0; bj < 2; ++bj) { const f32x4 v0 = acc[ai][bj][m][0] * sc, v1 = acc[ai][bj][m][1] * sc;
                    u32x2 w; w.x = pk4_fp8(v0[0], v0[1], v0[2], v0[3]); w.y = pk4_fp8(v1[0], v1[1], v1[2], v1[3]);
                    *(u32x2*)(rowp + bj * HALF) = w; } }
    }
};
struct EpiY { static constexpr bool PERM = true; bf16_t* Y;
    __device__ __forceinline__ void operator()(const f32x4 (&acc)[2][2][4][2], const Unit& u, int wr, int wc, int fr, int fq) const {
        const int row0 = u.pm * BM + wr * 64 + fr, col0 = u.pn * BM + wc * 32 + 8 * fq;
#pragma unroll
        for (int ai = 0; ai < 2; ++ai)
#pragma unroll
            for (int m = 0; m < 4; ++m) { bf16_t* rowp = Y + (size_t)(row0 + ai * HALF + m * 16) * D + col0;
#pragma unroll
                for (int bj = 0; bj < 2; ++bj) { const f32x4 v0 = acc[ai][bj][m][0], v1 = acc[ai][bj][m][1];
                    u32x4 w; w.x = cvt_pk_bf16(v0[0], v0[1]); w.y = cvt_pk_bf16(v0[2], v0[3]); w.z = cvt_pk_bf16(v1[0], v1[1]); w.w = cvt_pk_bf16(v1[2], v1[3]);
                    *(u32x4*)(rowp + bj * HALF) = w; } }
    }
};

template <class Epi, class Sched, bool ALIGN_EPI, bool GATHER, bool FP8>
__device__ __forceinline__ void gemm_phase(PG8_LAS unsigned char* lds, const Gemm g, const Sched& S, const Epi& E) {
    const int tid = threadIdx.x, wid = __builtin_amdgcn_readfirstlane(tid >> 6), lane = tid & 63, wr = wid >> 2, wc = wid & 3, fr = lane & 15, fq = lane >> 4;
    const int Kb = g.Kb, nt = Kb / (BK * 2);
    unsigned voffA[2], voffB[2]; int Ra[2];
#pragma unroll
    for (int i = 0; i < 2; ++i) { int R, Cb; if (FP8) stage_rc8(tid * 16 + i * 8192, R, Cb); else { stage_rc(tid * 16 + i * 8192, R, Cb); Cb *= 2; }
        const int Rb = Epi::PERM ? ((R & ~31) + perm32(R & 31)) : R;
        Ra[i] = R; voffA[i] = GATHER ? (unsigned)Cb : (unsigned)(R * Kb + Cb); voffB[i] = (unsigned)(Rb * Kb + Cb); }
    const size_t kstep = (size_t)(BK * 2);
    const size_t hstep = (size_t)HALF * Kb;
    const size_t hstepA = GATHER ? (size_t)0 : hstep;
    const unsigned ldsw = (unsigned)wid * 1024u;
    const int aoff = FP8 ? lds_byte8(wr * 64 + fr, 2 * fq) : lds_byte(wr * 64 + fr, fq * 8), boff = FP8 ? lds_byte8(wc * 32 + fr, 2 * fq) : lds_byte(wc * 32 + fr, fq * 8);
    const int aoff1 = FP8 ? lds_byte8(wr * 64 + fr, 2 * fq + 1) : 0, boff1 = FP8 ? lds_byte8(wc * 32 + fr, 2 * fq + 1) : 0;
#define PG8_SA(b, h) (((b) * 2 + (h)) * HTB)
#define PG8_SB(b, h) ((4 + (b) * 2 + (h)) * HTB)
#define PG8_STAGE(bufoff, gbase, voff) do { _Pragma("unroll") for (int _i = 0; _i < 2; ++_i) \
        __builtin_amdgcn_global_load_lds((const unsigned*)((const char*)(gbase) + (voff)[_i]), (PG8_LAS unsigned*)(lds + (bufoff) + ldsw + _i * 8192), 16, 0, 0); } while (0)
#define PG8_STAGE_A(bufoff, kbase, h) do { _Pragma("unroll") for (int _i = 0; _i < 2; ++_i) \
        __builtin_amdgcn_global_load_lds((const unsigned*)((const char*)(kbase) + (size_t)(h) * hstepA + (GATHER ? gC[h][_i] : 0u) + voffA[_i]), (PG8_LAS unsigned*)(lds + (bufoff) + ldsw + _i * 8192), 16, 0, 0); } while (0)
#define PG8_LD16(off) (*(const PG8_LAS v4i32*)(lds + (off)))
#define PG8_LDA(dst, b, h) do { _Pragma("unroll") for (int m = 0; m < 4; ++m) { if constexpr (FP8) dst##8[m] = __builtin_shufflevector(PG8_LD16(PG8_SA(b, h) + aoff + m * 2048), PG8_LD16(PG8_SA(b, h) + aoff1 + m * 2048), 0, 1, 2, 3, 4, 5, 6, 7); \
        else { _Pragma("unroll") for (int k = 0; k < 2; ++k) dst[m][k] = *(const PG8_LAS bf16x8*)(lds + PG8_SA(b, h) + aoff + m * 2048 + k * 1024); } } } while (0)
#define PG8_LDB(dst, b, h) do { _Pragma("unroll") for (int n = 0; n < 2; ++n) { if constexpr (FP8) dst##8[n] = __builtin_shufflevector(PG8_LD16(PG8_SB(b, h) + boff + n * 2048), PG8_LD16(PG8_SB(b, h) + boff1 + n * 2048), 0, 1, 2, 3, 4, 5, 6, 7); \
        else { _Pragma("unroll") for (int k = 0; k < 2; ++k) dst[n][k] = *(const PG8_LAS bf16x8*)(lds + PG8_SB(b, h) + boff + n * 2048 + k * 1024); } } } while (0)
#define PG8_MMA(ai, bj, At, Bt, ZF) do { __builtin_amdgcn_s_setprio(1); _Pragma("unroll") for (int m = 0; m < 4; ++m) _Pragma("unroll") for (int n = 0; n < 2; ++n) { \
        if constexpr (FP8) { if constexpr (ZF) asm volatile("v_mfma_f32_16x16x128_f8f6f4 %0, %1, %2, 0" : "=v"(acc[ai][bj][m][n]) : "v"(Bt##8[n]), "v"(At##8[m])); \
                             else asm volatile("v_mfma_f32_16x16x128_f8f6f4 %0, %1, %2, %0" : "+v"(acc[ai][bj][m][n]) : "v"(Bt##8[n]), "v"(At##8[m])); } \
        else { acc[ai][bj][m][n] = __builtin_amdgcn_mfma_f32_16x16x32_bf16(Bt[n][0], At[m][0], ZF ? (f32x4){0.f, 0.f, 0.f, 0.f} : acc[ai][bj][m][n], 0, 0, 0); \
               acc[ai][bj][m][n] = __builtin_amdgcn_mfma_f32_16x16x32_bf16(Bt[n][1], At[m][1], acc[ai][bj][m][n], 0, 0, 0); } } \
        __builtin_amdgcn_s_setprio(0); } while (0)
#define PG8_WAIT_V(n) asm volatile("s_waitcnt vmcnt(" #n ")" ::: "memory")
#define PG8_WAIT_L(n) asm volatile("s_waitcnt lgkmcnt(" #n ")" ::: "memory")
#define PG8_BAR __builtin_amdgcn_s_barrier()
#define PG8_SCHED __builtin_amdgcn_sched_barrier(0)
    Unit cur, nxt; int ui = 0;
    if (!S.next(0, cur)) return;
    f32x4 acc[2][2][4][2];
    bf16x8 At[4][2], B0[2][2], B1[2][2]; v8i32 At8[4], B08[2], B18[2];
#define PG8_TOK_ISSUE(u_, slot_) do { if (wid < 4) __builtin_amdgcn_global_load_lds((const unsigned*)S.tok_src(u_, tid), (PG8_LAS unsigned*)(S.tokt + (slot_) * 1024 + wid * 256), 4, 0, 0); } while (0)
#define PG8_TOK_READ(slot_) do { _Pragma("unroll") for (int h = 0; h < 2; ++h) _Pragma("unroll") for (int i = 0; i < 2; ++i) \
        gC[h][i] = *(const PG8_LAS unsigned*)(S.tokt + (slot_) * 1024 + (h * HALF + Ra[i]) * 4) * (unsigned)Kb; } while (0)
    unsigned gC[2][2];
#pragma unroll
    for (int h = 0; h < 2; ++h)
#pragma unroll
        for (int i = 0; i < 2; ++i) gC[h][i] = 0u;
    if constexpr (GATHER) { PG8_TOK_ISSUE(cur, 0); PG8_WAIT_V(0); PG8_BAR; PG8_TOK_READ(0); }
    const char* cA = (const char*)g.A + S.a_off(cur); const char* cB = (const char*)g.Bt + S.b_off(cur);
    PG8_STAGE(PG8_SB(0, 0), cB, voffB); PG8_STAGE(PG8_SB(0, 1), cB + hstep, voffB); PG8_STAGE_A(PG8_SA(0, 0), cA, 0); PG8_STAGE_A(PG8_SA(0, 1), cA, 1);
    if (wr == 1) PG8_BAR;
    PG8_WAIT_V(2); PG8_BAR;
    PG8_STAGE(PG8_SB(1, 0), cB + kstep, voffB); PG8_STAGE_A(PG8_SA(1, 0), cA + kstep, 0); PG8_STAGE(PG8_SB(1, 1), cB + hstep + kstep, voffB);
    PG8_WAIT_V(6); PG8_BAR;
    for (;;) {
        const bool has_next = S.next(ui + 1, nxt);
        const char* nA = has_next ? (const char*)g.A + S.a_off(nxt) : cA; const char* nB = has_next ? (const char*)g.Bt + S.b_off(nxt) : cB;
        if constexpr (GATHER) { if (has_next) PG8_TOK_ISSUE(nxt, (ui + 1) & 1); }
        if constexpr (FP8) {
        { constexpr bool ZF = true; const int t = 0;
            const bool last = (t == nt - 2);
            const char* a1 = cA + (size_t)(t + 1) * kstep;
            const char* a2 = last ? nA : cA + (size_t)(t + 2) * kstep; const char* b2 = last ? nB : cB + (size_t)(t + 2) * kstep;
            const char* a3 = a2 + kstep; const char* b3 = b2 + kstep;
            PG8_LDB(B0, 0, 0); PG8_LDB(B1, 0, 1); PG8_SCHED; PG8_LDA(At, 0, 0); PG8_STAGE_A(PG8_SA(1, 1), a1, 1);
            PG8_WAIT_V(8); PG8_WAIT_L(0); PG8_BAR; PG8_MMA(0, 0, At, B0, ZF); PG8_MMA(0, 1, At, B1, ZF); PG8_BAR; PG8_SCHED;
            if constexpr (GATHER) { if (last && has_next) PG8_TOK_READ((ui + 1) & 1); }
            PG8_LDA(At, 0, 1); PG8_STAGE(PG8_SB(0, 0), b2, voffB); PG8_STAGE(PG8_SB(0, 1), b2 + hstep, voffB); PG8_STAGE_A(PG8_SA(0, 0), a2, 0);
            PG8_WAIT_V(8); PG8_WAIT_L(0); PG8_BAR; PG8_MMA(1, 0, At, B0, ZF); PG8_MMA(1, 1, At, B1, ZF); PG8_BAR; PG8_SCHED;
            PG8_LDB(B0, 1, 0); PG8_LDB(B1, 1, 1); PG8_SCHED; PG8_LDA(At, 1, 0); PG8_STAGE_A(PG8_SA(0, 1), a2, 1);
            PG8_WAIT_V(8); PG8_WAIT_L(0); PG8_BAR; PG8_MMA(0, 0, At, B0, false); PG8_MMA(0, 1, At, B1, false); PG8_BAR; PG8_SCHED;
            PG8_LDA(At, 1, 1); PG8_STAGE(PG8_SB(1, 0), b3, voffB); PG8_STAGE(PG8_SB(1, 1), b3 + hstep, voffB); PG8_STAGE_A(PG8_SA(1, 0), a3, 0);
            PG8_WAIT_V(8); PG8_WAIT_L(0); PG8_BAR; PG8_MMA(1, 0, At, B0, false); PG8_MMA(1, 1, At, B1, false); PG8_BAR; PG8_SCHED;
                }
#pragma unroll 1
        for (int t = 2; t < nt; t += 2) { constexpr bool ZF = false;
            const bool last = (t == nt - 2);
            const char* a1 = cA + (size_t)(t + 1) * kstep;
            const char* a2 = last ? nA : cA + (size_t)(t + 2) * kstep; const char* b2 = last ? nB : cB + (size_t)(t + 2) * kstep;
            const char* a3 = a2 + kstep; const char* b3 = b2 + kstep;
            PG8_LDB(B0, 0, 0); PG8_LDB(B1, 0, 1); PG8_SCHED; PG8_LDA(At, 0, 0); PG8_STAGE_A(PG8_SA(1, 1), a1, 1);
            PG8_WAIT_V(8); PG8_WAIT_L(0); PG8_BAR; PG8_MMA(0, 0, At, B0, ZF); PG8_MMA(0, 1, At, B1, ZF); PG8_BAR; PG8_SCHED;
            if constexpr (GATHER) { if (last && has_next) PG8_TOK_READ((ui + 1) & 1); }
            PG8_LDA(At, 0, 1); PG8_STAGE(PG8_SB(0, 0), b2, voffB); PG8_STAGE(PG8_SB(0, 1), b2 + hstep, voffB); PG8_STAGE_A(PG8_SA(0, 0), a2, 0);
            PG8_WAIT_V(8); PG8_WAIT_L(0); PG8_BAR; PG8_MMA(1, 0, At, B0, ZF); PG8_MMA(1, 1, At, B1, ZF); PG8_BAR; PG8_SCHED;
            PG8_LDB(B0, 1, 0); PG8_LDB(B1, 1, 1); PG8_SCHED; PG8_LDA(At, 1, 0); PG8_STAGE_A(PG8_SA(0, 1), a2, 1);
            PG8_WAIT_V(8); PG8_WAIT_L(0); PG8_BAR; PG8_MMA(0, 0, At, B0, false); PG8_MMA(0, 1, At, B1, false); PG8_BAR; PG8_SCHED;
            PG8_LDA(At, 1, 1); PG8_STAGE(PG8_SB(1, 0), b3, voffB); PG8_STAGE(PG8_SB(1, 1), b3 + hstep, voffB); PG8_STAGE_A(PG8_SA(1, 0), a3, 0);
            PG8_WAIT_V(8); PG8_WAIT_L(0); PG8_BAR; PG8_MMA(1, 0, At, B0, false); PG8_MMA(1, 1, At, B1, false); PG8_BAR; PG8_SCHED;
                }
        } else {
#pragma unroll
        for (int a = 0; a < 2; ++a)
#pragma unroll
            for (int b = 0; b < 2; ++b)
#pragma unroll
                for (int m = 0; m < 4; ++m)
#pragma unroll
                    for (int n = 0; n < 2; ++n) acc[a][b][m][n] = (f32x4){0.f, 0.f, 0.f, 0.f};
#pragma unroll 1
        for (int t = 0; t < nt; t += 2) { constexpr bool ZF = false;
            const bool last = (t == nt - 2);
            const char* a1 = cA + (size_t)(t + 1) * kstep;
            const char* a2 = last ? nA : cA + (size_t)(t + 2) * kstep; const char* b2 = last ? nB : cB + (size_t)(t + 2) * kstep;
            const char* a3 = a2 + kstep; const char* b3 = b2 + kstep;
            PG8_LDB(B0, 0, 0); PG8_LDB(B1, 0, 1); PG8_SCHED; PG8_LDA(At, 0, 0); PG8_STAGE_A(PG8_SA(1, 1), a1, 1);
            PG8_WAIT_V(8); PG8_WAIT_L(0); PG8_BAR; PG8_MMA(0, 0, At, B0, ZF); PG8_MMA(0, 1, At, B1, ZF); PG8_BAR; PG8_SCHED;
            if constexpr (GATHER) { if (last && has_next) PG8_TOK_READ((ui + 1) & 1); }
            PG8_LDA(At, 0, 1); PG8_STAGE(PG8_SB(0, 0), b2, voffB); PG8_STAGE(PG8_SB(0, 1), b2 + hstep, voffB); PG8_STAGE_A(PG8_SA(0, 0), a2, 0);
            PG8_WAIT_V(8); PG8_WAIT_L(0); PG8_BAR; PG8_MMA(1, 0, At, B0, ZF); PG8_MMA(1, 1, At, B1, ZF); PG8_BAR; PG8_SCHED;
            PG8_LDB(B0, 1, 0); PG8_LDB(B1, 1, 1); PG8_SCHED; PG8_LDA(At, 1, 0); PG8_STAGE_A(PG8_SA(0, 1), a2, 1);
            PG8_WAIT_V(8); PG8_WAIT_L(0); PG8_BAR; PG8_MMA(0, 0, At, B0, false); PG8_MMA(0, 1, At, B1, false); PG8_BAR; PG8_SCHED;
            PG8_LDA(At, 1, 1); PG8_STAGE(PG8_SB(1, 0), b3, voffB); PG8_STAGE(PG8_SB(1, 1), b3 + hstep, voffB); PG8_STAGE_A(PG8_SA(1, 0), a3, 0);
            PG8_WAIT_V(8); PG8_WAIT_L(0); PG8_BAR; PG8_MMA(1, 0, At, B0, false); PG8_MMA(1, 1, At, B1, false); PG8_BAR; PG8_SCHED;
                }
        }
        if constexpr (ALIGN_EPI) { if (wr == 0) PG8_BAR; }
        if constexpr (FP8) asm volatile("s_nop 15\n\ts_nop 15" ::: "memory");
        E(acc, cur, wr, wc, fr, fq);
        if (!has_next) break;
        cur = nxt; cA = nA; cB = nB; ++ui;
        if constexpr (ALIGN_EPI) { if (wr == 1) PG8_BAR; }
    }
    PG8_WAIT_V(0);
    if constexpr (!ALIGN_EPI) { if (wr == 0) PG8_BAR; }
    PG8_BAR;
#undef PG8_SA
#undef PG8_SB
#undef PG8_STAGE
#undef PG8_STAGE_A
#undef PG8_TOK_ISSUE
#undef PG8_TOK_READ
#undef PG8_LDA
#undef PG8_LDB
#undef PG8_MMA
#undef PG8_LD16
#undef PG8_WAIT_V
#undef PG8_WAIT_L
#undef PG8_BAR
#undef PG8_SCHED
}
}
#define LAS __attribute__((address_space(3)))
#define GAS __attribute__((address_space(1)))
constexpr int NWAVES = 8, NTHREADS = 512;
constexpr int LDS_BYTES = 163840;
constexpr int SCR_BYTES = 147456;
constexpr int LDSCTL_OFF = SCR_BYTES;
constexpr int TAB_OFF = LDSCTL_OFF + 512;
constexpr int TAB_CNT = 0, TAB_P0 = 32, TAB_TE = 72;
constexpr int TOKT_OFF = TAB_OFF + 2048;
#define LDS_WAIT() asm volatile("s_waitcnt lgkmcnt(0)" ::: "memory")
#define WAVE_SYNC() do { asm volatile("s_waitcnt lgkmcnt(0)" ::: "memory"); __builtin_amdgcn_wave_barrier(); } while (0)

#ifndef MOE_FP8
#define MOE_FP8 1
#endif
constexpr float W13_SCALE = 32.f, W2_SCALE = 16.f, ACT_SCALE = 4.f, Y_SCALE = 16.f;
struct Args {
    const float* in[27]; float* out; unsigned char* ws; int ph_lo, ph_hi;
};
struct Frame {
    LAS unsigned char* lds; LAS int* tab; unsigned* ctl; unsigned char* ws;
    int tid, lane, wave, G, bid, vcu;
};
enum Phase { PH_A = 0, PH_B, PH_C, PH_D, PH_E, PH_F, PH_G, PH_H, PH_I, PH_J, PH_N };

#define XB_TMO      128
#define XB_XCNT(j)  (256  + 64 * (j))
#define XB_XSUB(j)  (1280 + 64 * (j))
#define XB_XGEN(j)  (2304 + 64 * (j))
#define XB_TOP      3328
#define XB_TOPGEN   3392
#define XCD_BAR_WORDS 3456
#define XB_SPIN_CAP (1u << 18)
__device__ __forceinline__ unsigned xb_ld(unsigned* p)              { return __hip_atomic_load(p, __ATOMIC_RELAXED, __HIP_MEMORY_SCOPE_AGENT); }
__device__ __forceinline__ unsigned xb_add(unsigned* p, unsigned v) { return __hip_atomic_fetch_add(p, v, __ATOMIC_RELAXED, __HIP_MEMORY_SCOPE_AGENT); }
__device__ __forceinline__ unsigned xb_xcc_id() { return (unsigned)__builtin_amdgcn_s_getreg((3 << 11) | 20) & 0xFu; }
#define XB_SPIN(cond, bar) do { unsigned _sp = 0; while (cond) { __builtin_amdgcn_s_sleep(1); \
    if ((++_sp & 255u) == 0u) { if (xb_ld(&(bar)[XB_TMO])) break; if (_sp > XB_SPIN_CAP) { atomicAdd(&(bar)[XB_TMO], 1u); break; } } } } while (0)
struct XcdBarrier { unsigned* bar; unsigned x; volatile LAS unsigned* st; };
__device__ __forceinline__ XcdBarrier xcd_barrier_post(unsigned* bar, volatile LAS unsigned* st) {
    XcdBarrier b; b.bar = bar; b.x = xb_xcc_id(); b.st = st;
    if (threadIdx.x == 0) (void)xb_add(&bar[XB_XCNT(b.x)], 1u);
    return b;
}
__device__ __forceinline__ void xcd_barrier_complete(unsigned* bar, unsigned x, unsigned& nloc, unsigned& nx) {
    const unsigned G = gridDim.x * gridDim.y * gridDim.z;
    unsigned sum, cnt, mine, sp = 0u;
    for (;;) {
        sum = 0u; cnt = 0u; mine = 0u;
#pragma unroll
        for (unsigned j = 0; j < 16; ++j) { const unsigned c = xb_ld(&bar[XB_XCNT(j)]); sum += c; cnt += (c > 0u) ? 1u : 0u; mine = (j == x) ? c : mine; }
        if (sum == G) break;
        __builtin_amdgcn_s_sleep(1);
        if ((++sp & 255u) == 0u) { if (xb_ld(&bar[XB_TMO])) break; if (sp > XB_SPIN_CAP) { atomicAdd(&bar[XB_TMO], 1u); break; } }
    }
    nloc = mine > 0u ? mine : 1u; nx = cnt > 0u ? cnt : 1u;
}
__device__ __forceinline__ void xcd_barrier(const XcdBarrier& b) {
    asm volatile("s_waitcnt vmcnt(0)" ::: "memory");
    __syncthreads();
    if (threadIdx.x == 0) {
        unsigned* bar = b.bar;
        __builtin_amdgcn_s_waitcnt(0);
        unsigned nloc = b.st[0], nx = b.st[1];
        if (nloc == 0u) { xcd_barrier_complete(bar, b.x, nloc, nx); b.st[0] = nloc; b.st[1] = nx; }
        const unsigned old = xb_add(&bar[XB_XSUB(b.x)], 1u);
        const unsigned gen = old / nloc;
        if (old + 1u == (gen + 1u) * nloc) {
            __builtin_amdgcn_fence(__ATOMIC_RELEASE, "agent");
            asm volatile("s_waitcnt vmcnt(0)" ::: "memory");
            asm volatile("buffer_inv sc1" ::: "memory");
            const unsigned og = xb_add(&bar[XB_TOP], 1u);
            asm volatile("s_waitcnt vmcnt(0)" ::: "memory");
            const unsigned tg = og / nx;
            if (og + 1u == (tg + 1u) * nx) xb_add(&bar[XB_TOPGEN], 1u);
            else XB_SPIN(xb_ld(&bar[XB_TOPGEN]) == tg, bar);
            xb_add(&bar[XB_XGEN(b.x)], 1u);
            asm volatile("s_waitcnt vmcnt(0)" ::: "memory");
        } else {
            asm volatile("buffer_inv sc1" ::: "memory");
            XB_SPIN(xb_ld(&bar[XB_XGEN(b.x)]) == gen, bar);
            asm volatile("s_waitcnt vmcnt(0)" ::: "memory");
        }
        __builtin_amdgcn_fence(__ATOMIC_ACQUIRE, "workgroup");
    }
    __syncthreads();
}

__device__ __forceinline__ void build_moe_table(Frame& F) {
    __syncthreads();
    if (F.tid < 64) {
        const int c = F.tid < NE ? (int)__hip_atomic_load(F.ctl + CW_CNT + CNT_STRIDE * F.tid, __ATOMIC_RELAXED, __HIP_MEMORY_SCOPE_AGENT) : 0;
        const int nt = (c + 255) >> 8; int p = nt;
#pragma unroll
        for (int o = 1; o < 32; o <<= 1) { const int v = __shfl_up(p, o); if (F.lane >= o) p += v; }
        const int excl = p - nt;
        if (F.tid < NE) { F.tab[TAB_CNT + F.tid] = c; F.tab[TAB_P0 + F.tid] = excl; for (int j = 0; j < nt; ++j) F.tab[TAB_TE + excl + j] = F.tid; }
        if (F.tid == NE - 1) F.tab[TAB_P0 + NE] = p;
    }
    __syncthreads();
}

struct TItem { const float* W; unsigned char* WT; int N, K, blk, rstride, rbase, k0, n0, fp8; float scale; };
__device__ __forceinline__ void titem_load(const TItem& d, f32x4 (&v)[16], int lane) {
#pragma unroll
    for (int i = 0; i < 16; ++i) v[i] = *(const f32x4*)(d.W + (size_t)(d.k0 + 16 * (lane >> 5) + i) * d.N + d.n0 + 4 * (lane & 31));
}
__device__ __forceinline__ unsigned pk4_fp8_nc(float a, float b, float c, float d) {
    unsigned w = 0u; w = __builtin_amdgcn_cvt_pk_fp8_f32(a, b, w, false); w = __builtin_amdgcn_cvt_pk_fp8_f32(c, d, w, true); return w; }
__device__ __forceinline__ void titem_store(const TItem& d, const f32x4 (&v)[16], int lane) {
#pragma unroll
    for (int q = 0; q < 4; ++q) {
        const int n = d.n0 + 4 * (lane & 31) + q, row = d.rbase + (n / d.blk) * d.rstride + (n % d.blk);
        if (d.fp8) { const float sc = d.scale; u32x4 o;
            o.x = pk4_fp8_nc(v[0][q] * sc, v[1][q] * sc, v[2][q] * sc, v[3][q] * sc); o.y = pk4_fp8_nc(v[4][q] * sc, v[5][q] * sc, v[6][q] * sc, v[7][q] * sc);
            o.z = pk4_fp8_nc(v[8][q] * sc, v[9][q] * sc, v[10][q] * sc, v[11][q] * sc); o.w = pk4_fp8_nc(v[12][q] * sc, v[13][q] * sc, v[14][q] * sc, v[15][q] * sc);
            *(u32x4*)(d.WT + (size_t)row * d.K + d.k0 + 16 * (lane >> 5)) = o;
        } else { u32x4 o0, o1;
            o0.x = pk2(v[0][q], v[1][q]); o0.y = pk2(v[2][q], v[3][q]); o0.z = pk2(v[4][q], v[5][q]); o0.w = pk2(v[6][q], v[7][q]);
            o1.x = pk2(v[8][q], v[9][q]); o1.y = pk2(v[10][q], v[11][q]); o1.z = pk2(v[12][q], v[13][q]); o1.w = pk2(v[14][q], v[15][q]);
            unsigned char* p = d.WT + ((size_t)row * d.K + d.k0 + 16 * (lane >> 5)) * 2; *(u32x4*)p = o0; *(u32x4*)(p + 16) = o1; }
    }
}
#ifndef CONV_PRE
#define CONV_PRE 1
#endif
constexpr int TI_IN = 512, TI_OUT = 256, TI_EXP = 384 * NE, TI_N = TI_IN + TI_OUT + TI_EXP;
__device__ __forceinline__ void titem_decode(const Args& args, unsigned char* ws, int it, TItem& d) {
    int r = it, item; d.fp8 = 0; d.scale = 1.f; d.rstride = 0; d.rbase = 0;
    if (r < TI_IN) { d.W = args.in[5]; d.WT = ws + OFF_WIN; d.K = 1024; d.N = 2048; d.blk = 2048; item = r; }
    else if ((r -= TI_IN) < TI_OUT) { d.W = args.in[17]; d.WT = ws + OFF_WOUT; d.K = 1024; d.N = 1024; d.blk = 1024; item = r; }
    else { r -= TI_OUT; const int e = r / 384, q = r % 384;
        if (q < 256) { d.W = (q < 128 ? args.in[23] : args.in[24]) + (size_t)e * 1024 * 512; d.K = 1024; d.N = 512; d.blk = 128; d.rstride = 256; d.rbase = q < 128 ? 0 : 128; item = q & 127;
            d.WT = ws + OFF_W13 + (size_t)e * 1024 * 1024 * (MOE_FP8 ? 1 : 2); d.scale = W13_SCALE; }
        else { d.W = args.in[25] + (size_t)e * 512 * 1024; d.K = 512; d.N = 1024; d.blk = 1024; item = q - 256; d.WT = ws + OFF_W2 + (size_t)e * 1024 * 512 * (MOE_FP8 ? 1 : 2); d.scale = W2_SCALE; }
        d.fp8 = MOE_FP8; if (!MOE_FP8) d.scale = 1.f; }
    const int nkb = d.K / 32; d.k0 = 32 * (item % nkb); d.n0 = 128 * (item / nkb);
}
__device__ __forceinline__ void phase_A(Frame& F, const Args& args) {
    unsigned char* ws = F.ws;
    const float* c = args.in[1]; const float* ada_w = args.in[2]; const float* ada_b = args.in[3];
    float* mod = (float*)(ws + OFF_MOD);
    for (int it = F.G - 1 - F.bid; it < 192; it += F.G) {
        LAS float* sc = (LAS float*)F.lds; LAS float* red = sc + 8192;
        for (int i = F.tid; i < 8192; i += NTHREADS) { const float v = c[i]; sc[(i & 1023) * 8 + (i >> 10)] = v / (1.0f + __expf(-v)); }
        __syncthreads();
        const int col = F.lane & 31, ks = F.lane >> 5, n = it * 32 + col, k0 = F.wave * 128 + ks;
        float acc[8];
#pragma unroll
        for (int b = 0; b < 8; ++b) acc[b] = 0.f;
#pragma unroll 1
        for (int i0 = 0; i0 < 64; i0 += 16) {
            float wv[16];
#pragma unroll
            for (int i = 0; i < 16; ++i) wv[i] = ada_w[(size_t)(k0 + 2 * (i0 + i)) * 6144 + n];
#pragma unroll
            for (int i = 0; i < 16; ++i) { const int k = k0 + 2 * (i0 + i);
                const f32x4 s0 = *(const LAS f32x4*)(sc + k * 8), s1 = *(const LAS f32x4*)(sc + k * 8 + 4);
#pragma unroll
                for (int b = 0; b < 4; ++b) { acc[b] += s0[b] * wv[i]; acc[4 + b] += s1[b] * wv[i]; } }
        }
#pragma unroll
        for (int b = 0; b < 8; ++b) { acc[b] += __shfl_xor(acc[b], 32); if (ks == 0) red[(F.wave * 8 + b) * 32 + col] = acc[b]; }
        __syncthreads();
        if (F.tid < 256) { const int b = F.tid >> 5, cc = F.tid & 31; float s = ada_b[it * 32 + cc];
#pragma unroll
            for (int w = 0; w < 8; ++w) s += red[(w * 8 + b) * 32 + cc];
            mod[b * 6144 + it * 32 + cc] = s; }
        __syncthreads();
    }
    {
        const int gw = F.vcu * NWAVES + F.wave, NGW = F.G * NWAVES;
        const int it_end = (F.G == 256) ? TI_IN + TI_OUT : TI_N;
        int it = gw;
        if (it < it_end) {
            TItem d, d2; f32x4 v[16], v2[16];
            titem_decode(args, ws, it, d); titem_load(d, v, F.lane);
            for (;;) {
                const int itn = it + NGW; const bool more = itn < it_end;
                if (more) { titem_decode(args, ws, itn, d2); titem_load(d2, v2, F.lane); }
                titem_store(d, v, F.lane);
                if (!more) break;
                d = d2; it = itn;
#pragma unroll
                for (int i = 0; i < 16; ++i) v[i] = v2[i];
            }
        }
    }
    {
        const int gt = F.bid * NTHREADS + F.tid, NGT = F.G * NTHREADS;
        const float* sgu_w = args.in[15]; const float* rgw = args.in[19]; const float* rew = args.in[21]; const float* lam = args.in[12];
        bf16_t* SGUW = (bf16_t*)(ws + OFF_SGUW); bf16_t* ROUTW = (bf16_t*)(ws + OFF_ROUTW); float* N8SP = (float*)(ws + OFF_N8SP);
        for (int i = gt; i < 8 * 128 * 128; i += NGT) { const int ii = (i >> 7) & 127, j = i & 127; SGUW[i] = (bf16_t)(((j >> 6) <= (ii >> 6)) ? f2bf(sgu_w[i]) : 0u); }
        for (int i = gt; i < 48 * 1024; i += NGT) { const int n = i >> 10, k = i & 1023; const float v = n < 4 ? rgw[k * 4 + n] : (n < 36 ? rew[k * 32 + n - 4] : 0.f); ROUTW[i] = (bf16_t)f2bf(v); }
        for (int i = gt; i < 512; i += NGT) N8SP[i] = -8.0f * 1.4426950408889634f * log1pf(expf(-lam[i]));
        { float* GB = (float*)(ws + OFF_GBIAS); const float* gab_ = args.in[9]; const float* gib_ = args.in[11];
          for (int i = gt; i < 1024; i += NGT) GB[i] = -1.4426950408889634f * (i < 512 ? gab_[i] : gib_[i - 512]); }
        { const float* gaw = args.in[8]; const float* giw = args.in[10]; bf16_t* GATEW = (bf16_t*)(ws + OFF_GATEW);
          for (int i = gt; i < 8 * 128 * 64; i += NGT) { const int h = i >> 13, ee = (i >> 6) & 127, dd = i & 63; const float v = -1.4426950408889634f * (ee < 64 ? gaw : giw)[h * 4096 + dd * 64 + (ee & 63)]; GATEW[i] = (bf16_t)f2bf(v); } }
    }
}

__device__ __forceinline__ void convert_experts(Frame& F, const Args& args, int gw, int NGW, int first, int count) {
    unsigned char* ws = F.ws;
    int it = first + gw; const int it_end = first + count;
    if (it < it_end) {
        TItem d, d2; f32x4 v[16], v2[16];
        titem_decode(args, ws, TI_IN + TI_OUT + it, d); titem_load(d, v, F.lane);
        for (;;) {
            const int itn = it + NGW; const bool more = itn < it_end;
            if (more) { titem_decode(args, ws, TI_IN + TI_OUT + itn, d2); titem_load(d2, v2, F.lane); }
            titem_store(d, v, F.lane);
            if (!more) break;
            d = d2; it = itn;
#pragma unroll
            for (int i = 0; i < 16; ++i) v[i] = v2[i];
        }
    }
}

__device__ __forceinline__ void phase_B(Frame& F, const Args& args) {
    const float* x = args.in[0]; const float* g = args.in[4]; const float* mod = (const float*)(F.ws + OFF_MOD); bf16_t* XN = (bf16_t*)(F.ws + OFF_XN);
    const int gw = F.bid * NWAVES + F.wave, NGW = F.G * NWAVES, lane = F.lane;
    constexpr int RPW = 16;
    for (int item = gw; item < T / RPW; item += NGW) {
        const int row0 = item * RPW, b = row0 / SEQ;
        const float* sh = mod + b * 6144; const float* sc = sh + 1024;
        f32x4 gm[4], sv[4];
#pragma unroll
        for (int j = 0; j < 4; ++j) { const int col = 4 * (lane + 64 * j); const f32x4 gg = *(const f32x4*)(g + col), s1 = *(const f32x4*)(sc + col); sv[j] = *(const f32x4*)(sh + col); gm[j] = gg * (1.0f + s1); }
        f32x4 v[4], nv[4];
#pragma unroll
        for (int j = 0; j < 4; ++j) v[j] = ((const f32x4*)(x + (size_t)row0 * D))[lane + 64 * j];
#pragma unroll 1
        for (int r = 0; r < RPW; ++r) {
            const int row = row0 + r, nrow = (r + 1 < RPW) ? row + 1 : row;
#pragma unroll
            for (int j = 0; j < 4; ++j) nv[j] = ((const f32x4*)(x + (size_t)nrow * D))[lane + 64 * j];
            float ss = 0.f;
#pragma unroll
            for (int j = 0; j < 4; ++j) ss += v[j][0] * v[j][0] + v[j][1] * v[j][1] + v[j][2] * v[j][2] + v[j][3] * v[j][3];
            const float rs = rsqrtf(wave_sum(ss) * (1.0f / D) + EPS);
#pragma unroll
            for (int j = 0; j < 4; ++j) { const int col = 4 * (lane + 64 * j); const f32x4 h = v[j] * rs * gm[j] + sv[j];
                u32x2 o; o.x = pk2(h[0], h[1]); o.y = pk2(h[2], h[3]);
                *(u32x2*)(XN + (size_t)row * D + col) = o; v[j] = nv[j]; }
        }
    }
}

#ifndef SGU_TR
#define SGU_TR 1
#endif
typedef short s16x4 __attribute__((ext_vector_type(4)));
typedef short v4i16_t __attribute__((ext_vector_type(4)));
constexpr int IMG_STRIDE = 1040;
__device__ __forceinline__ float bflo(unsigned w) { return __uint_as_float(w << 16); }
__device__ __forceinline__ float bfhi(unsigned w) { return __uint_as_float(w & 0xffff0000u); }
__device__ __forceinline__ void sgu_block(Frame& F, const Args& args, int blk) {
    const bf16_t* Z = (const bf16_t*)(F.ws + OFF_Z); bf16_t* YMIX = (bf16_t*)(F.ws + OFF_YMIX); const bf16_t* SGUW = (const bf16_t*)(F.ws + OFF_SGUW);
    const float* ln_g = args.in[13]; const float* ln_b = args.in[14]; const float* sgu_b = args.in[16];
    const int lane = F.lane, w = F.wave; const size_t t0 = (size_t)blk * 128;
    {
        u32x4 raw[16];
#pragma unroll
        for (int r = 0; r < 16; ++r) raw[r] = *(const u32x4*)(Z + (t0 + w * 16 + r) * 2048 + 1536 + 8 * lane);
        const f32x4 g0 = *(const f32x4*)(ln_g + 8 * lane), g1 = *(const f32x4*)(ln_g + 8 * lane + 4), b0 = *(const f32x4*)(ln_b + 8 * lane), b1 = *(const f32x4*)(ln_b + 8 * lane + 4);
#pragma unroll
        for (int r = 0; r < 16; ++r) {
            float v[8];
#pragma unroll
            for (int q = 0; q < 4; ++q) { v[2 * q] = bflo(raw[r][q]); v[2 * q + 1] = bfhi(raw[r][q]); }
            float s = 0.f;
#pragma unroll
            for (int q = 0; q < 8; ++q) s += v[q];
            const float mu = wave_sum(s) * (1.0f / 512.0f);
            float s2 = 0.f;
#pragma unroll
            for (int q = 0; q < 8; ++q) { v[q] -= mu; s2 += v[q] * v[q]; }
            const float rstd = rsqrtf(wave_sum(s2) * (1.0f / 512.0f) + EPS);
            u32x4 o;
            o.x = pk2(v[0] * rstd * g0[0] + b0[0], v[1] * rstd * g0[1] + b0[1]); o.y = pk2(v[2] * rstd * g0[2] + b0[2], v[3] * rstd * g0[3] + b0[3]);
            o.z = pk2(v[4] * rstd * g1[0] + b1[0], v[5] * rstd * g1[1] + b1[1]); o.w = pk2(v[6] * rstd * g1[2] + b1[2], v[7] * rstd * g1[3] + b1[3]);
            *(LAS u32x4*)(F.lds + (w * 16 + r) * IMG_STRIDE + 16 * lane) = o;
        }
    }
    __syncthreads();
    {
        const int g = w;
        int fr = lane & 15, fq = lane >> 4; asm volatile("" : "+v"(fr), "+v"(fq));
        bf16x8 af[4][4];
#pragma unroll
        for (int kt = 0; kt < 4; ++kt)
#pragma unroll
            for (int ct = 0; ct < 4; ++ct) {
#if SGU_TR
                LAS unsigned char* p = F.lds + (32 * kt + 8 * fq + (fr >> 2)) * IMG_STRIDE + (g * 64 + 32 * (ct >> 1) + 8 * (fr & 3) + 4 * (ct & 1)) * 2;
                const s16x4 lo = __builtin_bit_cast(s16x4, __builtin_amdgcn_ds_read_tr16_b64_v4i16((LAS v4i16_t*)p));
                const s16x4 hi = __builtin_bit_cast(s16x4, __builtin_amdgcn_ds_read_tr16_b64_v4i16((LAS v4i16_t*)(p + 4 * IMG_STRIDE)));
                af[kt][ct] = (bf16x8){lo[0], lo[1], lo[2], lo[3], hi[0], hi[1], hi[2], hi[3]};
#else
                const LAS bf16_t* p = (const LAS bf16_t*)(F.lds + (32 * kt + 8 * fq) * IMG_STRIDE) + g * 64 + 16 * (fr >> 2) + 4 * ct + (fr & 3);
#pragma unroll
                for (int e = 0; e < 8; ++e) af[kt][ct][e] = (short)p[e * (IMG_STRIDE / 2)];
#endif
            }
        bf16x8 wf[4], nwf[4]; u32x4 gu0, gu1, ngu0, ngu1; float bias, nbias;
        { const bf16_t* wp = SGUW + ((size_t)(g * 128 + fr)) * 128 + 8 * fq;
#pragma unroll
          for (int kt = 0; kt < 4; ++kt) wf[kt] = *(const bf16x8*)(wp + 32 * kt);
          const size_t t = t0 + fr; gu0 = *(const u32x4*)(Z + t * 2048 + 1024 + g * 64 + 8 * fq); gu1 = *(const u32x4*)(Z + t * 2048 + 1024 + g * 64 + 32 + 8 * fq); bias = sgu_b[g * 128 + fr]; }
#pragma unroll 1
        for (int it = 0; it < 8; ++it) {
            const int i0 = 16 * it, in0 = it < 7 ? i0 + 16 : i0;
            { const bf16_t* wp = SGUW + ((size_t)(g * 128 + in0 + fr)) * 128 + 8 * fq;
#pragma unroll
              for (int kt = 0; kt < 4; ++kt) nwf[kt] = *(const bf16x8*)(wp + 32 * kt);
              const size_t tn = t0 + in0 + fr; ngu0 = *(const u32x4*)(Z + tn * 2048 + 1024 + g * 64 + 8 * fq); ngu1 = *(const u32x4*)(Z + tn * 2048 + 1024 + g * 64 + 32 + 8 * fq); nbias = sgu_b[g * 128 + in0 + fr]; }
            f32x4 acc[4];
#pragma unroll
            for (int ct = 0; ct < 4; ++ct) acc[ct] = (f32x4){0.f, 0.f, 0.f, 0.f};
#pragma unroll
            for (int kt = 0; kt < 4; ++kt)
#pragma unroll
                for (int ct = 0; ct < 4; ++ct) acc[ct] = __builtin_amdgcn_mfma_f32_16x16x32_bf16(af[kt][ct], wf[kt], acc[ct], 0, 0, 0);
            const size_t t = t0 + i0 + fr;
            u32x4 o0, o1;
            o0.x = pk2(bflo(gu0.x) * (acc[0][0] + bias), bfhi(gu0.x) * (acc[0][1] + bias)); o0.y = pk2(bflo(gu0.y) * (acc[0][2] + bias), bfhi(gu0.y) * (acc[0][3] + bias));
            o0.z = pk2(bflo(gu0.z) * (acc[1][0] + bias), bfhi(gu0.z) * (acc[1][1] + bias)); o0.w = pk2(bflo(gu0.w) * (acc[1][2] + bias), bfhi(gu0.w) * (acc[1][3] + bias));
            o1.x = pk2(bflo(gu1.x) * (acc[2][0] + bias), bfhi(gu1.x) * (acc[2][1] + bias)); o1.y = pk2(bflo(gu1.y) * (acc[2][2] + bias), bfhi(gu1.y) * (acc[2][3] + bias));
            o1.z = pk2(bflo(gu1.z) * (acc[3][0] + bias), bfhi(gu1.z) * (acc[3][1] + bias)); o1.w = pk2(bflo(gu1.w) * (acc[3][2] + bias), bfhi(gu1.w) * (acc[3][3] + bias));
            *(u32x4*)(YMIX + t * D + 512 + g * 64 + 8 * fq) = o0; *(u32x4*)(YMIX + t * D + 512 + g * 64 + 32 + 8 * fq) = o1;
#pragma unroll
            for (int kt = 0; kt < 4; ++kt) wf[kt] = nwf[kt];
            gu0 = ngu0; gu1 = ngu1; bias = nbias;
        }
    }
}

constexpr int XC_STRIDE = 144;
constexpr int AU_STRIDE = 68;
constexpr int LRU_WAVE_BYTES = 64 * XC_STRIDE + 2 * 16 * AU_STRIDE * 4;
__device__ __forceinline__ float sigm_fast(float x) { return __builtin_amdgcn_rcpf(1.0f + __builtin_amdgcn_exp2f(-1.4426950408889634f * x)); }
template <int PASS>
__device__ __forceinline__ void lru_block(Frame& F, const Args& args, int blk) {
    const bf16_t* Z = (const bf16_t*)(F.ws + OFF_Z); bf16_t* YMIX = (bf16_t*)(F.ws + OFF_YMIX); const bf16_t* GATEW = (const bf16_t*)(F.ws + OFF_GATEW);
    const float* N8SP = (const float*)(F.ws + OFF_N8SP); float* CA = (float*)(F.ws + OFF_CARRY); float* CH = CA + 256 * 512;
    const float* cw = args.in[6]; const float* cb = args.in[7]; const float* gab = (const float*)(F.ws + OFF_GBIAS); const float* gib = gab + 512;
    const int lane = F.lane, h = F.wave, fr = lane & 15, fq = lane >> 4, cg = lane & 7, run = lane >> 3; const size_t t0 = (size_t)blk * 128;
    LAS unsigned char* xcT = F.lds + h * LRU_WAVE_BYTES; LAS float* Abuf = (LAS float*)(xcT + 64 * XC_STRIDE); LAS float* Ubuf = Abuf + 16 * AU_STRIDE;
    float hst = 0.f, pp = 1.f;
    if (PASS == 2) { const int b0 = blk & ~31, n = blk & 31;
        float ca[31], ch[31];
#pragma unroll
        for (int k = 0; k < 31; ++k) { const int kk = k < n ? k : 0; ca[k] = CA[(size_t)(b0 + kk) * 512 + 64 * h + lane]; ch[k] = CH[(size_t)(b0 + kk) * 512 + 64 * h + lane]; }
#pragma unroll
        for (int k = 0; k < 31; ++k) hst = k < n ? ca[k] * hst + ch[k] : hst; }
    bf16x8 gw[8][2];
#pragma unroll
    for (int et = 0; et < 8; ++et)
#pragma unroll
        for (int kt = 0; kt < 2; ++kt) gw[et][kt] = *(const bf16x8*)(GATEW + ((size_t)(h * 128 + 16 * et + fr)) * 64 + 32 * kt + 8 * fq);
    const bool seq_start = (blk & 31) == 0;
#pragma unroll 1
    for (int hb = 0; hb < 2; ++hb) {
        const size_t tb = t0 + 64 * hb;
        {
            float cwv[4][8], cbv[8];
#pragma unroll
            for (int k = 0; k < 4; ++k) { const f32x4 a = *(const f32x4*)(cw + k * 512 + 64 * h + 8 * cg), b = *(const f32x4*)(cw + k * 512 + 64 * h + 8 * cg + 4);
#pragma unroll
                for (int q = 0; q < 4; ++q) { cwv[k][q] = a[q]; cwv[k][4 + q] = b[q]; } }
            { const f32x4 a = *(const f32x4*)(cb + 64 * h + 8 * cg), b = *(const f32x4*)(cb + 64 * h + 8 * cg + 4);
#pragma unroll
              for (int q = 0; q < 4; ++q) { cbv[q] = a[q]; cbv[4 + q] = b[q]; } }
            u32x4 xr[11];
#pragma unroll
            for (int j = 0; j < 11; ++j) { const int rel = 8 * run - 3 + j;
                const bool pad = (j < 3) && (rel < 0) && (hb == 0) && seq_start;
                const u32x4 v = *(const u32x4*)(Z + (size_t)((long)tb + (pad ? 0 : rel)) * 2048 + 64 * h + 8 * cg);
                xr[j] = pad ? (u32x4){0u, 0u, 0u, 0u} : v; }
#pragma unroll
            for (int s = 0; s < 8; ++s) { float o[8];
#pragma unroll
                for (int q = 0; q < 8; ++q) o[q] = cbv[q];
#pragma unroll
                for (int k = 0; k < 4; ++k) { const u32x4 r = xr[s + k];
#pragma unroll
                    for (int q = 0; q < 4; ++q) { o[2 * q] += cwv[k][2 * q] * bflo(r[q]); o[2 * q + 1] += cwv[k][2 * q + 1] * bfhi(r[q]); } }
                u32x4 pkd; pkd.x = pk2(o[0], o[1]); pkd.y = pk2(o[2], o[3]); pkd.z = pk2(o[4], o[5]); pkd.w = pk2(o[6], o[7]);
                *(LAS u32x4*)(xcT + (8 * run + s) * XC_STRIDE + 16 * cg) = pkd; }
        }
        WAVE_SYNC();
        u32x4 g0 = {0u, 0u, 0u, 0u}, g1 = g0, ng0 = g0, ng1 = g0;
        if (PASS == 2) { const size_t t = tb + (lane >> 2); g0 = *(const u32x4*)(Z + t * 2048 + 512 + 64 * h + 8 * (lane & 3)); g1 = *(const u32x4*)(Z + t * 2048 + 512 + 64 * h + 32 + 8 * (lane & 3)); }
#pragma unroll 1
        for (int it = 0; it < 4; ++it) {
            if (PASS == 2) { const size_t t = tb + 16 * (it < 3 ? it + 1 : it) + (lane >> 2); ng0 = *(const u32x4*)(Z + t * 2048 + 512 + 64 * h + 8 * (lane & 3)); ng1 = *(const u32x4*)(Z + t * 2048 + 512 + 64 * h + 32 + 8 * (lane & 3)); }
            bf16x8 xf[2];
#pragma unroll
            for (int kt = 0; kt < 2; ++kt) xf[kt] = *(const LAS bf16x8*)(xcT + (16 * it + fr) * XC_STRIDE + (32 * kt + 8 * fq) * 2);
            int fqv = fq; asm volatile("" : "+v"(fqv));
            f32x4 acc[8];
#pragma unroll
            for (int et = 0; et < 4; ++et) { acc[et] = *(const f32x4*)(gab + 64 * h + 16 * et + 4 * fqv); acc[4 + et] = *(const f32x4*)(gib + 64 * h + 16 * et + 4 * fqv); }
#pragma unroll
            for (int et = 0; et < 8; ++et)
#pragma unroll
                for (int kt = 0; kt < 2; ++kt) acc[et] = __builtin_amdgcn_mfma_f32_16x16x32_bf16(gw[et][kt], xf[kt], acc[et], 0, 0, 0);
#pragma unroll
            for (int et = 0; et < 4; ++et) {
                const f32x4 sp = *(const f32x4*)(N8SP + 64 * h + 16 * et + 4 * fqv);
                const u32x2 xw = *(const LAS u32x2*)(xcT + (16 * it + fr) * XC_STRIDE + (16 * et + 4 * fq) * 2);
                const float xv[4] = {bflo(xw.x), bfhi(xw.x), bflo(xw.y), bfhi(xw.y)};
                f32x4 av, uv;
#pragma unroll
                for (int r = 0; r < 4; ++r) {
                    const float rg = __builtin_amdgcn_rcpf(1.0f + __builtin_amdgcn_exp2f(acc[et][r])), ig = __builtin_amdgcn_rcpf(1.0f + __builtin_amdgcn_exp2f(acc[4 + et][r]));
                    const float a = __builtin_amdgcn_exp2f(rg * sp[r]);
                    av[r] = a;
                    uv[r] = __builtin_amdgcn_sqrtf(__builtin_fmaf(-a, a, 1.0f)) * (ig * xv[r]);
                }
                *(LAS f32x4*)(Abuf + fr * AU_STRIDE + 16 * et + 4 * fq) = av; *(LAS f32x4*)(Ubuf + fr * AU_STRIDE + 16 * et + 4 * fq) = uv;
            }
            WAVE_SYNC();
            {
                float a[16], u[16];
#pragma unroll
                for (int tk = 0; tk < 16; ++tk) { a[tk] = Abuf[tk * AU_STRIDE + lane]; u[tk] = Ubuf[tk * AU_STRIDE + lane]; }
#pragma unroll
                for (int tk = 0; tk < 16; ++tk) { hst = a[tk] * hst + u[tk]; if (PASS == 1) pp *= a[tk]; else Ubuf[tk * AU_STRIDE + lane] = hst; }
            }
            if (PASS == 2) {
                WAVE_SYNC();
                const int tok = lane >> 2, cq = lane & 3; const size_t t = tb + 16 * it + tok;
                const LAS float* hp = Ubuf + tok * AU_STRIDE + 8 * cq;
                const f32x4 h0 = *(const LAS f32x4*)(hp), h1 = *(const LAS f32x4*)(hp + 4), h2 = *(const LAS f32x4*)(hp + 32), h3 = *(const LAS f32x4*)(hp + 36);
                u32x4 o0, o1;
                o0.x = pk2(h0[0] * bflo(g0.x), h0[1] * bfhi(g0.x)); o0.y = pk2(h0[2] * bflo(g0.y), h0[3] * bfhi(g0.y));
                o0.z = pk2(h1[0] * bflo(g0.z), h1[1] * bfhi(g0.z)); o0.w = pk2(h1[2] * bflo(g0.w), h1[3] * bfhi(g0.w));
                o1.x = pk2(h2[0] * bflo(g1.x), h2[1] * bfhi(g1.x)); o1.y = pk2(h2[2] * bflo(g1.y), h2[3] * bfhi(g1.y));
                o1.z = pk2(h3[0] * bflo(g1.z), h3[1] * bfhi(g1.z)); o1.w = pk2(h3[2] * bflo(g1.w), h3[3] * bfhi(g1.w));
                *(u32x4*)(YMIX + t * D + 64 * h + 8 * cq) = o0; *(u32x4*)(YMIX + t * D + 64 * h + 32 + 8 * cq) = o1;
                g0 = ng0; g1 = ng1;
            }
            WAVE_SYNC();
        }
    }
    if (PASS == 1) { CA[(size_t)blk * 512 + 64 * h + lane] = pp; CH[(size_t)blk * 512 + 64 * h + lane] = hst; }
}

constexpr int HT_STRIDE = 2064;
constexpr int RG_W_OFF = 0, RG_H_OFF = 36 * HT_STRIDE, RG_LOG_OFF = RG_H_OFF + 32 * HT_STRIDE, RG_MISC_OFF = RG_LOG_OFF + 32 * 48 * 4;
static_assert(RG_MISC_OFF + 256 <= SCR_BYTES, "phase G LDS map");
__device__ __forceinline__ void phase_G(Frame& F, const Args& args) {
    const bf16_t* X1 = (const bf16_t*)(F.ws + OFF_X1); bf16_t* H2 = (bf16_t*)(F.ws + OFF_XN); const bf16_t* ROUTW = (const bf16_t*)(F.ws + OFF_ROUTW);
    const float* mod = (const float*)(F.ws + OFF_MOD); const float* g2w = args.in[18]; const float* bg = args.in[20]; const float* be = args.in[22];
    int* list = (int*)(F.ws + OFF_LIST); int* toke = (int*)(F.ws + OFF_TOKE); float* tokw = (float*)(F.ws + OFF_TOKW); int* tokp = (int*)(F.ws + OFF_TOKP);
    const int lane = F.lane, w = F.wave, fr = lane & 15, fq = lane >> 4;
    LAS float* LG = (LAS float*)(F.lds + RG_LOG_OFF); LAS int* hist = (LAS int*)(F.lds + RG_MISC_OFF); LAS int* base = hist + 32;
    __syncthreads();
    for (int i = F.tid; i < 36 * 128; i += NTHREADS) { const int r = i >> 7, c = i & 127; *(LAS u32x4*)(F.lds + RG_W_OFF + r * HT_STRIDE + c * 16) = *(const u32x4*)(ROUTW + (size_t)r * 1024 + c * 8); }
    for (int grp = F.bid; grp < T / 128; grp += F.G) {
        const int grow0 = grp * 128, b = grow0 / SEQ;
        const float* sh = mod + b * 6144 + 3072; const float* sc = sh + 1024;
        float gm[16], sv[16];
#pragma unroll
        for (int jj = 0; jj < 2; ++jj)
#pragma unroll
            for (int q = 0; q < 8; ++q) { const int c = 512 * jj + 8 * lane + q; gm[8 * jj + q] = g2w[c] * (1.0f + sc[c]); sv[8 * jj + q] = sh[c]; }
        if (F.tid < 32) hist[F.tid] = 0;
        u32x4 raw[4][2];
#pragma unroll
        for (int r = 0; r < 4; ++r)
#pragma unroll
            for (int jj = 0; jj < 2; ++jj) raw[r][jj] = *(const u32x4*)(X1 + (size_t)(grow0 + 4 * w + r) * D + 512 * jj + 8 * lane);
        int e1 = 0, e2 = 0, l1 = 0, l2 = 0; float w1 = 0.f, w2 = 0.f;
#pragma unroll 1
        for (int ti = 0; ti < 4; ++ti) {
            const int row0 = grow0 + 32 * ti;
#pragma unroll
            for (int r = 0; r < 4; ++r) {
                float h[16]; float ss = 0.f;
#pragma unroll
                for (int jj = 0; jj < 2; ++jj)
#pragma unroll
                    for (int q = 0; q < 4; ++q) { h[8 * jj + 2 * q] = bflo(raw[r][jj][q]); h[8 * jj + 2 * q + 1] = bfhi(raw[r][jj][q]); }
#pragma unroll
                for (int q = 0; q < 16; ++q) ss += h[q] * h[q];
                const float rs = rsqrtf(wave_sum(ss) * (1.0f / D) + EPS);
#pragma unroll
                for (int jj = 0; jj < 2; ++jj) { u32x4 o; float hv[8];
#pragma unroll
                    for (int q = 0; q < 8; ++q) hv[q] = h[8 * jj + q] * rs * gm[8 * jj + q] + sv[8 * jj + q];
#pragma unroll
                    for (int q = 0; q < 4; ++q) o[q] = pk2(hv[2 * q], hv[2 * q + 1]);
#if MOE_FP8
                    { u32x2 f; f.x = pg8::pk4_fp8(hv[0], hv[1], hv[2], hv[3]); f.y = pg8::pk4_fp8(hv[4], hv[5], hv[6], hv[7]);
                      *(u32x2*)((unsigned char*)H2 + (size_t)(row0 + 4 * w + r) * D + 512 * jj + 8 * lane) = f; }
#else
                    *(u32x4*)(H2 + (size_t)(row0 + 4 * w + r) * D + 512 * jj + 8 * lane) = o;
#endif
                    *(LAS u32x4*)(F.lds + RG_H_OFF + (4 * w + r) * HT_STRIDE + (512 * jj + 8 * lane) * 2) = o; }
            }
            if (ti < 3) {
#pragma unroll
                for (int r = 0; r < 4; ++r)
#pragma unroll
                    for (int jj = 0; jj < 2; ++jj) raw[r][jj] = *(const u32x4*)(X1 + (size_t)(row0 + 32 + 4 * w + r) * D + 512 * jj + 8 * lane);
            }
            __syncthreads();
            if (w < 6) {
                const int rt = w / 3, ct = w % 3; int wrow = 16 * ct + fr; wrow = wrow < 36 ? wrow : 35;
                const LAS unsigned char* hp = F.lds + RG_H_OFF + (16 * rt + fr) * HT_STRIDE + 16 * fq; const LAS unsigned char* wp = F.lds + RG_W_OFF + wrow * HT_STRIDE + 16 * fq;
                f32x4 acc0 = {0.f, 0.f, 0.f, 0.f}, acc1 = {0.f, 0.f, 0.f, 0.f};
#pragma unroll 8
                for (int kt = 0; kt < 32; kt += 2) {
                    acc0 = __builtin_amdgcn_mfma_f32_16x16x32_bf16(*(const LAS bf16x8*)(wp + 64 * kt), *(const LAS bf16x8*)(hp + 64 * kt), acc0, 0, 0, 0);
                    acc1 = __builtin_amdgcn_mfma_f32_16x16x32_bf16(*(const LAS bf16x8*)(wp + 64 * kt + 64), *(const LAS bf16x8*)(hp + 64 * kt + 64), acc1, 0, 0, 0); }
                *(LAS f32x4*)(LG + (16 * rt + fr) * 48 + 16 * ct + 4 * fq) = acc0 + acc1;
            }
            __syncthreads();
            if ((F.tid >> 5) == ti) {
                const LAS float* L = LG + (F.tid & 31) * 48;
                float gl[4], el[8];
#pragma unroll
                for (int j = 0; j < 4; ++j) gl[j] = L[j] + bg[j];
                int gs = 0; float gmax = gl[0];
#pragma unroll
                for (int j = 1; j < 4; ++j) if (gl[j] > gmax) { gmax = gl[j]; gs = j; }
#pragma unroll
                for (int j = 0; j < 8; ++j) el[j] = L[4 + gs * 8 + j] + be[gs * 8 + j];
                float gsum = 0.f;
#pragma unroll
                for (int j = 0; j < 4; ++j) gsum += __expf(gl[j] - gmax);
                const float pg = 1.0f / gsum;
                int i1 = 0; float m1 = el[0];
#pragma unroll
                for (int j = 1; j < 8; ++j) if (el[j] > m1) { m1 = el[j]; i1 = j; }
                int i2 = -1; float m2 = -INFINITY;
#pragma unroll
                for (int j = 0; j < 8; ++j) if (j != i1 && el[j] > m2) { m2 = el[j]; i2 = j; }
                const float r = __expf(m2 - m1);
                w1 = pg / (1.0f + r); w2 = pg * r / (1.0f + r); e1 = gs * 8 + i1; e2 = gs * 8 + i2;
                l1 = __hip_atomic_fetch_add(hist + e1, 1, __ATOMIC_RELAXED, __HIP_MEMORY_SCOPE_WORKGROUP);
                l2 = __hip_atomic_fetch_add(hist + e2, 1, __ATOMIC_RELAXED, __HIP_MEMORY_SCOPE_WORKGROUP);
            }
        }
        __syncthreads();
        if (F.tid < 32) { const int n = hist[F.tid]; base[F.tid] = n ? (int)__hip_atomic_fetch_add(F.ctl + CW_CNT + CNT_STRIDE * F.tid, (unsigned)n, __ATOMIC_RELAXED, __HIP_MEMORY_SCOPE_AGENT) : 0; }
        __syncthreads();
        if (F.tid < 128) { const int row = grow0 + F.tid, p1 = base[e1] + l1, p2 = base[e2] + l2;
            list[(size_t)e1 * LISTCAP + p1] = row; list[(size_t)e2 * LISTCAP + p2] = row;
            toke[2 * row] = e1; toke[2 * row + 1] = e2; tokw[2 * row] = w1; tokw[2 * row + 1] = w2; tokp[2 * row] = p1; tokp[2 * row + 1] = p2; }
        __syncthreads();
    }
}

__device__ __forceinline__ void phase_J(Frame& F, const Args& args) {
    const bf16_t* X1 = (const bf16_t*)(F.ws + OFF_X1); const bf16_t* Y = (const bf16_t*)(F.ws + OFF_Y); const float* mod = (const float*)(F.ws + OFF_MOD);
    const int* toke = (const int*)(F.ws + OFF_TOKE); const float* tokw = (const float*)(F.ws + OFF_TOKW); const int* tokp = (const int*)(F.ws + OFF_TOKP);
    const float* fg = args.in[26]; float* out = args.out;
    const int gw = F.bid * NWAVES + F.wave, NGW = F.G * NWAVES, lane = F.lane;
    constexpr int RPW = 16;
    for (int item = gw; item < T / RPW; item += NGW) {
        const int row0 = item * RPW, b = row0 / SEQ;
        int q0l = 0, q1l = 0; float w0l = 0.f, w1l = 0.f;
        { const int rr = row0 + (lane & 15); const int e0 = toke[2 * rr], e1 = toke[2 * rr + 1];
          q0l = F.tab[TAB_P0 + e0] * 256 + tokp[2 * rr]; q1l = F.tab[TAB_P0 + e1] * 256 + tokp[2 * rr + 1]; w0l = tokw[2 * rr]; w1l = tokw[2 * rr + 1]; }
        const float* g2 = mod + b * 6144 + 5120;
        f32x4 g2v[4], fgv[4];
#pragma unroll
        for (int jj = 0; jj < 2; ++jj)
#pragma unroll
            for (int hh = 0; hh < 2; ++hh) { const int c = 512 * jj + 8 * lane + 4 * hh; g2v[2 * jj + hh] = *(const f32x4*)(g2 + c); fgv[2 * jj + hh] = *(const f32x4*)(fg + c); }
#if MOE_FP8
        typedef u32x2 yvec; const unsigned char* Yb = (const unsigned char*)Y;
#define YLOAD(q_, c0_) (*(const u32x2*)(Yb + (q_) * D + (c0_)))
#define YUNPACK(v_, o_) do { const auto a0_ = __builtin_amdgcn_cvt_pk_f32_fp8((v_).x, false), a1_ = __builtin_amdgcn_cvt_pk_f32_fp8((v_).x, true), a2_ = __builtin_amdgcn_cvt_pk_f32_fp8((v_).y, false), a3_ = __builtin_amdgcn_cvt_pk_f32_fp8((v_).y, true); \
        o_[0] = a0_[0]; o_[1] = a0_[1]; o_[2] = a1_[0]; o_[3] = a1_[1]; o_[4] = a2_[0]; o_[5] = a2_[1]; o_[6] = a3_[0]; o_[7] = a3_[1]; } while (0)
        constexpr float YINV = 1.0f / Y_SCALE;
#else
        typedef u32x4 yvec;
#define YLOAD(q_, c0_) (*(const u32x4*)(Y + (q_) * D + (c0_)))
#define YUNPACK(v_, o_) do { _Pragma("unroll") for (int q_ = 0; q_ < 4; ++q_) { o_[2 * q_] = bflo((v_)[q_]); o_[2 * q_ + 1] = bfhi((v_)[q_]); } } while (0)
        constexpr float YINV = 1.0f;
#endif
        u32x4 xr[2], nxr[2]; yvec ya[2], yb[2], nya[2], nyb[2];
        { const size_t q0 = (size_t)__shfl(q0l, 0), q1 = (size_t)__shfl(q1l, 0);
#pragma unroll
          for (int jj = 0; jj < 2; ++jj) { const int c0 = 512 * jj + 8 * lane; xr[jj] = *(const u32x4*)(X1 + (size_t)row0 * D + c0); ya[jj] = YLOAD(q0, c0); yb[jj] = YLOAD(q1, c0); } }
#pragma unroll 1
        for (int r = 0; r < RPW; ++r) {
            const int row = row0 + r, rn = (r + 1 < RPW) ? r + 1 : r;
            { const size_t q0 = (size_t)__shfl(q0l, rn), q1 = (size_t)__shfl(q1l, rn);
#pragma unroll
              for (int jj = 0; jj < 2; ++jj) { const int c0 = 512 * jj + 8 * lane; nxr[jj] = *(const u32x4*)(X1 + (size_t)(row0 + rn) * D + c0); nya[jj] = YLOAD(q0, c0); nyb[jj] = YLOAD(q1, c0); } }
            const float w0 = __shfl(w0l, r), w1 = __shfl(w1l, r);
            float v[16]; float ss = 0.f;
#pragma unroll
            for (int jj = 0; jj < 2; ++jj) { float yav[8], ybv[8]; YUNPACK(ya[jj], yav); YUNPACK(yb[jj], ybv);
#pragma unroll
                for (int q = 0; q < 4; ++q) {
                    const float y0 = (w0 * yav[2 * q] + w1 * ybv[2 * q]) * YINV, y1 = (w0 * yav[2 * q + 1] + w1 * ybv[2 * q + 1]) * YINV;
                    const f32x4 gg = g2v[2 * jj + (q >> 1)];
                    v[8 * jj + 2 * q] = bflo(xr[jj][q]) + gg[(2 * q) & 3] * y0; v[8 * jj + 2 * q + 1] = bfhi(xr[jj][q]) + gg[(2 * q + 1) & 3] * y1; } }
#pragma unroll
            for (int q = 0; q < 16; ++q) ss += v[q] * v[q];
            const float rs = rsqrtf(wave_sum(ss) * (1.0f / D) + EPS);
#pragma unroll
            for (int jj = 0; jj < 2; ++jj) { const int c0 = 512 * jj + 8 * lane;
                f32x4 o0, o1;
#pragma unroll
                for (int q = 0; q < 4; ++q) { o0[q] = v[8 * jj + q] * rs * fgv[2 * jj][q]; o1[q] = v[8 * jj + 4 + q] * rs * fgv[2 * jj + 1][q]; }
                *(f32x4*)(out + (size_t)row * D + c0) = o0; *(f32x4*)(out + (size_t)row * D + c0 + 4) = o1;
                xr[jj] = nxr[jj]; ya[jj] = nya[jj]; yb[jj] = nyb[jj]; }
        }
    }
#undef YLOAD
#undef YUNPACK
}

__global__ void __launch_bounds__(NTHREADS, 2) mk(Args args) {
    extern __shared__ __attribute__((aligned(16))) unsigned char lds_raw[];
    Frame F;
    F.lds = (LAS unsigned char*)lds_raw; F.tab = (LAS int*)(F.lds + TAB_OFF);
    F.tid = threadIdx.x; F.lane = F.tid & 63; F.wave = __builtin_amdgcn_readfirstlane(F.tid >> 6);
    F.G = gridDim.x; F.bid = blockIdx.x; F.vcu = (F.G % 8 == 0) ? (F.bid % 8) * (F.G / 8) + F.bid / 8 : F.bid;
    F.ws = args.ws; F.ctl = (unsigned*)(args.ws + OFF_CTL);
    unsigned char* ws = args.ws;
    bf16_t* WIN = (bf16_t*)(ws + OFF_WIN); bf16_t* WOUT = (bf16_t*)(ws + OFF_WOUT); bf16_t* W13 = (bf16_t*)(ws + OFF_W13); bf16_t* W2 = (bf16_t*)(ws + OFF_W2);
    bf16_t* XN = (bf16_t*)(ws + OFF_XN); bf16_t* Z = (bf16_t*)(ws + OFF_Z); bf16_t* YMIX = (bf16_t*)(ws + OFF_YMIX); bf16_t* X1 = (bf16_t*)(ws + OFF_X1);
    bf16_t* ACT = (bf16_t*)(ws + OFF_ACT); bf16_t* Y = (bf16_t*)(ws + OFF_Y); bf16_t* H2 = XN;
    const float* mod = (const float*)(ws + OFF_MOD); const int* list = (const int*)(ws + OFF_LIST);
    const int lo = args.ph_lo, hi = args.ph_hi;
    for (int u = F.tid; u < (LDS_BYTES - LDSCTL_OFF) / 4; u += NTHREADS) ((LAS unsigned*)(F.lds + LDSCTL_OFF))[u] = 0u;
    __syncthreads();
    XcdBarrier bar; bar.bar = F.ctl + CW_BAR; bar.x = 0; bar.st = nullptr;
    if (hi - lo > 1) bar = xcd_barrier_post(F.ctl + CW_BAR, (volatile LAS unsigned*)(F.lds + LDSCTL_OFF) + 8);
#ifndef PHMASK
#define PHMASK 0x3ff
#endif
#define IN(k) (((PHMASK >> (k)) & 1) && lo <= (k) && (k) < hi)
#ifdef PROBE_SPAN
#define STAMP(i) do { if (F.bid == 0 && F.tid == 0) { const unsigned long long t_ = __builtin_amdgcn_s_memrealtime(); LAS unsigned* st_ = (LAS unsigned*)(F.lds + LDSCTL_OFF) + 32 + 2 * (i); st_[0] = (unsigned)t_; st_[1] = (unsigned)(t_ >> 32); } } while (0)
#else
#define STAMP(i) do { } while (0)
#endif
#define SEAM(k) do { if (IN(k) && IN((k) + 1)) xcd_barrier(bar); STAMP((k) + 1); } while (0)

    STAMP(0);
    if (IN(PH_A)) phase_A(F, args);
    SEAM(PH_A);
    if (IN(PH_B)) phase_B(F, args);
    SEAM(PH_B);
    if (IN(PH_C)) {
        pg8::Gemm g{XN, WIN, 2048}; pg8::EpiZ E{Z};
        if (F.G == 256) {
            constexpr int NCONV = 64, UPA = 5;
            constexpr int CSHARE = (256 - NCONV) * NWAVES * CONV_PRE;
            const bool conv = F.bid >= 256 - NCONV;
            if (conv) convert_experts(F, args, (F.bid - (256 - NCONV)) * NWAVES + F.wave, NCONV * NWAVES, CSHARE, TI_EXP - CSHARE);
            else if (CONV_PRE > 0) convert_experts(F, args, F.bid * NWAVES + F.wave, (256 - NCONV) * NWAVES, 0, CSHARE);
            __syncthreads();
            pg8::SplitOrder S; S.tokt = F.lds; S.init2(T, 2048, 2048, 256 - NCONV, NCONV, UPA, conv ? 1 : 0, conv ? F.bid - (256 - NCONV) : F.bid);
            pg8::gemm_phase<pg8::EpiZ, pg8::SplitOrder, true, false, false>(F.lds, g, S, E);
        } else {
            pg8::StaticOrder S; S.tokt = F.lds; S.init(T, 2048, 2048, F.G, F.bid);
            pg8::gemm_phase<pg8::EpiZ, pg8::StaticOrder, true, false, false>(F.lds, g, S, E);
        }
    }
    SEAM(PH_C);
    if (IN(PH_D)) { for (int blk = F.bid; blk < T / 128; blk += F.G) { __syncthreads(); sgu_block(F, args, blk); __syncthreads(); lru_block<1>(F, args, blk); } }
    SEAM(PH_D);
    if (IN(PH_E)) { for (int blk = F.bid; blk < T / 128; blk += F.G) { __syncthreads(); lru_block<2>(F, args, blk); } }
    SEAM(PH_E);
    if (IN(PH_F)) {
        __syncthreads();
        pg8::Gemm g{YMIX, WOUT, 2048}; pg8::StaticOrder S; S.tokt = F.lds; S.init(T, 1024, 2048, F.G, F.bid);
        pg8::EpiX1 E{args.in[0], mod, X1};
        pg8::gemm_phase<pg8::EpiX1, pg8::StaticOrder, true, false, false>(F.lds, g, S, E);
    }
    SEAM(PH_F);
    if (IN(PH_G)) phase_G(F, args);
    SEAM(PH_G);
    if (IN(PH_H)) {
        build_moe_table(F);
        pg8::MoeOrder S; S.nunits = F.tab[TAB_P0 + NE] * 4; S.G = F.G; S.c = F.vcu;
        S.tile_e = F.tab + TAB_TE; S.p0 = F.tab + TAB_P0; S.cnt = F.tab + TAB_CNT; S.list = list; S.gather = true; S.tokt = F.lds + TOKT_OFF;
#if MOE_FP8
        S.Kb = 1024; S.estride = (size_t)1024 * 1024;
        pg8::Gemm g{H2, W13, 1024}; pg8::EpiAct8 E{(unsigned char*)ACT, 1.0f / W13_SCALE, ACT_SCALE};
        pg8::gemm_phase<pg8::EpiAct8, pg8::MoeOrder, true, true, true>(F.lds, g, S, E);
#else
        S.Kb = 2048; S.estride = (size_t)1024 * 1024 * 2;
        pg8::Gemm g{H2, W13, 2048}; pg8::EpiAct E{ACT};
        pg8::gemm_phase<pg8::EpiAct, pg8::MoeOrder, true, true, false>(F.lds, g, S, E);
#endif
    }
    SEAM(PH_H);
    if (IN(PH_I)) {
        build_moe_table(F);
        pg8::MoeOrder S; S.nunits = F.tab[TAB_P0 + NE] * 4; S.G = F.G; S.c = F.vcu;
        S.tile_e = F.tab + TAB_TE; S.p0 = F.tab + TAB_P0; S.cnt = F.tab + TAB_CNT; S.list = list; S.gather = false; S.tokt = F.lds + TOKT_OFF;
#if MOE_FP8
        S.Kb = 512; S.estride = (size_t)1024 * 512;
        pg8::Gemm g{ACT, W2, 512}; pg8::EpiY8 E{(unsigned char*)Y, Y_SCALE / (W2_SCALE * ACT_SCALE)};
        pg8::gemm_phase<pg8::EpiY8, pg8::MoeOrder, true, false, true>(F.lds, g, S, E);
#else
        S.Kb = 1024; S.estride = (size_t)1024 * 512 * 2;
        pg8::Gemm g{ACT, W2, 1024}; pg8::EpiY E{Y};
        pg8::gemm_phase<pg8::EpiY, pg8::MoeOrder, true, false, false>(F.lds, g, S, E);
#endif
    }
    SEAM(PH_I);
    if (IN(PH_J)) { build_moe_table(F); phase_J(F, args); }
#ifdef PROBE_SPAN
    STAMP(PH_N);
    if (F.bid == 0 && F.tid == 0) { LAS unsigned* st_ = (LAS unsigned*)(F.lds + LDSCTL_OFF) + 32;
        const unsigned long long a_ = ((unsigned long long)st_[2 * PROBE_SPAN + 1] << 32) | st_[2 * PROBE_SPAN], b_ = ((unsigned long long)st_[2 * PROBE_SPAN + 3] << 32) | st_[2 * PROBE_SPAN + 2];
        const unsigned long long t0_ = __builtin_amdgcn_s_memrealtime(), dt_ = (b_ - a_) * PROBE_MULT;
        while (__builtin_amdgcn_s_memrealtime() - t0_ < dt_) __builtin_amdgcn_s_sleep(8); }
#endif
#undef IN
#undef SEAM
}
#ifndef FUSED
#define FUSED 1
#endif
extern "C" void kernel_launch(void* const* d_in, const int* in_sizes, int n_in, void* d_out, int out_size, void* d_ws, size_t ws_size, hipStream_t stream) {
    if (n_in != 27 || out_size != T * D || ws_size < WS_NEED) { fprintf(stderr, "kernel_launch: unexpected shapes (n_in %d out %d ws %zu)\n", n_in, out_size, ws_size); return; }
    static int grid = 0;
    if (grid == 0) {
        int dev = 0, cus = 0;
        if (hipGetDevice(&dev) != hipSuccess || hipDeviceGetAttribute(&cus, hipDeviceAttributeMultiprocessorCount, dev) != hipSuccess) { fprintf(stderr, "kernel_launch: device query failed\n"); grid = -1; return; }
        if (hipFuncSetAttribute((const void*)mk, hipFuncAttributeMaxDynamicSharedMemorySize, LDS_BYTES) != hipSuccess) { fprintf(stderr, "kernel_launch: hipFuncSetAttribute failed\n"); grid = -1; return; }
        int per_cu = 0;
        if (hipOccupancyMaxActiveBlocksPerMultiprocessor(&per_cu, (const void*)mk, NTHREADS, LDS_BYTES) != hipSuccess || per_cu < 1) fprintf(stderr, "kernel_launch: occupancy query says %d\n", per_cu);
        (void)hipGetLastError();
        grid = cus;
    }
    if (grid < 0) return;
    Args a{}; for (int i = 0; i < 27; ++i) a.in[i] = (const float*)d_in[i]; a.out = (float*)d_out; a.ws = (unsigned char*)d_ws;
#define MK(lo_, hi_) do { a.ph_lo = (lo_); a.ph_hi = (hi_); hipLaunchKernelGGL(mk, dim3(grid), dim3(NTHREADS), LDS_BYTES, stream, a); } while (0)
    (void)hipMemsetAsync((char*)d_ws + OFF_CTL, 0, CTL_BYTES, stream);
#if FUSED
    MK(0, PH_N);
#else
    for (int p = 0; p < PH_N; ++p) MK(p, p + 1);
#endif
}
```

```cpp
#include <hip/hip_runtime.h>
#include <cstdio>
#include <cstdint>

typedef unsigned short bf16_t;
typedef short bf16x8 __attribute__((ext_vector_type(8)));
typedef float f32x4 __attribute__((ext_vector_type(4)));
typedef unsigned u32x2 __attribute__((ext_vector_type(2)));
typedef unsigned u32x4 __attribute__((ext_vector_type(4)));

constexpr int T = 32768, D = 1024, SEQ = 4096, NB = 8;
constexpr int DL = 512;
constexpr int NE = 32, DE = 512;
constexpr int LISTCAP = 65536;
constexpr int MAXTILES = 288, MAXROWS = MAXTILES * 256;
constexpr float EPS = 1e-6f;

constexpr size_t MiB = 1u << 20;
constexpr size_t OFF_CTL = 0, CTL_BYTES = 48 * 1024;
constexpr size_t OFF_MOD = 1 * MiB;
constexpr size_t OFF_TBL = 1 * MiB + 256 * 1024;
constexpr size_t OFF_TOKE = 1 * MiB + 512 * 1024;
constexpr size_t OFF_TOKW = 1 * MiB + 768 * 1024;
constexpr size_t OFF_TOKP = 2 * MiB;
constexpr size_t OFF_N8SP = 1 * MiB + 256 * 1024 + 16384;
constexpr size_t OFF_GBIAS = 1 * MiB + 256 * 1024 + 32768;
constexpr size_t OFF_GATEW = 2 * MiB + 256 * 1024;
constexpr size_t OFF_SGUW = 2 * MiB + 512 * 1024;
constexpr size_t OFF_ROUTW = 2 * MiB + 768 * 1024;
constexpr size_t OFF_CARRY = 3 * MiB;
constexpr size_t OFF_WIN = 4 * MiB;
constexpr size_t OFF_WOUT = 8 * MiB;
constexpr size_t OFF_W13 = 10 * MiB;
constexpr size_t OFF_W2 = 74 * MiB;
constexpr size_t OFF_XN = 106 * MiB;
constexpr size_t OFF_Z = 170 * MiB;
constexpr size_t OFF_YMIX = 298 * MiB;
constexpr size_t OFF_X1 = 362 * MiB;
constexpr size_t OFF_ACT = 426 * MiB;
constexpr size_t OFF_LIST = 498 * MiB;
constexpr size_t OFF_ROWTOK = 506 * MiB;
constexpr size_t OFF_Y = 170 * MiB;
constexpr size_t WS_NEED = 507 * MiB;
constexpr size_t OFF_VN = OFF_X1;
constexpr size_t OFF_XC = OFF_ACT;
constexpr int CW_BAR = 4096;
constexpr int CW_CNT = 8192, CNT_STRIDE = 64;

__device__ __forceinline__ unsigned f2bf(float f) { unsigned u = __float_as_uint(f); return (u + 0x7fffu + ((u >> 16) & 1u)) >> 16; }
__device__ __forceinline__ float bf2f(unsigned h) { return __uint_as_float(h << 16); }
__device__ __forceinline__ unsigned pk2(float lo, float hi) { unsigned r; asm("v_cvt_pk_bf16_f32 %0, %1, %2" : "=v"(r) : "v"(lo), "v"(hi)); return r; }
__device__ __forceinline__ float wave_sum(float v) {
#pragma unroll
    for (int o = 1; o < 64; o <<= 1) v += __shfl_xor(v, o);
    return v;
}
__device__ __forceinline__ float gelu_tanh(float x) {
    const float u = 1.5957691216057308f * (x + 0.044715f * x * x * x);
    return x / (1.0f + __expf(-u));
}
__device__ __forceinline__ float sigmoidf(float x) { return 1.0f / (1.0f + __expf(-x)); }

__global__ void __launch_bounds__(256) k_ada(const float* c, const float* ada_w, const float* ada_b, float* mod) {
    __shared__ float sc[8][1024];
    for (int i = threadIdx.x; i < 8192; i += 256) { const float v = c[i]; sc[i >> 10][i & 1023] = v / (1.0f + expf(-v)); }
    __syncthreads();
    const int n = blockIdx.x * 256 + threadIdx.x;
    float acc[8];
#pragma unroll
    for (int b = 0; b < 8; ++b) acc[b] = 0.f;
    for (int k = 0; k < 1024; ++k) {
        const float w = ada_w[(size_t)k * 6144 + n];
#pragma unroll
        for (int b = 0; b < 8; ++b) acc[b] += sc[b][k] * w;
    }
#pragma unroll
    for (int b = 0; b < 8; ++b) mod[b * 6144 + n] = acc[b] + ada_b[n];
}

__global__ void __launch_bounds__(256) k_transpose(const float* W, bf16_t* WT, int K, int N, int blk, int rstride, int rbase, size_t w_ms, size_t wt_ms) {
    __shared__ float tile[32][33];
    W += (size_t)blockIdx.z * w_ms; WT += (size_t)blockIdx.z * wt_ms;
    const int n0 = blockIdx.x * 32, k0 = blockIdx.y * 32, tx = threadIdx.x & 31, ty = threadIdx.x >> 5;
    for (int j = ty; j < 32; j += 8) tile[j][tx] = W[(size_t)(k0 + j) * N + n0 + tx];
    __syncthreads();
    for (int j = ty; j < 32; j += 8) { const int n = n0 + j; const int row = rbase + (n / blk) * rstride + (n % blk);
        WT[(size_t)row * K + k0 + tx] = (bf16_t)f2bf(tile[tx][j]); }
}

__global__ void __launch_bounds__(256) k_xn(const float* x, const float* g, const float* mod, bf16_t* XN) {
    const int row = blockIdx.x * 4 + (threadIdx.x >> 6), lane = threadIdx.x & 63, b = row / SEQ;
    const f32x4* xr = (const f32x4*)(x + (size_t)row * D);
    f32x4 v[4]; float ss = 0.f;
#pragma unroll
    for (int j = 0; j < 4; ++j) { v[j] = xr[lane + 64 * j]; ss += v[j][0] * v[j][0] + v[j][1] * v[j][1] + v[j][2] * v[j][2] + v[j][3] * v[j][3]; }
    ss = wave_sum(ss);
    const float rs = rsqrtf(ss * (1.0f / D) + EPS);
    const float* sh = mod + b * 6144; const float* sc = sh + 1024;
#pragma unroll
    for (int j = 0; j < 4; ++j) { const int col = 4 * (lane + 64 * j);
        const f32x4 gg = *(const f32x4*)(g + col), s1 = *(const f32x4*)(sc + col), s0 = *(const f32x4*)(sh + col);
        float h[4];
#pragma unroll
        for (int q = 0; q < 4; ++q) h[q] = v[j][q] * rs * gg[q] * (1.0f + s1[q]) + s0[q];
        u32x2 o; o.x = pk2(h[0], h[1]); o.y = pk2(h[2], h[3]);
        *(u32x2*)(XN + (size_t)row * D + col) = o; }
}

template <bool DUAL, class Epi>
__device__ __forceinline__ void sg_tile(const bf16_t* A, const int* arow, const bf16_t* Bt, const bf16_t* Bt2, int K, int m0, int n0, int lane, const Epi& epi) {
    const int fr = lane & 15, fq = lane >> 4;
    const bf16_t* pa[2]; const bf16_t* pb[4]; const bf16_t* pb2[4];
#pragma unroll
    for (int mi = 0; mi < 2; ++mi) { const int r = m0 + mi * 16 + fr; const int rr = arow ? arow[r] : r; pa[mi] = A + (size_t)rr * K + 8 * fq; }
#pragma unroll
    for (int ni = 0; ni < 4; ++ni) { pb[ni] = Bt + (size_t)(n0 + ni * 16 + fr) * K + 8 * fq; pb2[ni] = DUAL ? Bt2 + (size_t)(n0 + ni * 16 + fr) * K + 8 * fq : nullptr; }
    f32x4 acc[2][4], acc2[2][4];
#pragma unroll
    for (int mi = 0; mi < 2; ++mi)
#pragma unroll
        for (int ni = 0; ni < 4; ++ni) { acc[mi][ni] = (f32x4){0.f, 0.f, 0.f, 0.f}; acc2[mi][ni] = (f32x4){0.f, 0.f, 0.f, 0.f}; }
    for (int k0 = 0; k0 < K; k0 += 32) {
        bf16x8 a[2], b[4], b2[4];
#pragma unroll
        for (int mi = 0; mi < 2; ++mi) a[mi] = *(const bf16x8*)(pa[mi] + k0);
#pragma unroll
        for (int ni = 0; ni < 4; ++ni) { b[ni] = *(const bf16x8*)(pb[ni] + k0); if (DUAL) b2[ni] = *(const bf16x8*)(pb2[ni] + k0); }
#pragma unroll
        for (int mi = 0; mi < 2; ++mi)
#pragma unroll
            for (int ni = 0; ni < 4; ++ni) {
                acc[mi][ni] = __builtin_amdgcn_mfma_f32_16x16x32_bf16(b[ni], a[mi], acc[mi][ni], 0, 0, 0);
                if (DUAL) acc2[mi][ni] = __builtin_amdgcn_mfma_f32_16x16x32_bf16(b2[ni], a[mi], acc2[mi][ni], 0, 0, 0);
            }
    }
#pragma unroll
    for (int mi = 0; mi < 2; ++mi)
#pragma unroll
        for (int ni = 0; ni < 4; ++ni) epi(m0 + mi * 16 + fr, n0 + ni * 16 + 4 * fq, acc[mi][ni], acc2[mi][ni]);
}

struct EpiInProj { bf16_t* Z;
    __device__ __forceinline__ void operator()(int row, int col, f32x4 v, f32x4) const {
        if (col >= 512) { v[0] = gelu_tanh(v[0]); v[1] = gelu_tanh(v[1]); v[2] = gelu_tanh(v[2]); v[3] = gelu_tanh(v[3]); }
        u32x2 o; o.x = pk2(v[0], v[1]); o.y = pk2(v[2], v[3]); *(u32x2*)(Z + (size_t)row * 2048 + col) = o; } };
struct EpiOutProj { const float* x; const float* mod; bf16_t* X1;
    __device__ __forceinline__ void operator()(int row, int col, f32x4 v, f32x4) const {
        const int b = row / SEQ; const f32x4 xv = *(const f32x4*)(x + (size_t)row * D + col), g1 = *(const f32x4*)(mod + b * 6144 + 2048 + col);
        u32x2 o; o.x = pk2(xv[0] + g1[0] * v[0], xv[1] + g1[1] * v[1]); o.y = pk2(xv[2] + g1[2] * v[2], xv[3] + g1[3] * v[3]);
        *(u32x2*)(X1 + (size_t)row * D + col) = o; } };
struct EpiMoe1 { bf16_t* ACT;
    __device__ __forceinline__ void operator()(int row, int col, f32x4 g, f32x4 u) const {
        float a[4];
#pragma unroll
        for (int q = 0; q < 4; ++q) a[q] = g[q] / (1.0f + __expf(-g[q])) * u[q];
        u32x2 o; o.x = pk2(a[0], a[1]); o.y = pk2(a[2], a[3]); *(u32x2*)(ACT + (size_t)row * DE + col) = o; } };
struct EpiMoe2 { bf16_t* Y;
    __device__ __forceinline__ void operator()(int row, int col, f32x4 v, f32x4) const {
        u32x2 o; o.x = pk2(v[0], v[1]); o.y = pk2(v[2], v[3]); *(u32x2*)(Y + (size_t)row * D + col) = o; } };

template <class Epi>
__global__ void __launch_bounds__(256) k_sgemm(const bf16_t* A, const bf16_t* Bt, int M, int N, int K, Epi epi) {
    const int w = blockIdx.x * 4 + (threadIdx.x >> 6), lane = threadIdx.x & 63, nN = N / 64;
    const int mt = w / nN, nt = w % nN; if (mt * 32 >= M) return;
    sg_tile<false>(A, nullptr, Bt, nullptr, K, mt * 32, nt * 64, lane, epi);
}
__global__ void __launch_bounds__(256) k_moe1(const bf16_t* H2, const int* rowtok, const int* tbl, const bf16_t* W13, EpiMoe1 epi) {
    const int w = blockIdx.x * 4 + (threadIdx.x >> 6), lane = threadIdx.x & 63;
    const int mt = w / 8, nt = w % 8, tile = mt / 8;
    if (tile >= tbl[0]) return;
    const int e = tbl[64 + tile], n0 = nt * 64, q = n0 / 128, i0 = n0 % 128;
    const bf16_t* Wg = W13 + (size_t)e * 1024 * 1024 + (size_t)(256 * q + i0) * 1024 - (size_t)n0 * 1024;
    sg_tile<true>(H2, rowtok, Wg, Wg + (size_t)128 * 1024, 1024, mt * 32, n0, lane, epi);
}
__global__ void __launch_bounds__(256) k_moe2(const bf16_t* ACT, const int* tbl, const bf16_t* W2, EpiMoe2 epi) {
    const int w = blockIdx.x * 4 + (threadIdx.x >> 6), lane = threadIdx.x & 63;
    const int mt = w / 16, nt = w % 16, tile = mt / 8;
    if (tile >= tbl[0]) return;
    const int e = tbl[64 + tile];
    sg_tile<false>(ACT, nullptr, W2 + (size_t)e * 1024 * 512, nullptr, 512, mt * 32, nt * 64, lane, epi);
}

__global__ void __launch_bounds__(256) k_lnv(const bf16_t* Z, const float* g, const float* bb, bf16_t* VN) {
    const int row = blockIdx.x * 4 + (threadIdx.x >> 6), lane = threadIdx.x & 63;
    const u32x4 raw = *(const u32x4*)(Z + (size_t)row * 2048 + 1536 + 8 * lane);
    float v[8];
#pragma unroll
    for (int q = 0; q < 4; ++q) { v[2 * q] = bf2f(raw[q] & 0xffffu); v[2 * q + 1] = bf2f(raw[q] >> 16); }
    float s = 0.f;
#pragma unroll
    for (int q = 0; q < 8; ++q) s += v[q];
    const float mu = wave_sum(s) * (1.0f / 512.0f);
    float s2 = 0.f;
#pragma unroll
    for (int q = 0; q < 8; ++q) { v[q] -= mu; s2 += v[q] * v[q]; }
    const float rstd = rsqrtf(wave_sum(s2) * (1.0f / 512.0f) + EPS);
    u32x4 o;
#pragma unroll
    for (int q = 0; q < 4; ++q) { const int c = 8 * lane + 2 * q; o[q] = pk2(v[2 * q] * rstd * g[c] + bb[c], v[2 * q + 1] * rstd * g[c + 1] + bb[c + 1]); }
    *(u32x4*)(VN + (size_t)row * 512 + 8 * lane) = o;
}
__global__ void __launch_bounds__(256) k_sgu(const bf16_t* Z, const bf16_t* VN, const float* sgu_w, const float* sgu_b, bf16_t* YMIX) {
    const int idx = blockIdx.x * 256 + threadIdx.x, t = idx >> 9, ch = idx & 511, i = t & 127, blk = t >> 7, g = ch >> 6;
    const int jmax = (i < 64) ? 64 : 128;
    float s = sgu_b[g * 128 + i];
    const float* wrow = sgu_w + ((size_t)g * 128 + i) * 128;
    for (int j = 0; j < jmax; ++j) s += wrow[j] * bf2f(VN[((size_t)blk * 128 + j) * 512 + ch]);
    YMIX[(size_t)t * D + 512 + ch] = (bf16_t)f2bf(bf2f(Z[(size_t)t * 2048 + 1024 + ch]) * s);
}
__global__ void __launch_bounds__(256) k_conv(const bf16_t* Z, const float* cw, const float* cb, float* XC) {
    const int idx = blockIdx.x * 256 + threadIdx.x, t = idx >> 9, ch = idx & 511, pos = t & (SEQ - 1);
    float acc = cb[ch];
#pragma unroll
    for (int k = 0; k < 4; ++k) { const int d = k - 3; if (pos + d >= 0) acc += cw[k * 512 + ch] * bf2f(Z[(size_t)(t + d) * 2048 + ch]); }
    XC[idx] = acc;
}
__global__ void __launch_bounds__(256) k_gates(const float* XC, const float* wa, const float* ba, const float* wi, const float* bi, const float* lam, float* A_, float* U_) {
    const int idx = blockIdx.x * 256 + threadIdx.x, t = idx >> 9, ch = idx & 511, h = ch >> 6, e = ch & 63;
    const float* xrow = XC + (size_t)t * 512 + h * 64;
    float ra = ba[ch], ri = bi[ch];
    for (int d = 0; d < 64; ++d) { const float xv = xrow[d]; ra += xv * wa[h * 4096 + d * 64 + e]; ri += xv * wi[h * 4096 + d * 64 + e]; }
    const float r = sigmoidf(ra), ig = sigmoidf(ri);
    const float sp = log1pf(expf(-lam[ch]));
    const float log_a = -8.0f * r * sp;
    A_[idx] = expf(log_a);
    U_[idx] = sqrtf(-expm1f(2.0f * log_a)) * (ig * XC[idx]);
}
__global__ void __launch_bounds__(64) k_scan(const float* A_, const float* U_, const bf16_t* Z, bf16_t* YMIX) {
    const int idx = blockIdx.x * 64 + threadIdx.x, b = idx >> 9, ch = idx & 511;
    float h = 0.f;
    for (int p0 = 0; p0 < SEQ; p0 += 8) {
        float a[8], u[8], g[8];
#pragma unroll
        for (int q = 0; q < 8; ++q) { const size_t t = (size_t)b * SEQ + p0 + q; a[q] = A_[t * 512 + ch]; u[q] = U_[t * 512 + ch]; g[q] = bf2f(Z[t * 2048 + 512 + ch]); }
#pragma unroll
        for (int q = 0; q < 8; ++q) { const size_t t = (size_t)b * SEQ + p0 + q; h = a[q] * h + u[q]; YMIX[t * D + ch] = (bf16_t)f2bf(h * g[q]); }
    }
}

__global__ void __launch_bounds__(256) k_router(const bf16_t* X1, const float* g2w, const float* mod, const float* wg, const float* bg, const float* we, const float* be,
                                                bf16_t* H2, unsigned* cnt, int* list, int* toke, float* tokw, int* tokp) {
    const int row = blockIdx.x * 4 + (threadIdx.x >> 6), lane = threadIdx.x & 63, b = row / SEQ;
    float h[16]; float ss = 0.f;
#pragma unroll
    for (int jj = 0; jj < 2; ++jj) { const u32x4 raw = *(const u32x4*)(X1 + (size_t)row * D + 512 * jj + 8 * lane);
#pragma unroll
        for (int q = 0; q < 4; ++q) { h[8 * jj + 2 * q] = bf2f(raw[q] & 0xffffu); h[8 * jj + 2 * q + 1] = bf2f(raw[q] >> 16); } }
#pragma unroll
    for (int q = 0; q < 16; ++q) ss += h[q] * h[q];
    const float rs = rsqrtf(wave_sum(ss) * (1.0f / D) + EPS);
    const float* sh = mod + b * 6144 + 3072; const float* sc = sh + 1024;
#pragma unroll
    for (int jj = 0; jj < 2; ++jj) { u32x4 o;
#pragma unroll
        for (int q = 0; q < 4; ++q) { const int c = 512 * jj + 8 * lane + 2 * q;
            const float h0 = h[8 * jj + 2 * q] * rs * g2w[c] * (1.0f + sc[c]) + sh[c], h1 = h[8 * jj + 2 * q + 1] * rs * g2w[c + 1] * (1.0f + sc[c + 1]) + sh[c + 1];
            o[q] = pk2(h0, h1); h[8 * jj + 2 * q] = bf2f(o[q] & 0xffffu); h[8 * jj + 2 * q + 1] = bf2f(o[q] >> 16); }
        *(u32x4*)(H2 + (size_t)row * D + 512 * jj + 8 * lane) = o; }
    float gl[4], el[8];
#pragma unroll
    for (int j = 0; j < 4; ++j) { float p = 0.f;
#pragma unroll
        for (int q = 0; q < 16; ++q) { const int k = 512 * (q >> 3) + 8 * lane + (q & 7); p += h[q] * wg[k * 4 + j]; }
        gl[j] = wave_sum(p) + bg[j]; }
    int gs = 0; float gmax = gl[0];
#pragma unroll
    for (int j = 1; j < 4; ++j) if (gl[j] > gmax) { gmax = gl[j]; gs = j; }
#pragma unroll
    for (int j = 0; j < 8; ++j) { float p = 0.f;
#pragma unroll
        for (int q = 0; q < 16; ++q) { const int k = 512 * (q >> 3) + 8 * lane + (q & 7); p += h[q] * we[k * 32 + gs * 8 + j]; }
        el[j] = wave_sum(p) + be[gs * 8 + j]; }
    if (lane == 0) {
        float gsum = 0.f;
#pragma unroll
        for (int j = 0; j < 4; ++j) gsum += expf(gl[j] - gmax);
        const float pg = 1.0f / gsum;
        int i1 = 0; float m1 = el[0];
#pragma unroll
        for (int j = 1; j < 8; ++j) if (el[j] > m1) { m1 = el[j]; i1 = j; }
        int i2 = -1; float m2 = -INFINITY;
#pragma unroll
        for (int j = 0; j < 8; ++j) if (j != i1 && el[j] > m2) { m2 = el[j]; i2 = j; }
        const float r = expf(m2 - m1);
        const float w1 = pg / (1.0f + r), w2 = pg * r / (1.0f + r);
        const int e1 = gs * 8 + i1, e2 = gs * 8 + i2;
        const unsigned p1 = atomicAdd(cnt + CNT_STRIDE * e1, 1u), p2 = atomicAdd(cnt + CNT_STRIDE * e2, 1u);
        list[(size_t)e1 * LISTCAP + p1] = row; list[(size_t)e2 * LISTCAP + p2] = row;
        toke[2 * row] = e1; toke[2 * row + 1] = e2; tokw[2 * row] = w1; tokw[2 * row + 1] = w2; tokp[2 * row] = (int)p1; tokp[2 * row + 1] = (int)p2;
    }
}
__global__ void k_table(const unsigned* cnt, int* tbl) {
    if (threadIdx.x == 0) { int p = 0;
        for (int e = 0; e < NE; ++e) { tbl[1 + e] = p; const int nt = ((int)cnt[CNT_STRIDE * e] + 255) / 256; for (int j = 0; j < nt; ++j) tbl[64 + p + j] = e; p += nt; }
        tbl[1 + NE] = p; tbl[0] = p; }
}
__global__ void __launch_bounds__(256) k_rowtok(const unsigned* cnt, const int* tbl, const int* list, int* rowtok) {
    const int p = blockIdx.x * 256 + threadIdx.x, t = p >> 8; int tok = 0;
    if (t < tbl[0]) { const int e = tbl[64 + t], pos = (t - tbl[1 + e]) * 256 + (p & 255); if (pos < (int)cnt[CNT_STRIDE * e]) tok = list[(size_t)e * LISTCAP + pos]; }
    rowtok[p] = tok;
}
__global__ void __launch_bounds__(256) k_combine(const bf16_t* X1, const bf16_t* Y, const float* mod, const int* tbl, const int* toke, const float* tokw, const int* tokp, const float* fg, float* out) {
    const int row = blockIdx.x * 4 + (threadIdx.x >> 6), lane = threadIdx.x & 63, b = row / SEQ;
    const int e0 = toke[2 * row], e1 = toke[2 * row + 1];
    const size_t q0 = (size_t)tbl[1 + e0] * 256 + tokp[2 * row], q1 = (size_t)tbl[1 + e1] * 256 + tokp[2 * row + 1];
    const float w0 = tokw[2 * row], w1 = tokw[2 * row + 1];
    const float* g2 = mod + b * 6144 + 5120;
    float v[16]; float ss = 0.f;
#pragma unroll
    for (int jj = 0; jj < 2; ++jj) { const int c0 = 512 * jj + 8 * lane;
        const u32x4 xr = *(const u32x4*)(X1 + (size_t)row * D + c0), ya = *(const u32x4*)(Y + q0 * D + c0), yb = *(const u32x4*)(Y + q1 * D + c0);
#pragma unroll
        for (int q = 0; q < 4; ++q) {
            const float x0 = bf2f(xr[q] & 0xffffu), x1 = bf2f(xr[q] >> 16);
            const float y0 = w0 * bf2f(ya[q] & 0xffffu) + w1 * bf2f(yb[q] & 0xffffu), y1 = w0 * bf2f(ya[q] >> 16) + w1 * bf2f(yb[q] >> 16);
            v[8 * jj + 2 * q] = x0 + g2[c0 + 2 * q] * y0; v[8 * jj + 2 * q + 1] = x1 + g2[c0 + 2 * q + 1] * y1; } }
#pragma unroll
    for (int q = 0; q < 16; ++q) ss += v[q] * v[q];
    const float rs = rsqrtf(wave_sum(ss) * (1.0f / D) + EPS);
#pragma unroll
    for (int jj = 0; jj < 2; ++jj) { const int c0 = 512 * jj + 8 * lane;
        f32x4 o0, o1;
#pragma unroll
        for (int q = 0; q < 4; ++q) { o0[q] = v[8 * jj + q] * rs * fg[c0 + q]; o1[q] = v[8 * jj + 4 + q] * rs * fg[c0 + 4 + q]; }
        *(f32x4*)(out + (size_t)row * D + c0) = o0; *(f32x4*)(out + (size_t)row * D + c0 + 4) = o1; }
}

namespace pg8 {
#define PG8_LAS __attribute__((address_space(3)))
constexpr int BM = 256, BK = 64, HALF = 128, HTB = HALF * BK * 2  , STAGE_BYTES = 8 * HTB, NXCD = 8, WGM = 8;
__host__ __device__ __forceinline__ int lds_byte(int r, int c) { const int st = (r >> 4) * 2 + (c >> 5), rr = r & 15, cc = c & 31, ob = rr * 64 + cc * 2; return st * 1024 + (ob ^ (((ob >> 9) & 1) << 5)); }
__host__ __device__ __forceinline__ void stage_rc(int b, int& R, int& C) { const int st = b / 1024, sb = b % 1024, swz = sb ^ (((sb >> 9) & 1) << 5); R = (st >> 1) * 16 + swz / 64; C = (st & 1) * 32 + (swz % 64) / 2; }
__host__ __device__ __forceinline__ int perm32(int rho) { const int n = rho >> 4, i = rho & 15; return 8 * (i >> 2) + 4 * n + (i & 3); }

__host__ __device__ __forceinline__ int perm256(int h, int R) { return 64 * (R >> 5) + 16 * ((R >> 2) & 3) + 8 * h + 4 * ((R >> 4) & 1) + (R & 3); }

struct Unit { int pm, pn, e; };
struct Gemm { const void* A; const void* Bt; int Kb; };
__host__ __device__ __forceinline__ int swz8(int r8) { return ((r8 >> 1) & 1) | (((r8 >> 2) & 1) << 2); }
__host__ __device__ __forceinline__ int lds_byte8(int r, int piece) { return (r >> 3) * 1024 + ((r & 7) * 8 + (piece ^ swz8(r & 7))) * 16; }
__host__ __device__ __forceinline__ void stage_rc8(int b, int& R, int& Cb) { const int chunk = b >> 10, slot = (b & 1023) >> 4, r8 = slot >> 3, j = slot & 7; R = chunk * 8 + r8; Cb = (j ^ swz8(r8)) * 16; }
typedef int v8i32 __attribute__((ext_vector_type(8)));
typedef int v4i32 __attribute__((ext_vector_type(4)));

struct StaticOrder {
    int nM, nN, nwg, G, c; size_t tstep;
    __device__ void init(int M, int N, int Kb, int G_, int c_) { nM = M / BM; nN = N / BM; nwg = nM * nN; G = G_; c = c_; tstep = (size_t)BM * Kb; }
    __device__ bool next(int i, Unit& u) const {
        const long L = (long)i * G + c; if (L >= nwg) return false;
        int wgid = (int)L; { const int q = nwg / NXCD, r = nwg % NXCD, xcd = wgid % NXCD, off = wgid / NXCD; wgid = (xcd < r ? xcd * (q + 1) : r * (q + 1) + (xcd - r) * q) + off; }
        const int nig = WGM * nN, gid = wgid / nig, fm = gid * WGM, gsz = (nM - fm) < WGM ? (nM - fm) : WGM;
        u.pm = fm + ((wgid % nig) % gsz); u.pn = (wgid % nig) / gsz; u.e = 0; return true;
    }
    __device__ __forceinline__ size_t a_off(const Unit& u) const { return (size_t)u.pm * tstep; }
    __device__ __forceinline__ size_t b_off(const Unit& u) const { return (size_t)u.pn * tstep; }
    PG8_LAS unsigned char* tokt;
    __device__ __forceinline__ const int* tok_src(const Unit&, int) const { return nullptr; }
};
struct SplitOrder : StaticOrder {
    int nA, upa, cls, idx, nB;
    __device__ void init2(int M, int N, int Kb, int nA_, int nB_, int upa_, int cls_, int idx_) { init(M, N, Kb, 1, 0); nA = nA_; nB = nB_; upa = upa_; cls = cls_; idx = idx_; }
    __device__ bool next(int i, Unit& u) const {
        long L; if (cls == 0) { if (i >= upa) return false; L = (long)i * nA + idx; } else { L = (long)upa * nA + (long)i * nB + idx; }
        if (L >= nwg) return false;
        int wgid = (int)L; { const int q = nwg / NXCD, r = nwg % NXCD, xcd = wgid % NXCD, off = wgid / NXCD; wgid = (xcd < r ? xcd * (q + 1) : r * (q + 1) + (xcd - r) * q) + off; }
        const int nig = WGM * nN, gid = wgid / nig, fm = gid * WGM, gsz = (nM - fm) < WGM ? (nM - fm) : WGM;
        u.pm = fm + ((wgid % nig) % gsz); u.pn = (wgid % nig) / gsz; u.e = 0; return true;
    }
};
struct MoeOrder {
    int nunits, G, c, Kb; size_t estride;
    const PG8_LAS int* tile_e; const PG8_LAS int* p0; const PG8_LAS int* cnt; const int* list; bool gather;
    __device__ bool next(int i, Unit& u) const {
        const int L = i * G + c; if (L >= nunits) return false;
        u.pm = L >> 2; u.pn = L & 3; u.e = tile_e[u.pm]; return true;
    }
    __device__ __forceinline__ size_t a_off(const Unit& u) const { return gather ? (size_t)0 : (size_t)u.pm * BM * Kb; }
    __device__ __forceinline__ size_t b_off(const Unit& u) const { return (size_t)u.e * estride + (size_t)u.pn * BM * Kb; }
    PG8_LAS unsigned char* tokt;
    __device__ __forceinline__ const int* tok_src(const Unit& u, int r) const {
        const int pos = (u.pm - p0[u.e]) * 256 + r, last = cnt[u.e] - 1;
        return list + (size_t)u.e * LISTCAP + (pos < last ? pos : last);
    }
};

__device__ __forceinline__ unsigned cvt_pk_bf16(float lo, float hi) { unsigned r; asm volatile("v_cvt_pk_bf16_f32 %0, %1, %2" : "=v"(r) : "v"(lo), "v"(hi)); return r; }
typedef float f32x2 __attribute__((ext_vector_type(2)));
__device__ __forceinline__ f32x2 exp2_2(f32x2 a) { return (f32x2){__builtin_amdgcn_exp2f(a.x), __builtin_amdgcn_exp2f(a.y)}; }
__device__ __forceinline__ f32x2 rcp_2(f32x2 a) { return (f32x2){__builtin_amdgcn_rcpf(a.x), __builtin_amdgcn_rcpf(a.y)}; }
__device__ __forceinline__ f32x2 gelu_fast2(f32x2 x) {
    const f32x2 u = x * x, w = u * (f32x2){-0.10294324f, -0.10294324f} + (f32x2){-2.3022082f, -2.3022082f}, t = x * w;
    return x * rcp_2(exp2_2(t) + (f32x2){1.0f, 1.0f}); }
__device__ __forceinline__ f32x4 gelu_fast4(f32x4 v) { const f32x2 a = gelu_fast2((f32x2){v[0], v[1]}), b = gelu_fast2((f32x2){v[2], v[3]}); return (f32x4){a.x, a.y, b.x, b.y}; }
__device__ __forceinline__ float gelu_fast(float x) {
    const float u = -2.3022082f * (x + 0.044715f * x * x * x);
    return x * __builtin_amdgcn_rcpf(1.0f + __builtin_amdgcn_exp2f(u));
}
__device__ __forceinline__ float silu_fast(float x) { return x * __builtin_amdgcn_rcpf(1.0f + __builtin_amdgcn_exp2f(-1.4426950408889634f * x)); }

struct EpiZ { static constexpr bool PERM = true; bf16_t* Z;
    __device__ __forceinline__ void operator()(const f32x4 (&acc)[2][2][4][2], const Unit& u, int wr, int wc, int fr, int fq) const {
        const int row0 = u.pm * BM + wr * 64 + fr, col0 = u.pn * BM + wc * 32 + 8 * fq; const bool act = u.pn >= 2;
#pragma unroll
        for (int ai = 0; ai < 2; ++ai)
#pragma unroll
            for (int m = 0; m < 4; ++m) { bf16_t* rowp = Z + (size_t)(row0 + ai * HALF + m * 16) * 2048 + col0;
#pragma unroll
                for (int bj = 0; bj < 2; ++bj) { f32x4 v0 = acc[ai][bj][m][0], v1 = acc[ai][bj][m][1];
                    if (act) { v0 = gelu_fast4(v0); v1 = gelu_fast4(v1); }
                    u32x4 w; w.x = cvt_pk_bf16(v0[0], v0[1]); w.y = cvt_pk_bf16(v0[2], v0[3]); w.z = cvt_pk_bf16(v1[0], v1[1]); w.w = cvt_pk_bf16(v1[2], v1[3]);
                    *(u32x4*)(rowp + bj * HALF) = w; } }
    }
};
struct EpiX1 { static constexpr bool PERM = true; const float* x; const float* mod; bf16_t* X1;
    __device__ __forceinline__ void operator()(const f32x4 (&acc)[2][2][4][2], const Unit& u, int wr, int wc, int fr, int fq) const {
        const int row0 = u.pm * BM + wr * 64 + fr, col0 = u.pn * BM + wc * 32 + 8 * fq; const int b = (u.pm * BM) / SEQ;
        const float* g1 = mod + b * 6144 + 2048 + col0;
        f32x4 gv[2][2];
#pragma unroll
        for (int bj = 0; bj < 2; ++bj) { gv[bj][0] = *(const f32x4*)(g1 + bj * HALF); gv[bj][1] = *(const f32x4*)(g1 + bj * HALF + 4); }
#pragma unroll
        for (int ai = 0; ai < 2; ++ai)
#pragma unroll
            for (int m = 0; m < 4; ++m) { const size_t off = (size_t)(row0 + ai * HALF + m * 16) * D + col0;
#pragma unroll
                for (int bj = 0; bj < 2; ++bj) { const f32x4 x0 = *(const f32x4*)(x + off + bj * HALF), x1 = *(const f32x4*)(x + off + bj * HALF + 4);
                    const f32x4 v0 = x0 + gv[bj][0] * acc[ai][bj][m][0], v1 = x1 + gv[bj][1] * acc[ai][bj][m][1];
                    u32x4 w; w.x = cvt_pk_bf16(v0[0], v0[1]); w.y = cvt_pk_bf16(v0[2], v0[3]); w.z = cvt_pk_bf16(v1[0], v1[1]); w.w = cvt_pk_bf16(v1[2], v1[3]);
                    *(u32x4*)(X1 + off + bj * HALF) = w; } }
    }
};
struct EpiAct { static constexpr bool PERM = true; bf16_t* ACT;
    __device__ __forceinline__ void operator()(const f32x4 (&acc)[2][2][4][2], const Unit& u, int wr, int wc, int fr, int fq) const {
        const int row0 = u.pm * BM + wr * 64 + fr, col0 = u.pn * HALF + wc * 32 + 8 * fq;
#pragma unroll
        for (int ai = 0; ai < 2; ++ai)
#pragma unroll
            for (int m = 0; m < 4; ++m) { f32x4 v0, v1;
#pragma unroll
                for (int q = 0; q < 4; ++q) { v0[q] = silu_fast(acc[ai][0][m][0][q]) * acc[ai][1][m][0][q]; v1[q] = silu_fast(acc[ai][0][m][1][q]) * acc[ai][1][m][1][q]; }
                u32x4 w; w.x = cvt_pk_bf16(v0[0], v0[1]); w.y = cvt_pk_bf16(v0[2], v0[3]); w.z = cvt_pk_bf16(v1[0], v1[1]); w.w = cvt_pk_bf16(v1[2], v1[3]);
                *(u32x4*)(ACT + (size_t)(row0 + ai * HALF + m * 16) * DE + col0) = w; }
    }
};
__device__ __forceinline__ unsigned pk4_fp8(float a, float b, float c, float d) {
    a = __builtin_fminf(__builtin_fmaxf(a, -448.f), 448.f); b = __builtin_fminf(__builtin_fmaxf(b, -448.f), 448.f);
    c = __builtin_fminf(__builtin_fmaxf(c, -448.f), 448.f); d = __builtin_fminf(__builtin_fmaxf(d, -448.f), 448.f);
    unsigned w = 0u; w = __builtin_amdgcn_cvt_pk_fp8_f32(a, b, w, false); w = __builtin_amdgcn_cvt_pk_fp8_f32(c, d, w, true); return w; }
struct EpiAct8 { static constexpr bool PERM = true; unsigned char* ACT; float inv, oscale;
    __device__ __forceinline__ void operator()(const f32x4 (&acc)[2][2][4][2], const Unit& u, int wr, int wc, int fr, int fq) const {
        const int row0 = u.pm * BM + wr * 64 + fr, col0 = u.pn * HALF + wc * 32 + 8 * fq; const float ce = -1.4426950408889634f * inv, ik = 1.0f / (inv * inv * oscale);
#pragma unroll
        for (int ai = 0; ai < 2; ++ai)
#pragma unroll
            for (int m = 0; m < 4; ++m) { f32x4 v0, v1;
#pragma unroll
                for (int h = 0; h < 2; ++h)
#pragma unroll
                    for (int p = 0; p < 2; ++p) {
                        const f32x2 g = (f32x2){acc[ai][0][m][h][2 * p], acc[ai][0][m][h][2 * p + 1]}, uu = (f32x2){acc[ai][1][m][h][2 * p], acc[ai][1][m][h][2 * p + 1]};
                        const f32x2 e = exp2_2(g * (f32x2){ce, ce}), r = rcp_2(e * (f32x2){ik, ik} + (f32x2){ik, ik}), o = (g * uu) * r;
                        if (h == 0) { v0[2 * p] = o.x; v0[2 * p + 1] = o.y; } else { v1[2 * p] = o.x; v1[2 * p + 1] = o.y; } }
                u32x2 w; w.x = pk4_fp8(v0[0], v0[1], v0[2], v0[3]); w.y = pk4_fp8(v1[0], v1[1], v1[2], v1[3]);
                *(u32x2*)(ACT + (size_t)(row0 + ai * HALF + m * 16) * DE + col0) = w; }
    }
};
struct EpiY8 { static constexpr int PERM = 2; unsigned char* Y; float sc;
    __device__ __forceinline__ void operator()(const f32x4 (&acc)[2][2][4][2], const Unit& u, int wr, int wc, int fr, int fq) const {
        const int row0 = u.pm * BM + wr * 64 + fr, col0 = u.pn * BM + wc * 64 + 16 * fq;
#pragma unroll
        for (int ai = 0; ai < 2; ++ai)
#pragma unroll
            for (int m = 0; m < 4; ++m) { u32x4 w;
                { const f32x4 v0 = acc[ai][0][m][0] * sc, v1 = acc[ai][0][m][1] * sc; w.x = pk4_fp8(v0[0], v0[1], v0[2], v0[3]); w.y = pk4_fp8(v1[0], v1[1], v1[2], v1[3]); }
                { const f32x4 v0 = acc[ai][1][m][0] * sc, v1 = acc[ai][1][m][1] * sc; w.z = pk4_fp8(v0[0], v0[1], v0[2], v0[3]); w.w = pk4_fp8(v1[0], v1[1], v1[2], v1[3]); }
                *(u32x4*)(Y + (size_t)(row0 + ai * HALF + m * 16) * D + col0) = w; }
    }
};
struct EpiY { static constexpr bool PERM = true; bf16_t* Y;
    __device__ __forceinline__ void operator()(const f32x4 (&acc)[2][2][4][2], const Unit& u, int wr, int wc, int fr, int fq) const {
        const int row0 = u.pm * BM + wr * 64 + fr, col0 = u.pn * BM + wc * 32 + 8 * fq;
#pragma unroll
        for (int ai = 0; ai < 2; ++ai)
#pragma unroll
            for (int m = 0; m < 4; ++m) { bf16_t* rowp = Y + (size_t)(row0 + ai * HALF + m * 16) * D + col0;
#pragma unroll
                for (int bj = 0; bj < 2; ++bj) { const f32x4 v0 = acc[ai][bj][m][0], v1 = acc[ai][bj][m][1];
                    u32x4 w; w.x = cvt_pk_bf16(v0[0], v0[1]); w.y = cvt_pk_bf16(v0[2], v0[3]); w.z = cvt_pk_bf16(v1[0], v1[1]); w.w = cvt_pk_bf16(v1[2], v1[3]);
                    *(u32x4*)(rowp + bj * HALF) = w; } }
    }
};

template <class Epi, class Sched, bool ALIGN_EPI, bool GATHER, bool FP8>
__device__ __forceinline__ void gemm_phase(PG8_LAS unsigned char* lds, const Gemm g, const Sched& S, const Epi& E) {
    const int tid = threadIdx.x, wid = __builtin_amdgcn_readfirstlane(tid >> 6), lane = tid & 63, wr = wid >> 2, wc = wid & 3, fr = lane & 15, fq = lane >> 4;
    const int Kb = g.Kb, nt = Kb / (BK * 2);
    unsigned voffA[2], voffB[2][2]; int Ra[2];
#pragma unroll
    for (int i = 0; i < 2; ++i) { int R, Cb; if (FP8) stage_rc8(tid * 16 + i * 8192, R, Cb); else { stage_rc(tid * 16 + i * 8192, R, Cb); Cb *= 2; }
        const int Rb = Epi::PERM ? ((R & ~31) + perm32(R & 31)) : R;
        Ra[i] = R; voffA[i] = GATHER ? (unsigned)Cb : (unsigned)(R * Kb + Cb);
#pragma unroll
        for (int h = 0; h < 2; ++h) voffB[h][i] = (int)Epi::PERM == 2 ? (unsigned)(perm256(h, R) * Kb + Cb) : (unsigned)((Rb + h * HALF) * Kb + Cb); }
    const size_t kstep = (size_t)(BK * 2);
    const size_t hstep = (size_t)HALF * Kb;
    const size_t hstepA = GATHER ? (size_t)0 : hstep;
    const unsigned ldsw = (unsigned)wid * 1024u;
    const int aoff = FP8 ? lds_byte8(wr * 64 + fr, 2 * fq) : lds_byte(wr * 64 + fr, fq * 8), boff = FP8 ? lds_byte8(wc * 32 + fr, 2 * fq) : lds_byte(wc * 32 + fr, fq * 8);
    const int aoff1 = FP8 ? lds_byte8(wr * 64 + fr, 2 * fq + 1) : 0, boff1 = FP8 ? lds_byte8(wc * 32 + fr, 2 * fq + 1) : 0;
#define PG8_SA(b, h) (((b) * 2 + (h)) * HTB)
#define PG8_SB(b, h) ((4 + (b) * 2 + (h)) * HTB)
#define PG8_STAGE(bufoff, gbase, voff) do { _Pragma("unroll") for (int _i = 0; _i < 2; ++_i) \
        __builtin_amdgcn_global_load_lds((const unsigned*)((const char*)(gbase) + (voff)[_i]), (PG8_LAS unsigned*)(lds + (bufoff) + ldsw + _i * 8192), 16, 0, 0); } while (0)
#define PG8_STAGE_A(bufoff, kbase, h) do { _Pragma("unroll") for (int _i = 0; _i < 2; ++_i) \
        __builtin_amdgcn_global_load_lds((const unsigned*)((const char*)(kbase) + (size_t)(h) * hstepA + (GATHER ? gC[h][_i] : 0u) + voffA[_i]), (PG8_LAS unsigned*)(lds + (bufoff) + ldsw + _i * 8192), 16, 0, 0); } while (0)
#define PG8_LD16(off) (*(const PG8_LAS v4i32*)(lds + (off)))
#define PG8_LDA(dst, b, h) do { _Pragma("unroll") for (int m = 0; m < 4; ++m) { if constexpr (FP8) dst##8[m] = __builtin_shufflevector(PG8_LD16(PG8_SA(b, h) + aoff + m * 2048), PG8_LD16(PG8_SA(b, h) + aoff1 + m * 2048), 0, 1, 2, 3, 4, 5, 6, 7); \
        else { _Pragma("unroll") for (int k = 0; k < 2; ++k) dst[m][k] = *(const PG8_LAS bf16x8*)(lds + PG8_SA(b, h) + aoff + m * 2048 + k * 1024); } } } while (0)
#define PG8_LDB(dst, b, h) do { _Pragma("unroll") for (int n = 0; n < 2; ++n) { if constexpr (FP8) dst##8[n] = __builtin_shufflevector(PG8_LD16(PG8_SB(b, h) + boff + n * 2048), PG8_LD16(PG8_SB(b, h) + boff1 + n * 2048), 0, 1, 2, 3, 4, 5, 6, 7); \
        else { _Pragma("unroll") for (int k = 0; k < 2; ++k) dst[n][k] = *(const PG8_LAS bf16x8*)(lds + PG8_SB(b, h) + boff + n * 2048 + k * 1024); } } } while (0)
#define PG8_MMA(ai, bj, At, Bt, ZF) do { __builtin_amdgcn_s_setprio(1); _Pragma("unroll") for (int m = 0; m < 4; ++m) _Pragma("unroll") for (int n = 0; n < 2; ++n) { \
        if constexpr (FP8) { if constexpr (ZF) asm volatile("v_mfma_f32_16x16x128_f8f6f4 %0, %1, %2, 0" : "=v"(acc[ai][bj][m][n]) : "v"(Bt##8[n]), "v"(At##8[m])); \
                             else asm volatile("v_mfma_f32_16x16x128_f8f6f4 %0, %1, %2, %0" : "+v"(acc[ai][bj][m][n]) : "v"(Bt##8[n]), "v"(At##8[m])); } \
        else { acc[ai][bj][m][n] = __builtin_amdgcn_mfma_f32_16x16x32_bf16(Bt[n][0], At[m][0], ZF ? (f32x4){0.f, 0.f, 0.f, 0.f} : acc[ai][bj][m][n], 0, 0, 0); \
               acc[ai][bj][m][n] = __builtin_amdgcn_mfma_f32_16x16x32_bf16(Bt[n][1], At[m][1], acc[ai][bj][m][n], 0, 0, 0); } } \
        __builtin_amdgcn_s_setprio(0); } while (0)
#define PG8_WAIT_V(n) asm volatile("s_waitcnt vmcnt(" #n ")" ::: "memory")
#define PG8_WAIT_L(n) asm volatile("s_waitcnt lgkmcnt(" #n ")" ::: "memory")
#define PG8_BAR __builtin_amdgcn_s_barrier()
#define PG8_SCHED __builtin_amdgcn_sched_barrier(0)
    Unit cur, nxt; int ui = 0;
    if (!S.next(0, cur)) return;
    f32x4 acc[2][2][4][2];
    bf16x8 At[4][2], B0[2][2], B1[2][2]; v8i32 At8[4], B08[2], B18[2];
#define PG8_TOK_ISSUE(u_, slot_) do { if (wid < 4) __builtin_amdgcn_global_load_lds((const unsigned*)S.tok_src(u_, tid), (PG8_LAS unsigned*)(S.tokt + (slot_) * 1024 + wid * 256), 4, 0, 0); } while (0)
#define PG8_TOK_READ(slot_) do { _Pragma("unroll") for (int h = 0; h < 2; ++h) _Pragma("unroll") for (int i = 0; i < 2; ++i) \
        gC[h][i] = *(const PG8_LAS unsigned*)(S.tokt + (slot_) * 1024 + (h * HALF + Ra[i]) * 4) * (unsigned)Kb; } while (0)
    unsigned gC[2][2];
#pragma unroll
    for (int h = 0; h < 2; ++h)
#pragma unroll
        for (int i = 0; i < 2; ++i) gC[h][i] = 0u;
    if constexpr (GATHER) { PG8_TOK_ISSUE(cur, 0); PG8_WAIT_V(0); PG8_BAR; PG8_TOK_READ(0); }
    const char* cA = (const char*)g.A + S.a_off(cur); const char* cB = (const char*)g.Bt + S.b_off(cur);
    PG8_STAGE(PG8_SB(0, 0), cB, voffB[0]); PG8_STAGE(PG8_SB(0, 1), cB, voffB[1]); PG8_STAGE_A(PG8_SA(0, 0), cA, 0); PG8_STAGE_A(PG8_SA(0, 1), cA, 1);
    if (wr == 1) PG8_BAR;
    PG8_WAIT_V(2); PG8_BAR;
    PG8_STAGE(PG8_SB(1, 0), cB + kstep, voffB[0]); PG8_STAGE_A(PG8_SA(1, 0), cA + kstep, 0); PG8_STAGE(PG8_SB(1, 1), cB + kstep, voffB[1]);
    PG8_WAIT_V(6); PG8_BAR;
    for (;;) {
        const bool has_next = S.next(ui + 1, nxt);
        const char* nA = has_next ? (const char*)g.A + S.a_off(nxt) : cA; const char* nB = has_next ? (const char*)g.Bt + S.b_off(nxt) : cB;
        if constexpr (GATHER) { if (has_next) PG8_TOK_ISSUE(nxt, (ui + 1) & 1); }
        if constexpr (FP8) {
        { constexpr bool ZF = true; const int t = 0;
            const bool last = (t == nt - 2);
            const char* a1 = cA + (size_t)(t + 1) * kstep;
            const char* a2 = last ? nA : cA + (size_t)(t + 2) * kstep; const char* b2 = last ? nB : cB + (size_t)(t + 2) * kstep;
            const char* a3 = a2 + kstep; const char* b3 = b2 + kstep;
            PG8_LDB(B0, 0, 0); PG8_LDB(B1, 0, 1); PG8_SCHED; PG8_LDA(At, 0, 0); PG8_STAGE_A(PG8_SA(1, 1), a1, 1);
            PG8_WAIT_V(8); PG8_WAIT_L(0); PG8_BAR; PG8_MMA(0, 0, At, B0, ZF); PG8_MMA(0, 1, At, B1, ZF); PG8_BAR; PG8_SCHED;
            if constexpr (GATHER) { if (last && has_next) PG8_TOK_READ((ui + 1) & 1); }
            PG8_LDA(At, 0, 1); PG8_STAGE(PG8_SB(0, 0), b2, voffB[0]); PG8_STAGE(PG8_SB(0, 1), b2, voffB[1]); PG8_STAGE_A(PG8_SA(0, 0), a2, 0);
            PG8_WAIT_V(8); PG8_WAIT_L(0); PG8_BAR; PG8_MMA(1, 0, At, B0, ZF); PG8_MMA(1, 1, At, B1, ZF); PG8_BAR; PG8_SCHED;
            PG8_LDB(B0, 1, 0); PG8_LDB(B1, 1, 1); PG8_SCHED; PG8_LDA(At, 1, 0); PG8_STAGE_A(PG8_SA(0, 1), a2, 1);
            PG8_WAIT_V(8); PG8_WAIT_L(0); PG8_BAR; PG8_MMA(0, 0, At, B0, false); PG8_MMA(0, 1, At, B1, false); PG8_BAR; PG8_SCHED;
            PG8_LDA(At, 1, 1); PG8_STAGE(PG8_SB(1, 0), b3, voffB[0]); PG8_STAGE(PG8_SB(1, 1), b3, voffB[1]); PG8_STAGE_A(PG8_SA(1, 0), a3, 0);
            PG8_WAIT_V(8); PG8_WAIT_L(0); PG8_BAR; PG8_MMA(1, 0, At, B0, false); PG8_MMA(1, 1, At, B1, false); PG8_BAR; PG8_SCHED;
                }
#pragma unroll 1
        for (int t = 2; t < nt; t += 2) { constexpr bool ZF = false;
            const bool last = (t == nt - 2);
            const char* a1 = cA + (size_t)(t + 1) * kstep;
            const char* a2 = last ? nA : cA + (size_t)(t + 2) * kstep; const char* b2 = last ? nB : cB + (size_t)(t + 2) * kstep;
            const char* a3 = a2 + kstep; const char* b3 = b2 + kstep;
            PG8_LDB(B0, 0, 0); PG8_LDB(B1, 0, 1); PG8_SCHED; PG8_LDA(At, 0, 0); PG8_STAGE_A(PG8_SA(1, 1), a1, 1);
            PG8_WAIT_V(8); PG8_WAIT_L(0); PG8_BAR; PG8_MMA(0, 0, At, B0, ZF); PG8_MMA(0, 1, At, B1, ZF); PG8_BAR; PG8_SCHED;
            if constexpr (GATHER) { if (last && has_next) PG8_TOK_READ((ui + 1) & 1); }
            PG8_LDA(At, 0, 1); PG8_STAGE(PG8_SB(0, 0), b2, voffB[0]); PG8_STAGE(PG8_SB(0, 1), b2, voffB[1]); PG8_STAGE_A(PG8_SA(0, 0), a2, 0);
            PG8_WAIT_V(8); PG8_WAIT_L(0); PG8_BAR; PG8_MMA(1, 0, At, B0, ZF); PG8_MMA(1, 1, At, B1, ZF); PG8_BAR; PG8_SCHED;
            PG8_LDB(B0, 1, 0); PG8_LDB(B1, 1, 1); PG8_SCHED; PG8_LDA(At, 1, 0); PG8_STAGE_A(PG8_SA(0, 1), a2, 1);
            PG8_WAIT_V(8); PG8_WAIT_L(0); PG8_BAR; PG8_MMA(0, 0, At, B0, false); PG8_MMA(0, 1, At, B1, false); PG8_BAR; PG8_SCHED;
            PG8_LDA(At, 1, 1); PG8_STAGE(PG8_SB(1, 0), b3, voffB[0]); PG8_STAGE(PG8_SB(1, 1), b3, voffB[1]); PG8_STAGE_A(PG8_SA(1, 0), a3, 0);
            PG8_WAIT_V(8); PG8_WAIT_L(0); PG8_BAR; PG8_MMA(1, 0, At, B0, false); PG8_MMA(1, 1, At, B1, false); PG8_BAR; PG8_SCHED;
                }
        } else {
#pragma unroll
        for (int a = 0; a < 2; ++a)
#pragma unroll
            for (int b = 0; b < 2; ++b)
#pragma unroll
                for (int m = 0; m < 4; ++m)
#pragma unroll
                    for (int n = 0; n < 2; ++n) acc[a][b][m][n] = (f32x4){0.f, 0.f, 0.f, 0.f};
#pragma unroll 1
        for (int t = 0; t < nt; t += 2) { constexpr bool ZF = false;
            const bool last = (t == nt - 2);
            const char* a1 = cA + (size_t)(t + 1) * kstep;
            const char* a2 = last ? nA : cA + (size_t)(t + 2) * kstep; const char* b2 = last ? nB : cB + (size_t)(t + 2) * kstep;
            const char* a3 = a2 + kstep; const char* b3 = b2 + kstep;
            PG8_LDB(B0, 0, 0); PG8_LDB(B1, 0, 1); PG8_SCHED; PG8_LDA(At, 0, 0); PG8_STAGE_A(PG8_SA(1, 1), a1, 1);
            PG8_WAIT_V(8); PG8_WAIT_L(0); PG8_BAR; PG8_MMA(0, 0, At, B0, ZF); PG8_MMA(0, 1, At, B1, ZF); PG8_BAR; PG8_SCHED;
            if constexpr (GATHER) { if (last && has_next) PG8_TOK_READ((ui + 1) & 1); }
            PG8_LDA(At, 0, 1); PG8_STAGE(PG8_SB(0, 0), b2, voffB[0]); PG8_STAGE(PG8_SB(0, 1), b2, voffB[1]); PG8_STAGE_A(PG8_SA(0, 0), a2, 0);
            PG8_WAIT_V(8); PG8_WAIT_L(0); PG8_BAR; PG8_MMA(1, 0, At, B0, ZF); PG8_MMA(1, 1, At, B1, ZF); PG8_BAR; PG8_SCHED;
            PG8_LDB(B0, 1, 0); PG8_LDB(B1, 1, 1); PG8_SCHED; PG8_LDA(At, 1, 0); PG8_STAGE_A(PG8_SA(0, 1), a2, 1);
            PG8_WAIT_V(8); PG8_WAIT_L(0); PG8_BAR; PG8_MMA(0, 0, At, B0, false); PG8_MMA(0, 1, At, B1, false); PG8_BAR; PG8_SCHED;
            PG8_LDA(At, 1, 1); PG8_STAGE(PG8_SB(1, 0), b3, voffB[0]); PG8_STAGE(PG8_SB(1, 1), b3, voffB[1]); PG8_STAGE_A(PG8_SA(1, 0), a3, 0);
            PG8_WAIT_V(8); PG8_WAIT_L(0); PG8_BAR; PG8_MMA(1, 0, At, B0, false); PG8_MMA(1, 1, At, B1, false); PG8_BAR; PG8_SCHED;
                }
        }
        if constexpr (ALIGN_EPI) { if (wr == 0) PG8_BAR; }
        if constexpr (FP8) asm volatile("s_nop 15\n\ts_nop 15" ::: "memory");
        E(acc, cur, wr, wc, fr, fq);
        if (!has_next) break;
        cur = nxt; cA = nA; cB = nB; ++ui;
        if constexpr (ALIGN_EPI) { if (wr == 1) PG8_BAR; }
    }
    PG8_WAIT_V(0);
    if constexpr (!ALIGN_EPI) { if (wr == 0) PG8_BAR; }
    PG8_BAR;
#undef PG8_SA
#undef PG8_SB
#undef PG8_STAGE
#undef PG8_STAGE_A
#undef PG8_TOK_ISSUE
#undef PG8_TOK_READ
#undef PG8_LDA
#undef PG8_LDB
#undef PG8_MMA
#undef PG8_LD16
#undef PG8_WAIT_V
#undef PG8_WAIT_L
#undef PG8_BAR
#undef PG8_SCHED
}
}
#define LAS __attribute__((address_space(3)))
#define GAS __attribute__((address_space(1)))
constexpr int NWAVES = 8, NTHREADS = 512;
constexpr int LDS_BYTES = 163840;
constexpr int SCR_BYTES = 147456;
constexpr int LDSCTL_OFF = SCR_BYTES;
constexpr int TAB_OFF = LDSCTL_OFF + 512;
constexpr int TAB_CNT = 0, TAB_P0 = 32, TAB_TE = 72;
constexpr int TOKT_OFF = TAB_OFF + 2048;
#define LDS_WAIT() asm volatile("s_waitcnt lgkmcnt(0)" ::: "memory")
#define WAVE_SYNC() do { asm volatile("s_waitcnt lgkmcnt(0)" ::: "memory"); __builtin_amdgcn_wave_barrier(); } while (0)

#ifndef MOE_FP8
#define MOE_FP8 1
#endif
constexpr float W13_SCALE = 32.f, W2_SCALE = 16.f, ACT_SCALE = 4.f, Y_SCALE = 16.f;
struct Args {
    const float* in[27]; float* out; unsigned char* ws; int ph_lo, ph_hi;
};
struct Frame {
    LAS unsigned char* lds; LAS int* tab; unsigned* ctl; unsigned char* ws;
    int tid, lane, wave, G, bid, vcu;
};
enum Phase { PH_A = 0, PH_B, PH_C, PH_D, PH_E, PH_F, PH_G, PH_H, PH_I, PH_J, PH_N };

#define XB_TMO      128
#define XB_XCNT(j)  (256  + 64 * (j))
#define XB_XSUB(j)  (1280 + 64 * (j))
#define XB_XGEN(j)  (2304 + 64 * (j))
#define XB_TOP      3328
#define XB_TOPGEN   3392
#define XCD_BAR_WORDS 3456
#define XB_SPIN_CAP (1u << 18)
__device__ __forceinline__ unsigned xb_ld(unsigned* p)              { return __hip_atomic_load(p, __ATOMIC_RELAXED, __HIP_MEMORY_SCOPE_AGENT); }
__device__ __forceinline__ unsigned xb_add(unsigned* p, unsigned v) { return __hip_atomic_fetch_add(p, v, __ATOMIC_RELAXED, __HIP_MEMORY_SCOPE_AGENT); }
__device__ __forceinline__ unsigned xb_xcc_id() { return (unsigned)__builtin_amdgcn_s_getreg((3 << 11) | 20) & 0xFu; }
#define XB_SPIN(cond, bar) do { unsigned _sp = 0; while (cond) { __builtin_amdgcn_s_sleep(1); \
    if ((++_sp & 255u) == 0u) { if (xb_ld(&(bar)[XB_TMO])) break; if (_sp > XB_SPIN_CAP) { atomicAdd(&(bar)[XB_TMO], 1u); break; } } } } while (0)
struct XcdBarrier { unsigned* bar; unsigned x; volatile LAS unsigned* st; };
__device__ __forceinline__ XcdBarrier xcd_barrier_post(unsigned* bar, volatile LAS unsigned* st) {
    XcdBarrier b; b.bar = bar; b.x = xb_xcc_id(); b.st = st;
    if (threadIdx.x == 0) (void)xb_add(&bar[XB_XCNT(b.x)], 1u);
    return b;
}
__device__ __forceinline__ void xcd_barrier_complete(unsigned* bar, unsigned x, unsigned& nloc, unsigned& nx) {
    const unsigned G = gridDim.x * gridDim.y * gridDim.z;
    unsigned sum, cnt, mine, sp = 0u;
    for (;;) {
        sum = 0u; cnt = 0u; mine = 0u;
#pragma unroll
        for (unsigned j = 0; j < 16; ++j) { const unsigned c = xb_ld(&bar[XB_XCNT(j)]); sum += c; cnt += (c > 0u) ? 1u : 0u; mine = (j == x) ? c : mine; }
        if (sum == G) break;
        __builtin_amdgcn_s_sleep(1);
        if ((++sp & 255u) == 0u) { if (xb_ld(&bar[XB_TMO])) break; if (sp > XB_SPIN_CAP) { atomicAdd(&bar[XB_TMO], 1u); break; } }
    }
    nloc = mine > 0u ? mine : 1u; nx = cnt > 0u ? cnt : 1u;
}
__device__ __forceinline__ void xcd_barrier(const XcdBarrier& b) {
    asm volatile("s_waitcnt vmcnt(0)" ::: "memory");
    __syncthreads();
    if (threadIdx.x == 0) {
        unsigned* bar = b.bar;
        __builtin_amdgcn_s_waitcnt(0);
        unsigned nloc = b.st[0], nx = b.st[1];
        if (nloc == 0u) { xcd_barrier_complete(bar, b.x, nloc, nx); b.st[0] = nloc; b.st[1] = nx; }
        const unsigned old = xb_add(&bar[XB_XSUB(b.x)], 1u);
        const unsigned gen = old / nloc;
        if (old + 1u == (gen + 1u) * nloc) {
            __builtin_amdgcn_fence(__ATOMIC_RELEASE, "agent");
            asm volatile("s_waitcnt vmcnt(0)" ::: "memory");
            asm volatile("buffer_inv sc1" ::: "memory");
            const unsigned og = xb_add(&bar[XB_TOP], 1u);
            asm volatile("s_waitcnt vmcnt(0)" ::: "memory");
            const unsigned tg = og / nx;
            if (og + 1u == (tg + 1u) * nx) xb_add(&bar[XB_TOPGEN], 1u);
            else XB_SPIN(xb_ld(&bar[XB_TOPGEN]) == tg, bar);
            xb_add(&bar[XB_XGEN(b.x)], 1u);
            asm volatile("s_waitcnt vmcnt(0)" ::: "memory");
        } else {
            asm volatile("buffer_inv sc1" ::: "memory");
            XB_SPIN(xb_ld(&bar[XB_XGEN(b.x)]) == gen, bar);
            asm volatile("s_waitcnt vmcnt(0)" ::: "memory");
        }
        __builtin_amdgcn_fence(__ATOMIC_ACQUIRE, "workgroup");
    }
    __syncthreads();
}

__device__ __forceinline__ void build_moe_table(Frame& F) {
    __syncthreads();
    if (F.tid < 64) {
        const int c = F.tid < NE ? (int)__hip_atomic_load(F.ctl + CW_CNT + CNT_STRIDE * F.tid, __ATOMIC_RELAXED, __HIP_MEMORY_SCOPE_AGENT) : 0;
        const int nt = (c + 255) >> 8; int p = nt;
#pragma unroll
        for (int o = 1; o < 32; o <<= 1) { const int v = __shfl_up(p, o); if (F.lane >= o) p += v; }
        const int excl = p - nt;
        if (F.tid < NE) { F.tab[TAB_CNT + F.tid] = c; F.tab[TAB_P0 + F.tid] = excl; for (int j = 0; j < nt; ++j) F.tab[TAB_TE + excl + j] = F.tid; }
        if (F.tid == NE - 1) F.tab[TAB_P0 + NE] = p;
    }
    __syncthreads();
}

struct TItem { const float* W; unsigned char* WT; int N, K, blk, rstride, rbase, k0, n0, fp8; float scale; };
__device__ __forceinline__ void titem_load(const TItem& d, f32x4 (&v)[16], int lane) {
#pragma unroll
    for (int i = 0; i < 16; ++i) v[i] = *(const f32x4*)(d.W + (size_t)(d.k0 + 16 * (lane >> 5) + i) * d.N + d.n0 + 4 * (lane & 31));
}
__device__ __forceinline__ unsigned pk4_fp8_nc(float a, float b, float c, float d) {
    unsigned w = 0u; w = __builtin_amdgcn_cvt_pk_fp8_f32(a, b, w, false); w = __builtin_amdgcn_cvt_pk_fp8_f32(c, d, w, true); return w; }
__device__ __forceinline__ void titem_store(const TItem& d, const f32x4 (&v)[16], int lane) {
#pragma unroll
    for (int q = 0; q < 4; ++q) {
        const int n = d.n0 + 4 * (lane & 31) + q, row = d.rbase + (n / d.blk) * d.rstride + (n % d.blk);
        if (d.fp8) { const float sc = d.scale; u32x4 o;
            o.x = pk4_fp8_nc(v[0][q] * sc, v[1][q] * sc, v[2][q] * sc, v[3][q] * sc); o.y = pk4_fp8_nc(v[4][q] * sc, v[5][q] * sc, v[6][q] * sc, v[7][q] * sc);
            o.z = pk4_fp8_nc(v[8][q] * sc, v[9][q] * sc, v[10][q] * sc, v[11][q] * sc); o.w = pk4_fp8_nc(v[12][q] * sc, v[13][q] * sc, v[14][q] * sc, v[15][q] * sc);
            *(u32x4*)(d.WT + (size_t)row * d.K + d.k0 + 16 * (lane >> 5)) = o;
        } else { u32x4 o0, o1;
            o0.x = pk2(v[0][q], v[1][q]); o0.y = pk2(v[2][q], v[3][q]); o0.z = pk2(v[4][q], v[5][q]); o0.w = pk2(v[6][q], v[7][q]);
            o1.x = pk2(v[8][q], v[9][q]); o1.y = pk2(v[10][q], v[11][q]); o1.z = pk2(v[12][q], v[13][q]); o1.w = pk2(v[14][q], v[15][q]);
            unsigned char* p = d.WT + ((size_t)row * d.K + d.k0 + 16 * (lane >> 5)) * 2; *(u32x4*)p = o0; *(u32x4*)(p + 16) = o1; }
    }
}
#ifndef CONV_PRE
#define CONV_PRE 1
#endif
constexpr int TI_IN = 512, TI_OUT = 256, TI_EXP = 384 * NE, TI_N = TI_IN + TI_OUT + TI_EXP;
__device__ __forceinline__ void titem_decode(const Args& args, unsigned char* ws, int it, TItem& d) {
    int r = it, item; d.fp8 = 0; d.scale = 1.f; d.rstride = 0; d.rbase = 0;
    if (r < TI_IN) { d.W = args.in[5]; d.WT = ws + OFF_WIN; d.K = 1024; d.N = 2048; d.blk = 2048; item = r; }
    else if ((r -= TI_IN) < TI_OUT) { d.W = args.in[17]; d.WT = ws + OFF_WOUT; d.K = 1024; d.N = 1024; d.blk = 1024; item = r; }
    else { r -= TI_OUT; const int e = r / 384, q = r % 384;
        if (q < 256) { d.W = (q < 128 ? args.in[23] : args.in[24]) + (size_t)e * 1024 * 512; d.K = 1024; d.N = 512; d.blk = 128; d.rstride = 256; d.rbase = q < 128 ? 0 : 128; item = q & 127;
            d.WT = ws + OFF_W13 + (size_t)e * 1024 * 1024 * (MOE_FP8 ? 1 : 2); d.scale = W13_SCALE; }
        else { d.W = args.in[25] + (size_t)e * 512 * 1024; d.K = 512; d.N = 1024; d.blk = 1024; item = q - 256; d.WT = ws + OFF_W2 + (size_t)e * 1024 * 512 * (MOE_FP8 ? 1 : 2); d.scale = W2_SCALE; }
        d.fp8 = MOE_FP8; if (!MOE_FP8) d.scale = 1.f; }
    const int nkb = d.K / 32; d.k0 = 32 * (item % nkb); d.n0 = 128 * (item / nkb);
}
__device__ __forceinline__ void phase_A(Frame& F, const Args& args) {
    unsigned char* ws = F.ws;
    const float* c = args.in[1]; const float* ada_w = args.in[2]; const float* ada_b = args.in[3];
    float* mod = (float*)(ws + OFF_MOD);
    for (int it = F.G - 1 - F.bid; it < 192; it += F.G) {
        LAS float* sc = (LAS float*)F.lds; LAS float* red = sc + 8192;
        for (int i = F.tid; i < 8192; i += NTHREADS) { const float v = c[i]; sc[(i & 1023) * 8 + (i >> 10)] = v / (1.0f + __expf(-v)); }
        __syncthreads();
        const int col = F.lane & 31, ks = F.lane >> 5, n = it * 32 + col, k0 = F.wave * 128 + ks;
        float acc[8];
#pragma unroll
        for (int b = 0; b < 8; ++b) acc[b] = 0.f;
#pragma unroll 1
        for (int i0 = 0; i0 < 64; i0 += 16) {
            float wv[16];
#pragma unroll
            for (int i = 0; i < 16; ++i) wv[i] = ada_w[(size_t)(k0 + 2 * (i0 + i)) * 6144 + n];
#pragma unroll
            for (int i = 0; i < 16; ++i) { const int k = k0 + 2 * (i0 + i);
                const f32x4 s0 = *(const LAS f32x4*)(sc + k * 8), s1 = *(const LAS f32x4*)(sc + k * 8 + 4);
#pragma unroll
                for (int b = 0; b < 4; ++b) { acc[b] += s0[b] * wv[i]; acc[4 + b] += s1[b] * wv[i]; } }
        }
#pragma unroll
        for (int b = 0; b < 8; ++b) { acc[b] += __shfl_xor(acc[b], 32); if (ks == 0) red[(F.wave * 8 + b) * 32 + col] = acc[b]; }
        __syncthreads();
        if (F.tid < 256) { const int b = F.tid >> 5, cc = F.tid & 31; float s = ada_b[it * 32 + cc];
#pragma unroll
            for (int w = 0; w < 8; ++w) s += red[(w * 8 + b) * 32 + cc];
            mod[b * 6144 + it * 32 + cc] = s; }
        __syncthreads();
    }
    {
        const int gw = F.vcu * NWAVES + F.wave, NGW = F.G * NWAVES;
        const int it_end = (F.G == 256) ? TI_IN + TI_OUT : TI_N;
        int it = gw;
        if (it < it_end) {
            TItem d, d2; f32x4 v[16], v2[16];
            titem_decode(args, ws, it, d); titem_load(d, v, F.lane);
            for (;;) {
                const int itn = it + NGW; const bool more = itn < it_end;
                if (more) { titem_decode(args, ws, itn, d2); titem_load(d2, v2, F.lane); }
                titem_store(d, v, F.lane);
                if (!more) break;
                d = d2; it = itn;
#pragma unroll
                for (int i = 0; i < 16; ++i) v[i] = v2[i];
            }
        }
    }
    {
        const int gt = F.bid * NTHREADS + F.tid, NGT = F.G * NTHREADS;
        const float* sgu_w = args.in[15]; const float* rgw = args.in[19]; const float* rew = args.in[21]; const float* lam = args.in[12];
        bf16_t* SGUW = (bf16_t*)(ws + OFF_SGUW); bf16_t* ROUTW = (bf16_t*)(ws + OFF_ROUTW); float* N8SP = (float*)(ws + OFF_N8SP);
        for (int i = gt; i < 8 * 128 * 128; i += NGT) { const int ii = (i >> 7) & 127, j = i & 127; SGUW[i] = (bf16_t)(((j >> 6) <= (ii >> 6)) ? f2bf(sgu_w[i]) : 0u); }
        for (int i = gt; i < 48 * 1024; i += NGT) { const int n = i >> 10, k = i & 1023; const float v = n < 4 ? rgw[k * 4 + n] : (n < 36 ? rew[k * 32 + n - 4] : 0.f); ROUTW[i] = (bf16_t)f2bf(v); }
        for (int i = gt; i < 512; i += NGT) N8SP[i] = -8.0f * 1.4426950408889634f * log1pf(expf(-lam[i]));
        { float* GB = (float*)(ws + OFF_GBIAS); const float* gab_ = args.in[9]; const float* gib_ = args.in[11];
          for (int i = gt; i < 1024; i += NGT) GB[i] = -1.4426950408889634f * (i < 512 ? gab_[i] : gib_[i - 512]); }
        { const float* gaw = args.in[8]; const float* giw = args.in[10]; bf16_t* GATEW = (bf16_t*)(ws + OFF_GATEW);
          for (int i = gt; i < 8 * 128 * 64; i += NGT) { const int h = i >> 13, ee = (i >> 6) & 127, dd = i & 63; const float v = -1.4426950408889634f * (ee < 64 ? gaw : giw)[h * 4096 + dd * 64 + (ee & 63)]; GATEW[i] = (bf16_t)f2bf(v); } }
    }
}

__device__ __forceinline__ void convert_experts(Frame& F, const Args& args, int gw, int NGW, int first, int count) {
    unsigned char* ws = F.ws;
    int it = first + gw; const int it_end = first + count;
    if (it < it_end) {
        TItem d, d2; f32x4 v[16], v2[16];
        titem_decode(args, ws, TI_IN + TI_OUT + it, d); titem_load(d, v, F.lane);
        for (;;) {
            const int itn = it + NGW; const bool more = itn < it_end;
            if (more) { titem_decode(args, ws, TI_IN + TI_OUT + itn, d2); titem_load(d2, v2, F.lane); }
            titem_store(d, v, F.lane);
            if (!more) break;
            d = d2; it = itn;
#pragma unroll
            for (int i = 0; i < 16; ++i) v[i] = v2[i];
        }
    }
}

__device__ __forceinline__ void phase_B(Frame& F, const Args& args) {
    const float* x = args.in[0]; const float* g = args.in[4]; const float* mod = (const float*)(F.ws + OFF_MOD); bf16_t* XN = (bf16_t*)(F.ws + OFF_XN);
    const int gw = F.bid * NWAVES + F.wave, NGW = F.G * NWAVES, lane = F.lane;
    constexpr int RPW = 16;
    for (int item = gw; item < T / RPW; item += NGW) {
        const int row0 = item * RPW, b = row0 / SEQ;
        const float* sh = mod + b * 6144; const float* sc = sh + 1024;
        f32x4 gm[4], sv[4];
#pragma unroll
        for (int j = 0; j < 4; ++j) { const int col = 4 * (lane + 64 * j); const f32x4 gg = *(const f32x4*)(g + col), s1 = *(const f32x4*)(sc + col); sv[j] = *(const f32x4*)(sh + col); gm[j] = gg * (1.0f + s1); }
        f32x4 v[4], nv[4];
#pragma unroll
        for (int j = 0; j < 4; ++j) v[j] = ((const f32x4*)(x + (size_t)row0 * D))[lane + 64 * j];
#pragma unroll 1
        for (int r = 0; r < RPW; ++r) {
            const int row = row0 + r, nrow = (r + 1 < RPW) ? row + 1 : row;
#pragma unroll
            for (int j = 0; j < 4; ++j) nv[j] = ((const f32x4*)(x + (size_t)nrow * D))[lane + 64 * j];
            float ss = 0.f;
#pragma unroll
            for (int j = 0; j < 4; ++j) ss += v[j][0] * v[j][0] + v[j][1] * v[j][1] + v[j][2] * v[j][2] + v[j][3] * v[j][3];
            const float rs = rsqrtf(wave_sum(ss) * (1.0f / D) + EPS);
#pragma unroll
            for (int j = 0; j < 4; ++j) { const int col = 4 * (lane + 64 * j); const f32x4 h = v[j] * rs * gm[j] + sv[j];
                u32x2 o; o.x = pk2(h[0], h[1]); o.y = pk2(h[2], h[3]);
                *(u32x2*)(XN + (size_t)row * D + col) = o; v[j] = nv[j]; }
        }
    }
}

#ifndef SGU_TR
#define SGU_TR 1
#endif
typedef short s16x4 __attribute__((ext_vector_type(4)));
typedef short v4i16_t __attribute__((ext_vector_type(4)));
constexpr int IMG_STRIDE = 1040;
__device__ __forceinline__ float bflo(unsigned w) { return __uint_as_float(w << 16); }
__device__ __forceinline__ float bfhi(unsigned w) { return __uint_as_float(w & 0xffff0000u); }
__device__ __forceinline__ void sgu_block(Frame& F, const Args& args, int blk) {
    const bf16_t* Z = (const bf16_t*)(F.ws + OFF_Z); bf16_t* YMIX = (bf16_t*)(F.ws + OFF_YMIX); const bf16_t* SGUW = (const bf16_t*)(F.ws + OFF_SGUW);
    const float* ln_g = args.in[13]; const float* ln_b = args.in[14]; const float* sgu_b = args.in[16];
    const int lane = F.lane, w = F.wave; const size_t t0 = (size_t)blk * 128;
    {
        u32x4 raw[16];
#pragma unroll
        for (int r = 0; r < 16; ++r) raw[r] = *(const u32x4*)(Z + (t0 + w * 16 + r) * 2048 + 1536 + 8 * lane);
        const f32x4 g0 = *(const f32x4*)(ln_g + 8 * lane), g1 = *(const f32x4*)(ln_g + 8 * lane + 4), b0 = *(const f32x4*)(ln_b + 8 * lane), b1 = *(const f32x4*)(ln_b + 8 * lane + 4);
#pragma unroll
        for (int r = 0; r < 16; ++r) {
            float v[8];
#pragma unroll
            for (int q = 0; q < 4; ++q) { v[2 * q] = bflo(raw[r][q]); v[2 * q + 1] = bfhi(raw[r][q]); }
            float s = 0.f;
#pragma unroll
            for (int q = 0; q < 8; ++q) s += v[q];
            const float mu = wave_sum(s) * (1.0f / 512.0f);
            float s2 = 0.f;
#pragma unroll
            for (int q = 0; q < 8; ++q) { v[q] -= mu; s2 += v[q] * v[q]; }
            const float rstd = rsqrtf(wave_sum(s2) * (1.0f / 512.0f) + EPS);
            u32x4 o;
            o.x = pk2(v[0] * rstd * g0[0] + b0[0], v[1] * rstd * g0[1] + b0[1]); o.y = pk2(v[2] * rstd * g0[2] + b0[2], v[3] * rstd * g0[3] + b0[3]);
            o.z = pk2(v[4] * rstd * g1[0] + b1[0], v[5] * rstd * g1[1] + b1[1]); o.w = pk2(v[6] * rstd * g1[2] + b1[2], v[7] * rstd * g1[3] + b1[3]);
            *(LAS u32x4*)(F.lds + (w * 16 + r) * IMG_STRIDE + 16 * lane) = o;
        }
    }
    __syncthreads();
    {
        const int g = w;
        int fr = lane & 15, fq = lane >> 4; asm volatile("" : "+v"(fr), "+v"(fq));
        bf16x8 af[4][4];
#pragma unroll
        for (int kt = 0; kt < 4; ++kt)
#pragma unroll
            for (int ct = 0; ct < 4; ++ct) {
#if SGU_TR
                LAS unsigned char* p = F.lds + (32 * kt + 8 * fq + (fr >> 2)) * IMG_STRIDE + (g * 64 + 32 * (ct >> 1) + 8 * (fr & 3) + 4 * (ct & 1)) * 2;
                const s16x4 lo = __builtin_bit_cast(s16x4, __builtin_amdgcn_ds_read_tr16_b64_v4i16((LAS v4i16_t*)p));
                const s16x4 hi = __builtin_bit_cast(s16x4, __builtin_amdgcn_ds_read_tr16_b64_v4i16((LAS v4i16_t*)(p + 4 * IMG_STRIDE)));
                af[kt][ct] = (bf16x8){lo[0], lo[1], lo[2], lo[3], hi[0], hi[1], hi[2], hi[3]};
#else
                const LAS bf16_t* p = (const LAS bf16_t*)(F.lds + (32 * kt + 8 * fq) * IMG_STRIDE) + g * 64 + 16 * (fr >> 2) + 4 * ct + (fr & 3);
#pragma unroll
                for (int e = 0; e < 8; ++e) af[kt][ct][e] = (short)p[e * (IMG_STRIDE / 2)];
#endif
            }
        bf16x8 wf[4], nwf[4]; u32x4 gu0, gu1, ngu0, ngu1; float bias, nbias;
        { const bf16_t* wp = SGUW + ((size_t)(g * 128 + fr)) * 128 + 8 * fq;
#pragma unroll
          for (int kt = 0; kt < 4; ++kt) wf[kt] = *(const bf16x8*)(wp + 32 * kt);
          const size_t t = t0 + fr; gu0 = *(const u32x4*)(Z + t * 2048 + 1024 + g * 64 + 8 * fq); gu1 = *(const u32x4*)(Z + t * 2048 + 1024 + g * 64 + 32 + 8 * fq); bias = sgu_b[g * 128 + fr]; }
#pragma unroll 1
        for (int it = 0; it < 8; ++it) {
            const int i0 = 16 * it, in0 = it < 7 ? i0 + 16 : i0;
            { const bf16_t* wp = SGUW + ((size_t)(g * 128 + in0 + fr)) * 128 + 8 * fq;
#pragma unroll
              for (int kt = 0; kt < 4; ++kt) nwf[kt] = *(const bf16x8*)(wp + 32 * kt);
              const size_t tn = t0 + in0 + fr; ngu0 = *(const u32x4*)(Z + tn * 2048 + 1024 + g * 64 + 8 * fq); ngu1 = *(const u32x4*)(Z + tn * 2048 + 1024 + g * 64 + 32 + 8 * fq); nbias = sgu_b[g * 128 + in0 + fr]; }
            f32x4 acc[4];
#pragma unroll
            for (int ct = 0; ct < 4; ++ct) acc[ct] = (f32x4){0.f, 0.f, 0.f, 0.f};
#pragma unroll
            for (int kt = 0; kt < 4; ++kt)
#pragma unroll
                for (int ct = 0; ct < 4; ++ct) acc[ct] = __builtin_amdgcn_mfma_f32_16x16x32_bf16(af[kt][ct], wf[kt], acc[ct], 0, 0, 0);
            const size_t t = t0 + i0 + fr;
            u32x4 o0, o1;
            o0.x = pk2(bflo(gu0.x) * (acc[0][0] + bias), bfhi(gu0.x) * (acc[0][1] + bias)); o0.y = pk2(bflo(gu0.y) * (acc[0][2] + bias), bfhi(gu0.y) * (acc[0][3] + bias));
            o0.z = pk2(bflo(gu0.z) * (acc[1][0] + bias), bfhi(gu0.z) * (acc[1][1] + bias)); o0.w = pk2(bflo(gu0.w) * (acc[1][2] + bias), bfhi(gu0.w) * (acc[1][3] + bias));
            o1.x = pk2(bflo(gu1.x) * (acc[2][0] + bias), bfhi(gu1.x) * (acc[2][1] + bias)); o1.y = pk2(bflo(gu1.y) * (acc[2][2] + bias), bfhi(gu1.y) * (acc[2][3] + bias));
            o1.z = pk2(bflo(gu1.z) * (acc[3][0] + bias), bfhi(gu1.z) * (acc[3][1] + bias)); o1.w = pk2(bflo(gu1.w) * (acc[3][2] + bias), bfhi(gu1.w) * (acc[3][3] + bias));
            *(u32x4*)(YMIX + t * D + 512 + g * 64 + 8 * fq) = o0; *(u32x4*)(YMIX + t * D + 512 + g * 64 + 32 + 8 * fq) = o1;
#pragma unroll
            for (int kt = 0; kt < 4; ++kt) wf[kt] = nwf[kt];
            gu0 = ngu0; gu1 = ngu1; bias = nbias;
        }
    }
}

constexpr int XC_STRIDE = 144;
constexpr int AU_STRIDE = 68;
constexpr int LRU_WAVE_BYTES = 64 * XC_STRIDE + 2 * 16 * AU_STRIDE * 4;
__device__ __forceinline__ float sigm_fast(float x) { return __builtin_amdgcn_rcpf(1.0f + __builtin_amdgcn_exp2f(-1.4426950408889634f * x)); }
template <int PASS>
__device__ __forceinline__ void lru_block(Frame& F, const Args& args, int blk) {
    const bf16_t* Z = (const bf16_t*)(F.ws + OFF_Z); bf16_t* YMIX = (bf16_t*)(F.ws + OFF_YMIX); const bf16_t* GATEW = (const bf16_t*)(F.ws + OFF_GATEW);
    const float* N8SP = (const float*)(F.ws + OFF_N8SP); float* CA = (float*)(F.ws + OFF_CARRY); float* CH = CA + 256 * 512;
    const float* cw = args.in[6]; const float* cb = args.in[7]; const float* gab = (const float*)(F.ws + OFF_GBIAS); const float* gib = gab + 512;
    const int lane = F.lane, h = F.wave, fr = lane & 15, fq = lane >> 4, cg = lane & 7, run = lane >> 3; const size_t t0 = (size_t)blk * 128;
    LAS unsigned char* xcT = F.lds + h * LRU_WAVE_BYTES; LAS float* Abuf = (LAS float*)(xcT + 64 * XC_STRIDE); LAS float* Ubuf = Abuf + 16 * AU_STRIDE;
    float hst = 0.f, pp = 1.f;
    if (PASS == 2) { const int b0 = blk & ~31, n = blk & 31;
        float ca[31], ch[31];
#pragma unroll
        for (int k = 0; k < 31; ++k) { const int kk = k < n ? k : 0; ca[k] = CA[(size_t)(b0 + kk) * 512 + 64 * h + lane]; ch[k] = CH[(size_t)(b0 + kk) * 512 + 64 * h + lane]; }
#pragma unroll
        for (int k = 0; k < 31; ++k) hst = k < n ? ca[k] * hst + ch[k] : hst; }
    bf16x8 gw[8][2];
#pragma unroll
    for (int et = 0; et < 8; ++et)
#pragma unroll
        for (int kt = 0; kt < 2; ++kt) gw[et][kt] = *(const bf16x8*)(GATEW + ((size_t)(h * 128 + 16 * et + fr)) * 64 + 32 * kt + 8 * fq);
    const bool seq_start = (blk & 31) == 0;
#pragma unroll 1
    for (int hb = 0; hb < 2; ++hb) {
        const size_t tb = t0 + 64 * hb;
        {
            float cwv[4][8], cbv[8];
#pragma unroll
            for (int k = 0; k < 4; ++k) { const f32x4 a = *(const f32x4*)(cw + k * 512 + 64 * h + 8 * cg), b = *(const f32x4*)(cw + k * 512 + 64 * h + 8 * cg + 4);
#pragma unroll
                for (int q = 0; q < 4; ++q) { cwv[k][q] = a[q]; cwv[k][4 + q] = b[q]; } }
            { const f32x4 a = *(const f32x4*)(cb + 64 * h + 8 * cg), b = *(const f32x4*)(cb + 64 * h + 8 * cg + 4);
#pragma unroll
              for (int q = 0; q < 4; ++q) { cbv[q] = a[q]; cbv[4 + q] = b[q]; } }
            u32x4 xr[11];
#pragma unroll
            for (int j = 0; j < 11; ++j) { const int rel = 8 * run - 3 + j;
                const bool pad = (j < 3) && (rel < 0) && (hb == 0) && seq_start;
                const u32x4 v = *(const u32x4*)(Z + (size_t)((long)tb + (pad ? 0 : rel)) * 2048 + 64 * h + 8 * cg);
                xr[j] = pad ? (u32x4){0u, 0u, 0u, 0u} : v; }
#pragma unroll
            for (int s = 0; s < 8; ++s) { float o[8];
#pragma unroll
                for (int q = 0; q < 8; ++q) o[q] = cbv[q];
#pragma unroll
                for (int k = 0; k < 4; ++k) { const u32x4 r = xr[s + k];
#pragma unroll
                    for (int q = 0; q < 4; ++q) { o[2 * q] += cwv[k][2 * q] * bflo(r[q]); o[2 * q + 1] += cwv[k][2 * q + 1] * bfhi(r[q]); } }
                u32x4 pkd; pkd.x = pk2(o[0], o[1]); pkd.y = pk2(o[2], o[3]); pkd.z = pk2(o[4], o[5]); pkd.w = pk2(o[6], o[7]);
                *(LAS u32x4*)(xcT + (8 * run + s) * XC_STRIDE + 16 * cg) = pkd; }
        }
        WAVE_SYNC();
        u32x4 g0 = {0u, 0u, 0u, 0u}, g1 = g0, ng0 = g0, ng1 = g0;
        if (PASS == 2) { const size_t t = tb + (lane >> 2); g0 = *(const u32x4*)(Z + t * 2048 + 512 + 64 * h + 8 * (lane & 3)); g1 = *(const u32x4*)(Z + t * 2048 + 512 + 64 * h + 32 + 8 * (lane & 3)); }
#pragma unroll 1
        for (int it = 0; it < 4; ++it) {
            if (PASS == 2) { const size_t t = tb + 16 * (it < 3 ? it + 1 : it) + (lane >> 2); ng0 = *(const u32x4*)(Z + t * 2048 + 512 + 64 * h + 8 * (lane & 3)); ng1 = *(const u32x4*)(Z + t * 2048 + 512 + 64 * h + 32 + 8 * (lane & 3)); }
            bf16x8 xf[2];
#pragma unroll
            for (int kt = 0; kt < 2; ++kt) xf[kt] = *(const LAS bf16x8*)(xcT + (16 * it + fr) * XC_STRIDE + (32 * kt + 8 * fq) * 2);
            int fqv = fq; asm volatile("" : "+v"(fqv));
            f32x4 acc[8];
#pragma unroll
            for (int et = 0; et < 4; ++et) { acc[et] = *(const f32x4*)(gab + 64 * h + 16 * et + 4 * fqv); acc[4 + et] = *(const f32x4*)(gib + 64 * h + 16 * et + 4 * fqv); }
#pragma unroll
            for (int et = 0; et < 8; ++et)
#pragma unroll
                for (int kt = 0; kt < 2; ++kt) acc[et] = __builtin_amdgcn_mfma_f32_16x16x32_bf16(gw[et][kt], xf[kt], acc[et], 0, 0, 0);
#pragma unroll
            for (int et = 0; et < 4; ++et) {
                const f32x4 sp = *(const f32x4*)(N8SP + 64 * h + 16 * et + 4 * fqv);
                const u32x2 xw = *(const LAS u32x2*)(xcT + (16 * it + fr) * XC_STRIDE + (16 * et + 4 * fq) * 2);
                const float xv[4] = {bflo(xw.x), bfhi(xw.x), bflo(xw.y), bfhi(xw.y)};
                f32x4 av, uv;
#pragma unroll
                for (int r = 0; r < 4; ++r) {
                    const float rg = __builtin_amdgcn_rcpf(1.0f + __builtin_amdgcn_exp2f(acc[et][r])), ig = __builtin_amdgcn_rcpf(1.0f + __builtin_amdgcn_exp2f(acc[4 + et][r]));
                    const float a = __builtin_amdgcn_exp2f(rg * sp[r]);
                    av[r] = a;
                    uv[r] = __builtin_amdgcn_sqrtf(__builtin_fmaf(-a, a, 1.0f)) * (ig * xv[r]);
                }
                *(LAS f32x4*)(Abuf + fr * AU_STRIDE + 16 * et + 4 * fq) = av; *(LAS f32x4*)(Ubuf + fr * AU_STRIDE + 16 * et + 4 * fq) = uv;
            }
            WAVE_SYNC();
            {
                float a[16], u[16];
#pragma unroll
                for (int tk = 0; tk < 16; ++tk) { a[tk] = Abuf[tk * AU_STRIDE + lane]; u[tk] = Ubuf[tk * AU_STRIDE + lane]; }
#pragma unroll
                for (int tk = 0; tk < 16; ++tk) { hst = a[tk] * hst + u[tk]; if (PASS == 1) pp *= a[tk]; else Ubuf[tk * AU_STRIDE + lane] = hst; }
            }
            if (PASS == 2) {
                WAVE_SYNC();
                const int tok = lane >> 2, cq = lane & 3; const size_t t = tb + 16 * it + tok;
                const LAS float* hp = Ubuf + tok * AU_STRIDE + 8 * cq;
                const f32x4 h0 = *(const LAS f32x4*)(hp), h1 = *(const LAS f32x4*)(hp + 4), h2 = *(const LAS f32x4*)(hp + 32), h3 = *(const LAS f32x4*)(hp + 36);
                u32x4 o0, o1;
                o0.x = pk2(h0[0] * bflo(g0.x), h0[1] * bfhi(g0.x)); o0.y = pk2(h0[2] * bflo(g0.y), h0[3] * bfhi(g0.y));
                o0.z = pk2(h1[0] * bflo(g0.z), h1[1] * bfhi(g0.z)); o0.w = pk2(h1[2] * bflo(g0.w), h1[3] * bfhi(g0.w));
                o1.x = pk2(h2[0] * bflo(g1.x), h2[1] * bfhi(g1.x)); o1.y = pk2(h2[2] * bflo(g1.y), h2[3] * bfhi(g1.y));
                o1.z = pk2(h3[0] * bflo(g1.z), h3[1] * bfhi(g1.z)); o1.w = pk2(h3[2] * bflo(g1.w), h3[3] * bfhi(g1.w));
                *(u32x4*)(YMIX + t * D + 64 * h + 8 * cq) = o0; *(u32x4*)(YMIX + t * D + 64 * h + 32 + 8 * cq) = o1;
                g0 = ng0; g1 = ng1;
            }
            WAVE_SYNC();
        }
    }
    if (PASS == 1) { CA[(size_t)blk * 512 + 64 * h + lane] = pp; CH[(size_t)blk * 512 + 64 * h + lane] = hst; }
}

constexpr int HT_STRIDE = 2064;
constexpr int RG_W_OFF = 0, RG_H_OFF = 36 * HT_STRIDE, RG_LOG_OFF = RG_H_OFF + 32 * HT_STRIDE, RG_MISC_OFF = RG_LOG_OFF + 32 * 48 * 4;
static_assert(RG_MISC_OFF + 256 <= SCR_BYTES, "phase G LDS map");
__device__ __forceinline__ void phase_G(Frame& F, const Args& args) {
    const bf16_t* X1 = (const bf16_t*)(F.ws + OFF_X1); bf16_t* H2 = (bf16_t*)(F.ws + OFF_XN); const bf16_t* ROUTW = (const bf16_t*)(F.ws + OFF_ROUTW);
    const float* mod = (const float*)(F.ws + OFF_MOD); const float* g2w = args.in[18]; const float* bg = args.in[20]; const float* be = args.in[22];
    int* list = (int*)(F.ws + OFF_LIST); int* toke = (int*)(F.ws + OFF_TOKE); float* tokw = (float*)(F.ws + OFF_TOKW); int* tokp = (int*)(F.ws + OFF_TOKP);
    const int lane = F.lane, w = F.wave, fr = lane & 15, fq = lane >> 4;
    LAS float* LG = (LAS float*)(F.lds + RG_LOG_OFF); LAS int* hist = (LAS int*)(F.lds + RG_MISC_OFF); LAS int* base = hist + 32;
    __syncthreads();
    for (int i = F.tid; i < 36 * 128; i += NTHREADS) { const int r = i >> 7, c = i & 127; *(LAS u32x4*)(F.lds + RG_W_OFF + r * HT_STRIDE + c * 16) = *(const u32x4*)(ROUTW + (size_t)r * 1024 + c * 8); }
    for (int grp = F.bid; grp < T / 128; grp += F.G) {
        const int grow0 = grp * 128, b = grow0 / SEQ;
        const float* sh = mod + b * 6144 + 3072; const float* sc = sh + 1024;
        float gm[16], sv[16];
#pragma unroll
        for (int jj = 0; jj < 2; ++jj)
#pragma unroll
            for (int q = 0; q < 8; ++q) { const int c = 512 * jj + 8 * lane + q; gm[8 * jj + q] = g2w[c] * (1.0f + sc[c]); sv[8 * jj + q] = sh[c]; }
        if (F.tid < 32) hist[F.tid] = 0;
        u32x4 raw[4][2];
#pragma unroll
        for (int r = 0; r < 4; ++r)
#pragma unroll
            for (int jj = 0; jj < 2; ++jj) raw[r][jj] = *(const u32x4*)(X1 + (size_t)(grow0 + 4 * w + r) * D + 512 * jj + 8 * lane);
        int e1 = 0, e2 = 0, l1 = 0, l2 = 0; float w1 = 0.f, w2 = 0.f;
#pragma unroll 1
        for (int ti = 0; ti < 4; ++ti) {
            const int row0 = grow0 + 32 * ti;
#pragma unroll
            for (int r = 0; r < 4; ++r) {
                float h[16]; float ss = 0.f;
#pragma unroll
                for (int jj = 0; jj < 2; ++jj)
#pragma unroll
                    for (int q = 0; q < 4; ++q) { h[8 * jj + 2 * q] = bflo(raw[r][jj][q]); h[8 * jj + 2 * q + 1] = bfhi(raw[r][jj][q]); }
#pragma unroll
                for (int q = 0; q < 16; ++q) ss += h[q] * h[q];
                const float rs = rsqrtf(wave_sum(ss) * (1.0f / D) + EPS);
#pragma unroll
                for (int jj = 0; jj < 2; ++jj) { u32x4 o; float hv[8];
#pragma unroll
                    for (int q = 0; q < 8; ++q) hv[q] = h[8 * jj + q] * rs * gm[8 * jj + q] + sv[8 * jj + q];
#pragma unroll
                    for (int q = 0; q < 4; ++q) o[q] = pk2(hv[2 * q], hv[2 * q + 1]);
#if MOE_FP8
                    { u32x2 f; f.x = pg8::pk4_fp8(hv[0], hv[1], hv[2], hv[3]); f.y = pg8::pk4_fp8(hv[4], hv[5], hv[6], hv[7]);
                      *(u32x2*)((unsigned char*)H2 + (size_t)(row0 + 4 * w + r) * D + 512 * jj + 8 * lane) = f; }
#else
                    *(u32x4*)(H2 + (size_t)(row0 + 4 * w + r) * D + 512 * jj + 8 * lane) = o;
#endif
                    *(LAS u32x4*)(F.lds + RG_H_OFF + (4 * w + r) * HT_STRIDE + (512 * jj + 8 * lane) * 2) = o; }
            }
            if (ti < 3) {
#pragma unroll
                for (int r = 0; r < 4; ++r)
#pragma unroll
                    for (int jj = 0; jj < 2; ++jj) raw[r][jj] = *(const u32x4*)(X1 + (size_t)(row0 + 32 + 4 * w + r) * D + 512 * jj + 8 * lane);
            }
            __syncthreads();
            if (w < 6) {
                const int rt = w / 3, ct = w % 3; int wrow = 16 * ct + fr; wrow = wrow < 36 ? wrow : 35;
                const LAS unsigned char* hp = F.lds + RG_H_OFF + (16 * rt + fr) * HT_STRIDE + 16 * fq; const LAS unsigned char* wp = F.lds + RG_W_OFF + wrow * HT_STRIDE + 16 * fq;
                f32x4 acc0 = {0.f, 0.f, 0.f, 0.f}, acc1 = {0.f, 0.f, 0.f, 0.f};
#pragma unroll 8
                for (int kt = 0; kt < 32; kt += 2) {
                    acc0 = __builtin_amdgcn_mfma_f32_16x16x32_bf16(*(const LAS bf16x8*)(wp + 64 * kt), *(const LAS bf16x8*)(hp + 64 * kt), acc0, 0, 0, 0);
                    acc1 = __builtin_amdgcn_mfma_f32_16x16x32_bf16(*(const LAS bf16x8*)(wp + 64 * kt + 64), *(const LAS bf16x8*)(hp + 64 * kt + 64), acc1, 0, 0, 0); }
                *(LAS f32x4*)(LG + (16 * rt + fr) * 48 + 16 * ct + 4 * fq) = acc0 + acc1;
            }
            __syncthreads();
            if ((F.tid >> 5) == ti) {
                const LAS float* L = LG + (F.tid & 31) * 48;
                float gl[4], el[8];
#pragma unroll
                for (int j = 0; j < 4; ++j) gl[j] = L[j] + bg[j];
                int gs = 0; float gmax = gl[0];
#pragma unroll
                for (int j = 1; j < 4; ++j) if (gl[j] > gmax) { gmax = gl[j]; gs = j; }
#pragma unroll
                for (int j = 0; j < 8; ++j) el[j] = L[4 + gs * 8 + j] + be[gs * 8 + j];
                float gsum = 0.f;
#pragma unroll
                for (int j = 0; j < 4; ++j) gsum += __expf(gl[j] - gmax);
                const float pg = 1.0f / gsum;
                int i1 = 0; float m1 = el[0];
#pragma unroll
                for (int j = 1; j < 8; ++j) if (el[j] > m1) { m1 = el[j]; i1 = j; }
                int i2 = -1; float m2 = -INFINITY;
#pragma unroll
                for (int j = 0; j < 8; ++j) if (j != i1 && el[j] > m2) { m2 = el[j]; i2 = j; }
                const float r = __expf(m2 - m1);
                w1 = pg / (1.0f + r); w2 = pg * r / (1.0f + r); e1 = gs * 8 + i1; e2 = gs * 8 + i2;
                l1 = __hip_atomic_fetch_add(hist + e1, 1, __ATOMIC_RELAXED, __HIP_MEMORY_SCOPE_WORKGROUP);
                l2 = __hip_atomic_fetch_add(hist + e2, 1, __ATOMIC_RELAXED, __HIP_MEMORY_SCOPE_WORKGROUP);
            }
        }
        __syncthreads();
        if (F.tid < 32) { const int n = hist[F.tid]; base[F.tid] = n ? (int)__hip_atomic_fetch_add(F.ctl + CW_CNT + CNT_STRIDE * F.tid, (unsigned)n, __ATOMIC_RELAXED, __HIP_MEMORY_SCOPE_AGENT) : 0; }
        __syncthreads();
        if (F.tid < 128) { const int row = grow0 + F.tid, p1 = base[e1] + l1, p2 = base[e2] + l2;
            list[(size_t)e1 * LISTCAP + p1] = row; list[(size_t)e2 * LISTCAP + p2] = row;
            toke[2 * row] = e1; toke[2 * row + 1] = e2; tokw[2 * row] = w1; tokw[2 * row + 1] = w2; tokp[2 * row] = p1; tokp[2 * row + 1] = p2; }
        __syncthreads();
    }
}

__device__ __forceinline__ void phase_J(Frame& F, const Args& args) {
    const bf16_t* X1 = (const bf16_t*)(F.ws + OFF_X1); const bf16_t* Y = (const bf16_t*)(F.ws + OFF_Y); const float* mod = (const float*)(F.ws + OFF_MOD);
    const int* toke = (const int*)(F.ws + OFF_TOKE); const float* tokw = (const float*)(F.ws + OFF_TOKW); const int* tokp = (const int*)(F.ws + OFF_TOKP);
    const float* fg = args.in[26]; float* out = args.out;
    const int gw = F.bid * NWAVES + F.wave, NGW = F.G * NWAVES, lane = F.lane;
    constexpr int RPW = 16;
    for (int item = gw; item < T / RPW; item += NGW) {
        const int row0 = item * RPW, b = row0 / SEQ;
        int q0l = 0, q1l = 0; float w0l = 0.f, w1l = 0.f;
        { const int rr = row0 + (lane & 15); const int e0 = toke[2 * rr], e1 = toke[2 * rr + 1];
          q0l = F.tab[TAB_P0 + e0] * 256 + tokp[2 * rr]; q1l = F.tab[TAB_P0 + e1] * 256 + tokp[2 * rr + 1]; w0l = tokw[2 * rr]; w1l = tokw[2 * rr + 1]; }
        const float* g2 = mod + b * 6144 + 5120;
        f32x4 g2v[4], fgv[4];
#pragma unroll
        for (int jj = 0; jj < 2; ++jj)
#pragma unroll
            for (int hh = 0; hh < 2; ++hh) { const int c = 512 * jj + 8 * lane + 4 * hh; g2v[2 * jj + hh] = *(const f32x4*)(g2 + c); fgv[2 * jj + hh] = *(const f32x4*)(fg + c); }
#if MOE_FP8
        typedef u32x2 yvec; const unsigned char* Yb = (const unsigned char*)Y;
#define YLOAD(q_, c0_) (*(const u32x2*)(Yb + (q_) * D + (c0_)))
#define YUNPACK(v_, o_) do { const auto a0_ = __builtin_amdgcn_cvt_pk_f32_fp8((v_).x, false), a1_ = __builtin_amdgcn_cvt_pk_f32_fp8((v_).x, true), a2_ = __builtin_amdgcn_cvt_pk_f32_fp8((v_).y, false), a3_ = __builtin_amdgcn_cvt_pk_f32_fp8((v_).y, true); \
        o_[0] = a0_[0]; o_[1] = a0_[1]; o_[2] = a1_[0]; o_[3] = a1_[1]; o_[4] = a2_[0]; o_[5] = a2_[1]; o_[6] = a3_[0]; o_[7] = a3_[1]; } while (0)
        constexpr float YINV = 1.0f / Y_SCALE;
#else
        typedef u32x4 yvec;
#define YLOAD(q_, c0_) (*(const u32x4*)(Y + (q_) * D + (c0_)))
#define YUNPACK(v_, o_) do { _Pragma("unroll") for (int q_ = 0; q_ < 4; ++q_) { o_[2 * q_] = bflo((v_)[q_]); o_[2 * q_ + 1] = bfhi((v_)[q_]); } } while (0)
        constexpr float YINV = 1.0f;
#endif
        u32x4 xr[2], nxr[2]; yvec ya[2], yb[2], nya[2], nyb[2];
        { const size_t q0 = (size_t)__shfl(q0l, 0), q1 = (size_t)__shfl(q1l, 0);
#pragma unroll
          for (int jj = 0; jj < 2; ++jj) { const int c0 = 512 * jj + 8 * lane; xr[jj] = *(const u32x4*)(X1 + (size_t)row0 * D + c0); ya[jj] = YLOAD(q0, c0); yb[jj] = YLOAD(q1, c0); } }
#pragma unroll 1
        for (int r = 0; r < RPW; ++r) {
            const int row = row0 + r, rn = (r + 1 < RPW) ? r + 1 : r;
            { const size_t q0 = (size_t)__shfl(q0l, rn), q1 = (size_t)__shfl(q1l, rn);
#pragma unroll
              for (int jj = 0; jj < 2; ++jj) { const int c0 = 512 * jj + 8 * lane; nxr[jj] = *(const u32x4*)(X1 + (size_t)(row0 + rn) * D + c0); nya[jj] = YLOAD(q0, c0); nyb[jj] = YLOAD(q1, c0); } }
            const float w0 = __shfl(w0l, r), w1 = __shfl(w1l, r);
            float v[16]; float ss = 0.f;
#pragma unroll
            for (int jj = 0; jj < 2; ++jj) { float yav[8], ybv[8]; YUNPACK(ya[jj], yav); YUNPACK(yb[jj], ybv);
#pragma unroll
                for (int q = 0; q < 4; ++q) {
                    const float y0 = (w0 * yav[2 * q] + w1 * ybv[2 * q]) * YINV, y1 = (w0 * yav[2 * q + 1] + w1 * ybv[2 * q + 1]) * YINV;
                    const f32x4 gg = g2v[2 * jj + (q >> 1)];
                    v[8 * jj + 2 * q] = bflo(xr[jj][q]) + gg[(2 * q) & 3] * y0; v[8 * jj + 2 * q + 1] = bfhi(xr[jj][q]) + gg[(2 * q + 1) & 3] * y1; } }
#pragma unroll
            for (int q = 0; q < 16; ++q) ss += v[q] * v[q];
            const float rs = rsqrtf(wave_sum(ss) * (1.0f / D) + EPS);
#pragma unroll
            for (int jj = 0; jj < 2; ++jj) { const int c0 = 512 * jj + 8 * lane;
                f32x4 o0, o1;
#pragma unroll
                for (int q = 0; q < 4; ++q) { o0[q] = v[8 * jj + q] * rs * fgv[2 * jj][q]; o1[q] = v[8 * jj + 4 + q] * rs * fgv[2 * jj + 1][q]; }
                *(f32x4*)(out + (size_t)row * D + c0) = o0; *(f32x4*)(out + (size_t)row * D + c0 + 4) = o1;
                xr[jj] = nxr[jj]; ya[jj] = nya[jj]; yb[jj] = nyb[jj]; }
        }
    }
#undef YLOAD
#undef YUNPACK
}

__global__ void __launch_bounds__(NTHREADS, 2) mk(Args args) {
    extern __shared__ __attribute__((aligned(16))) unsigned char lds_raw[];
    Frame F;
    F.lds = (LAS unsigned char*)lds_raw; F.tab = (LAS int*)(F.lds + TAB_OFF);
    F.tid = threadIdx.x; F.lane = F.tid & 63; F.wave = __builtin_amdgcn_readfirstlane(F.tid >> 6);
    F.G = gridDim.x; F.bid = blockIdx.x; F.vcu = (F.G % 8 == 0) ? (F.bid % 8) * (F.G / 8) + F.bid / 8 : F.bid;
    F.ws = args.ws; F.ctl = (unsigned*)(args.ws + OFF_CTL);
    unsigned char* ws = args.ws;
    bf16_t* WIN = (bf16_t*)(ws + OFF_WIN); bf16_t* WOUT = (bf16_t*)(ws + OFF_WOUT); bf16_t* W13 = (bf16_t*)(ws + OFF_W13); bf16_t* W2 = (bf16_t*)(ws + OFF_W2);
    bf16_t* XN = (bf16_t*)(ws + OFF_XN); bf16_t* Z = (bf16_t*)(ws + OFF_Z); bf16_t* YMIX = (bf16_t*)(ws + OFF_YMIX); bf16_t* X1 = (bf16_t*)(ws + OFF_X1);
    bf16_t* ACT = (bf16_t*)(ws + OFF_ACT); bf16_t* Y = (bf16_t*)(ws + OFF_Y); bf16_t* H2 = XN;
    const float* mod = (const float*)(ws + OFF_MOD); const int* list = (const int*)(ws + OFF_LIST);
    const int lo = args.ph_lo, hi = args.ph_hi;
    for (int u = F.tid; u < (LDS_BYTES - LDSCTL_OFF) / 4; u += NTHREADS) ((LAS unsigned*)(F.lds + LDSCTL_OFF))[u] = 0u;
    __syncthreads();
    XcdBarrier bar; bar.bar = F.ctl + CW_BAR; bar.x = 0; bar.st = nullptr;
    if (hi - lo > 1) bar = xcd_barrier_post(F.ctl + CW_BAR, (volatile LAS unsigned*)(F.lds + LDSCTL_OFF) + 8);
#ifndef PHMASK
#define PHMASK 0x3ff
#endif
#define IN(k) (((PHMASK >> (k)) & 1) && lo <= (k) && (k) < hi)
#ifdef PROBE_SPAN
#define STAMP(i) do { if (F.bid == 0 && F.tid == 0) { const unsigned long long t_ = __builtin_amdgcn_s_memrealtime(); LAS unsigned* st_ = (LAS unsigned*)(F.lds + LDSCTL_OFF) + 32 + 2 * (i); st_[0] = (unsigned)t_; st_[1] = (unsigned)(t_ >> 32); } } while (0)
#else
#define STAMP(i) do { } while (0)
#endif
#define SEAM(k) do { if (IN(k) && IN((k) + 1)) xcd_barrier(bar); STAMP((k) + 1); } while (0)

    STAMP(0);
    if (IN(PH_A)) phase_A(F, args);
    SEAM(PH_A);
    if (IN(PH_B)) phase_B(F, args);
    SEAM(PH_B);
    if (IN(PH_C)) {
        pg8::Gemm g{XN, WIN, 2048}; pg8::EpiZ E{Z};
        if (F.G == 256) {
            constexpr int NCONV = 64, UPA = 5;
            constexpr int CSHARE = (256 - NCONV) * NWAVES * CONV_PRE;
            const bool conv = F.bid >= 256 - NCONV;
            if (conv) convert_experts(F, args, (F.bid - (256 - NCONV)) * NWAVES + F.wave, NCONV * NWAVES, CSHARE, TI_EXP - CSHARE);
            else if (CONV_PRE > 0) convert_experts(F, args, F.bid * NWAVES + F.wave, (256 - NCONV) * NWAVES, 0, CSHARE);
            __syncthreads();
            pg8::SplitOrder S; S.tokt = F.lds; S.init2(T, 2048, 2048, 256 - NCONV, NCONV, UPA, conv ? 1 : 0, conv ? F.bid - (256 - NCONV) : F.bid);
            pg8::gemm_phase<pg8::EpiZ, pg8::SplitOrder, true, false, false>(F.lds, g, S, E);
        } else {
            pg8::StaticOrder S; S.tokt = F.lds; S.init(T, 2048, 2048, F.G, F.bid);
            pg8::gemm_phase<pg8::EpiZ, pg8::StaticOrder, true, false, false>(F.lds, g, S, E);
        }
    }
    SEAM(PH_C);
    if (IN(PH_D)) { for (int blk = F.bid; blk < T / 128; blk += F.G) { __syncthreads(); sgu_block(F, args, blk); __syncthreads(); lru_block<1>(F, args, blk); } }
    SEAM(PH_D);
    if (IN(PH_E)) { for (int blk = F.bid; blk < T / 128; blk += F.G) { __syncthreads(); lru_block<2>(F, args, blk); } }
    SEAM(PH_E);
    if (IN(PH_F)) {
        __syncthreads();
        pg8::Gemm g{YMIX, WOUT, 2048}; pg8::StaticOrder S; S.tokt = F.lds; S.init(T, 1024, 2048, F.G, F.bid);
        pg8::EpiX1 E{args.in[0], mod, X1};
        pg8::gemm_phase<pg8::EpiX1, pg8::StaticOrder, true, false, false>(F.lds, g, S, E);
    }
    SEAM(PH_F);
    if (IN(PH_G)) phase_G(F, args);
    SEAM(PH_G);
    if (IN(PH_H)) {
        build_moe_table(F);
        pg8::MoeOrder S; S.nunits = F.tab[TAB_P0 + NE] * 4; S.G = F.G; S.c = F.vcu;
        S.tile_e = F.tab + TAB_TE; S.p0 = F.tab + TAB_P0; S.cnt = F.tab + TAB_CNT; S.list = list; S.gather = true; S.tokt = F.lds + TOKT_OFF;
#if MOE_FP8
        S.Kb = 1024; S.estride = (size_t)1024 * 1024;
        pg8::Gemm g{H2, W13, 1024}; pg8::EpiAct8 E{(unsigned char*)ACT, 1.0f / W13_SCALE, ACT_SCALE};
        pg8::gemm_phase<pg8::EpiAct8, pg8::MoeOrder, true, true, true>(F.lds, g, S, E);
#else
        S.Kb = 2048; S.estride = (size_t)1024 * 1024 * 2;
        pg8::Gemm g{H2, W13, 2048}; pg8::EpiAct E{ACT};
        pg8::gemm_phase<pg8::EpiAct, pg8::MoeOrder, true, true, false>(F.lds, g, S, E);
#endif
    }
    SEAM(PH_H);
    if (IN(PH_I)) {
        build_moe_table(F);
        pg8::MoeOrder S; S.nunits = F.tab[TAB_P0 + NE] * 4; S.G = F.G; S.c = F.vcu;
        S.tile_e = F.tab + TAB_TE; S.p0 = F.tab + TAB_P0; S.cnt = F.tab + TAB_CNT; S.list = list; S.gather = false; S.tokt = F.lds + TOKT_OFF;
#if MOE_FP8
        S.Kb = 512; S.estride = (size_t)1024 * 512;
        pg8::Gemm g{ACT, W2, 512}; pg8::EpiY8 E{(unsigned char*)Y, Y_SCALE / (W2_SCALE * ACT_SCALE)};
        pg8::gemm_phase<pg8::EpiY8, pg8::MoeOrder, true, false, true>(F.lds, g, S, E);
#else
        S.Kb = 1024; S.estride = (size_t)1024 * 512 * 2;
        pg8::Gemm g{ACT, W2, 1024}; pg8::EpiY E{Y};
        pg8::gemm_phase<pg8::EpiY, pg8::MoeOrder, true, false, false>(F.lds, g, S, E);
#endif
    }
    SEAM(PH_I);
    if (IN(PH_J)) { build_moe_table(F); phase_J(F, args); }
#ifdef PROBE_SPAN
    STAMP(PH_N);
    if (F.bid == 0 && F.tid == 0) { LAS unsigned* st_ = (LAS unsigned*)(F.lds + LDSCTL_OFF) + 32;
        const unsigned long long a_ = ((unsigned long long)st_[2 * PROBE_SPAN + 1] << 32) | st_[2 * PROBE_SPAN], b_ = ((unsigned long long)st_[2 * PROBE_SPAN + 3] << 32) | st_[2 * PROBE_SPAN + 2];
        const unsigned long long t0_ = __builtin_amdgcn_s_memrealtime(), dt_ = (b_ - a_) * PROBE_MULT;
        while (__builtin_amdgcn_s_memrealtime() - t0_ < dt_) __builtin_amdgcn_s_sleep(8); }
#endif
#undef IN
#undef SEAM
}
#ifndef FUSED
#define FUSED 1
#endif
extern "C" void kernel_launch(void* const* d_in, const int* in_sizes, int n_in, void* d_out, int out_size, void* d_ws, size_t ws_size, hipStream_t stream) {
    if (n_in != 27 || out_size != T * D || ws_size < WS_NEED) { fprintf(stderr, "kernel_launch: unexpected shapes (n_in %d out %d ws %zu)\n", n_in, out_size, ws_size); return; }
    static int grid = 0;
    if (grid == 0) {
        int dev = 0, cus = 0;
        if (hipGetDevice(&dev) != hipSuccess || hipDeviceGetAttribute(&cus, hipDeviceAttributeMultiprocessorCount, dev) != hipSuccess) { fprintf(stderr, "kernel_launch: device query failed\n"); grid = -1; return; }
        if (hipFuncSetAttribute((const void*)mk, hipFuncAttributeMaxDynamicSharedMemorySize, LDS_BYTES) != hipSuccess) { fprintf(stderr, "kernel_launch: hipFuncSetAttribute failed\n"); grid = -1; return; }
        int per_cu = 0;
        if (hipOccupancyMaxActiveBlocksPerMultiprocessor(&per_cu, (const void*)mk, NTHREADS, LDS_BYTES) != hipSuccess || per_cu < 1) fprintf(stderr, "kernel_launch: occupancy query says %d\n", per_cu);
        (void)hipGetLastError();
        grid = cus;
    }
    if (grid < 0) return;
    Args a{}; for (int i = 0; i < 27; ++i) a.in[i] = (const float*)d_in[i]; a.out = (float*)d_out; a.ws = (unsigned char*)d_ws;
#define MK(lo_, hi_) do { a.ph_lo = (lo_); a.ph_hi = (hi_); hipLaunchKernelGGL(mk, dim3(grid), dim3(NTHREADS), LDS_BYTES, stream, a); } while (0)
    (void)hipMemsetAsync((char*)d_ws + OFF_CTL, 0, CTL_BYTES, stream);
#if FUSED
    MK(0, PH_N);
#else
    for (int p = 0; p < PH_N; ++p) MK(p, p + 1);
#endif
}
```

```cpp
#include <hip/hip_runtime.h>
#include <cstdio>
#include <cstdint>

typedef unsigned short bf16_t;
typedef short bf16x8 __attribute__((ext_vector_type(8)));
typedef float f32x4 __attribute__((ext_vector_type(4)));
typedef unsigned u32x2 __attribute__((ext_vector_type(2)));
typedef unsigned u32x4 __attribute__((ext_vector_type(4)));

constexpr int T = 32768, D = 1024, SEQ = 4096, NB = 8;
constexpr int DL = 512;
constexpr int NE = 32, DE = 512;
constexpr int LISTCAP = 65536;
constexpr int MAXTILES = 288, MAXROWS = MAXTILES * 256;
constexpr float EPS = 1e-6f;

constexpr size_t MiB = 1u << 20;
constexpr size_t OFF_CTL = 0, CTL_BYTES = 48 * 1024;
constexpr size_t OFF_MOD = 1 * MiB;
constexpr size_t OFF_TBL = 1 * MiB + 256 * 1024;
constexpr size_t OFF_TOKE = 1 * MiB + 512 * 1024;
constexpr size_t OFF_TOKW = 1 * MiB + 768 * 1024;
constexpr size_t OFF_TOKP = 2 * MiB;
constexpr size_t OFF_N8SP = 1 * MiB + 256 * 1024 + 16384;
constexpr size_t OFF_GBIAS = 1 * MiB + 256 * 1024 + 32768;
constexpr size_t OFF_GATEW = 2 * MiB + 256 * 1024;
constexpr size_t OFF_SGUW = 2 * MiB + 512 * 1024;
constexpr size_t OFF_ROUTW = 2 * MiB + 768 * 1024;
constexpr size_t OFF_CARRY = 3 * MiB;
constexpr size_t OFF_WIN = 4 * MiB;
constexpr size_t OFF_WOUT = 8 * MiB;
constexpr size_t OFF_W13 = 10 * MiB;
constexpr size_t OFF_W2 = 74 * MiB;
constexpr size_t OFF_XN = 106 * MiB;
constexpr size_t OFF_Z = 170 * MiB;
constexpr size_t OFF_YMIX = 298 * MiB;
constexpr size_t OFF_X1 = 362 * MiB;
constexpr size_t OFF_ACT = 426 * MiB;
constexpr size_t OFF_LIST = 498 * MiB;
constexpr size_t OFF_ROWTOK = 506 * MiB;
constexpr size_t OFF_Y = 170 * MiB;
constexpr size_t WS_NEED = 507 * MiB;
constexpr size_t OFF_VN = OFF_X1;
constexpr size_t OFF_XC = OFF_ACT;
constexpr int CW_BAR = 4096;
constexpr int CW_CNT = 8192, CNT_STRIDE = 64;

__device__ __forceinline__ unsigned f2bf(float f) { unsigned u = __float_as_uint(f); return (u + 0x7fffu + ((u >> 16) & 1u)) >> 16; }
__device__ __forceinline__ float bf2f(unsigned h) { return __uint_as_float(h << 16); }
__device__ __forceinline__ unsigned pk2(float lo, float hi) { unsigned r; asm("v_cvt_pk_bf16_f32 %0, %1, %2" : "=v"(r) : "v"(lo), "v"(hi)); return r; }
__device__ __forceinline__ float wave_sum(float v) {
#pragma unroll
    for (int o = 1; o < 64; o <<= 1) v += __shfl_xor(v, o);
    return v;
}
__device__ __forceinline__ float gelu_tanh(float x) {
    const float u = 1.5957691216057308f * (x + 0.044715f * x * x * x);
    return x / (1.0f + __expf(-u));
}
__device__ __forceinline__ float sigmoidf(float x) { return 1.0f / (1.0f + __expf(-x)); }

__global__ void __launch_bounds__(256) k_ada(const float* c, const float* ada_w, const float* ada_b, float* mod) {
    __shared__ float sc[8][1024];
    for (int i = threadIdx.x; i < 8192; i += 256) { const float v = c[i]; sc[i >> 10][i & 1023] = v / (1.0f + expf(-v)); }
    __syncthreads();
    const int n = blockIdx.x * 256 + threadIdx.x;
    float acc[8];
#pragma unroll
    for (int b = 0; b < 8; ++b) acc[b] = 0.f;
    for (int k = 0; k < 1024; ++k) {
        const float w = ada_w[(size_t)k * 6144 + n];
#pragma unroll
        for (int b = 0; b < 8; ++b) acc[b] += sc[b][k] * w;
    }
#pragma unroll
    for (int b = 0; b < 8; ++b) mod[b * 6144 + n] = acc[b] + ada_b[n];
}

__global__ void __launch_bounds__(256) k_transpose(const float* W, bf16_t* WT, int K, int N, int blk, int rstride, int rbase, size_t w_ms, size_t wt_ms) {
    __shared__ float tile[32][33];
    W += (size_t)blockIdx.z * w_ms; WT += (size_t)blockIdx.z * wt_ms;
    const int n0 = blockIdx.x * 32, k0 = blockIdx.y * 32, tx = threadIdx.x & 31, ty = threadIdx.x >> 5;
    for (int j = ty; j < 32; j += 8) tile[j][tx] = W[(size_t)(k0 + j) * N + n0 + tx];
    __syncthreads();
    for (int j = ty; j < 32; j += 8) { const int n = n0 + j; const int row = rbase + (n / blk) * rstride + (n % blk);
        WT[(size_t)row * K + k0 + tx] = (bf16_t)f2bf(tile[tx][j]); }
}

__global__ void __launch_bounds__(256) k_xn(const float* x, const float* g, const float* mod, bf16_t* XN) {
    const int row = blockIdx.x * 4 + (threadIdx.x >> 6), lane = threadIdx.x & 63, b = row / SEQ;
    const f32x4* xr = (const f32x4*)(x + (size_t)row * D);
    f32x4 v[4]; float ss = 0.f;
#pragma unroll
    for (int j = 0; j < 4; ++j) { v[j] = xr[lane + 64 * j]; ss += v[j][0] * v[j][0] + v[j][1] * v[j][1] + v[j][2] * v[j][2] + v[j][3] * v[j][3]; }
    ss = wave_sum(ss);
    const float rs = rsqrtf(ss * (1.0f / D) + EPS);
    const float* sh = mod + b * 6144; const float* sc = sh + 1024;
#pragma unroll
    for (int j = 0; j < 4; ++j) { const int col = 4 * (lane + 64 * j);
        const f32x4 gg = *(const f32x4*)(g + col), s1 = *(const f32x4*)(sc + col), s0 = *(const f32x4*)(sh + col);
        float h[4];
#pragma unroll
        for (int q = 0; q < 4; ++q) h[q] = v[j][q] * rs * gg[q] * (1.0f + s1[q]) + s0[q];
        u32x2 o; o.x = pk2(h[0], h[1]); o.y = pk2(h[2], h[3]);
        *(u32x2*)(XN + (size_t)row * D + col) = o; }
}

template <bool DUAL, class Epi>
__device__ __forceinline__ void sg_tile(const bf16_t* A, const int* arow, const bf16_t* Bt, const bf16_t* Bt2, int K, int m0, int n0, int lane, const Epi& epi) {
    const int fr = lane & 15, fq = lane >> 4;
    const bf16_t* pa[2]; const bf16_t* pb[4]; const bf16_t* pb2[4];
#pragma unroll
    for (int mi = 0; mi < 2; ++mi) { const int r = m0 + mi * 16 + fr; const int rr = arow ? arow[r] : r; pa[mi] = A + (size_t)rr * K + 8 * fq; }
#pragma unroll
    for (int ni = 0; ni < 4; ++ni) { pb[ni] = Bt + (size_t)(n0 + ni * 16 + fr) * K + 8 * fq; pb2[ni] = DUAL ? Bt2 + (size_t)(n0 + ni * 16 + fr) * K + 8 * fq : nullptr; }
    f32x4 acc[2][4], acc2[2][4];
#pragma unroll
    for (int mi = 0; mi < 2; ++mi)
#pragma unroll
        for (int ni = 0; ni < 4; ++ni) { acc[mi][ni] = (f32x4){0.f, 0.f, 0.f, 0.f}; acc2[mi][ni] = (f32x4){0.f, 0.f, 0.f, 0.f}; }
    for (int k0 = 0; k0 < K; k0 += 32) {
        bf16x8 a[2], b[4], b2[4];
#pragma unroll
        for (int mi = 0; mi < 2; ++mi) a[mi] = *(const bf16x8*)(pa[mi] + k0);
#pragma unroll
        for (int ni = 0; ni < 4; ++ni) { b[ni] = *(const bf16x8*)(pb[ni] + k0); if (DUAL) b2[ni] = *(const bf16x8*)(pb2[ni] + k0); }
#pragma unroll
        for (int mi = 0; mi < 2; ++mi)
#pragma unroll
            for (int ni = 0; ni < 4; ++ni) {
                acc[mi][ni] = __builtin_amdgcn_mfma_f32_16x16x32_bf16(b[ni], a[mi], acc[mi][ni], 0, 0, 0);
                if (DUAL) acc2[mi][ni] = __builtin_amdgcn_mfma_f32_16x16x32_bf16(b2[ni], a[mi], acc2[mi][ni], 0, 0, 0);
            }
    }
#pragma unroll
    for (int mi = 0; mi < 2; ++mi)
#pragma unroll
        for (int ni = 0; ni < 4; ++ni) epi(m0 + mi * 16 + fr, n0 + ni * 16 + 4 * fq, acc[mi][ni], acc2[mi][ni]);
}

struct EpiInProj { bf16_t* Z;
    __device__ __forceinline__ void operator()(int row, int col, f32x4 v, f32x4) const {
        if (col >= 512) { v[0] = gelu_tanh(v[0]); v[1] = gelu_tanh(v[1]); v[2] = gelu_tanh(v[2]); v[3] = gelu_tanh(v[3]); }
        u32x2 o; o.x = pk2(v[0], v[1]); o.y = pk2(v[2], v[3]); *(u32x2*)(Z + (size_t)row * 2048 + col) = o; } };
struct EpiOutProj { const float* x; const float* mod; bf16_t* X1;
    __device__ __forceinline__ void operator()(int row, int col, f32x4 v, f32x4) const {
        const int b = row / SEQ; const f32x4 xv = *(const f32x4*)(x + (size_t)row * D + col), g1 = *(const f32x4*)(mod + b * 6144 + 2048 + col);
        u32x2 o; o.x = pk2(xv[0] + g1[0] * v[0], xv[1] + g1[1] * v[1]); o.y = pk2(xv[2] + g1[2] * v[2], xv[3] + g1[3] * v[3]);
        *(u32x2*)(X1 + (size_t)row * D + col) = o; } };
struct EpiMoe1 { bf16_t* ACT;
    __device__ __forceinline__ void operator()(int row, int col, f32x4 g, f32x4 u) const {
        float a[4];
#pragma unroll
        for (int q = 0; q < 4; ++q) a[q] = g[q] / (1.0f + __expf(-g[q])) * u[q];
        u32x2 o; o.x = pk2(a[0], a[1]); o.y = pk2(a[2], a[3]); *(u32x2*)(ACT + (size_t)row * DE + col) = o; } };
struct EpiMoe2 { bf16_t* Y;
    __device__ __forceinline__ void operator()(int row, int col, f32x4 v, f32x4) const {
        u32x2 o; o.x = pk2(v[0], v[1]); o.y = pk2(v[2], v[3]); *(u32x2*)(Y + (size_t)row * D + col) = o; } };

template <class Epi>
__global__ void __launch_bounds__(256) k_sgemm(const bf16_t* A, const bf16_t* Bt, int M, int N, int K, Epi epi) {
    const int w = blockIdx.x * 4 + (threadIdx.x >> 6), lane = threadIdx.x & 63, nN = N / 64;
    const int mt = w / nN, nt = w % nN; if (mt * 32 >= M) return;
    sg_tile<false>(A, nullptr, Bt, nullptr, K, mt * 32, nt * 64, lane, epi);
}
__global__ void __launch_bounds__(256) k_moe1(const bf16_t* H2, const int* rowtok, const int* tbl, const bf16_t* W13, EpiMoe1 epi) {
    const int w = blockIdx.x * 4 + (threadIdx.x >> 6), lane = threadIdx.x & 63;
    const int mt = w / 8, nt = w % 8, tile = mt / 8;
    if (tile >= tbl[0]) return;
    const int e = tbl[64 + tile], n0 = nt * 64, q = n0 / 128, i0 = n0 % 128;
    const bf16_t* Wg = W13 + (size_t)e * 1024 * 1024 + (size_t)(256 * q + i0) * 1024 - (size_t)n0 * 1024;
    sg_tile<true>(H2, rowtok, Wg, Wg + (size_t)128 * 1024, 1024, mt * 32, n0, lane, epi);
}
__global__ void __launch_bounds__(256) k_moe2(const bf16_t* ACT, const int* tbl, const bf16_t* W2, EpiMoe2 epi) {
    const int w = blockIdx.x * 4 + (threadIdx.x >> 6), lane = threadIdx.x & 63;
    const int mt = w / 16, nt = w % 16, tile = mt / 8;
    if (tile >= tbl[0]) return;
    const int e = tbl[64 + tile];
    sg_tile<false>(ACT, nullptr, W2 + (size_t)e * 1024 * 512, nullptr, 512, mt * 32, nt * 64, lane, epi);
}

__global__ void __launch_bounds__(256) k_lnv(const bf16_t* Z, const float* g, const float* bb, bf16_t* VN) {
    const int row = blockIdx.x * 4 + (threadIdx.x >> 6), lane = threadIdx.x & 63;
    const u32x4 raw = *(const u32x4*)(Z + (size_t)row * 2048 + 1536 + 8 * lane);
    float v[8];
#pragma unroll
    for (int q = 0; q < 4; ++q) { v[2 * q] = bf2f(raw[q] & 0xffffu); v[2 * q + 1] = bf2f(raw[q] >> 16); }
    float s = 0.f;
#pragma unroll
    for (int q = 0; q < 8; ++q) s += v[q];
    const float mu = wave_sum(s) * (1.0f / 512.0f);
    float s2 = 0.f;
#pragma unroll
    for (int q = 0; q < 8; ++q) { v[q] -= mu; s2 += v[q] * v[q]; }
    const float rstd = rsqrtf(wave_sum(s2) * (1.0f / 512.0f) + EPS);
    u32x4 o;
#pragma unroll
    for (int q = 0; q < 4; ++q) { const int c = 8 * lane + 2 * q; o[q] = pk2(v[2 * q] * rstd * g[c] + bb[c], v[2 * q + 1] * rstd * g[c + 1] + bb[c + 1]); }
    *(u32x4*)(VN + (size_t)row * 512 + 8 * lane) = o;
}
__global__ void __launch_bounds__(256) k_sgu(const bf16_t* Z, const bf16_t* VN, const float* sgu_w, const float* sgu_b, bf16_t* YMIX) {
    const int idx = blockIdx.x * 256 + threadIdx.x, t = idx >> 9, ch = idx & 511, i = t & 127, blk = t >> 7, g = ch >> 6;
    const int jmax = (i < 64) ? 64 : 128;
    float s = sgu_b[g * 128 + i];
    const float* wrow = sgu_w + ((size_t)g * 128 + i) * 128;
    for (int j = 0; j < jmax; ++j) s += wrow[j] * bf2f(VN[((size_t)blk * 128 + j) * 512 + ch]);
    YMIX[(size_t)t * D + 512 + ch] = (bf16_t)f2bf(bf2f(Z[(size_t)t * 2048 + 1024 + ch]) * s);
}
__global__ void __launch_bounds__(256) k_conv(const bf16_t* Z, const float* cw, const float* cb, float* XC) {
    const int idx = blockIdx.x * 256 + threadIdx.x, t = idx >> 9, ch = idx & 511, pos = t & (SEQ - 1);
    float acc = cb[ch];
#pragma unroll
    for (int k = 0; k < 4; ++k) { const int d = k - 3; if (pos + d >= 0) acc += cw[k * 512 + ch] * bf2f(Z[(size_t)(t + d) * 2048 + ch]); }
    XC[idx] = acc;
}
__global__ void __launch_bounds__(256) k_gates(const float* XC, const float* wa, const float* ba, const float* wi, const float* bi, const float* lam, float* A_, float* U_) {
    const int idx = blockIdx.x * 256 + threadIdx.x, t = idx >> 9, ch = idx & 511, h = ch >> 6, e = ch & 63;
    const float* xrow = XC + (size_t)t * 512 + h * 64;
    float ra = ba[ch], ri = bi[ch];
    for (int d = 0; d < 64; ++d) { const float xv = xrow[d]; ra += xv * wa[h * 4096 + d * 64 + e]; ri += xv * wi[h * 4096 + d * 64 + e]; }
    const float r = sigmoidf(ra), ig = sigmoidf(ri);
    const float sp = log1pf(expf(-lam[ch]));
    const float log_a = -8.0f * r * sp;
    A_[idx] = expf(log_a);
    U_[idx] = sqrtf(-expm1f(2.0f * log_a)) * (ig * XC[idx]);
}
__global__ void __launch_bounds__(64) k_scan(const float* A_, const float* U_, const bf16_t* Z, bf16_t* YMIX) {
    const int idx = blockIdx.x * 64 + threadIdx.x, b = idx >> 9, ch = idx & 511;
    float h = 0.f;
    for (int p0 = 0; p0 < SEQ; p0 += 8) {
        float a[8], u[8], g[8];
#pragma unroll
        for (int q = 0; q < 8; ++q) { const size_t t = (size_t)b * SEQ + p0 + q; a[q] = A_[t * 512 + ch]; u[q] = U_[t * 512 + ch]; g[q] = bf2f(Z[t * 2048 + 512 + ch]); }
#pragma unroll
        for (int q = 0; q < 8; ++q) { const size_t t = (size_t)b * SEQ + p0 + q; h = a[q] * h + u[q]; YMIX[t * D + ch] = (bf16_t)f2bf(h * g[q]); }
    }
}

__global__ void __launch_bounds__(256) k_router(const bf16_t* X1, const float* g2w, const float* mod, const float* wg, const float* bg, const float* we, const float* be,
                                                bf16_t* H2, unsigned* cnt, int* list, int* toke, float* tokw, int* tokp) {
    const int row = blockIdx.x * 4 + (threadIdx.x >> 6), lane = threadIdx.x & 63, b = row / SEQ;
    float h[16]; float ss = 0.f;
#pragma unroll
    for (int jj = 0; jj < 2; ++jj) { const u32x4 raw = *(const u32x4*)(X1 + (size_t)row * D + 512 * jj + 8 * lane);
#pragma unroll
        for (int q = 0; q < 4; ++q) { h[8 * jj + 2 * q] = bf2f(raw[q] & 0xffffu); h[8 * jj + 2 * q + 1] = bf2f(raw[q] >> 16); } }
#pragma unroll
    for (int q = 0; q < 16; ++q) ss += h[q] * h[q];
    const float rs = rsqrtf(wave_sum(ss) * (1.0f / D) + EPS);
    const float* sh = mod + b * 6144 + 3072; const float* sc = sh + 1024;
#pragma unroll
    for (int jj = 0; jj < 2; ++jj) { u32x4 o;
#pragma unroll
        for (int q = 0; q < 4; ++q) { const int c = 512 * jj + 8 * lane + 2 * q;
            const float h0 = h[8 * jj + 2 * q] * rs * g2w[c] * (1.0f + sc[c]) + sh[c], h1 = h[8 * jj + 2 * q + 1] * rs * g2w[c + 1] * (1.0f + sc[c + 1]) + sh[c + 1];
            o[q] = pk2(h0, h1); h[8 * jj + 2 * q] = bf2f(o[q] & 0xffffu); h[8 * jj + 2 * q + 1] = bf2f(o[q] >> 16); }
        *(u32x4*)(H2 + (size_t)row * D + 512 * jj + 8 * lane) = o; }
    float gl[4], el[8];
#pragma unroll
    for (int j = 0; j < 4; ++j) { float p = 0.f;
#pragma unroll
        for (int q = 0; q < 16; ++q) { const int k = 512 * (q >> 3) + 8 * lane + (q & 7); p += h[q] * wg[k * 4 + j]; }
        gl[j] = wave_sum(p) + bg[j]; }
    int gs = 0; float gmax = gl[0];
#pragma unroll
    for (int j = 1; j < 4; ++j) if (gl[j] > gmax) { gmax = gl[j]; gs = j; }
#pragma unroll
    for (int j = 0; j < 8; ++j) { float p = 0.f;
#pragma unroll
        for (int q = 0; q < 16; ++q) { const int k = 512 * (q >> 3) + 8 * lane + (q & 7); p += h[q] * we[k * 32 + gs * 8 + j]; }
        el[j] = wave_sum(p) + be[gs * 8 + j]; }
    if (lane == 0) {
        float gsum = 0.f;
#pragma unroll
        for (int j = 0; j < 4; ++j) gsum += expf(gl[j] - gmax);
        const float pg = 1.0f / gsum;
        int i1 = 0; float m1 = el[0];
#pragma unroll
        for (int j = 1; j < 8; ++j) if (el[j] > m1) { m1 = el[j]; i1 = j; }
        int i2 = -1; float m2 = -INFINITY;
#pragma unroll
        for (int j = 0; j < 8; ++j) if (j != i1 && el[j] > m2) { m2 = el[j]; i2 = j; }
        const float r = expf(m2 - m1);
        const float w1 = pg / (1.0f + r), w2 = pg * r / (1.0f + r);
        const int e1 = gs * 8 + i1, e2 = gs * 8 + i2;
        const unsigned p1 = atomicAdd(cnt + CNT_STRIDE * e1, 1u), p2 = atomicAdd(cnt + CNT_STRIDE * e2, 1u);
        list[(size_t)e1 * LISTCAP + p1] = row; list[(size_t)e2 * LISTCAP + p2] = row;
        toke[2 * row] = e1; toke[2 * row + 1] = e2; tokw[2 * row] = w1; tokw[2 * row + 1] = w2; tokp[2 * row] = (int)p1; tokp[2 * row + 1] = (int)p2;
    }
}
__global__ void k_table(const unsigned* cnt, int* tbl) {
    if (threadIdx.x == 0) { int p = 0;
        for (int e = 0; e < NE; ++e) { tbl[1 + e] = p; const int nt = ((int)cnt[CNT_STRIDE * e] + 255) / 256; for (int j = 0; j < nt; ++j) tbl[64 + p + j] = e; p += nt; }
        tbl[1 + NE] = p; tbl[0] = p; }
}
__global__ void __launch_bounds__(256) k_rowtok(const unsigned* cnt, const int* tbl, const int* list, int* rowtok) {
    const int p = blockIdx.x * 256 + threadIdx.x, t = p >> 8; int tok = 0;
    if (t < tbl[0]) { const int e = tbl[64 + t], pos = (t - tbl[1 + e]) * 256 + (p & 255); if (pos < (int)cnt[CNT_STRIDE * e]) tok = list[(size_t)e * LISTCAP + pos]; }
    rowtok[p] = tok;
}
__global__ void __launch_bounds__(256) k_combine(const bf16_t* X1, const bf16_t* Y, const float* mod, const int* tbl, const int* toke, const float* tokw, const int* tokp, const float* fg, float* out) {
    const int row = blockIdx.x * 4 + (threadIdx.x >> 6), lane = threadIdx.x & 63, b = row / SEQ;
    const int e0 = toke[2 * row], e1 = toke[2 * row + 1];
    const size_t q0 = (size_t)tbl[1 + e0] * 256 + tokp[2 * row], q1 = (size_t)tbl[1 + e1] * 256 + tokp[2 * row + 1];
    const float w0 = tokw[2 * row], w1 = tokw[2 * row + 1];
    const float* g2 = mod + b * 6144 + 5120;
    float v[16]; float ss = 0.f;
#pragma unroll
    for (int jj = 0; jj < 2; ++jj) { const int c0 = 512 * jj + 8 * lane;
        const u32x4 xr = *(const u32x4*)(X1 + (size_t)row * D + c0), ya = *(const u32x4*)(Y + q0 * D + c0), yb = *(const u32x4*)(Y + q1 * D + c0);
#pragma unroll
        for (int q = 0; q < 4; ++q) {
            const float x0 = bf2f(xr[q] & 0xffffu), x1 = bf2f(xr[q] >> 16);
            const float y0 = w0 * bf2f(ya[q] & 0xffffu) + w1 * bf2f(yb[q] & 0xffffu), y1 = w0 * bf2f(ya[q] >> 16) + w1 * bf2f(yb[q] >> 16);
            v[8 * jj + 2 * q] = x0 + g2[c0 + 2 * q] * y0; v[8 * jj + 2 * q + 1] = x1 + g2[c0 + 2 * q + 1] * y1; } }
#pragma unroll
    for (int q = 0; q < 16; ++q) ss += v[q] * v[q];
    const float rs = rsqrtf(wave_sum(ss) * (1.0f / D) + EPS);
#pragma unroll
    for (int jj = 0; jj < 2; ++jj) { const int c0 = 512 * jj + 8 * lane;
        f32x4 o0, o1;
#pragma unroll
        for (int q = 0; q < 4; ++q) { o0[q] = v[8 * jj + q] * rs * fg[c0 + q]; o1[q] = v[8 * jj + 4 + q] * rs * fg[c0 + 4 + q]; }
        *(f32x4*)(out + (size_t)row * D + c0) = o0; *(f32x4*)(out + (size_t)row * D + c0 + 4) = o1; }
}

namespace pg8 {
#define PG8_LAS __attribute__((address_space(3)))
constexpr int BM = 256, BK = 64, HALF = 128, HTB = HALF * BK * 2  , STAGE_BYTES = 8 * HTB, NXCD = 8, WGM = 8;
__host__ __device__ __forceinline__ int lds_byte(int r, int c) { const int st = (r >> 4) * 2 + (c >> 5), rr = r & 15, cc = c & 31, ob = rr * 64 + cc * 2; return st * 1024 + (ob ^ (((ob >> 9) & 1) << 5)); }
__host__ __device__ __forceinline__ void stage_rc(int b, int& R, int& C) { const int st = b / 1024, sb = b % 1024, swz = sb ^ (((sb >> 9) & 1) << 5); R = (st >> 1) * 16 + swz / 64; C = (st & 1) * 32 + (swz % 64) / 2; }
__host__ __device__ __forceinline__ int perm32(int rho) { const int n = rho >> 4, i = rho & 15; return 8 * (i >> 2) + 4 * n + (i & 3); }

__host__ __device__ __forceinline__ int perm256(int h, int R) { return 64 * (R >> 5) + 16 * ((R >> 2) & 3) + 8 * h + 4 * ((R >> 4) & 1) + (R & 3); }

struct Unit { int pm, pn, e; };
struct Gemm { const void* A; const void* Bt; int Kb; };
__host__ __device__ __forceinline__ int swz8(int r8) { return ((r8 >> 1) & 1) | (((r8 >> 2) & 1) << 2); }
__host__ __device__ __forceinline__ int lds_byte8(int r, int piece) { return (r >> 3) * 1024 + ((r & 7) * 8 + (piece ^ swz8(r & 7))) * 16; }
__host__ __device__ __forceinline__ void stage_rc8(int b, int& R, int& Cb) { const int chunk = b >> 10, slot = (b & 1023) >> 4, r8 = slot >> 3, j = slot & 7; R = chunk * 8 + r8; Cb = (j ^ swz8(r8)) * 16; }
typedef int v8i32 __attribute__((ext_vector_type(8)));
typedef int v4i32 __attribute__((ext_vector_type(4)));

struct StaticOrder {
    int nM, nN, nwg, G, c; size_t tstep;
    __device__ void init(int M, int N, int Kb, int G_, int c_) { nM = M / BM; nN = N / BM; nwg = nM * nN; G = G_; c = c_; tstep = (size_t)BM * Kb; }
    __device__ bool next(int i, Unit& u) const {
        const long L = (long)i * G + c; if (L >= nwg) return false;
        int wgid = (int)L; { const int q = nwg / NXCD, r = nwg % NXCD, xcd = wgid % NXCD, off = wgid / NXCD; wgid = (xcd < r ? xcd * (q + 1) : r * (q + 1) + (xcd - r) * q) + off; }
        const int nig = WGM * nN, gid = wgid / nig, fm = gid * WGM, gsz = (nM - fm) < WGM ? (nM - fm) : WGM;
        u.pm = fm + ((wgid % nig) % gsz); u.pn = (wgid % nig) / gsz; u.e = 0; return true;
    }
    __device__ __forceinline__ size_t a_off(const Unit& u) const { return (size_t)u.pm * tstep; }
    __device__ __forceinline__ size_t b_off(const Unit& u) const { return (size_t)u.pn * tstep; }
    PG8_LAS unsigned char* tokt;
    __device__ __forceinline__ const int* tok_src(const Unit&, int) const { return nullptr; }
};
struct SplitOrder : StaticOrder {
    int nA, upa, cls, idx, nB;
    __device__ void init2(int M, int N, int Kb, int nA_, int nB_, int upa_, int cls_, int idx_) { init(M, N, Kb, 1, 0); nA = nA_; nB = nB_; upa = upa_; cls = cls_; idx = idx_; }
    __device__ bool next(int i, Unit& u) const {
        long L; if (cls == 0) { if (i >= upa) return false; L = (long)i * nA + idx; } else { L = (long)upa * nA + (long)i * nB + idx; }
        if (L >= nwg) return false;
        int wgid = (int)L; { const int q = nwg / NXCD, r = nwg % NXCD, xcd = wgid % NXCD, off = wgid / NXCD; wgid = (xcd < r ? xcd * (q + 1) : r * (q + 1) + (xcd - r) * q) + off; }
        const int nig = WGM * nN, gid = wgid / nig, fm = gid * WGM, gsz = (nM - fm) < WGM ? (nM - fm) : WGM;
        u.pm = fm + ((wgid % nig) % gsz); u.pn = (wgid % nig) / gsz; u.e = 0; return true;
    }
};
struct MoeOrder {
    int nunits, G, c, Kb; size_t estride;
    const PG8_LAS int* tile_e; const PG8_LAS int* p0; const PG8_LAS int* cnt; const int* list; bool gather;
    __device__ bool next(int i, Unit& u) const {
        const int L = i * G + c; if (L >= nunits) return false;
        u.pm = L >> 2; u.pn = L & 3; u.e = tile_e[u.pm]; return true;
    }
    __device__ __forceinline__ size_t a_off(const Unit& u) const { return gather ? (size_t)0 : (size_t)u.pm * BM * Kb; }
    __device__ __forceinline__ size_t b_off(const Unit& u) const { return (size_t)u.e * estride + (size_t)u.pn * BM * Kb; }
    PG8_LAS unsigned char* tokt;
    __device__ __forceinline__ const int* tok_src(const Unit& u, int r) const {
        const int pos = (u.pm - p0[u.e]) * 256 + r, last = cnt[u.e] - 1;
        return list + (size_t)u.e * LISTCAP + (pos < last ? pos : last);
    }
};

__device__ __forceinline__ unsigned cvt_pk_bf16(float lo, float hi) { unsigned r; asm volatile("v_cvt_pk_bf16_f32 %0, %1, %2" : "=v"(r) : "v"(lo), "v"(hi)); return r; }
typedef float f32x2 __attribute__((ext_vector_type(2)));
__device__ __forceinline__ f32x2 exp2_2(f32x2 a) { return (f32x2){__builtin_amdgcn_exp2f(a.x), __builtin_amdgcn_exp2f(a.y)}; }
__device__ __forceinline__ f32x2 rcp_2(f32x2 a) { return (f32x2){__builtin_amdgcn_rcpf(a.x), __builtin_amdgcn_rcpf(a.y)}; }
__device__ __forceinline__ f32x2 gelu_fast2(f32x2 x) {
    const f32x2 u = x * x, w = u * (f32x2){-0.10294324f, -0.10294324f} + (f32x2){-2.3022082f, -2.3022082f}, t = x * w;
    return x * rcp_2(exp2_2(t) + (f32x2){1.0f, 1.0f}); }
__device__ __forceinline__ f32x4 gelu_fast4(f32x4 v) { const f32x2 a = gelu_fast2((f32x2){v[0], v[1]}), b = gelu_fast2((f32x2){v[2], v[3]}); return (f32x4){a.x, a.y, b.x, b.y}; }
__device__ __forceinline__ float gelu_fast(float x) {
    const float u = -2.3022082f * (x + 0.044715f * x * x * x);
    return x * __builtin_amdgcn_rcpf(1.0f + __builtin_amdgcn_exp2f(u));
}
__device__ __forceinline__ float silu_fast(float x) { return x * __builtin_amdgcn_rcpf(1.0f + __builtin_amdgcn_exp2f(-1.4426950408889634f * x)); }

__device__ __forceinline__ unsigned dpp_swap1(unsigned v) { return (unsigned)__builtin_amdgcn_mov_dpp((int)v, 0xB1, 0xF, 0xF, true); }
__device__ __forceinline__ void st_rowpair(bf16_t* rowp_even, size_t rstride, bool odd, const u32x4& lo, const u32x4& hi) {
    u32x4 t, r, a, b;
#pragma unroll
    for (int i = 0; i < 4; ++i) { t[i] = odd ? lo[i] : hi[i]; r[i] = dpp_swap1(t[i]); a[i] = odd ? r[i] : lo[i]; b[i] = odd ? hi[i] : r[i]; }
    *(u32x4*)rowp_even = a; *(u32x4*)(rowp_even + rstride) = b;
}
struct EpiZ { static constexpr int PERM = 2; bf16_t* Z;
    __device__ __forceinline__ void operator()(const f32x4 (&acc)[2][2][4][2], const Unit& u, int wr, int wc, int fr, int fq) const {
        const bool odd = fr & 1; const int rowe = u.pm * BM + wr * 64 + (fr & ~1), col0 = u.pn * BM + wc * 64 + 16 * fq + (odd ? 8 : 0); const bool act = u.pn >= 2;
#pragma unroll
        for (int ai = 0; ai < 2; ++ai)
#pragma unroll
            for (int m = 0; m < 4; ++m) { u32x4 h[2];
#pragma unroll
                for (int bj = 0; bj < 2; ++bj) { f32x4 v0 = acc[ai][bj][m][0], v1 = acc[ai][bj][m][1];
                    if (act) { v0 = gelu_fast4(v0); v1 = gelu_fast4(v1); }
                    h[bj].x = cvt_pk_bf16(v0[0], v0[1]); h[bj].y = cvt_pk_bf16(v0[2], v0[3]); h[bj].z = cvt_pk_bf16(v1[0], v1[1]); h[bj].w = cvt_pk_bf16(v1[2], v1[3]); }
                st_rowpair(Z + (size_t)(rowe + ai * HALF + m * 16) * 2048 + col0, 2048, odd, h[0], h[1]); }
    }
};
struct EpiX1 { static constexpr int PERM = 2; const float* x; const float* mod; bf16_t* X1;
    __device__ __forceinline__ void operator()(const f32x4 (&acc)[2][2][4][2], const Unit& u, int wr, int wc, int fr, int fq) const {
        const bool odd = fr & 1; const int row0 = u.pm * BM + wr * 64 + fr, col0 = u.pn * BM + wc * 64 + 16 * fq; const int b = (u.pm * BM) / SEQ;
        const float* g1 = mod + b * 6144 + 2048 + col0;
        f32x4 gv[4];
#pragma unroll
        for (int j = 0; j < 4; ++j) gv[j] = *(const f32x4*)(g1 + 4 * j);
#pragma unroll
        for (int ai = 0; ai < 2; ++ai)
#pragma unroll
            for (int m = 0; m < 4; ++m) { const float* xp = x + (size_t)(row0 + ai * HALF + m * 16) * D + col0; u32x4 h[2];
#pragma unroll
                for (int bj = 0; bj < 2; ++bj) { const f32x4 x0 = *(const f32x4*)(xp + 8 * bj), x1 = *(const f32x4*)(xp + 8 * bj + 4);
                    const f32x4 v0 = x0 + gv[2 * bj] * acc[ai][bj][m][0], v1 = x1 + gv[2 * bj + 1] * acc[ai][bj][m][1];
                    h[bj].x = cvt_pk_bf16(v0[0], v0[1]); h[bj].y = cvt_pk_bf16(v0[2], v0[3]); h[bj].z = cvt_pk_bf16(v1[0], v1[1]); h[bj].w = cvt_pk_bf16(v1[2], v1[3]); }
                st_rowpair(X1 + (size_t)((row0 & ~1) + ai * HALF + m * 16) * D + col0 + (odd ? 8 : 0), D, odd, h[0], h[1]); }
    }
};
struct EpiAct { static constexpr bool PERM = true; bf16_t* ACT;
    __device__ __forceinline__ void operator()(const f32x4 (&acc)[2][2][4][2], const Unit& u, int wr, int wc, int fr, int fq) const {
        const int row0 = u.pm * BM + wr * 64 + fr, col0 = u.pn * HALF + wc * 32 + 8 * fq;
#pragma unroll
        for (int ai = 0; ai < 2; ++ai)
#pragma unroll
            for (int m = 0; m < 4; ++m) { f32x4 v0, v1;
#pragma unroll
                for (int q = 0; q < 4; ++q) { v0[q] = silu_fast(acc[ai][0][m][0][q]) * acc[ai][1][m][0][q]; v1[q] = silu_fast(acc[ai][0][m][1][q]) * acc[ai][1][m][1][q]; }
                u32x4 w; w.x = cvt_pk_bf16(v0[0], v0[1]); w.y = cvt_pk_bf16(v0[2], v0[3]); w.z = cvt_pk_bf16(v1[0], v1[1]); w.w = cvt_pk_bf16(v1[2], v1[3]);
                *(u32x4*)(ACT + (size_t)(row0 + ai * HALF + m * 16) * DE + col0) = w; }
    }
};
__device__ __forceinline__ unsigned pk4_fp8(float a, float b, float c, float d) {
    a = __builtin_fminf(__builtin_fmaxf(a, -448.f), 448.f); b = __builtin_fminf(__builtin_fmaxf(b, -448.f), 448.f);
    c = __builtin_fminf(__builtin_fmaxf(c, -448.f), 448.f); d = __builtin_fminf(__builtin_fmaxf(d, -448.f), 448.f);
    unsigned w = 0u; w = __builtin_amdgcn_cvt_pk_fp8_f32(a, b, w, false); w = __builtin_amdgcn_cvt_pk_fp8_f32(c, d, w, true); return w; }
struct EpiAct8 { static constexpr bool PERM = true; unsigned char* ACT; float inv, oscale;
    __device__ __forceinline__ void operator()(const f32x4 (&acc)[2][2][4][2], const Unit& u, int wr, int wc, int fr, int fq) const {
        const int row0 = u.pm * BM + wr * 64 + fr, col0 = u.pn * HALF + wc * 32 + 8 * fq; const float ce = -1.4426950408889634f * inv, ik = 1.0f / (inv * inv * oscale);
#pragma unroll
        for (int ai = 0; ai < 2; ++ai)
#pragma unroll
            for (int m = 0; m < 4; ++m) { f32x4 v0, v1;
#pragma unroll
                for (int h = 0; h < 2; ++h)
#pragma unroll
                    for (int p = 0; p < 2; ++p) {
                        const f32x2 g = (f32x2){acc[ai][0][m][h][2 * p], acc[ai][0][m][h][2 * p + 1]}, uu = (f32x2){acc[ai][1][m][h][2 * p], acc[ai][1][m][h][2 * p + 1]};
                        const f32x2 e = exp2_2(g * (f32x2){ce, ce}), r = rcp_2(e * (f32x2){ik, ik} + (f32x2){ik, ik}), o = (g * uu) * r;
                        if (h == 0) { v0[2 * p] = o.x; v0[2 * p + 1] = o.y; } else { v1[2 * p] = o.x; v1[2 * p + 1] = o.y; } }
                u32x2 w; w.x = pk4_fp8(v0[0], v0[1], v0[2], v0[3]); w.y = pk4_fp8(v1[0], v1[1], v1[2], v1[3]);
                *(u32x2*)(ACT + (size_t)(row0 + ai * HALF + m * 16) * DE + col0) = w; }
    }
};
struct EpiY8 { static constexpr int PERM = 2; unsigned char* Y; float sc;
    __device__ __forceinline__ void operator()(const f32x4 (&acc)[2][2][4][2], const Unit& u, int wr, int wc, int fr, int fq) const {
        const int row0 = u.pm * BM + wr * 64 + fr, col0 = u.pn * BM + wc * 64 + 16 * fq;
#pragma unroll
        for (int ai = 0; ai < 2; ++ai)
#pragma unroll
            for (int m = 0; m < 4; ++m) { u32x4 w;
                { const f32x4 v0 = acc[ai][0][m][0] * sc, v1 = acc[ai][0][m][1] * sc; w.x = pk4_fp8(v0[0], v0[1], v0[2], v0[3]); w.y = pk4_fp8(v1[0], v1[1], v1[2], v1[3]); }
                { const f32x4 v0 = acc[ai][1][m][0] * sc, v1 = acc[ai][1][m][1] * sc; w.z = pk4_fp8(v0[0], v0[1], v0[2], v0[3]); w.w = pk4_fp8(v1[0], v1[1], v1[2], v1[3]); }
                *(u32x4*)(Y + (size_t)(row0 + ai * HALF + m * 16) * D + col0) = w; }
    }
};
struct EpiY { static constexpr bool PERM = true; bf16_t* Y;
    __device__ __forceinline__ void operator()(const f32x4 (&acc)[2][2][4][2], const Unit& u, int wr, int wc, int fr, int fq) const {
        const int row0 = u.pm * BM + wr * 64 + fr, col0 = u.pn * BM + wc * 32 + 8 * fq;
#pragma unroll
        for (int ai = 0; ai < 2; ++ai)
#pragma unroll
            for (int m = 0; m < 4; ++m) { bf16_t* rowp = Y + (size_t)(row0 + ai * HALF + m * 16) * D + col0;
#pragma unroll
                for (int bj = 0; bj < 2; ++bj) { const f32x4 v0 = acc[ai][bj][m][0], v1 = acc[ai][bj][m][1];
                    u32x4 w; w.x = cvt_pk_bf16(v0[0], v0[1]); w.y = cvt_pk_bf16(v0[2], v0[3]); w.z = cvt_pk_bf16(v1[0], v1[1]); w.w = cvt_pk_bf16(v1[2], v1[3]);
                    *(u32x4*)(rowp + bj * HALF) = w; } }
    }
};

template <class Epi, class Sched, bool ALIGN_EPI, bool GATHER, bool FP8>
__device__ __forceinline__ void gemm_phase(PG8_LAS unsigned char* lds, const Gemm g, const Sched& S, const Epi& E) {
    const int tid = threadIdx.x, wid = __builtin_amdgcn_readfirstlane(tid >> 6), lane = tid & 63, wr = wid >> 2, wc = wid & 3, fr = lane & 15, fq = lane >> 4;
    const int Kb = g.Kb, nt = Kb / (BK * 2);
    unsigned voffA[2], voffB[2][2]; int Ra[2];
#pragma unroll
    for (int i = 0; i < 2; ++i) { int R, Cb; if (FP8) stage_rc8(tid * 16 + i * 8192, R, Cb); else { stage_rc(tid * 16 + i * 8192, R, Cb); Cb *= 2; }
        const int Rb = Epi::PERM ? ((R & ~31) + perm32(R & 31)) : R;
        Ra[i] = R; voffA[i] = GATHER ? (unsigned)Cb : (unsigned)(R * Kb + Cb);
#pragma unroll
        for (int h = 0; h < 2; ++h) voffB[h][i] = (int)Epi::PERM == 2 ? (unsigned)(perm256(h, R) * Kb + Cb) : (unsigned)((Rb + h * HALF) * Kb + Cb); }
    const size_t kstep = (size_t)(BK * 2);
    const size_t hstep = (size_t)HALF * Kb;
    const size_t hstepA = GATHER ? (size_t)0 : hstep;
    const unsigned ldsw = (unsigned)wid * 1024u;
    const int aoff = FP8 ? lds_byte8(wr * 64 + fr, 2 * fq) : lds_byte(wr * 64 + fr, fq * 8), boff = FP8 ? lds_byte8(wc * 32 + fr, 2 * fq) : lds_byte(wc * 32 + fr, fq * 8);
    const int aoff1 = FP8 ? lds_byte8(wr * 64 + fr, 2 * fq + 1) : 0, boff1 = FP8 ? lds_byte8(wc * 32 + fr, 2 * fq + 1) : 0;
#define PG8_SA(b, h) (((b) * 2 + (h)) * HTB)
#define PG8_SB(b, h) ((4 + (b) * 2 + (h)) * HTB)
#define PG8_STAGE(bufoff, gbase, voff) do { _Pragma("unroll") for (int _i = 0; _i < 2; ++_i) \
        __builtin_amdgcn_global_load_lds((const unsigned*)((const char*)(gbase) + (voff)[_i]), (PG8_LAS unsigned*)(lds + (bufoff) + ldsw + _i * 8192), 16, 0, 0); } while (0)
#define PG8_STAGE_A(bufoff, kbase, h) do { _Pragma("unroll") for (int _i = 0; _i < 2; ++_i) \
        __builtin_amdgcn_global_load_lds((const unsigned*)((const char*)(kbase) + (size_t)(h) * hstepA + (GATHER ? gC[h][_i] : 0u) + voffA[_i]), (PG8_LAS unsigned*)(lds + (bufoff) + ldsw + _i * 8192), 16, 0, 0); } while (0)
#define PG8_LD16(off) (*(const PG8_LAS v4i32*)(lds + (off)))
#define PG8_LDA(dst, b, h) do { _Pragma("unroll") for (int m = 0; m < 4; ++m) { if constexpr (FP8) dst##8[m] = __builtin_shufflevector(PG8_LD16(PG8_SA(b, h) + aoff + m * 2048), PG8_LD16(PG8_SA(b, h) + aoff1 + m * 2048), 0, 1, 2, 3, 4, 5, 6, 7); \
        else { _Pragma("unroll") for (int k = 0; k < 2; ++k) dst[m][k] = *(const PG8_LAS bf16x8*)(lds + PG8_SA(b, h) + aoff + m * 2048 + k * 1024); } } } while (0)
#define PG8_LDB(dst, b, h) do { _Pragma("unroll") for (int n = 0; n < 2; ++n) { if constexpr (FP8) dst##8[n] = __builtin_shufflevector(PG8_LD16(PG8_SB(b, h) + boff + n * 2048), PG8_LD16(PG8_SB(b, h) + boff1 + n * 2048), 0, 1, 2, 3, 4, 5, 6, 7); \
        else { _Pragma("unroll") for (int k = 0; k < 2; ++k) dst[n][k] = *(const PG8_LAS bf16x8*)(lds + PG8_SB(b, h) + boff + n * 2048 + k * 1024); } } } while (0)
#define PG8_MMA(ai, bj, At, Bt, ZF) do { __builtin_amdgcn_s_setprio(1); _Pragma("unroll") for (int m = 0; m < 4; ++m) _Pragma("unroll") for (int n = 0; n < 2; ++n) { \
        if constexpr (FP8) { if constexpr (ZF) asm volatile("v_mfma_f32_16x16x128_f8f6f4 %0, %1, %2, 0" : "=v"(acc[ai][bj][m][n]) : "v"(Bt##8[n]), "v"(At##8[m])); \
                             else asm volatile("v_mfma_f32_16x16x128_f8f6f4 %0, %1, %2, %0" : "+v"(acc[ai][bj][m][n]) : "v"(Bt##8[n]), "v"(At##8[m])); } \
        else { acc[ai][bj][m][n] = __builtin_amdgcn_mfma_f32_16x16x32_bf16(Bt[n][0], At[m][0], ZF ? (f32x4){0.f, 0.f, 0.f, 0.f} : acc[ai][bj][m][n], 0, 0, 0); \
               acc[ai][bj][m][n] = __builtin_amdgcn_mfma_f32_16x16x32_bf16(Bt[n][1], At[m][1], acc[ai][bj][m][n], 0, 0, 0); } } \
        __builtin_amdgcn_s_setprio(0); } while (0)
#define PG8_WAIT_V(n) asm volatile("s_waitcnt vmcnt(" #n ")" ::: "memory")
#define PG8_WAIT_L(n) asm volatile("s_waitcnt lgkmcnt(" #n ")" ::: "memory")
#define PG8_BAR __builtin_amdgcn_s_barrier()
#define PG8_SCHED __builtin_amdgcn_sched_barrier(0)
    Unit cur, nxt; int ui = 0;
    if (!S.next(0, cur)) return;
    f32x4 acc[2][2][4][2];
    bf16x8 At[4][2], B0[2][2], B1[2][2]; v8i32 At8[4], B08[2], B18[2];
#define PG8_TOK_ISSUE(u_, slot_) do { if (wid < 4) __builtin_amdgcn_global_load_lds((const unsigned*)S.tok_src(u_, tid), (PG8_LAS unsigned*)(S.tokt + (slot_) * 1024 + wid * 256), 4, 0, 0); } while (0)
#define PG8_TOK_READ(slot_) do { _Pragma("unroll") for (int h = 0; h < 2; ++h) _Pragma("unroll") for (int i = 0; i < 2; ++i) \
        gC[h][i] = *(const PG8_LAS unsigned*)(S.tokt + (slot_) * 1024 + (h * HALF + Ra[i]) * 4) * (unsigned)Kb; } while (0)
    unsigned gC[2][2];
#pragma unroll
    for (int h = 0; h < 2; ++h)
#pragma unroll
        for (int i = 0; i < 2; ++i) gC[h][i] = 0u;
    if constexpr (GATHER) { PG8_TOK_ISSUE(cur, 0); PG8_WAIT_V(0); PG8_BAR; PG8_TOK_READ(0); }
    const char* cA = (const char*)g.A + S.a_off(cur); const char* cB = (const char*)g.Bt + S.b_off(cur);
    PG8_STAGE(PG8_SB(0, 0), cB, voffB[0]); PG8_STAGE(PG8_SB(0, 1), cB, voffB[1]); PG8_STAGE_A(PG8_SA(0, 0), cA, 0); PG8_STAGE_A(PG8_SA(0, 1), cA, 1);
    if (wr == 1) PG8_BAR;
    PG8_WAIT_V(2); PG8_BAR;
    PG8_STAGE(PG8_SB(1, 0), cB + kstep, voffB[0]); PG8_STAGE_A(PG8_SA(1, 0), cA + kstep, 0); PG8_STAGE(PG8_SB(1, 1), cB + kstep, voffB[1]);
    PG8_WAIT_V(6); PG8_BAR;
    for (;;) {
        const bool has_next = S.next(ui + 1, nxt);
        const char* nA = has_next ? (const char*)g.A + S.a_off(nxt) : cA; const char* nB = has_next ? (const char*)g.Bt + S.b_off(nxt) : cB;
        if constexpr (GATHER) { if (has_next) PG8_TOK_ISSUE(nxt, (ui + 1) & 1); }
        if constexpr (FP8) {
        { constexpr bool ZF = true; const int t = 0;
            const bool last = (t == nt - 2);
            const char* a1 = cA + (size_t)(t + 1) * kstep;
            const char* a2 = last ? nA : cA + (size_t)(t + 2) * kstep; const char* b2 = last ? nB : cB + (size_t)(t + 2) * kstep;
            const char* a3 = a2 + kstep; const char* b3 = b2 + kstep;
            PG8_LDB(B0, 0, 0); PG8_LDB(B1, 0, 1); PG8_SCHED; PG8_LDA(At, 0, 0); PG8_STAGE_A(PG8_SA(1, 1), a1, 1);
            PG8_WAIT_V(8); PG8_WAIT_L(0); PG8_BAR; PG8_MMA(0, 0, At, B0, ZF); PG8_MMA(0, 1, At, B1, ZF); PG8_BAR; PG8_SCHED;
            if constexpr (GATHER) { if (last && has_next) PG8_TOK_READ((ui + 1) & 1); }
            PG8_LDA(At, 0, 1); PG8_STAGE(PG8_SB(0, 0), b2, voffB[0]); PG8_STAGE(PG8_SB(0, 1), b2, voffB[1]); PG8_STAGE_A(PG8_SA(0, 0), a2, 0);
            PG8_WAIT_V(8); PG8_WAIT_L(0); PG8_BAR; PG8_MMA(1, 0, At, B0, ZF); PG8_MMA(1, 1, At, B1, ZF); PG8_BAR; PG8_SCHED;
            PG8_LDB(B0, 1, 0); PG8_LDB(B1, 1, 1); PG8_SCHED; PG8_LDA(At, 1, 0); PG8_STAGE_A(PG8_SA(0, 1), a2, 1);
            PG8_WAIT_V(8); PG8_WAIT_L(0); PG8_BAR; PG8_MMA(0, 0, At, B0, false); PG8_MMA(0, 1, At, B1, false); PG8_BAR; PG8_SCHED;
            PG8_LDA(At, 1, 1); PG8_STAGE(PG8_SB(1, 0), b3, voffB[0]); PG8_STAGE(PG8_SB(1, 1), b3, voffB[1]); PG8_STAGE_A(PG8_SA(1, 0), a3, 0);
            PG8_WAIT_V(8); PG8_WAIT_L(0); PG8_BAR; PG8_MMA(1, 0, At, B0, false); PG8_MMA(1, 1, At, B1, false); PG8_BAR; PG8_SCHED;
                }
#pragma unroll 1
        for (int t = 2; t < nt; t += 2) { constexpr bool ZF = false;
            const bool last = (t == nt - 2);
            const char* a1 = cA + (size_t)(t + 1) * kstep;
            const char* a2 = last ? nA : cA + (size_t)(t + 2) * kstep; const char* b2 = last ? nB : cB + (size_t)(t + 2) * kstep;
            const char* a3 = a2 + kstep; const char* b3 = b2 + kstep;
            PG8_LDB(B0, 0, 0); PG8_LDB(B1, 0, 1); PG8_SCHED; PG8_LDA(At, 0, 0); PG8_STAGE_A(PG8_SA(1, 1), a1, 1);
            PG8_WAIT_V(8); PG8_WAIT_L(0); PG8_BAR; PG8_MMA(0, 0, At, B0, ZF); PG8_MMA(0, 1, At, B1, ZF); PG8_BAR; PG8_SCHED;
            if constexpr (GATHER) { if (last && has_next) PG8_TOK_READ((ui + 1) & 1); }
            PG8_LDA(At, 0, 1); PG8_STAGE(PG8_SB(0, 0), b2, voffB[0]); PG8_STAGE(PG8_SB(0, 1), b2, voffB[1]); PG8_STAGE_A(PG8_SA(0, 0), a2, 0);
            PG8_WAIT_V(8); PG8_WAIT_L(0); PG8_BAR; PG8_MMA(1, 0, At, B0, ZF); PG8_MMA(1, 1, At, B1, ZF); PG8_BAR; PG8_SCHED;
            PG8_LDB(B0, 1, 0); PG8_LDB(B1, 1, 1); PG8_SCHED; PG8_LDA(At, 1, 0); PG8_STAGE_A(PG8_SA(0, 1), a2, 1);
            PG8_WAIT_V(8); PG8_WAIT_L(0); PG8_BAR; PG8_MMA(0, 0, At, B0, false); PG8_MMA(0, 1, At, B1, false); PG8_BAR; PG8_SCHED;
            PG8_LDA(At, 1, 1); PG8_STAGE(PG8_SB(1, 0), b3, voffB[0]); PG8_STAGE(PG8_SB(1, 1), b3, voffB[1]); PG8_STAGE_A(PG8_SA(1, 0), a3, 0);
            PG8_WAIT_V(8); PG8_WAIT_L(0); PG8_BAR; PG8_MMA(1, 0, At, B0, false); PG8_MMA(1, 1, At, B1, false); PG8_BAR; PG8_SCHED;
                }
        } else {
#pragma unroll
        for (int a = 0; a < 2; ++a)
#pragma unroll
            for (int b = 0; b < 2; ++b)
#pragma unroll
                for (int m = 0; m < 4; ++m)
#pragma unroll
                    for (int n = 0; n < 2; ++n) acc[a][b][m][n] = (f32x4){0.f, 0.f, 0.f, 0.f};
#pragma unroll 1
        for (int t = 0; t < nt; t += 2) { constexpr bool ZF = false;
            const bool last = (t == nt - 2);
            const char* a1 = cA + (size_t)(t + 1) * kstep;
            const char* a2 = last ? nA : cA + (size_t)(t + 2) * kstep; const char* b2 = last ? nB : cB + (size_t)(t + 2) * kstep;
            const char* a3 = a2 + kstep; const char* b3 = b2 + kstep;
            PG8_LDB(B0, 0, 0); PG8_LDB(B1, 0, 1); PG8_SCHED; PG8_LDA(At, 0, 0); PG8_STAGE_A(PG8_SA(1, 1), a1, 1);
            PG8_WAIT_V(8); PG8_WAIT_L(0); PG8_BAR; PG8_MMA(0, 0, At, B0, ZF); PG8_MMA(0, 1, At, B1, ZF); PG8_BAR; PG8_SCHED;
            if constexpr (GATHER) { if (last && has_next) PG8_TOK_READ((ui + 1) & 1); }
            PG8_LDA(At, 0, 1); PG8_STAGE(PG8_SB(0, 0), b2, voffB[0]); PG8_STAGE(PG8_SB(0, 1), b2, voffB[1]); PG8_STAGE_A(PG8_SA(0, 0), a2, 0);
            PG8_WAIT_V(8); PG8_WAIT_L(0); PG8_BAR; PG8_MMA(1, 0, At, B0, ZF); PG8_MMA(1, 1, At, B1, ZF); PG8_BAR; PG8_SCHED;
            PG8_LDB(B0, 1, 0); PG8_LDB(B1, 1, 1); PG8_SCHED; PG8_LDA(At, 1, 0); PG8_STAGE_A(PG8_SA(0, 1), a2, 1);
            PG8_WAIT_V(8); PG8_WAIT_L(0); PG8_BAR; PG8_MMA(0, 0, At, B0, false); PG8_MMA(0, 1, At, B1, false); PG8_BAR; PG8_SCHED;
            PG8_LDA(At, 1, 1); PG8_STAGE(PG8_SB(1, 0), b3, voffB[0]); PG8_STAGE(PG8_SB(1, 1), b3, voffB[1]); PG8_STAGE_A(PG8_SA(1, 0), a3, 0);
            PG8_WAIT_V(8); PG8_WAIT_L(0); PG8_BAR; PG8_MMA(1, 0, At, B0, false); PG8_MMA(1, 1, At, B1, false); PG8_BAR; PG8_SCHED;
                }
        }
        if constexpr (ALIGN_EPI) { if (wr == 0) PG8_BAR; }
        if constexpr (FP8) asm volatile("s_nop 15\n\ts_nop 15" ::: "memory");
        E(acc, cur, wr, wc, fr, fq);
        if (!has_next) break;
        cur = nxt; cA = nA; cB = nB; ++ui;
        if constexpr (ALIGN_EPI) { if (wr == 1) PG8_BAR; }
    }
    PG8_WAIT_V(0);
    if constexpr (!ALIGN_EPI) { if (wr == 0) PG8_BAR; }
    PG8_BAR;
#undef PG8_SA
#undef PG8_SB
#undef PG8_STAGE
#undef PG8_STAGE_A
#undef PG8_TOK_ISSUE
#undef PG8_TOK_READ
#undef PG8_LDA
#undef PG8_LDB
#undef PG8_MMA
#undef PG8_LD16
#undef PG8_WAIT_V
#undef PG8_WAIT_L
#undef PG8_BAR
#undef PG8_SCHED
}
}
#define LAS __attribute__((address_space(3)))
#define GAS __attribute__((address_space(1)))
constexpr int NWAVES = 8, NTHREADS = 512;
constexpr int LDS_BYTES = 163840;
constexpr int SCR_BYTES = 147456;
constexpr int LDSCTL_OFF = SCR_BYTES;
constexpr int TAB_OFF = LDSCTL_OFF + 512;
constexpr int TAB_CNT = 0, TAB_P0 = 32, TAB_TE = 72;
constexpr int TOKT_OFF = TAB_OFF + 2048;
#define LDS_WAIT() asm volatile("s_waitcnt lgkmcnt(0)" ::: "memory")
#define WAVE_SYNC() do { asm volatile("s_waitcnt lgkmcnt(0)" ::: "memory"); __builtin_amdgcn_wave_barrier(); } while (0)

#ifndef MOE_FP8
#define MOE_FP8 1
#endif
constexpr float W13_SCALE = 32.f, W2_SCALE = 16.f, ACT_SCALE = 4.f, Y_SCALE = 16.f;
struct Args {
    const float* in[27]; float* out; unsigned char* ws; int ph_lo, ph_hi;
};
struct Frame {
    LAS unsigned char* lds; LAS int* tab; unsigned* ctl; unsigned char* ws;
    int tid, lane, wave, G, bid, vcu;
};
enum Phase { PH_A = 0, PH_B, PH_C, PH_D, PH_E, PH_F, PH_G, PH_H, PH_I, PH_J, PH_N };

#define XB_TMO      128
#define XB_XCNT(j)  (256  + 64 * (j))
#define XB_XSUB(j)  (1280 + 64 * (j))
#define XB_XGEN(j)  (2304 + 64 * (j))
#define XB_TOP      3328
#define XB_TOPGEN   3392
#define XCD_BAR_WORDS 3456
#define XB_SPIN_CAP (1u << 18)
__device__ __forceinline__ unsigned xb_ld(unsigned* p)              { return __hip_atomic_load(p, __ATOMIC_RELAXED, __HIP_MEMORY_SCOPE_AGENT); }
__device__ __forceinline__ unsigned xb_add(unsigned* p, unsigned v) { return __hip_atomic_fetch_add(p, v, __ATOMIC_RELAXED, __HIP_MEMORY_SCOPE_AGENT); }
__device__ __forceinline__ unsigned xb_xcc_id() { return (unsigned)__builtin_amdgcn_s_getreg((3 << 11) | 20) & 0xFu; }
#define XB_SPIN(cond, bar) do { unsigned _sp = 0; while (cond) { __builtin_amdgcn_s_sleep(1); \
    if ((++_sp & 255u) == 0u) { if (xb_ld(&(bar)[XB_TMO])) break; if (_sp > XB_SPIN_CAP) { atomicAdd(&(bar)[XB_TMO], 1u); break; } } } } while (0)
struct XcdBarrier { unsigned* bar; unsigned x; volatile LAS unsigned* st; };
__device__ __forceinline__ XcdBarrier xcd_barrier_post(unsigned* bar, volatile LAS unsigned* st) {
    XcdBarrier b; b.bar = bar; b.x = xb_xcc_id(); b.st = st;
    if (threadIdx.x == 0) (void)xb_add(&bar[XB_XCNT(b.x)], 1u);
    return b;
}
__device__ __forceinline__ void xcd_barrier_complete(unsigned* bar, unsigned x, unsigned& nloc, unsigned& nx) {
    const unsigned G = gridDim.x * gridDim.y * gridDim.z;
    unsigned sum, cnt, mine, sp = 0u;
    for (;;) {
        sum = 0u; cnt = 0u; mine = 0u;
#pragma unroll
        for (unsigned j = 0; j < 16; ++j) { const unsigned c = xb_ld(&bar[XB_XCNT(j)]); sum += c; cnt += (c > 0u) ? 1u : 0u; mine = (j == x) ? c : mine; }
        if (sum == G) break;
        __builtin_amdgcn_s_sleep(1);
        if ((++sp & 255u) == 0u) { if (xb_ld(&bar[XB_TMO])) break; if (sp > XB_SPIN_CAP) { atomicAdd(&bar[XB_TMO], 1u); break; } }
    }
    nloc = mine > 0u ? mine : 1u; nx = cnt > 0u ? cnt : 1u;
}
__device__ __forceinline__ void xcd_barrier(const XcdBarrier& b) {
    asm volatile("s_waitcnt vmcnt(0)" ::: "memory");
    __syncthreads();
    if (threadIdx.x == 0) {
        unsigned* bar = b.bar;
        __builtin_amdgcn_s_waitcnt(0);
        unsigned nloc = b.st[0], nx = b.st[1];
        if (nloc == 0u) { xcd_barrier_complete(bar, b.x, nloc, nx); b.st[0] = nloc; b.st[1] = nx; }
        const unsigned old = xb_add(&bar[XB_XSUB(b.x)], 1u);
        const unsigned gen = old / nloc;
        if (old + 1u == (gen + 1u) * nloc) {
            __builtin_amdgcn_fence(__ATOMIC_RELEASE, "agent");
            asm volatile("s_waitcnt vmcnt(0)" ::: "memory");
            asm volatile("buffer_inv sc1" ::: "memory");
            const unsigned og = xb_add(&bar[XB_TOP], 1u);
            asm volatile("s_waitcnt vmcnt(0)" ::: "memory");
            const unsigned tg = og / nx;
            if (og + 1u == (tg + 1u) * nx) xb_add(&bar[XB_TOPGEN], 1u);
            else XB_SPIN(xb_ld(&bar[XB_TOPGEN]) == tg, bar);
            xb_add(&bar[XB_XGEN(b.x)], 1u);
            asm volatile("s_waitcnt vmcnt(0)" ::: "memory");
        } else {
            asm volatile("buffer_inv sc1" ::: "memory");
            XB_SPIN(xb_ld(&bar[XB_XGEN(b.x)]) == gen, bar);
            asm volatile("s_waitcnt vmcnt(0)" ::: "memory");
        }
        __builtin_amdgcn_fence(__ATOMIC_ACQUIRE, "workgroup");
    }
    __syncthreads();
}

__device__ __forceinline__ void build_moe_table(Frame& F) {
    __syncthreads();
    if (F.tid < 64) {
        const int c = F.tid < NE ? (int)__hip_atomic_load(F.ctl + CW_CNT + CNT_STRIDE * F.tid, __ATOMIC_RELAXED, __HIP_MEMORY_SCOPE_AGENT) : 0;
        const int nt = (c + 255) >> 8; int p = nt;
#pragma unroll
        for (int o = 1; o < 32; o <<= 1) { const int v = __shfl_up(p, o); if (F.lane >= o) p += v; }
        const int excl = p - nt;
        if (F.tid < NE) { F.tab[TAB_CNT + F.tid] = c; F.tab[TAB_P0 + F.tid] = excl; for (int j = 0; j < nt; ++j) F.tab[TAB_TE + excl + j] = F.tid; }
        if (F.tid == NE - 1) F.tab[TAB_P0 + NE] = p;
    }
    __syncthreads();
}

struct TItem { const float* W; unsigned char* WT; int N, K, blk, rstride, rbase, k0, n0, fp8; float scale; };
__device__ __forceinline__ void titem_load(const TItem& d, f32x4 (&v)[16], int lane) {
#pragma unroll
    for (int i = 0; i < 16; ++i) v[i] = *(const f32x4*)(d.W + (size_t)(d.k0 + 16 * (lane >> 5) + i) * d.N + d.n0 + 4 * (lane & 31));
}
__device__ __forceinline__ unsigned pk4_fp8_nc(float a, float b, float c, float d) {
    unsigned w = 0u; w = __builtin_amdgcn_cvt_pk_fp8_f32(a, b, w, false); w = __builtin_amdgcn_cvt_pk_fp8_f32(c, d, w, true); return w; }
__device__ __forceinline__ void titem_store(const TItem& d, const f32x4 (&v)[16], int lane) {
#pragma unroll
    for (int q = 0; q < 4; ++q) {
        const int n = d.n0 + 4 * (lane & 31) + q, row = d.rbase + (n / d.blk) * d.rstride + (n % d.blk);
        if (d.fp8) { const float sc = d.scale; u32x4 o;
            o.x = pk4_fp8_nc(v[0][q] * sc, v[1][q] * sc, v[2][q] * sc, v[3][q] * sc); o.y = pk4_fp8_nc(v[4][q] * sc, v[5][q] * sc, v[6][q] * sc, v[7][q] * sc);
            o.z = pk4_fp8_nc(v[8][q] * sc, v[9][q] * sc, v[10][q] * sc, v[11][q] * sc); o.w = pk4_fp8_nc(v[12][q] * sc, v[13][q] * sc, v[14][q] * sc, v[15][q] * sc);
            *(u32x4*)(d.WT + (size_t)row * d.K + d.k0 + 16 * (lane >> 5)) = o;
        } else { u32x4 o0, o1;
            o0.x = pk2(v[0][q], v[1][q]); o0.y = pk2(v[2][q], v[3][q]); o0.z = pk2(v[4][q], v[5][q]); o0.w = pk2(v[6][q], v[7][q]);
            o1.x = pk2(v[8][q], v[9][q]); o1.y = pk2(v[10][q], v[11][q]); o1.z = pk2(v[12][q], v[13][q]); o1.w = pk2(v[14][q], v[15][q]);
            unsigned char* p = d.WT + ((size_t)row * d.K + d.k0 + 16 * (lane >> 5)) * 2; *(u32x4*)p = o0; *(u32x4*)(p + 16) = o1; }
    }
}
#ifndef CONV_PRE
#define CONV_PRE 1
#endif
constexpr int TI_IN = 512, TI_OUT = 256, TI_EXP = 384 * NE, TI_N = TI_IN + TI_OUT + TI_EXP;
__device__ __forceinline__ void titem_decode(const Args& args, unsigned char* ws, int it, TItem& d) {
    int r = it, item; d.fp8 = 0; d.scale = 1.f; d.rstride = 0; d.rbase = 0;
    if (r < TI_IN) { d.W = args.in[5]; d.WT = ws + OFF_WIN; d.K = 1024; d.N = 2048; d.blk = 2048; item = r; }
    else if ((r -= TI_IN) < TI_OUT) { d.W = args.in[17]; d.WT = ws + OFF_WOUT; d.K = 1024; d.N = 1024; d.blk = 1024; item = r; }
    else { r -= TI_OUT; const int e = r / 384, q = r % 384;
        if (q < 256) { d.W = (q < 128 ? args.in[23] : args.in[24]) + (size_t)e * 1024 * 512; d.K = 1024; d.N = 512; d.blk = 128; d.rstride = 256; d.rbase = q < 128 ? 0 : 128; item = q & 127;
            d.WT = ws + OFF_W13 + (size_t)e * 1024 * 1024 * (MOE_FP8 ? 1 : 2); d.scale = W13_SCALE; }
        else { d.W = args.in[25] + (size_t)e * 512 * 1024; d.K = 512; d.N = 1024; d.blk = 1024; item = q - 256; d.WT = ws + OFF_W2 + (size_t)e * 1024 * 512 * (MOE_FP8 ? 1 : 2); d.scale = W2_SCALE; }
        d.fp8 = MOE_FP8; if (!MOE_FP8) d.scale = 1.f; }
    const int nkb = d.K / 32; d.k0 = 32 * (item % nkb); d.n0 = 128 * (item / nkb);
}
__device__ __forceinline__ void phase_A(Frame& F, const Args& args) {
    unsigned char* ws = F.ws;
    const float* c = args.in[1]; const float* ada_w = args.in[2]; const float* ada_b = args.in[3];
    float* mod = (float*)(ws + OFF_MOD);
    for (int it = F.G - 1 - F.bid; it < 192; it += F.G) {
        LAS float* sc = (LAS float*)F.lds; LAS float* red = sc + 8192;
        for (int i = F.tid; i < 8192; i += NTHREADS) { const float v = c[i]; sc[(i & 1023) * 8 + (i >> 10)] = v / (1.0f + __expf(-v)); }
        __syncthreads();
        const int col = F.lane & 31, ks = F.lane >> 5, n = it * 32 + col, k0 = F.wave * 128 + ks;
        float acc[8];
#pragma unroll
        for (int b = 0; b < 8; ++b) acc[b] = 0.f;
#pragma unroll 1
        for (int i0 = 0; i0 < 64; i0 += 16) {
            float wv[16];
#pragma unroll
            for (int i = 0; i < 16; ++i) wv[i] = ada_w[(size_t)(k0 + 2 * (i0 + i)) * 6144 + n];
#pragma unroll
            for (int i = 0; i < 16; ++i) { const int k = k0 + 2 * (i0 + i);
                const f32x4 s0 = *(const LAS f32x4*)(sc + k * 8), s1 = *(const LAS f32x4*)(sc + k * 8 + 4);
#pragma unroll
                for (int b = 0; b < 4; ++b) { acc[b] += s0[b] * wv[i]; acc[4 + b] += s1[b] * wv[i]; } }
        }
#pragma unroll
        for (int b = 0; b < 8; ++b) { acc[b] += __shfl_xor(acc[b], 32); if (ks == 0) red[(F.wave * 8 + b) * 32 + col] = acc[b]; }
        __syncthreads();
        if (F.tid < 256) { const int b = F.tid >> 5, cc = F.tid & 31; float s = ada_b[it * 32 + cc];
#pragma unroll
            for (int w = 0; w < 8; ++w) s += red[(w * 8 + b) * 32 + cc];
            mod[b * 6144 + it * 32 + cc] = s; }
        __syncthreads();
    }
    {
        const int gw = F.vcu * NWAVES + F.wave, NGW = F.G * NWAVES;
        const int it_end = (F.G == 256) ? TI_IN + TI_OUT : TI_N;
        int it = gw;
        if (it < it_end) {
            TItem d, d2; f32x4 v[16], v2[16];
            titem_decode(args, ws, it, d); titem_load(d, v, F.lane);
            for (;;) {
                const int itn = it + NGW; const bool more = itn < it_end;
                if (more) { titem_decode(args, ws, itn, d2); titem_load(d2, v2, F.lane); }
                titem_store(d, v, F.lane);
                if (!more) break;
                d = d2; it = itn;
#pragma unroll
                for (int i = 0; i < 16; ++i) v[i] = v2[i];
            }
        }
    }
    {
        const int gt = F.bid * NTHREADS + F.tid, NGT = F.G * NTHREADS;
        const float* sgu_w = args.in[15]; const float* rgw = args.in[19]; const float* rew = args.in[21]; const float* lam = args.in[12];
        bf16_t* SGUW = (bf16_t*)(ws + OFF_SGUW); bf16_t* ROUTW = (bf16_t*)(ws + OFF_ROUTW); float* N8SP = (float*)(ws + OFF_N8SP);
        for (int i = gt; i < 8 * 128 * 128; i += NGT) { const int ii = (i >> 7) & 127, j = i & 127; SGUW[i] = (bf16_t)(((j >> 6) <= (ii >> 6)) ? f2bf(sgu_w[i]) : 0u); }
        for (int i = gt; i < 48 * 1024; i += NGT) { const int n = i >> 10, k = i & 1023; const float v = n < 4 ? rgw[k * 4 + n] : (n < 36 ? rew[k * 32 + n - 4] : 0.f); ROUTW[i] = (bf16_t)f2bf(v); }
        for (int i = gt; i < 512; i += NGT) N8SP[i] = -8.0f * 1.4426950408889634f * log1pf(expf(-lam[i]));
        { float* GB = (float*)(ws + OFF_GBIAS); const float* gab_ = args.in[9]; const float* gib_ = args.in[11];
          for (int i = gt; i < 1024; i += NGT) GB[i] = -1.4426950408889634f * (i < 512 ? gab_[i] : gib_[i - 512]); }
        { const float* gaw = args.in[8]; const float* giw = args.in[10]; bf16_t* GATEW = (bf16_t*)(ws + OFF_GATEW);
          for (int i = gt; i < 8 * 128 * 64; i += NGT) { const int h = i >> 13, ee = (i >> 6) & 127, dd = i & 63; const float v = -1.4426950408889634f * (ee < 64 ? gaw : giw)[h * 4096 + dd * 64 + (ee & 63)]; GATEW[i] = (bf16_t)f2bf(v); } }
    }
}

__device__ __forceinline__ void convert_experts(Frame& F, const Args& args, int gw, int NGW, int first, int count) {
    unsigned char* ws = F.ws;
    int it = first + gw; const int it_end = first + count;
    if (it < it_end) {
        TItem d, d2; f32x4 v[16], v2[16];
        titem_decode(args, ws, TI_IN + TI_OUT + it, d); titem_load(d, v, F.lane);
        for (;;) {
            const int itn = it + NGW; const bool more = itn < it_end;
            if (more) { titem_decode(args, ws, TI_IN + TI_OUT + itn, d2); titem_load(d2, v2, F.lane); }
            titem_store(d, v, F.lane);
            if (!more) break;
            d = d2; it = itn;
#pragma unroll
            for (int i = 0; i < 16; ++i) v[i] = v2[i];
        }
    }
}

__device__ __forceinline__ void phase_B(Frame& F, const Args& args) {
    const float* x = args.in[0]; const float* g = args.in[4]; const float* mod = (const float*)(F.ws + OFF_MOD); bf16_t* XN = (bf16_t*)(F.ws + OFF_XN);
    const int gw = F.bid * NWAVES + F.wave, NGW = F.G * NWAVES, lane = F.lane;
    constexpr int RPW = 16;
    for (int item = gw; item < T / RPW; item += NGW) {
        const int row0 = item * RPW, b = row0 / SEQ;
        const float* sh = mod + b * 6144; const float* sc = sh + 1024;
        f32x4 gm[4], sv[4];
#pragma unroll
        for (int j = 0; j < 4; ++j) { const int col = 4 * (lane + 64 * j); const f32x4 gg = *(const f32x4*)(g + col), s1 = *(const f32x4*)(sc + col); sv[j] = *(const f32x4*)(sh + col); gm[j] = gg * (1.0f + s1); }
        f32x4 v[4], nv[4];
#pragma unroll
        for (int j = 0; j < 4; ++j) v[j] = ((const f32x4*)(x + (size_t)row0 * D))[lane + 64 * j];
#pragma unroll 1
        for (int r = 0; r < RPW; ++r) {
            const int row = row0 + r, nrow = (r + 1 < RPW) ? row + 1 : row;
#pragma unroll
            for (int j = 0; j < 4; ++j) nv[j] = ((const f32x4*)(x + (size_t)nrow * D))[lane + 64 * j];
            float ss = 0.f;
#pragma unroll
            for (int j = 0; j < 4; ++j) ss += v[j][0] * v[j][0] + v[j][1] * v[j][1] + v[j][2] * v[j][2] + v[j][3] * v[j][3];
            const float rs = rsqrtf(wave_sum(ss) * (1.0f / D) + EPS);
#pragma unroll
            for (int j = 0; j < 4; ++j) { const int col = 4 * (lane + 64 * j); const f32x4 h = v[j] * rs * gm[j] + sv[j];
                u32x2 o; o.x = pk2(h[0], h[1]); o.y = pk2(h[2], h[3]);
                *(u32x2*)(XN + (size_t)row * D + col) = o; v[j] = nv[j]; }
        }
    }
}

#ifndef SGU_TR
#define SGU_TR 1
#endif
typedef short s16x4 __attribute__((ext_vector_type(4)));
typedef short v4i16_t __attribute__((ext_vector_type(4)));
constexpr int IMG_STRIDE = 1040;
__device__ __forceinline__ float bflo(unsigned w) { return __uint_as_float(w << 16); }
__device__ __forceinline__ float bfhi(unsigned w) { return __uint_as_float(w & 0xffff0000u); }
__device__ __forceinline__ void sgu_block(Frame& F, const Args& args, int blk) {
    const bf16_t* Z = (const bf16_t*)(F.ws + OFF_Z); bf16_t* YMIX = (bf16_t*)(F.ws + OFF_YMIX); const bf16_t* SGUW = (const bf16_t*)(F.ws + OFF_SGUW);
    const float* ln_g = args.in[13]; const float* ln_b = args.in[14]; const float* sgu_b = args.in[16];
    const int lane = F.lane, w = F.wave; const size_t t0 = (size_t)blk * 128;
    {
        u32x4 raw[16];
#pragma unroll
        for (int r = 0; r < 16; ++r) raw[r] = *(const u32x4*)(Z + (t0 + w * 16 + r) * 2048 + 1536 + 8 * lane);
        const f32x4 g0 = *(const f32x4*)(ln_g + 8 * lane), g1 = *(const f32x4*)(ln_g + 8 * lane + 4), b0 = *(const f32x4*)(ln_b + 8 * lane), b1 = *(const f32x4*)(ln_b + 8 * lane + 4);
#pragma unroll
        for (int r = 0; r < 16; ++r) {
            float v[8];
#pragma unroll
            for (int q = 0; q < 4; ++q) { v[2 * q] = bflo(raw[r][q]); v[2 * q + 1] = bfhi(raw[r][q]); }
            float s = 0.f;
#pragma unroll
            for (int q = 0; q < 8; ++q) s += v[q];
            const float mu = wave_sum(s) * (1.0f / 512.0f);
            float s2 = 0.f;
#pragma unroll
            for (int q = 0; q < 8; ++q) { v[q] -= mu; s2 += v[q] * v[q]; }
            const float rstd = rsqrtf(wave_sum(s2) * (1.0f / 512.0f) + EPS);
            u32x4 o;
            o.x = pk2(v[0] * rstd * g0[0] + b0[0], v[1] * rstd * g0[1] + b0[1]); o.y = pk2(v[2] * rstd * g0[2] + b0[2], v[3] * rstd * g0[3] + b0[3]);
            o.z = pk2(v[4] * rstd * g1[0] + b1[0], v[5] * rstd * g1[1] + b1[1]); o.w = pk2(v[6] * rstd * g1[2] + b1[2], v[7] * rstd * g1[3] + b1[3]);
            *(LAS u32x4*)(F.lds + (w * 16 + r) * IMG_STRIDE + 16 * lane) = o;
        }
    }
    __syncthreads();
    {
        const int g = w;
        int fr = lane & 15, fq = lane >> 4; asm volatile("" : "+v"(fr), "+v"(fq));
        bf16x8 af[4][4];
#pragma unroll
        for (int kt = 0; kt < 4; ++kt)
#pragma unroll
            for (int ct = 0; ct < 4; ++ct) {
#if SGU_TR
                LAS unsigned char* p = F.lds + (32 * kt + 8 * fq + (fr >> 2)) * IMG_STRIDE + (g * 64 + 32 * (ct >> 1) + 8 * (fr & 3) + 4 * (ct & 1)) * 2;
                const s16x4 lo = __builtin_bit_cast(s16x4, __builtin_amdgcn_ds_read_tr16_b64_v4i16((LAS v4i16_t*)p));
                const s16x4 hi = __builtin_bit_cast(s16x4, __builtin_amdgcn_ds_read_tr16_b64_v4i16((LAS v4i16_t*)(p + 4 * IMG_STRIDE)));
                af[kt][ct] = (bf16x8){lo[0], lo[1], lo[2], lo[3], hi[0], hi[1], hi[2], hi[3]};
#else
                const LAS bf16_t* p = (const LAS bf16_t*)(F.lds + (32 * kt + 8 * fq) * IMG_STRIDE) + g * 64 + 16 * (fr >> 2) + 4 * ct + (fr & 3);
#pragma unroll
                for (int e = 0; e < 8; ++e) af[kt][ct][e] = (short)p[e * (IMG_STRIDE / 2)];
#endif
            }
        bf16x8 wf[4], nwf[4]; u32x4 gu0, gu1, ngu0, ngu1; float bias, nbias;
        { const bf16_t* wp = SGUW + ((size_t)(g * 128 + fr)) * 128 + 8 * fq;
#pragma unroll
          for (int kt = 0; kt < 4; ++kt) wf[kt] = *(const bf16x8*)(wp + 32 * kt);
          const size_t t = t0 + fr; gu0 = *(const u32x4*)(Z + t * 2048 + 1024 + g * 64 + 8 * fq); gu1 = *(const u32x4*)(Z + t * 2048 + 1024 + g * 64 + 32 + 8 * fq); bias = sgu_b[g * 128 + fr]; }
#pragma unroll 1
        for (int it = 0; it < 8; ++it) {
            const int i0 = 16 * it, in0 = it < 7 ? i0 + 16 : i0;
            { const bf16_t* wp = SGUW + ((size_t)(g * 128 + in0 + fr)) * 128 + 8 * fq;
#pragma unroll
              for (int kt = 0; kt < 4; ++kt) nwf[kt] = *(const bf16x8*)(wp + 32 * kt);
              const size_t tn = t0 + in0 + fr; ngu0 = *(const u32x4*)(Z + tn * 2048 + 1024 + g * 64 + 8 * fq); ngu1 = *(const u32x4*)(Z + tn * 2048 + 1024 + g * 64 + 32 + 8 * fq); nbias = sgu_b[g * 128 + in0 + fr]; }
            f32x4 acc[4];
#pragma unroll
            for (int ct = 0; ct < 4; ++ct) acc[ct] = (f32x4){0.f, 0.f, 0.f, 0.f};
#pragma unroll
            for (int kt = 0; kt < 4; ++kt)
#pragma unroll
                for (int ct = 0; ct < 4; ++ct) acc[ct] = __builtin_amdgcn_mfma_f32_16x16x32_bf16(af[kt][ct], wf[kt], acc[ct], 0, 0, 0);
            const size_t t = t0 + i0 + fr;
            u32x4 o0, o1;
            o0.x = pk2(bflo(gu0.x) * (acc[0][0] + bias), bfhi(gu0.x) * (acc[0][1] + bias)); o0.y = pk2(bflo(gu0.y) * (acc[0][2] + bias), bfhi(gu0.y) * (acc[0][3] + bias));
            o0.z = pk2(bflo(gu0.z) * (acc[1][0] + bias), bfhi(gu0.z) * (acc[1][1] + bias)); o0.w = pk2(bflo(gu0.w) * (acc[1][2] + bias), bfhi(gu0.w) * (acc[1][3] + bias));
            o1.x = pk2(bflo(gu1.x) * (acc[2][0] + bias), bfhi(gu1.x) * (acc[2][1] + bias)); o1.y = pk2(bflo(gu1.y) * (acc[2][2] + bias), bfhi(gu1.y) * (acc[2][3] + bias));
            o1.z = pk2(bflo(gu1.z) * (acc[3][0] + bias), bfhi(gu1.z) * (acc[3][1] + bias)); o1.w = pk2(bflo(gu1.w) * (acc[3][2] + bias), bfhi(gu1.w) * (acc[3][3] + bias));
            *(u32x4*)(YMIX + t * D + 512 + g * 64 + 8 * fq) = o0; *(u32x4*)(YMIX + t * D + 512 + g * 64 + 32 + 8 * fq) = o1;
#pragma unroll
            for (int kt = 0; kt < 4; ++kt) wf[kt] = nwf[kt];
            gu0 = ngu0; gu1 = ngu1; bias = nbias;
        }
    }
}

constexpr int XC_STRIDE = 144;
constexpr int AU_STRIDE = 68;
constexpr int LRU_WAVE_BYTES = 64 * XC_STRIDE + 2 * 16 * AU_STRIDE * 4;
__device__ __forceinline__ float sigm_fast(float x) { return __builtin_amdgcn_rcpf(1.0f + __builtin_amdgcn_exp2f(-1.4426950408889634f * x)); }
template <int PASS>
__device__ __forceinline__ void lru_block(Frame& F, const Args& args, int blk) {
    const bf16_t* Z = (const bf16_t*)(F.ws + OFF_Z); bf16_t* YMIX = (bf16_t*)(F.ws + OFF_YMIX); const bf16_t* GATEW = (const bf16_t*)(F.ws + OFF_GATEW);
    const float* N8SP = (const float*)(F.ws + OFF_N8SP); float* CA = (float*)(F.ws + OFF_CARRY); float* CH = CA + 256 * 512;
    const float* cw = args.in[6]; const float* cb = args.in[7]; const float* gab = (const float*)(F.ws + OFF_GBIAS); const float* gib = gab + 512;
    const int lane = F.lane, h = F.wave, fr = lane & 15, fq = lane >> 4, cg = lane & 7, run = lane >> 3; const size_t t0 = (size_t)blk * 128;
    LAS unsigned char* xcT = F.lds + h * LRU_WAVE_BYTES; LAS float* Abuf = (LAS float*)(xcT + 64 * XC_STRIDE); LAS float* Ubuf = Abuf + 16 * AU_STRIDE;
    float hst = 0.f, pp = 1.f;
    if (PASS == 2) { const int b0 = blk & ~31, n = blk & 31;
        float ca[31], ch[31];
#pragma unroll
        for (int k = 0; k < 31; ++k) { const int kk = k < n ? k : 0; ca[k] = CA[(size_t)(b0 + kk) * 512 + 64 * h + lane]; ch[k] = CH[(size_t)(b0 + kk) * 512 + 64 * h + lane]; }
#pragma unroll
        for (int k = 0; k < 31; ++k) hst = k < n ? ca[k] * hst + ch[k] : hst; }
    bf16x8 gw[8][2];
#pragma unroll
    for (int et = 0; et < 8; ++et)
#pragma unroll
        for (int kt = 0; kt < 2; ++kt) gw[et][kt] = *(const bf16x8*)(GATEW + ((size_t)(h * 128 + 16 * et + fr)) * 64 + 32 * kt + 8 * fq);
    const bool seq_start = (blk & 31) == 0;
#pragma unroll 1
    for (int hb = 0; hb < 2; ++hb) {
        const size_t tb = t0 + 64 * hb;
        {
            float cwv[4][8], cbv[8];
#pragma unroll
            for (int k = 0; k < 4; ++k) { const f32x4 a = *(const f32x4*)(cw + k * 512 + 64 * h + 8 * cg), b = *(const f32x4*)(cw + k * 512 + 64 * h + 8 * cg + 4);
#pragma unroll
                for (int q = 0; q < 4; ++q) { cwv[k][q] = a[q]; cwv[k][4 + q] = b[q]; } }
            { const f32x4 a = *(const f32x4*)(cb + 64 * h + 8 * cg), b = *(const f32x4*)(cb + 64 * h + 8 * cg + 4);
#pragma unroll
              for (int q = 0; q < 4; ++q) { cbv[q] = a[q]; cbv[4 + q] = b[q]; } }
            u32x4 xr[11];
#pragma unroll
            for (int j = 0; j < 11; ++j) { const int rel = 8 * run - 3 + j;
                const bool pad = (j < 3) && (rel < 0) && (hb == 0) && seq_start;
                const u32x4 v = *(const u32x4*)(Z + (size_t)((long)tb + (pad ? 0 : rel)) * 2048 + 64 * h + 8 * cg);
                xr[j] = pad ? (u32x4){0u, 0u, 0u, 0u} : v; }
#pragma unroll
            for (int s = 0; s < 8; ++s) { float o[8];
#pragma unroll
                for (int q = 0; q < 8; ++q) o[q] = cbv[q];
#pragma unroll
                for (int k = 0; k < 4; ++k) { const u32x4 r = xr[s + k];
#pragma unroll
                    for (int q = 0; q < 4; ++q) { o[2 * q] += cwv[k][2 * q] * bflo(r[q]); o[2 * q + 1] += cwv[k][2 * q + 1] * bfhi(r[q]); } }
                u32x4 pkd; pkd.x = pk2(o[0], o[1]); pkd.y = pk2(o[2], o[3]); pkd.z = pk2(o[4], o[5]); pkd.w = pk2(o[6], o[7]);
                *(LAS u32x4*)(xcT + (8 * run + s) * XC_STRIDE + 16 * cg) = pkd; }
        }
        WAVE_SYNC();
        u32x4 g0 = {0u, 0u, 0u, 0u}, g1 = g0, ng0 = g0, ng1 = g0;
        if (PASS == 2) { const size_t t = tb + (lane >> 2); g0 = *(const u32x4*)(Z + t * 2048 + 512 + 64 * h + 8 * (lane & 3)); g1 = *(const u32x4*)(Z + t * 2048 + 512 + 64 * h + 32 + 8 * (lane & 3)); }
#pragma unroll 1
        for (int it = 0; it < 4; ++it) {
            if (PASS == 2) { const size_t t = tb + 16 * (it < 3 ? it + 1 : it) + (lane >> 2); ng0 = *(const u32x4*)(Z + t * 2048 + 512 + 64 * h + 8 * (lane & 3)); ng1 = *(const u32x4*)(Z + t * 2048 + 512 + 64 * h + 32 + 8 * (lane & 3)); }
            bf16x8 xf[2];
#pragma unroll
            for (int kt = 0; kt < 2; ++kt) xf[kt] = *(const LAS bf16x8*)(xcT + (16 * it + fr) * XC_STRIDE + (32 * kt + 8 * fq) * 2);
            int fqv = fq; asm volatile("" : "+v"(fqv));
            f32x4 acc[8];
#pragma unroll
            for (int et = 0; et < 4; ++et) { acc[et] = *(const f32x4*)(gab + 64 * h + 16 * et + 4 * fqv); acc[4 + et] = *(const f32x4*)(gib + 64 * h + 16 * et + 4 * fqv); }
#pragma unroll
            for (int et = 0; et < 8; ++et)
#pragma unroll
                for (int kt = 0; kt < 2; ++kt) acc[et] = __builtin_amdgcn_mfma_f32_16x16x32_bf16(gw[et][kt], xf[kt], acc[et], 0, 0, 0);
#pragma unroll
            for (int et = 0; et < 4; ++et) {
                const f32x4 sp = *(const f32x4*)(N8SP + 64 * h + 16 * et + 4 * fqv);
                const u32x2 xw = *(const LAS u32x2*)(xcT + (16 * it + fr) * XC_STRIDE + (16 * et + 4 * fq) * 2);
                const float xv[4] = {bflo(xw.x), bfhi(xw.x), bflo(xw.y), bfhi(xw.y)};
                f32x4 av, uv;
#pragma unroll
                for (int r = 0; r < 4; ++r) {
                    const float rg = __builtin_amdgcn_rcpf(1.0f + __builtin_amdgcn_exp2f(acc[et][r])), ig = __builtin_amdgcn_rcpf(1.0f + __builtin_amdgcn_exp2f(acc[4 + et][r]));
                    const float a = __builtin_amdgcn_exp2f(rg * sp[r]);
                    av[r] = a;
                    uv[r] = __builtin_amdgcn_sqrtf(__builtin_fmaf(-a, a, 1.0f)) * (ig * xv[r]);
                }
                *(LAS f32x4*)(Abuf + fr * AU_STRIDE + 16 * et + 4 * fq) = av; *(LAS f32x4*)(Ubuf + fr * AU_STRIDE + 16 * et + 4 * fq) = uv;
            }
            WAVE_SYNC();
            {
                float a[16], u[16];
#pragma unroll
                for (int tk = 0; tk < 16; ++tk) { a[tk] = Abuf[tk * AU_STRIDE + lane]; u[tk] = Ubuf[tk * AU_STRIDE + lane]; }
#pragma unroll
                for (int tk = 0; tk < 16; ++tk) { hst = a[tk] * hst + u[tk]; if (PASS == 1) pp *= a[tk]; else Ubuf[tk * AU_STRIDE + lane] = hst; }
            }
            if (PASS == 2) {
                WAVE_SYNC();
                const int tok = lane >> 2, cq = lane & 3; const size_t t = tb + 16 * it + tok;
                const LAS float* hp = Ubuf + tok * AU_STRIDE + 8 * cq;
                const f32x4 h0 = *(const LAS f32x4*)(hp), h1 = *(const LAS f32x4*)(hp + 4), h2 = *(const LAS f32x4*)(hp + 32), h3 = *(const LAS f32x4*)(hp + 36);
                u32x4 o0, o1;
                o0.x = pk2(h0[0] * bflo(g0.x), h0[1] * bfhi(g0.x)); o0.y = pk2(h0[2] * bflo(g0.y), h0[3] * bfhi(g0.y));
                o0.z = pk2(h1[0] * bflo(g0.z), h1[1] * bfhi(g0.z)); o0.w = pk2(h1[2] * bflo(g0.w), h1[3] * bfhi(g0.w));
                o1.x = pk2(h2[0] * bflo(g1.x), h2[1] * bfhi(g1.x)); o1.y = pk2(h2[2] * bflo(g1.y), h2[3] * bfhi(g1.y));
                o1.z = pk2(h3[0] * bflo(g1.z), h3[1] * bfhi(g1.z)); o1.w = pk2(h3[2] * bflo(g1.w), h3[3] * bfhi(g1.w));
                *(u32x4*)(YMIX + t * D + 64 * h + 8 * cq) = o0; *(u32x4*)(YMIX + t * D + 64 * h + 32 + 8 * cq) = o1;
                g0 = ng0; g1 = ng1;
            }
            WAVE_SYNC();
        }
    }
    if (PASS == 1) { CA[(size_t)blk * 512 + 64 * h + lane] = pp; CH[(size_t)blk * 512 + 64 * h + lane] = hst; }
}

constexpr int HT_STRIDE = 2064;
constexpr int RG_W_OFF = 0, RG_H_OFF = 36 * HT_STRIDE, RG_LOG_OFF = RG_H_OFF + 32 * HT_STRIDE, RG_MISC_OFF = RG_LOG_OFF + 32 * 48 * 4;
static_assert(RG_MISC_OFF + 256 <= SCR_BYTES, "phase G LDS map");
__device__ __forceinline__ void phase_G(Frame& F, const Args& args) {
    const bf16_t* X1 = (const bf16_t*)(F.ws + OFF_X1); bf16_t* H2 = (bf16_t*)(F.ws + OFF_XN); const bf16_t* ROUTW = (const bf16_t*)(F.ws + OFF_ROUTW);
    const float* mod = (const float*)(F.ws + OFF_MOD); const float* g2w = args.in[18]; const float* bg = args.in[20]; const float* be = args.in[22];
    int* list = (int*)(F.ws + OFF_LIST); int* toke = (int*)(F.ws + OFF_TOKE); float* tokw = (float*)(F.ws + OFF_TOKW); int* tokp = (int*)(F.ws + OFF_TOKP);
    const int lane = F.lane, w = F.wave, fr = lane & 15, fq = lane >> 4;
    LAS float* LG = (LAS float*)(F.lds + RG_LOG_OFF); LAS int* hist = (LAS int*)(F.lds + RG_MISC_OFF); LAS int* base = hist + 32;
    __syncthreads();
    for (int i = F.tid; i < 36 * 128; i += NTHREADS) { const int r = i >> 7, c = i & 127; *(LAS u32x4*)(F.lds + RG_W_OFF + r * HT_STRIDE + c * 16) = *(const u32x4*)(ROUTW + (size_t)r * 1024 + c * 8); }
    for (int grp = F.bid; grp < T / 128; grp += F.G) {
        const int grow0 = grp * 128, b = grow0 / SEQ;
        const float* sh = mod + b * 6144 + 3072; const float* sc = sh + 1024;
        float gm[16], sv[16];
#pragma unroll
        for (int jj = 0; jj < 2; ++jj)
#pragma unroll
            for (int q = 0; q < 8; ++q) { const int c = 512 * jj + 8 * lane + q; gm[8 * jj + q] = g2w[c] * (1.0f + sc[c]); sv[8 * jj + q] = sh[c]; }
        if (F.tid < 32) hist[F.tid] = 0;
        u32x4 raw[4][2];
#pragma unroll
        for (int r = 0; r < 4; ++r)
#pragma unroll
            for (int jj = 0; jj < 2; ++jj) raw[r][jj] = *(const u32x4*)(X1 + (size_t)(grow0 + 4 * w + r) * D + 512 * jj + 8 * lane);
        int e1 = 0, e2 = 0, l1 = 0, l2 = 0; float w1 = 0.f, w2 = 0.f;
#pragma unroll 1
        for (int ti = 0; ti < 4; ++ti) {
            const int row0 = grow0 + 32 * ti;
#pragma unroll
            for (int r = 0; r < 4; ++r) {
                float h[16]; float ss = 0.f;
#pragma unroll
                for (int jj = 0; jj < 2; ++jj)
#pragma unroll
                    for (int q = 0; q < 4; ++q) { h[8 * jj + 2 * q] = bflo(raw[r][jj][q]); h[8 * jj + 2 * q + 1] = bfhi(raw[r][jj][q]); }
#pragma unroll
                for (int q = 0; q < 16; ++q) ss += h[q] * h[q];
                const float rs = rsqrtf(wave_sum(ss) * (1.0f / D) + EPS);
#pragma unroll
                for (int jj = 0; jj < 2; ++jj) { u32x4 o; float hv[8];
#pragma unroll
                    for (int q = 0; q < 8; ++q) hv[q] = h[8 * jj + q] * rs * gm[8 * jj + q] + sv[8 * jj + q];
#pragma unroll
                    for (int q = 0; q < 4; ++q) o[q] = pk2(hv[2 * q], hv[2 * q + 1]);
#if MOE_FP8
                    { u32x2 f; f.x = pg8::pk4_fp8(hv[0], hv[1], hv[2], hv[3]); f.y = pg8::pk4_fp8(hv[4], hv[5], hv[6], hv[7]);
                      *(u32x2*)((unsigned char*)H2 + (size_t)(row0 + 4 * w + r) * D + 512 * jj + 8 * lane) = f; }
#else
                    *(u32x4*)(H2 + (size_t)(row0 + 4 * w + r) * D + 512 * jj + 8 * lane) = o;
#endif
                    *(LAS u32x4*)(F.lds + RG_H_OFF + (4 * w + r) * HT_STRIDE + (512 * jj + 8 * lane) * 2) = o; }
            }
            if (ti < 3) {
#pragma unroll
                for (int r = 0; r < 4; ++r)
#pragma unroll
                    for (int jj = 0; jj < 2; ++jj) raw[r][jj] = *(const u32x4*)(X1 + (size_t)(row0 + 32 + 4 * w + r) * D + 512 * jj + 8 * lane);
            }
            __syncthreads();
            if (w < 6) {
                const int rt = w / 3, ct = w % 3; int wrow = 16 * ct + fr; wrow = wrow < 36 ? wrow : 35;
                const LAS unsigned char* hp = F.lds + RG_H_OFF + (16 * rt + fr) * HT_STRIDE + 16 * fq; const LAS unsigned char* wp = F.lds + RG_W_OFF + wrow * HT_STRIDE + 16 * fq;
                f32x4 acc0 = {0.f, 0.f, 0.f, 0.f}, acc1 = {0.f, 0.f, 0.f, 0.f};
#pragma unroll 8
                for (int kt = 0; kt < 32; kt += 2) {
                    acc0 = __builtin_amdgcn_mfma_f32_16x16x32_bf16(*(const LAS bf16x8*)(wp + 64 * kt), *(const LAS bf16x8*)(hp + 64 * kt), acc0, 0, 0, 0);
                    acc1 = __builtin_amdgcn_mfma_f32_16x16x32_bf16(*(const LAS bf16x8*)(wp + 64 * kt + 64), *(const LAS bf16x8*)(hp + 64 * kt + 64), acc1, 0, 0, 0); }
                *(LAS f32x4*)(LG + (16 * rt + fr) * 48 + 16 * ct + 4 * fq) = acc0 + acc1;
            }
            __syncthreads();
            if ((F.tid >> 5) == ti) {
                const LAS float* L = LG + (F.tid & 31) * 48;
                float gl[4], el[8];
#pragma unroll
                for (int j = 0; j < 4; ++j) gl[j] = L[j] + bg[j];
                int gs = 0; float gmax = gl[0];
#pragma unroll
                for (int j = 1; j < 4; ++j) if (gl[j] > gmax) { gmax = gl[j]; gs = j; }
#pragma unroll
                for (int j = 0; j < 8; ++j) el[j] = L[4 + gs * 8 + j] + be[gs * 8 + j];
                float gsum = 0.f;
#pragma unroll
                for (int j = 0; j < 4; ++j) gsum += __expf(gl[j] - gmax);
                const float pg = 1.0f / gsum;
                int i1 = 0; float m1 = el[0];
#pragma unroll
                for (int j = 1; j < 8; ++j) if (el[j] > m1) { m1 = el[j]; i1 = j; }
                int i2 = -1; float m2 = -INFINITY;
#pragma unroll
                for (int j = 0; j < 8; ++j) if (j != i1 && el[j] > m2) { m2 = el[j]; i2 = j; }
                const float r = __expf(m2 - m1);
                w1 = pg / (1.0f + r); w2 = pg * r / (1.0f + r); e1 = gs * 8 + i1; e2 = gs * 8 + i2;
                l1 = __hip_atomic_fetch_add(hist + e1, 1, __ATOMIC_RELAXED, __HIP_MEMORY_SCOPE_WORKGROUP);
                l2 = __hip_atomic_fetch_add(hist + e2, 1, __ATOMIC_RELAXED, __HIP_MEMORY_SCOPE_WORKGROUP);
            }
        }
        __syncthreads();
        if (F.tid < 32) { const int n = hist[F.tid]; base[F.tid] = n ? (int)__hip_atomic_fetch_add(F.ctl + CW_CNT + CNT_STRIDE * F.tid, (unsigned)n, __ATOMIC_RELAXED, __HIP_MEMORY_SCOPE_AGENT) : 0; }
        __syncthreads();
        if (F.tid < 128) { const int row = grow0 + F.tid, p1 = base[e1] + l1, p2 = base[e2] + l2;
            list[(size_t)e1 * LISTCAP + p1] = row; list[(size_t)e2 * LISTCAP + p2] = row;
            toke[2 * row] = e1; toke[2 * row + 1] = e2; tokw[2 * row] = w1; tokw[2 * row + 1] = w2; tokp[2 * row] = p1; tokp[2 * row + 1] = p2; }
        __syncthreads();
    }
}

__device__ __forceinline__ void phase_J(Frame& F, const Args& args) {
    const bf16_t* X1 = (const bf16_t*)(F.ws + OFF_X1); const bf16_t* Y = (const bf16_t*)(F.ws + OFF_Y); const float* mod = (const float*)(F.ws + OFF_MOD);
    const int* toke = (const int*)(F.ws + OFF_TOKE); const float* tokw = (const float*)(F.ws + OFF_TOKW); const int* tokp = (const int*)(F.ws + OFF_TOKP);
    const float* fg = args.in[26]; float* out = args.out;
    const int gw = F.bid * NWAVES + F.wave, NGW = F.G * NWAVES, lane = F.lane;
    constexpr int RPW = 16;
    for (int item = gw; item < T / RPW; item += NGW) {
        const int row0 = item * RPW, b = row0 / SEQ;
        int q0l = 0, q1l = 0; float w0l = 0.f, w1l = 0.f;
        { const int rr = row0 + (lane & 15); const int e0 = toke[2 * rr], e1 = toke[2 * rr + 1];
          q0l = F.tab[TAB_P0 + e0] * 256 + tokp[2 * rr]; q1l = F.tab[TAB_P0 + e1] * 256 + tokp[2 * rr + 1]; w0l = tokw[2 * rr]; w1l = tokw[2 * rr + 1]; }
        const float* g2 = mod + b * 6144 + 5120;
        f32x4 g2v[4], fgv[4];
#pragma unroll
        for (int jj = 0; jj < 2; ++jj)
#pragma unroll
            for (int hh = 0; hh < 2; ++hh) { const int c = 512 * jj + 8 * lane + 4 * hh; g2v[2 * jj + hh] = *(const f32x4*)(g2 + c); fgv[2 * jj + hh] = *(const f32x4*)(fg + c); }
#if MOE_FP8
        typedef u32x2 yvec; const unsigned char* Yb = (const unsigned char*)Y;
#define YLOAD(q_, c0_) (*(const u32x2*)(Yb + (q_) * D + (c0_)))
#define YUNPACK(v_, o_) do { const auto a0_ = __builtin_amdgcn_cvt_pk_f32_fp8((v_).x, false), a1_ = __builtin_amdgcn_cvt_pk_f32_fp8((v_).x, true), a2_ = __builtin_amdgcn_cvt_pk_f32_fp8((v_).y, false), a3_ = __builtin_amdgcn_cvt_pk_f32_fp8((v_).y, true); \
        o_[0] = a0_[0]; o_[1] = a0_[1]; o_[2] = a1_[0]; o_[3] = a1_[1]; o_[4] = a2_[0]; o_[5] = a2_[1]; o_[6] = a3_[0]; o_[7] = a3_[1]; } while (0)
        constexpr float YINV = 1.0f / Y_SCALE;
#else
        typedef u32x4 yvec;
#define YLOAD(q_, c0_) (*(const u32x4*)(Y + (q_) * D + (c0_)))
#define YUNPACK(v_, o_) do { _Pragma("unroll") for (int q_ = 0; q_ < 4; ++q_) { o_[2 * q_] = bflo((v_)[q_]); o_[2 * q_ + 1] = bfhi((v_)[q_]); } } while (0)
        constexpr float YINV = 1.0f;
#endif
        u32x4 xr[2], nxr[2]; yvec ya[2], yb[2], nya[2], nyb[2];
        { const size_t q0 = (size_t)__shfl(q0l, 0), q1 = (size_t)__shfl(q1l, 0);
#pragma unroll
          for (int jj = 0; jj < 2; ++jj) { const int c0 = 512 * jj + 8 * lane; xr[jj] = *(const u32x4*)(X1 + (size_t)row0 * D + c0); ya[jj] = YLOAD(q0, c0); yb[jj] = YLOAD(q1, c0); } }
#pragma unroll 1
        for (int r = 0; r < RPW; ++r) {
            const int row = row0 + r, rn = (r + 1 < RPW) ? r + 1 : r;
            { const size_t q0 = (size_t)__shfl(q0l, rn), q1 = (size_t)__shfl(q1l, rn);
#pragma unroll
              for (int jj = 0; jj < 2; ++jj) { const int c0 = 512 * jj + 8 * lane; nxr[jj] = *(const u32x4*)(X1 + (size_t)(row0 + rn) * D + c0); nya[jj] = YLOAD(q0, c0); nyb[jj] = YLOAD(q1, c0); } }
            const float w0 = __shfl(w0l, r), w1 = __shfl(w1l, r);
            float v[16]; float ss = 0.f;
#pragma unroll
            for (int jj = 0; jj < 2; ++jj) { float yav[8], ybv[8]; YUNPACK(ya[jj], yav); YUNPACK(yb[jj], ybv);
#pragma unroll
                for (int q = 0; q < 4; ++q) {
                    const float y0 = (w0 * yav[2 * q] + w1 * ybv[2 * q]) * YINV, y1 = (w0 * yav[2 * q + 1] + w1 * ybv[2 * q + 1]) * YINV;
                    const f32x4 gg = g2v[2 * jj + (q >> 1)];
                    v[8 * jj + 2 * q] = bflo(xr[jj][q]) + gg[(2 * q) & 3] * y0; v[8 * jj + 2 * q + 1] = bfhi(xr[jj][q]) + gg[(2 * q + 1) & 3] * y1; } }
#pragma unroll
            for (int q = 0; q < 16; ++q) ss += v[q] * v[q];
            const float rs = rsqrtf(wave_sum(ss) * (1.0f / D) + EPS);
#pragma unroll
            for (int jj = 0; jj < 2; ++jj) { const int c0 = 512 * jj + 8 * lane;
                f32x4 o0, o1;
#pragma unroll
                for (int q = 0; q < 4; ++q) { o0[q] = v[8 * jj + q] * rs * fgv[2 * jj][q]; o1[q] = v[8 * jj + 4 + q] * rs * fgv[2 * jj + 1][q]; }
                *(f32x4*)(out + (size_t)row * D + c0) = o0; *(f32x4*)(out + (size_t)row * D + c0 + 4) = o1;
                xr[jj] = nxr[jj]; ya[jj] = nya[jj]; yb[jj] = nyb[jj]; }
        }
    }
#undef YLOAD
#undef YUNPACK
}

__global__ void __launch_bounds__(NTHREADS, 2) mk(Args args) {
    extern __shared__ __attribute__((aligned(16))) unsigned char lds_raw[];
    Frame F;
    F.lds = (LAS unsigned char*)lds_raw; F.tab = (LAS int*)(F.lds + TAB_OFF);
    F.tid = threadIdx.x; F.lane = F.tid & 63; F.wave = __builtin_amdgcn_readfirstlane(F.tid >> 6);
    F.G = gridDim.x; F.bid = blockIdx.x; F.vcu = (F.G % 8 == 0) ? (F.bid % 8) * (F.G / 8) + F.bid / 8 : F.bid;
    F.ws = args.ws; F.ctl = (unsigned*)(args.ws + OFF_CTL);
    unsigned char* ws = args.ws;
    bf16_t* WIN = (bf16_t*)(ws + OFF_WIN); bf16_t* WOUT = (bf16_t*)(ws + OFF_WOUT); bf16_t* W13 = (bf16_t*)(ws + OFF_W13); bf16_t* W2 = (bf16_t*)(ws + OFF_W2);
    bf16_t* XN = (bf16_t*)(ws + OFF_XN); bf16_t* Z = (bf16_t*)(ws + OFF_Z); bf16_t* YMIX = (bf16_t*)(ws + OFF_YMIX); bf16_t* X1 = (bf16_t*)(ws + OFF_X1);
    bf16_t* ACT = (bf16_t*)(ws + OFF_ACT); bf16_t* Y = (bf16_t*)(ws + OFF_Y); bf16_t* H2 = XN;
    const float* mod = (const float*)(ws + OFF_MOD); const int* list = (const int*)(ws + OFF_LIST);
    const int lo = args.ph_lo, hi = args.ph_hi;
    for (int u = F.tid; u < (LDS_BYTES - LDSCTL_OFF) / 4; u += NTHREADS) ((LAS unsigned*)(F.lds + LDSCTL_OFF))[u] = 0u;
    __syncthreads();
    XcdBarrier bar; bar.bar = F.ctl + CW_BAR; bar.x = 0; bar.st = nullptr;
    if (hi - lo > 1) bar = xcd_barrier_post(F.ctl + CW_BAR, (volatile LAS unsigned*)(F.lds + LDSCTL_OFF) + 8);
#ifndef PHMASK
#define PHMASK 0x3ff
#endif
#define IN(k) (((PHMASK >> (k)) & 1) && lo <= (k) && (k) < hi)
#ifdef PROBE_SPAN
#define STAMP(i) do { if (F.bid == 0 && F.tid == 0) { const unsigned long long t_ = __builtin_amdgcn_s_memrealtime(); LAS unsigned* st_ = (LAS unsigned*)(F.lds + LDSCTL_OFF) + 32 + 2 * (i); st_[0] = (unsigned)t_; st_[1] = (unsigned)(t_ >> 32); } } while (0)
#else
#define STAMP(i) do { } while (0)
#endif
#define SEAM(k) do { if (IN(k) && IN((k) + 1)) xcd_barrier(bar); STAMP((k) + 1); } while (0)

    STAMP(0);
    if (IN(PH_A)) phase_A(F, args);
    SEAM(PH_A);
    if (IN(PH_B)) phase_B(F, args);
    SEAM(PH_B);
    if (IN(PH_C)) {
        pg8::Gemm g{XN, WIN, 2048}; pg8::EpiZ E{Z};
        if (F.G == 256) {
            constexpr int NCONV = 64, UPA = 5;
            constexpr int CSHARE = (256 - NCONV) * NWAVES * CONV_PRE;
            const bool conv = F.bid >= 256 - NCONV;
            if (conv) convert_experts(F, args, (F.bid - (256 - NCONV)) * NWAVES + F.wave, NCONV * NWAVES, CSHARE, TI_EXP - CSHARE);
            else if (CONV_PRE > 0) convert_experts(F, args, F.bid * NWAVES + F.wave, (256 - NCONV) * NWAVES, 0, CSHARE);
            __syncthreads();
            pg8::SplitOrder S; S.tokt = F.lds; S.init2(T, 2048, 2048, 256 - NCONV, NCONV, UPA, conv ? 1 : 0, conv ? F.bid - (256 - NCONV) : F.bid);
            pg8::gemm_phase<pg8::EpiZ, pg8::SplitOrder, true, false, false>(F.lds, g, S, E);
        } else {
            pg8::StaticOrder S; S.tokt = F.lds; S.init(T, 2048, 2048, F.G, F.bid);
            pg8::gemm_phase<pg8::EpiZ, pg8::StaticOrder, true, false, false>(F.lds, g, S, E);
        }
    }
    SEAM(PH_C);
    if (IN(PH_D)) { for (int blk = F.bid; blk < T / 128; blk += F.G) { __syncthreads(); sgu_block(F, args, blk); __syncthreads(); lru_block<1>(F, args, blk); } }
    SEAM(PH_D);
    if (IN(PH_E)) { for (int blk = F.bid; blk < T / 128; blk += F.G) { __syncthreads(); lru_block<2>(F, args, blk); } }
    SEAM(PH_E);
    if (IN(PH_F)) {
        __syncthreads();
        pg8::Gemm g{YMIX, WOUT, 2048}; pg8::StaticOrder S; S.tokt = F.lds; S.init(T, 1024, 2048, F.G, F.bid);
        pg8::EpiX1 E{args.in[0], mod, X1};
        pg8::gemm_phase<pg8::EpiX1, pg8::StaticOrder, true, false, false>(F.lds, g, S, E);
    }
    SEAM(PH_F);
    if (IN(PH_G)) phase_G(F, args);
    SEAM(PH_G);
    if (IN(PH_H)) {
        build_moe_table(F);
        pg8::MoeOrder S; S.nunits = F.tab[TAB_P0 + NE] * 4; S.G = F.G; S.c = F.vcu;
        S.tile_e = F.tab + TAB_TE; S.p0 = F.tab + TAB_P0; S.cnt = F.tab + TAB_CNT; S.list = list; S.gather = true; S.tokt = F.lds + TOKT_OFF;
#if MOE_FP8
        S.Kb = 1024; S.estride = (size_t)1024 * 1024;
        pg8::Gemm g{H2, W13, 1024}; pg8::EpiAct8 E{(unsigned char*)ACT, 1.0f / W13_SCALE, ACT_SCALE};
        pg8::gemm_phase<pg8::EpiAct8, pg8::MoeOrder, true, true, true>(F.lds, g, S, E);
#else
        S.Kb = 2048; S.estride = (size_t)1024 * 1024 * 2;
        pg8::Gemm g{H2, W13, 2048}; pg8::EpiAct E{ACT};
        pg8::gemm_phase<pg8::EpiAct, pg8::MoeOrder, true, true, false>(F.lds, g, S, E);
#endif
    }
    SEAM(PH_H);
    if (IN(PH_I)) {
        build_moe_table(F);
        pg8::MoeOrder S; S.nunits = F.tab[TAB_P0 + NE] * 4; S.G = F.G; S.c = F.vcu;
        S.tile_e = F.tab + TAB_TE; S.p0 = F.tab + TAB_P0; S.cnt = F.tab + TAB_CNT; S.list = list; S.gather = false; S.tokt = F.lds + TOKT_OFF;
#if MOE_FP8
        S.Kb = 512; S.estride = (size_t)1024 * 512;
        pg8::Gemm g{ACT, W2, 512}; pg8::EpiY8 E{(unsigned char*)Y, Y_SCALE / (W2_SCALE * ACT_SCALE)};
        pg8::gemm_phase<pg8::EpiY8, pg8::MoeOrder, true, false, true>(F.lds, g, S, E);
#else
        S.Kb = 1024; S.estride = (size_t)1024 * 512 * 2;
        pg8::Gemm g{ACT, W2, 1024}; pg8::EpiY E{Y};
        pg8::gemm_phase<pg8::EpiY, pg8::MoeOrder, true, false, false>(F.lds, g, S, E);
#endif
    }
    SEAM(PH_I);
    if (IN(PH_J)) { build_moe_table(F); phase_J(F, args); }
#ifdef PROBE_SPAN
    STAMP(PH_N);
    if (F.bid == 0 && F.tid == 0) { LAS unsigned* st_ = (LAS unsigned*)(F.lds + LDSCTL_OFF) + 32;
        const unsigned long long a_ = ((unsigned long long)st_[2 * PROBE_SPAN + 1] << 32) | st_[2 * PROBE_SPAN], b_ = ((unsigned long long)st_[2 * PROBE_SPAN + 3] << 32) | st_[2 * PROBE_SPAN + 2];
        const unsigned long long t0_ = __builtin_amdgcn_s_memrealtime(), dt_ = (b_ - a_) * PROBE_MULT;
        while (__builtin_amdgcn_s_memrealtime() - t0_ < dt_) __builtin_amdgcn_s_sleep(8); }
#endif
#undef IN
#undef SEAM
}
#ifndef FUSED
#define FUSED 1
#endif
extern "C" void kernel_launch(void* const* d_in, const int* in_sizes, int n_in, void* d_out, int out_size, void* d_ws, size_t ws_size, hipStream_t stream) {
    if (n_in != 27 || out_size != T * D || ws_size < WS_NEED) { fprintf(stderr, "kernel_launch: unexpected shapes (n_in %d out %d ws %zu)\n", n_in, out_size, ws_size); return; }
    static int grid = 0;
    if (grid == 0) {
        int dev = 0, cus = 0;
        if (hipGetDevice(&dev) != hipSuccess || hipDeviceGetAttribute(&cus, hipDeviceAttributeMultiprocessorCount, dev) != hipSuccess) { fprintf(stderr, "kernel_launch: device query failed\n"); grid = -1; return; }
        if (hipFuncSetAttribute((const void*)mk, hipFuncAttributeMaxDynamicSharedMemorySize, LDS_BYTES) != hipSuccess) { fprintf(stderr, "kernel_launch: hipFuncSetAttribute failed\n"); grid = -1; return; }
        int per_cu = 0;
        if (hipOccupancyMaxActiveBlocksPerMultiprocessor(&per_cu, (const void*)mk, NTHREADS, LDS_BYTES) != hipSuccess || per_cu < 1) fprintf(stderr, "kernel_launch: occupancy query says %d\n", per_cu);
        (void)hipGetLastError();
        grid = cus;
    }
    if (grid < 0) return;
    Args a{}; for (int i = 0; i < 27; ++i) a.in[i] = (const float*)d_in[i]; a.out = (float*)d_out; a.ws = (unsigned char*)d_ws;
#define MK(lo_, hi_) do { a.ph_lo = (lo_); a.ph_hi = (hi_); hipLaunchKernelGGL(mk, dim3(grid), dim3(NTHREADS), LDS_BYTES, stream, a); } while (0)
    (void)hipMemsetAsync((char*)d_ws + OFF_CTL, 0, CTL_BYTES, stream);
#if FUSED
    MK(0, PH_N);
#else
    for (int p = 0; p < PH_N; ++p) MK(p, p + 1);
#endif
}
```

```cpp
#include <hip/hip_runtime.h>
#include <cstdio>
#include <cstdint>

typedef unsigned short bf16_t;
typedef short bf16x8 __attribute__((ext_vector_type(8)));
typedef float f32x4 __attribute__((ext_vector_type(4)));
typedef unsigned u32x2 __attribute__((ext_vector_type(2)));
typedef unsigned u32x4 __attribute__((ext_vector_type(4)));

constexpr int T = 32768, D = 1024, SEQ = 4096, NB = 8;
constexpr int DL = 512;
constexpr int NE = 32, DE = 512;
constexpr int LISTCAP = 65536;
constexpr int MAXTILES = 288, MAXROWS = MAXTILES * 256;
constexpr float EPS = 1e-6f;

constexpr size_t MiB = 1u << 20;
constexpr int ZLD = 2048 + 128;
constexpr size_t OFF_CTL = 0, CTL_BYTES = 48 * 1024;
constexpr size_t OFF_MOD = 1 * MiB;
constexpr size_t OFF_TBL = 1 * MiB + 256 * 1024;
constexpr size_t OFF_TOKE = 1 * MiB + 512 * 1024;
constexpr size_t OFF_TOKW = 1 * MiB + 768 * 1024;
constexpr size_t OFF_TOKP = 2 * MiB;
constexpr size_t OFF_N8SP = 1 * MiB + 256 * 1024 + 16384;
constexpr size_t OFF_GBIAS = 1 * MiB + 256 * 1024 + 32768;
constexpr size_t OFF_GATEW = 2 * MiB + 256 * 1024;
constexpr size_t OFF_SGUW = 2 * MiB + 512 * 1024;
constexpr size_t OFF_ROUTW = 2 * MiB + 768 * 1024;
constexpr size_t OFF_CARRY = 3 * MiB;
constexpr size_t OFF_WIN = 4 * MiB;
constexpr size_t OFF_WOUT = 8 * MiB;
constexpr size_t OFF_W13 = 10 * MiB;
constexpr size_t OFF_W2 = 74 * MiB;
constexpr size_t OFF_XN = 362 * MiB;
constexpr size_t OFF_Z = 170 * MiB;
constexpr size_t OFF_YMIX = 308 * MiB;
constexpr size_t OFF_X1 = 106 * MiB;
constexpr size_t OFF_ACT = 426 * MiB;
constexpr size_t OFF_LIST = 498 * MiB;
constexpr size_t OFF_ROWTOK = 506 * MiB;
constexpr size_t OFF_Y = 170 * MiB;
constexpr size_t WS_NEED = 507 * MiB;
constexpr size_t OFF_VN = OFF_X1;
constexpr size_t OFF_XC = OFF_ACT;
constexpr int CW_BAR = 4096;
constexpr int CW_CNT = 8192, CNT_STRIDE = 64;

__device__ __forceinline__ unsigned f2bf(float f) { unsigned u = __float_as_uint(f); return (u + 0x7fffu + ((u >> 16) & 1u)) >> 16; }
__device__ __forceinline__ float bf2f(unsigned h) { return __uint_as_float(h << 16); }
__device__ __forceinline__ unsigned pk2(float lo, float hi) { unsigned r; asm("v_cvt_pk_bf16_f32 %0, %1, %2" : "=v"(r) : "v"(lo), "v"(hi)); return r; }
__device__ __forceinline__ float wave_sum(float v) {
#pragma unroll
    for (int o = 1; o < 64; o <<= 1) v += __shfl_xor(v, o);
    return v;
}
__device__ __forceinline__ float gelu_tanh(float x) {
    const float u = 1.5957691216057308f * (x + 0.044715f * x * x * x);
    return x / (1.0f + __expf(-u));
}
__device__ __forceinline__ float sigmoidf(float x) { return 1.0f / (1.0f + __expf(-x)); }

namespace pg8 {
#define PG8_LAS __attribute__((address_space(3)))
constexpr int BM = 256, BK = 64, HALF = 128, HTB = HALF * BK * 2  , STAGE_BYTES = 8 * HTB, NXCD = 8, WGM = 8;
__host__ __device__ __forceinline__ int lds_byte(int r, int c) { const int st = (r >> 4) * 2 + (c >> 5), rr = r & 15, cc = c & 31, ob = rr * 64 + cc * 2; return st * 1024 + (ob ^ (((ob >> 9) & 1) << 5)); }
__host__ __device__ __forceinline__ void stage_rc(int b, int& R, int& C) { const int st = b / 1024, sb = b % 1024, swz = sb ^ (((sb >> 9) & 1) << 5); R = (st >> 1) * 16 + swz / 64; C = (st & 1) * 32 + (swz % 64) / 2; }
__host__ __device__ __forceinline__ int perm32(int rho) { const int n = rho >> 4, i = rho & 15; return 8 * (i >> 2) + 4 * n + (i & 3); }

__host__ __device__ __forceinline__ int perm256(int h, int R) { return 64 * (R >> 5) + 16 * ((R >> 2) & 3) + 8 * h + 4 * ((R >> 4) & 1) + (R & 3); }

struct Unit { int pm, pn, e; };
struct Gemm { const void* A; const void* Bt; int Kb; };
__host__ __device__ __forceinline__ int swz8(int r8) { return ((r8 >> 1) & 1) | (((r8 >> 2) & 1) << 2); }
__host__ __device__ __forceinline__ int lds_byte8(int r, int piece) { return (r >> 3) * 1024 + ((r & 7) * 8 + (piece ^ swz8(r & 7))) * 16; }
__host__ __device__ __forceinline__ void stage_rc8(int b, int& R, int& Cb) { const int chunk = b >> 10, slot = (b & 1023) >> 4, r8 = slot >> 3, j = slot & 7; R = chunk * 8 + r8; Cb = (j ^ swz8(r8)) * 16; }
typedef int v8i32 __attribute__((ext_vector_type(8)));
typedef int v4i32 __attribute__((ext_vector_type(4)));

struct StaticOrder {
    int nM, nN, nwg, G, c; size_t tstep;
    __device__ void init(int M, int N, int Kb, int G_, int c_) { nM = M / BM; nN = N / BM; nwg = nM * nN; G = G_; c = c_; tstep = (size_t)BM * Kb; }
    __device__ bool next(int i, Unit& u) const {
        const long L = (long)i * G + c; if (L >= nwg) return false;
        int wgid = (int)L; { const int q = nwg / NXCD, r = nwg % NXCD, xcd = wgid % NXCD, off = wgid / NXCD; wgid = (xcd < r ? xcd * (q + 1) : r * (q + 1) + (xcd - r) * q) + off; }
        const int nig = WGM * nN, gid = wgid / nig, fm = gid * WGM, gsz = (nM - fm) < WGM ? (nM - fm) : WGM;
        u.pm = fm + ((wgid % nig) % gsz); u.pn = (wgid % nig) / gsz; u.e = 0; return true;
    }
    __device__ __forceinline__ size_t a_off(const Unit& u) const { return (size_t)u.pm * tstep; }
    __device__ __forceinline__ size_t b_off(const Unit& u) const { return (size_t)u.pn * tstep; }
    PG8_LAS unsigned char* tokt;
    __device__ __forceinline__ const int* tok_src(const Unit&, int) const { return nullptr; }
};
struct SplitOrder : StaticOrder {
    int nA, upa, cls, idx, nB;
    __device__ void init2(int M, int N, int Kb, int nA_, int nB_, int upa_, int cls_, int idx_) { init(M, N, Kb, 1, 0); nA = nA_; nB = nB_; upa = upa_; cls = cls_; idx = idx_; }
    __device__ bool next(int i, Unit& u) const {
        long L; if (cls == 0) { if (i >= upa) return false; L = (long)i * nA + idx; } else { L = (long)upa * nA + (long)i * nB + idx; }
        if (L >= nwg) return false;
        int wgid = (int)L; { const int q = nwg / NXCD, r = nwg % NXCD, xcd = wgid % NXCD, off = wgid / NXCD; wgid = (xcd < r ? xcd * (q + 1) : r * (q + 1) + (xcd - r) * q) + off; }
        const int nig = WGM * nN, gid = wgid / nig, fm = gid * WGM, gsz = (nM - fm) < WGM ? (nM - fm) : WGM;
        u.pm = fm + ((wgid % nig) % gsz); u.pn = (wgid % nig) / gsz; u.e = 0; return true;
    }
};
struct MoeOrder {
    int nunits, G, c, Kb; size_t estride;
    const PG8_LAS int* tile_e; const PG8_LAS int* p0; const PG8_LAS int* cnt; const int* list; bool gather;
    __device__ bool next(int i, Unit& u) const {
        const int L = i * G + c; if (L >= nunits) return false;
        u.pm = L >> 2; u.pn = L & 3; u.e = tile_e[u.pm]; return true;
    }
    __device__ __forceinline__ size_t a_off(const Unit& u) const { return gather ? (size_t)0 : (size_t)u.pm * BM * Kb; }
    __device__ __forceinline__ size_t b_off(const Unit& u) const { return (size_t)u.e * estride + (size_t)u.pn * BM * Kb; }
    PG8_LAS unsigned char* tokt;
    __device__ __forceinline__ const int* tok_src(const Unit& u, int r) const {
        const int pos = (u.pm - p0[u.e]) * 256 + r, last = cnt[u.e] - 1;
        return list + (size_t)u.e * LISTCAP + (pos < last ? pos : last);
    }
};

__device__ __forceinline__ unsigned cvt_pk_bf16(float lo, float hi) { unsigned r; asm volatile("v_cvt_pk_bf16_f32 %0, %1, %2" : "=v"(r) : "v"(lo), "v"(hi)); return r; }
typedef float f32x2 __attribute__((ext_vector_type(2)));
__device__ __forceinline__ f32x2 exp2_2(f32x2 a) { return (f32x2){__builtin_amdgcn_exp2f(a.x), __builtin_amdgcn_exp2f(a.y)}; }
__device__ __forceinline__ f32x2 rcp_2(f32x2 a) { return (f32x2){__builtin_amdgcn_rcpf(a.x), __builtin_amdgcn_rcpf(a.y)}; }
__device__ __forceinline__ f32x2 gelu_fast2(f32x2 x) {
    const f32x2 u = x * x, w = u * (f32x2){-0.10294324f, -0.10294324f} + (f32x2){-2.3022082f, -2.3022082f}, t = x * w;
    return x * rcp_2(exp2_2(t) + (f32x2){1.0f, 1.0f}); }
__device__ __forceinline__ f32x4 gelu_fast4(f32x4 v) { const f32x2 a = gelu_fast2((f32x2){v[0], v[1]}), b = gelu_fast2((f32x2){v[2], v[3]}); return (f32x4){a.x, a.y, b.x, b.y}; }
__device__ __forceinline__ float gelu_fast(float x) {
    const float u = -2.3022082f * (x + 0.044715f * x * x * x);
    return x * __builtin_amdgcn_rcpf(1.0f + __builtin_amdgcn_exp2f(u));
}
__device__ __forceinline__ float silu_fast(float x) { return x * __builtin_amdgcn_rcpf(1.0f + __builtin_amdgcn_exp2f(-1.4426950408889634f * x)); }

__device__ __forceinline__ unsigned dpp_swap1(unsigned v) { return (unsigned)__builtin_amdgcn_mov_dpp((int)v, 0xB1, 0xF, 0xF, true); }
__device__ __forceinline__ void st_rowpair(bf16_t* rowp_even, size_t rstride, bool odd, const u32x4& lo, const u32x4& hi) {
    u32x4 t, r, a, b;
#pragma unroll
    for (int i = 0; i < 4; ++i) { t[i] = odd ? lo[i] : hi[i]; r[i] = dpp_swap1(t[i]); a[i] = odd ? r[i] : lo[i]; b[i] = odd ? hi[i] : r[i]; }
    *(u32x4*)rowp_even = a; *(u32x4*)(rowp_even + rstride) = b;
}
struct EpiZ { static constexpr int PERM = 2; bf16_t* Z;
    __device__ __forceinline__ void operator()(const f32x4 (&acc)[2][2][4][2], const Unit& u, int wr, int wc, int fr, int fq) const {
        const bool odd = fr & 1; const int rowe = u.pm * BM + wr * 64 + (fr & ~1), col0 = u.pn * BM + wc * 64 + 16 * fq + (odd ? 8 : 0); const bool act = u.pn >= 2;
#pragma unroll
        for (int ai = 0; ai < 2; ++ai)
#pragma unroll
            for (int m = 0; m < 4; ++m) { u32x4 h[2];
#pragma unroll
                for (int bj = 0; bj < 2; ++bj) { f32x4 v0 = acc[ai][bj][m][0], v1 = acc[ai][bj][m][1];
                    if (act) { v0 = gelu_fast4(v0); v1 = gelu_fast4(v1); }
                    h[bj].x = cvt_pk_bf16(v0[0], v0[1]); h[bj].y = cvt_pk_bf16(v0[2], v0[3]); h[bj].z = cvt_pk_bf16(v1[0], v1[1]); h[bj].w = cvt_pk_bf16(v1[2], v1[3]); }
                st_rowpair(Z + (size_t)(rowe + ai * HALF + m * 16) * ZLD + col0, ZLD, odd, h[0], h[1]); }
    }
};
struct EpiX1 { static constexpr int PERM = 2; const float* x; const float* mod; bf16_t* X1;
    __device__ __forceinline__ void operator()(const f32x4 (&acc)[2][2][4][2], const Unit& u, int wr, int wc, int fr, int fq) const {
        const bool odd = fr & 1; const int row0 = u.pm * BM + wr * 64 + fr, col0 = u.pn * BM + wc * 64 + 16 * fq; const int b = (u.pm * BM) / SEQ;
        const float* g1 = mod + b * 6144 + 2048 + col0;
        f32x4 gv[4];
#pragma unroll
        for (int j = 0; j < 4; ++j) gv[j] = *(const f32x4*)(g1 + 4 * j);
#pragma unroll
        for (int ai = 0; ai < 2; ++ai)
#pragma unroll
            for (int m = 0; m < 4; ++m) { const float* xp = x + (size_t)(row0 + ai * HALF + m * 16) * D + col0; u32x4 h[2];
#pragma unroll
                for (int bj = 0; bj < 2; ++bj) { const f32x4 x0 = *(const f32x4*)(xp + 8 * bj), x1 = *(const f32x4*)(xp + 8 * bj + 4);
                    const f32x4 v0 = x0 + gv[2 * bj] * acc[ai][bj][m][0], v1 = x1 + gv[2 * bj + 1] * acc[ai][bj][m][1];
                    h[bj].x = cvt_pk_bf16(v0[0], v0[1]); h[bj].y = cvt_pk_bf16(v0[2], v0[3]); h[bj].z = cvt_pk_bf16(v1[0], v1[1]); h[bj].w = cvt_pk_bf16(v1[2], v1[3]); }
                st_rowpair(X1 + (size_t)((row0 & ~1) + ai * HALF + m * 16) * D + col0 + (odd ? 8 : 0), D, odd, h[0], h[1]); }
    }
};
struct EpiAct { static constexpr bool PERM = true; bf16_t* ACT;
    __device__ __forceinline__ void operator()(const f32x4 (&acc)[2][2][4][2], const Unit& u, int wr, int wc, int fr, int fq) const {
        const int row0 = u.pm * BM + wr * 64 + fr, col0 = u.pn * HALF + wc * 32 + 8 * fq;
#pragma unroll
        for (int ai = 0; ai < 2; ++ai)
#pragma unroll
            for (int m = 0; m < 4; ++m) { f32x4 v0, v1;
#pragma unroll
                for (int q = 0; q < 4; ++q) { v0[q] = silu_fast(acc[ai][0][m][0][q]) * acc[ai][1][m][0][q]; v1[q] = silu_fast(acc[ai][0][m][1][q]) * acc[ai][1][m][1][q]; }
                u32x4 w; w.x = cvt_pk_bf16(v0[0], v0[1]); w.y = cvt_pk_bf16(v0[2], v0[3]); w.z = cvt_pk_bf16(v1[0], v1[1]); w.w = cvt_pk_bf16(v1[2], v1[3]);
                *(u32x4*)(ACT + (size_t)(row0 + ai * HALF + m * 16) * DE + col0) = w; }
    }
};
__device__ __forceinline__ unsigned pk4_fp8(float a, float b, float c, float d) {
    a = __builtin_fminf(__builtin_fmaxf(a, -448.f), 448.f); b = __builtin_fminf(__builtin_fmaxf(b, -448.f), 448.f);
    c = __builtin_fminf(__builtin_fmaxf(c, -448.f), 448.f); d = __builtin_fminf(__builtin_fmaxf(d, -448.f), 448.f);
    unsigned w = 0u; w = __builtin_amdgcn_cvt_pk_fp8_f32(a, b, w, false); w = __builtin_amdgcn_cvt_pk_fp8_f32(c, d, w, true); return w; }
struct EpiAct8 { static constexpr bool PERM = true; unsigned char* ACT; float inv, oscale;
    __device__ __forceinline__ void operator()(const f32x4 (&acc)[2][2][4][2], const Unit& u, int wr, int wc, int fr, int fq) const {
        const int row0 = u.pm * BM + wr * 64 + fr + ((fq & 1) ? 16 : 0), col0 = u.pn * HALF + wc * 32 + 8 * (fq & ~1); const float ce = -1.4426950408889634f * inv, ik = 1.0f / (inv * inv * oscale);
#pragma unroll
        for (int ai = 0; ai < 2; ++ai)
#pragma unroll
            for (int mp = 0; mp < 2; ++mp) { u32x2 w[2];
#pragma unroll
                for (int mm = 0; mm < 2; ++mm) { const int m = 2 * mp + mm; f32x4 v0, v1;
#pragma unroll
                    for (int h = 0; h < 2; ++h)
#pragma unroll
                        for (int p = 0; p < 2; ++p) {
                            const f32x2 g = (f32x2){acc[ai][0][m][h][2 * p], acc[ai][0][m][h][2 * p + 1]}, uu = (f32x2){acc[ai][1][m][h][2 * p], acc[ai][1][m][h][2 * p + 1]};
                            const f32x2 e = exp2_2(g * (f32x2){ce, ce}), r = rcp_2(e * (f32x2){ik, ik} + (f32x2){ik, ik}), o = (g * uu) * r;
                            if (h == 0) { v0[2 * p] = o.x; v0[2 * p + 1] = o.y; } else { v1[2 * p] = o.x; v1[2 * p + 1] = o.y; } }
                    w[mm].x = pk4_fp8(v0[0], v0[1], v0[2], v0[3]); w[mm].y = pk4_fp8(v1[0], v1[1], v1[2], v1[3]); }
                const auto sx = __builtin_amdgcn_permlane16_swap(w[0].x, w[1].x, false, false), sy = __builtin_amdgcn_permlane16_swap(w[0].y, w[1].y, false, false);
                u32x4 o4; o4.x = sx[0]; o4.y = sy[0]; o4.z = sx[1]; o4.w = sy[1];
                *(u32x4*)(ACT + (size_t)(row0 + ai * HALF + mp * 32) * DE + col0) = o4; }
    }
};
struct EpiY8 { static constexpr int PERM = 2; unsigned char* Y; float sc;
    __device__ __forceinline__ void operator()(const f32x4 (&acc)[2][2][4][2], const Unit& u, int wr, int wc, int fr, int fq) const {
        const int row0 = u.pm * BM + wr * 64 + fr, col0 = u.pn * BM + wc * 64 + 16 * fq;
#pragma unroll
        for (int ai = 0; ai < 2; ++ai)
#pragma unroll
            for (int m = 0; m < 4; ++m) { u32x4 w;
                { const f32x4 v0 = acc[ai][0][m][0] * sc, v1 = acc[ai][0][m][1] * sc; w.x = pk4_fp8(v0[0], v0[1], v0[2], v0[3]); w.y = pk4_fp8(v1[0], v1[1], v1[2], v1[3]); }
                { const f32x4 v0 = acc[ai][1][m][0] * sc, v1 = acc[ai][1][m][1] * sc; w.z = pk4_fp8(v0[0], v0[1], v0[2], v0[3]); w.w = pk4_fp8(v1[0], v1[1], v1[2], v1[3]); }
                *(u32x4*)(Y + (size_t)(row0 + ai * HALF + m * 16) * D + col0) = w; }
    }
};
struct EpiY { static constexpr bool PERM = true; bf16_t* Y;
    __device__ __forceinline__ void operator()(const f32x4 (&acc)[2][2][4][2], const Unit& u, int wr, int wc, int fr, int fq) const {
        const int row0 = u.pm * BM + wr * 64 + fr, col0 = u.pn * BM + wc * 32 + 8 * fq;
#pragma unroll
        for (int ai = 0; ai < 2; ++ai)
#pragma unroll
            for (int m = 0; m < 4; ++m) { bf16_t* rowp = Y + (size_t)(row0 + ai * HALF + m * 16) * D + col0;
#pragma unroll
                for (int bj = 0; bj < 2; ++bj) { const f32x4 v0 = acc[ai][bj][m][0], v1 = acc[ai][bj][m][1];
                    u32x4 w; w.x = cvt_pk_bf16(v0[0], v0[1]); w.y = cvt_pk_bf16(v0[2], v0[3]); w.z = cvt_pk_bf16(v1[0], v1[1]); w.w = cvt_pk_bf16(v1[2], v1[3]);
                    *(u32x4*)(rowp + bj * HALF) = w; } }
    }
};

template <class Epi, class Sched, bool ALIGN_EPI, bool GATHER, bool FP8>
__device__ __forceinline__ void gemm_phase(PG8_LAS unsigned char* lds, const Gemm g, const Sched& S, const Epi& E) {
    const int tid = threadIdx.x, wid = __builtin_amdgcn_readfirstlane(tid >> 6), lane = tid & 63, wr = wid >> 2, wc = wid & 3, fr = lane & 15, fq = lane >> 4;
    const int Kb = g.Kb, nt = Kb / (BK * 2);
    unsigned voffA[2], voffB[2][2]; int Ra[2];
#pragma unroll
    for (int i = 0; i < 2; ++i) { int R, Cb; if (FP8) stage_rc8(tid * 16 + i * 8192, R, Cb); else { stage_rc(tid * 16 + i * 8192, R, Cb); Cb *= 2; }
        const int Rb = Epi::PERM ? ((R & ~31) + perm32(R & 31)) : R;
        Ra[i] = R; voffA[i] = GATHER ? (unsigned)Cb : (unsigned)(R * Kb + Cb);
#pragma unroll
        for (int h = 0; h < 2; ++h) voffB[h][i] = (int)Epi::PERM == 2 ? (unsigned)(perm256(h, R) * Kb + Cb) : (unsigned)((Rb + h * HALF) * Kb + Cb); }
    const size_t kstep = (size_t)(BK * 2);
    const size_t hstep = (size_t)HALF * Kb;
    const size_t hstepA = GATHER ? (size_t)0 : hstep;
    const unsigned ldsw = (unsigned)wid * 1024u;
    const int aoff = FP8 ? lds_byte8(wr * 64 + fr, 2 * fq) : lds_byte(wr * 64 + fr, fq * 8), boff = FP8 ? lds_byte8(wc * 32 + fr, 2 * fq) : lds_byte(wc * 32 + fr, fq * 8);
    const int aoff1 = FP8 ? lds_byte8(wr * 64 + fr, 2 * fq + 1) : 0, boff1 = FP8 ? lds_byte8(wc * 32 + fr, 2 * fq + 1) : 0;
#define PG8_SA(b, h) (((b) * 2 + (h)) * HTB)
#define PG8_SB(b, h) ((4 + (b) * 2 + (h)) * HTB)
#define PG8_STAGE(bufoff, gbase, voff) do { _Pragma("unroll") for (int _i = 0; _i < 2; ++_i) \
        __builtin_amdgcn_global_load_lds((const unsigned*)((const char*)(gbase) + (voff)[_i]), (PG8_LAS unsigned*)(lds + (bufoff) + ldsw + _i * 8192), 16, 0, 0); } while (0)
#define PG8_STAGE_A(bufoff, kbase, h) do { _Pragma("unroll") for (int _i = 0; _i < 2; ++_i) \
        __builtin_amdgcn_global_load_lds((const unsigned*)((const char*)(kbase) + (size_t)(h) * hstepA + (GATHER ? gC[h][_i] : 0u) + voffA[_i]), (PG8_LAS unsigned*)(lds + (bufoff) + ldsw + _i * 8192), 16, 0, 0); } while (0)
#define PG8_LD16(off) (*(const PG8_LAS v4i32*)(lds + (off)))
#define PG8_LDA(dst, b, h) do { _Pragma("unroll") for (int m = 0; m < 4; ++m) { if constexpr (FP8) dst##8[m] = __builtin_shufflevector(PG8_LD16(PG8_SA(b, h) + aoff + m * 2048), PG8_LD16(PG8_SA(b, h) + aoff1 + m * 2048), 0, 1, 2, 3, 4, 5, 6, 7); \
        else { _Pragma("unroll") for (int k = 0; k < 2; ++k) dst[m][k] = *(const PG8_LAS bf16x8*)(lds + PG8_SA(b, h) + aoff + m * 2048 + k * 1024); } } } while (0)
#define PG8_LDB(dst, b, h) do { _Pragma("unroll") for (int n = 0; n < 2; ++n) { if constexpr (FP8) dst##8[n] = __builtin_shufflevector(PG8_LD16(PG8_SB(b, h) + boff + n * 2048), PG8_LD16(PG8_SB(b, h) + boff1 + n * 2048), 0, 1, 2, 3, 4, 5, 6, 7); \
        else { _Pragma("unroll") for (int k = 0; k < 2; ++k) dst[n][k] = *(const PG8_LAS bf16x8*)(lds + PG8_SB(b, h) + boff + n * 2048 + k * 1024); } } } while (0)
#define PG8_MMA(ai, bj, At, Bt, ZF) do { __builtin_amdgcn_s_setprio(1); _Pragma("unroll") for (int m = 0; m < 4; ++m) _Pragma("unroll") for (int n = 0; n < 2; ++n) { \
        if constexpr (FP8) { if constexpr (ZF) asm volatile("v_mfma_f32_16x16x128_f8f6f4 %0, %1, %2, 0" : "=v"(acc[ai][bj][m][n]) : "v"(Bt##8[n]), "v"(At##8[m])); \
                             else asm volatile("v_mfma_f32_16x16x128_f8f6f4 %0, %1, %2, %0" : "+v"(acc[ai][bj][m][n]) : "v"(Bt##8[n]), "v"(At##8[m])); } \
        else { acc[ai][bj][m][n] = __builtin_amdgcn_mfma_f32_16x16x32_bf16(Bt[n][0], At[m][0], ZF ? (f32x4){0.f, 0.f, 0.f, 0.f} : acc[ai][bj][m][n], 0, 0, 0); \
               acc[ai][bj][m][n] = __builtin_amdgcn_mfma_f32_16x16x32_bf16(Bt[n][1], At[m][1], acc[ai][bj][m][n], 0, 0, 0); } } \
        __builtin_amdgcn_s_setprio(0); } while (0)
#define PG8_WAIT_V(n) asm volatile("s_waitcnt vmcnt(" #n ")" ::: "memory")
#define PG8_WAIT_L(n) asm volatile("s_waitcnt lgkmcnt(" #n ")" ::: "memory")
#define PG8_BAR __builtin_amdgcn_s_barrier()
#define PG8_SCHED __builtin_amdgcn_sched_barrier(0)
    Unit cur, nxt; int ui = 0;
    if (!S.next(0, cur)) return;
    f32x4 acc[2][2][4][2];
    bf16x8 At[4][2], B0[2][2], B1[2][2]; v8i32 At8[4], B08[2], B18[2];
#define PG8_TOK_ISSUE(u_, slot_) do { if (wid < 4) __builtin_amdgcn_global_load_lds((const unsigned*)S.tok_src(u_, tid), (PG8_LAS unsigned*)(S.tokt + (slot_) * 1024 + wid * 256), 4, 0, 0); } while (0)
#define PG8_TOK_READ(slot_) do { _Pragma("unroll") for (int h = 0; h < 2; ++h) _Pragma("unroll") for (int i = 0; i < 2; ++i) \
        gC[h][i] = *(const PG8_LAS unsigned*)(S.tokt + (slot_) * 1024 + (h * HALF + Ra[i]) * 4) * (unsigned)Kb; } while (0)
    unsigned gC[2][2];
#pragma unroll
    for (int h = 0; h < 2; ++h)
#pragma unroll
        for (int i = 0; i < 2; ++i) gC[h][i] = 0u;
    if constexpr (GATHER) { PG8_TOK_ISSUE(cur, 0); PG8_WAIT_V(0); PG8_BAR; PG8_TOK_READ(0); }
    const char* cA = (const char*)g.A + S.a_off(cur); const char* cB = (const char*)g.Bt + S.b_off(cur);
    PG8_STAGE(PG8_SB(0, 0), cB, voffB[0]); PG8_STAGE(PG8_SB(0, 1), cB, voffB[1]); PG8_STAGE_A(PG8_SA(0, 0), cA, 0); PG8_STAGE_A(PG8_SA(0, 1), cA, 1);
    if (wr == 1) PG8_BAR;
    PG8_WAIT_V(2); PG8_BAR;
    PG8_STAGE(PG8_SB(1, 0), cB + kstep, voffB[0]); PG8_STAGE_A(PG8_SA(1, 0), cA + kstep, 0); PG8_STAGE(PG8_SB(1, 1), cB + kstep, voffB[1]);
    PG8_WAIT_V(6); PG8_BAR;
    for (;;) {
        const bool has_next = S.next(ui + 1, nxt);
        const char* nA = has_next ? (const char*)g.A + S.a_off(nxt) : cA; const char* nB = has_next ? (const char*)g.Bt + S.b_off(nxt) : cB;
        if constexpr (GATHER) { if (has_next) PG8_TOK_ISSUE(nxt, (ui + 1) & 1); }
        if constexpr (FP8) {
        { constexpr bool ZF = true; const int t = 0;
            const bool last = (t == nt - 2);
            const char* a1 = cA + (size_t)(t + 1) * kstep;
            const char* a2 = last ? nA : cA + (size_t)(t + 2) * kstep; const char* b2 = last ? nB : cB + (size_t)(t + 2) * kstep;
            const char* a3 = a2 + kstep; const char* b3 = b2 + kstep;
            PG8_LDB(B0, 0, 0); PG8_LDB(B1, 0, 1); PG8_SCHED; PG8_LDA(At, 0, 0); PG8_STAGE_A(PG8_SA(1, 1), a1, 1);
            PG8_WAIT_V(8); PG8_WAIT_L(0); PG8_BAR; PG8_MMA(0, 0, At, B0, ZF); PG8_MMA(0, 1, At, B1, ZF); PG8_BAR; PG8_SCHED;
            if constexpr (GATHER) { if (last && has_next) PG8_TOK_READ((ui + 1) & 1); }
            PG8_LDA(At, 0, 1); PG8_STAGE(PG8_SB(0, 0), b2, voffB[0]); PG8_STAGE(PG8_SB(0, 1), b2, voffB[1]); PG8_STAGE_A(PG8_SA(0, 0), a2, 0);
            PG8_WAIT_V(8); PG8_WAIT_L(0); PG8_BAR; PG8_MMA(1, 0, At, B0, ZF); PG8_MMA(1, 1, At, B1, ZF); PG8_BAR; PG8_SCHED;
            PG8_LDB(B0, 1, 0); PG8_LDB(B1, 1, 1); PG8_SCHED; PG8_LDA(At, 1, 0); PG8_STAGE_A(PG8_SA(0, 1), a2, 1);
            PG8_WAIT_V(8); PG8_WAIT_L(0); PG8_BAR; PG8_MMA(0, 0, At, B0, false); PG8_MMA(0, 1, At, B1, false); PG8_BAR; PG8_SCHED;
            PG8_LDA(At, 1, 1); PG8_STAGE(PG8_SB(1, 0), b3, voffB[0]); PG8_STAGE(PG8_SB(1, 1), b3, voffB[1]); PG8_STAGE_A(PG8_SA(1, 0), a3, 0);
            PG8_WAIT_V(8); PG8_WAIT_L(0); PG8_BAR; PG8_MMA(1, 0, At, B0, false); PG8_MMA(1, 1, At, B1, false); PG8_BAR; PG8_SCHED;
                }
#pragma unroll 1
        for (int t = 2; t < nt; t += 2) { constexpr bool ZF = false;
            const bool last = (t == nt - 2);
            const char* a1 = cA + (size_t)(t + 1) * kstep;
            const char* a2 = last ? nA : cA + (size_t)(t + 2) * kstep; const char* b2 = last ? nB : cB + (size_t)(t + 2) * kstep;
            const char* a3 = a2 + kstep; const char* b3 = b2 + kstep;
            PG8_LDB(B0, 0, 0); PG8_LDB(B1, 0, 1); PG8_SCHED; PG8_LDA(At, 0, 0); PG8_STAGE_A(PG8_SA(1, 1), a1, 1);
            PG8_WAIT_V(8); PG8_WAIT_L(0); PG8_BAR; PG8_MMA(0, 0, At, B0, ZF); PG8_MMA(0, 1, At, B1, ZF); PG8_BAR; PG8_SCHED;
            if constexpr (GATHER) { if (last && has_next) PG8_TOK_READ((ui + 1) & 1); }
            PG8_LDA(At, 0, 1); PG8_STAGE(PG8_SB(0, 0), b2, voffB[0]); PG8_STAGE(PG8_SB(0, 1), b2, voffB[1]); PG8_STAGE_A(PG8_SA(0, 0), a2, 0);
            PG8_WAIT_V(8); PG8_WAIT_L(0); PG8_BAR; PG8_MMA(1, 0, At, B0, ZF); PG8_MMA(1, 1, At, B1, ZF); PG8_BAR; PG8_SCHED;
            PG8_LDB(B0, 1, 0); PG8_LDB(B1, 1, 1); PG8_SCHED; PG8_LDA(At, 1, 0); PG8_STAGE_A(PG8_SA(0, 1), a2, 1);
            PG8_WAIT_V(8); PG8_WAIT_L(0); PG8_BAR; PG8_MMA(0, 0, At, B0, false); PG8_MMA(0, 1, At, B1, false); PG8_BAR; PG8_SCHED;
            PG8_LDA(At, 1, 1); PG8_STAGE(PG8_SB(1, 0), b3, voffB[0]); PG8_STAGE(PG8_SB(1, 1), b3, voffB[1]); PG8_STAGE_A(PG8_SA(1, 0), a3, 0);
            PG8_WAIT_V(8); PG8_WAIT_L(0); PG8_BAR; PG8_MMA(1, 0, At, B0, false); PG8_MMA(1, 1, At, B1, false); PG8_BAR; PG8_SCHED;
                }
        } else {
#pragma unroll
        for (int a = 0; a < 2; ++a)
#pragma unroll
            for (int b = 0; b < 2; ++b)
#pragma unroll
                for (int m = 0; m < 4; ++m)
#pragma unroll
                    for (int n = 0; n < 2; ++n) acc[a][b][m][n] = (f32x4){0.f, 0.f, 0.f, 0.f};
#pragma unroll 1
        for (int t = 0; t < nt; t += 2) { constexpr bool ZF = false;
            const bool last = (t == nt - 2);
            const char* a1 = cA + (size_t)(t + 1) * kstep;
            const char* a2 = last ? nA : cA + (size_t)(t + 2) * kstep; const char* b2 = last ? nB : cB + (size_t)(t + 2) * kstep;
            const char* a3 = a2 + kstep; const char* b3 = b2 + kstep;
            PG8_LDB(B0, 0, 0); PG8_LDB(B1, 0, 1); PG8_SCHED; PG8_LDA(At, 0, 0); PG8_STAGE_A(PG8_SA(1, 1), a1, 1);
            PG8_WAIT_V(8); PG8_WAIT_L(0); PG8_BAR; PG8_MMA(0, 0, At, B0, ZF); PG8_MMA(0, 1, At, B1, ZF); PG8_BAR; PG8_SCHED;
            if constexpr (GATHER) { if (last && has_next) PG8_TOK_READ((ui + 1) & 1); }
            PG8_LDA(At, 0, 1); PG8_STAGE(PG8_SB(0, 0), b2, voffB[0]); PG8_STAGE(PG8_SB(0, 1), b2, voffB[1]); PG8_STAGE_A(PG8_SA(0, 0), a2, 0);
            PG8_WAIT_V(8); PG8_WAIT_L(0); PG8_BAR; PG8_MMA(1, 0, At, B0, ZF); PG8_MMA(1, 1, At, B1, ZF); PG8_BAR; PG8_SCHED;
            PG8_LDB(B0, 1, 0); PG8_LDB(B1, 1, 1); PG8_SCHED; PG8_LDA(At, 1, 0); PG8_STAGE_A(PG8_SA(0, 1), a2, 1);
            PG8_WAIT_V(8); PG8_WAIT_L(0); PG8_BAR; PG8_MMA(0, 0, At, B0, false); PG8_MMA(0, 1, At, B1, false); PG8_BAR; PG8_SCHED;
            PG8_LDA(At, 1, 1); PG8_STAGE(PG8_SB(1, 0), b3, voffB[0]); PG8_STAGE(PG8_SB(1, 1), b3, voffB[1]); PG8_STAGE_A(PG8_SA(1, 0), a3, 0);
            PG8_WAIT_V(8); PG8_WAIT_L(0); PG8_BAR; PG8_MMA(1, 0, At, B0, false); PG8_MMA(1, 1, At, B1, false); PG8_BAR; PG8_SCHED;
                }
        }
        if constexpr (ALIGN_EPI) { if (wr == 0) PG8_BAR; }
        if constexpr (FP8) asm volatile("s_nop 15\n\ts_nop 15" ::: "memory");
        E(acc, cur, wr, wc, fr, fq);
        if (!has_next) break;
        cur = nxt; cA = nA; cB = nB; ++ui;
        if constexpr (ALIGN_EPI) { if (wr == 1) PG8_BAR; }
    }
    PG8_WAIT_V(0);
    if constexpr (!ALIGN_EPI) { if (wr == 0) PG8_BAR; }
    PG8_BAR;
#undef PG8_SA
#undef PG8_SB
#undef PG8_STAGE
#undef PG8_STAGE_A
#undef PG8_TOK_ISSUE
#undef PG8_TOK_READ
#undef PG8_LDA
#undef PG8_LDB
#undef PG8_MMA
#undef PG8_LD16
#undef PG8_WAIT_V
#undef PG8_WAIT_L
#undef PG8_BAR
#undef PG8_SCHED
}
}
#define LAS __attribute__((address_space(3)))
#define GAS __attribute__((address_space(1)))
constexpr int NWAVES = 8, NTHREADS = 512;
constexpr int LDS_BYTES = 163840;
constexpr int SCR_BYTES = 147456;
constexpr int LDSCTL_OFF = SCR_BYTES;
constexpr int TAB_OFF = LDSCTL_OFF + 512;
constexpr int TAB_CNT = 0, TAB_P0 = 32, TAB_TE = 72;
constexpr int TOKT_OFF = TAB_OFF + 2048;
#define LDS_WAIT() asm volatile("s_waitcnt lgkmcnt(0)" ::: "memory")
#define WAVE_SYNC() do { asm volatile("s_waitcnt lgkmcnt(0)" ::: "memory"); __builtin_amdgcn_wave_barrier(); } while (0)

#ifndef MOE_FP8
#define MOE_FP8 1
#endif
constexpr float W13_SCALE = 32.f, W2_SCALE = 16.f, ACT_SCALE = 4.f, Y_SCALE = 16.f;
struct Args {
    const float* in[27]; float* out; unsigned char* ws; int ph_lo, ph_hi;
};
struct Frame {
    LAS unsigned char* lds; LAS int* tab; unsigned* ctl; unsigned char* ws;
    int tid, lane, wave, G, bid, vcu;
};
enum Phase { PH_A = 0, PH_B, PH_C, PH_D, PH_E, PH_F, PH_G, PH_H, PH_I, PH_J, PH_N };

#define XB_TMO      128
#define XB_XCNT(j)  (256  + 64 * (j))
#define XB_XSUB(j)  (1280 + 64 * (j))
#define XB_XGEN(j)  (2304 + 64 * (j))
#define XB_TOP      3328
#define XB_TOPGEN   3392
#define XCD_BAR_WORDS 3456
#define XB_SPIN_CAP (1u << 18)
__device__ __forceinline__ unsigned xb_ld(unsigned* p)              { return __hip_atomic_load(p, __ATOMIC_RELAXED, __HIP_MEMORY_SCOPE_AGENT); }
__device__ __forceinline__ unsigned xb_add(unsigned* p, unsigned v) { return __hip_atomic_fetch_add(p, v, __ATOMIC_RELAXED, __HIP_MEMORY_SCOPE_AGENT); }
__device__ __forceinline__ unsigned xb_xcc_id() { return (unsigned)__builtin_amdgcn_s_getreg((3 << 11) | 20) & 0xFu; }
#define XB_SPIN(cond, bar) do { unsigned _sp = 0; while (cond) { __builtin_amdgcn_s_sleep(1); \
    if ((++_sp & 255u) == 0u) { if (xb_ld(&(bar)[XB_TMO])) break; if (_sp > XB_SPIN_CAP) { atomicAdd(&(bar)[XB_TMO], 1u); break; } } } } while (0)
struct XcdBarrier { unsigned* bar; unsigned x; volatile LAS unsigned* st; };
__device__ __forceinline__ XcdBarrier xcd_barrier_post(unsigned* bar, volatile LAS unsigned* st) {
    XcdBarrier b; b.bar = bar; b.x = xb_xcc_id(); b.st = st;
    if (threadIdx.x == 0) (void)xb_add(&bar[XB_XCNT(b.x)], 1u);
    return b;
}
__device__ __forceinline__ void xcd_barrier_complete(unsigned* bar, unsigned x, unsigned& nloc, unsigned& nx) {
    const unsigned G = gridDim.x * gridDim.y * gridDim.z;
    unsigned sum, cnt, mine, sp = 0u;
    for (;;) {
        sum = 0u; cnt = 0u; mine = 0u;
#pragma unroll
        for (unsigned j = 0; j < 16; ++j) { const unsigned c = xb_ld(&bar[XB_XCNT(j)]); sum += c; cnt += (c > 0u) ? 1u : 0u; mine = (j == x) ? c : mine; }
        if (sum == G) break;
        __builtin_amdgcn_s_sleep(1);
        if ((++sp & 255u) == 0u) { if (xb_ld(&bar[XB_TMO])) break; if (sp > XB_SPIN_CAP) { atomicAdd(&bar[XB_TMO], 1u); break; } }
    }
    nloc = mine > 0u ? mine : 1u; nx = cnt > 0u ? cnt : 1u;
}
__device__ __forceinline__ void xcd_barrier_t0(const XcdBarrier& b) {
    {
        unsigned* bar = b.bar;
        __builtin_amdgcn_s_waitcnt(0);
        unsigned nloc = b.st[0], nx = b.st[1];
        if (nloc == 0u) { xcd_barrier_complete(bar, b.x, nloc, nx); b.st[0] = nloc; b.st[1] = nx; }
        const unsigned old = xb_add(&bar[XB_XSUB(b.x)], 1u);
        const unsigned gen = old / nloc;
        if (old + 1u == (gen + 1u) * nloc) {
            asm volatile("buffer_inv sc1" ::: "memory");
            __builtin_amdgcn_fence(__ATOMIC_RELEASE, "agent");
            asm volatile("s_waitcnt vmcnt(0)" ::: "memory");
            const unsigned og = xb_add(&bar[XB_TOP], 1u);
            const unsigned tg = og / nx;
            if (og + 1u == (tg + 1u) * nx) xb_add(&bar[XB_TOPGEN], 1u);
            else XB_SPIN(xb_ld(&bar[XB_TOPGEN]) == tg, bar);
            xb_add(&bar[XB_XGEN(b.x)], 1u);
            asm volatile("s_waitcnt vmcnt(0)" ::: "memory");
        } else {
            asm volatile("buffer_inv sc1" ::: "memory");
            XB_SPIN(xb_ld(&bar[XB_XGEN(b.x)]) == gen, bar);
            asm volatile("s_waitcnt vmcnt(0)" ::: "memory");
        }
        __builtin_amdgcn_fence(__ATOMIC_ACQUIRE, "workgroup");
    }
}
__device__ __forceinline__ void xcd_barrier(const XcdBarrier& b) {
    asm volatile("s_waitcnt vmcnt(0)" ::: "memory");
    __syncthreads();
    if (threadIdx.x == 0) xcd_barrier_t0(b);
    __syncthreads();
}
template <class PW>
__device__ __forceinline__ void xcd_barrier_pw(const XcdBarrier& b, const PW& pw) {
    asm volatile("s_waitcnt vmcnt(0)" ::: "memory");
    __syncthreads();
    if (threadIdx.x == 0) xcd_barrier_t0(b);
    else if (threadIdx.x >= 64) pw((int)threadIdx.x - 64, NTHREADS - 64);
    __syncthreads();
}

__device__ __forceinline__ void build_moe_table(Frame& F) {
    __syncthreads();
    if (F.tid < 64) {
        const int c = F.tid < NE ? (int)__hip_atomic_load(F.ctl + CW_CNT + CNT_STRIDE * F.tid, __ATOMIC_RELAXED, __HIP_MEMORY_SCOPE_AGENT) : 0;
        const int nt = (c + 255) >> 8; int p = nt;
#pragma unroll
        for (int o = 1; o < 32; o <<= 1) { const int v = __shfl_up(p, o); if (F.lane >= o) p += v; }
        const int excl = p - nt;
        if (F.tid < NE) { F.tab[TAB_CNT + F.tid] = c; F.tab[TAB_P0 + F.tid] = excl; for (int j = 0; j < nt; ++j) F.tab[TAB_TE + excl + j] = F.tid; }
        if (F.tid == NE - 1) F.tab[TAB_P0 + NE] = p;
    }
    __syncthreads();
}

struct TItem { const float* W; unsigned char* WT; int N, K, blk, rstride, rbase, k0, n0, fp8; float scale; };
template <bool NT = false>
__device__ __forceinline__ void titem_load(const TItem& d, f32x4 (&v)[16], int lane) {
#pragma unroll
    for (int i = 0; i < 16; ++i) { const f32x4* q = (const f32x4*)(d.W + (size_t)(d.k0 + 16 * (lane >> 5) + i) * d.N + d.n0 + 4 * (lane & 31)); v[i] = NT ? __builtin_nontemporal_load(q) : *q; }
}
__device__ __forceinline__ unsigned pk4_fp8_nc(float a, float b, float c, float d) {
    unsigned w = 0u; w = __builtin_amdgcn_cvt_pk_fp8_f32(a, b, w, false); w = __builtin_amdgcn_cvt_pk_fp8_f32(c, d, w, true); return w; }
__device__ __forceinline__ void titem_store(const TItem& d, const f32x4 (&v)[16], int lane) {
#pragma unroll
    for (int q = 0; q < 4; ++q) {
        const int n = d.n0 + 4 * (lane & 31) + q, row = d.rbase + (n / d.blk) * d.rstride + (n % d.blk);
        if (d.fp8) { const float sc = d.scale; u32x4 o;
            o.x = pk4_fp8_nc(v[0][q] * sc, v[1][q] * sc, v[2][q] * sc, v[3][q] * sc); o.y = pk4_fp8_nc(v[4][q] * sc, v[5][q] * sc, v[6][q] * sc, v[7][q] * sc);
            o.z = pk4_fp8_nc(v[8][q] * sc, v[9][q] * sc, v[10][q] * sc, v[11][q] * sc); o.w = pk4_fp8_nc(v[12][q] * sc, v[13][q] * sc, v[14][q] * sc, v[15][q] * sc);
            *(u32x4*)(d.WT + (size_t)row * d.K + d.k0 + 16 * (lane >> 5)) = o;
        } else { u32x4 o0, o1;
            o0.x = pk2(v[0][q], v[1][q]); o0.y = pk2(v[2][q], v[3][q]); o0.z = pk2(v[4][q], v[5][q]); o0.w = pk2(v[6][q], v[7][q]);
            o1.x = pk2(v[8][q], v[9][q]); o1.y = pk2(v[10][q], v[11][q]); o1.z = pk2(v[12][q], v[13][q]); o1.w = pk2(v[14][q], v[15][q]);
            unsigned char* p = d.WT + ((size_t)row * d.K + d.k0 + 16 * (lane >> 5)) * 2; *(u32x4*)p = o0; *(u32x4*)(p + 16) = o1; }
    }
}
#ifndef CONV_PRE
#define CONV_PRE 1
#endif
constexpr int TI_IN = 512, TI_OUT = 256, TI_EXP = 384 * NE, TI_N = TI_IN + TI_OUT + TI_EXP;
__device__ __forceinline__ void titem_decode(const Args& args, unsigned char* ws, int it, TItem& d) {
    int r = it, item; d.fp8 = 0; d.scale = 1.f; d.rstride = 0; d.rbase = 0;
    if (r < TI_IN) { d.W = args.in[5]; d.WT = ws + OFF_WIN; d.K = 1024; d.N = 2048; d.blk = 2048; item = r; }
    else if ((r -= TI_IN) < TI_OUT) { d.W = args.in[17]; d.WT = ws + OFF_WOUT; d.K = 1024; d.N = 1024; d.blk = 1024; item = r; }
    else { r -= TI_OUT; const int e = r / 384, q = r % 384;
        if (q < 256) { d.W = (q < 128 ? args.in[23] : args.in[24]) + (size_t)e * 1024 * 512; d.K = 1024; d.N = 512; d.blk = 128; d.rstride = 256; d.rbase = q < 128 ? 0 : 128; item = q & 127;
            d.WT = ws + OFF_W13 + (size_t)e * 1024 * 1024 * (MOE_FP8 ? 1 : 2); d.scale = W13_SCALE; }
        else { d.W = args.in[25] + (size_t)e * 512 * 1024; d.K = 512; d.N = 1024; d.blk = 1024; item = q - 256; d.WT = ws + OFF_W2 + (size_t)e * 1024 * 512 * (MOE_FP8 ? 1 : 2); d.scale = W2_SCALE; }
        d.fp8 = MOE_FP8; if (!MOE_FP8) d.scale = 1.f; }
    const int nkb = d.K / 32; d.k0 = 32 * (item % nkb); d.n0 = 128 * (item / nkb);
}
__device__ __forceinline__ void phase_A(Frame& F, const Args& args) {
    unsigned char* ws = F.ws;
    const float* c = args.in[1]; const float* ada_w = args.in[2]; const float* ada_b = args.in[3];
    float* mod = (float*)(ws + OFF_MOD);
    for (int it = F.G - 1 - F.bid; it < 192; it += F.G) {
        LAS float* sc = (LAS float*)F.lds; LAS float* red = sc + 8192;
        for (int i = F.tid; i < 8192; i += NTHREADS) { const float v = c[i]; sc[(i & 1023) * 8 + (i >> 10)] = v / (1.0f + __expf(-v)); }
        __syncthreads();
        const int col = F.lane & 31, ks = F.lane >> 5, n = it * 32 + col, k0 = F.wave * 128 + ks;
        float acc[8];
#pragma unroll
        for (int b = 0; b < 8; ++b) acc[b] = 0.f;
#pragma unroll 1
        for (int i0 = 0; i0 < 64; i0 += 16) {
            float wv[16];
#pragma unroll
            for (int i = 0; i < 16; ++i) wv[i] = ada_w[(size_t)(k0 + 2 * (i0 + i)) * 6144 + n];
#pragma unroll
            for (int i = 0; i < 16; ++i) { const int k = k0 + 2 * (i0 + i);
                const f32x4 s0 = *(const LAS f32x4*)(sc + k * 8), s1 = *(const LAS f32x4*)(sc + k * 8 + 4);
#pragma unroll
                for (int b = 0; b < 4; ++b) { acc[b] += s0[b] * wv[i]; acc[4 + b] += s1[b] * wv[i]; } }
        }
#pragma unroll
        for (int b = 0; b < 8; ++b) { acc[b] += __shfl_xor(acc[b], 32); if (ks == 0) red[(F.wave * 8 + b) * 32 + col] = acc[b]; }
        __syncthreads();
        if (F.tid < 256) { const int b = F.tid >> 5, cc = F.tid & 31; float s = ada_b[it * 32 + cc];
#pragma unroll
            for (int w = 0; w < 8; ++w) s += red[(w * 8 + b) * 32 + cc];
            mod[b * 6144 + it * 32 + cc] = s; }
        __syncthreads();
    }
    {
        const bool split = F.G == 256;
        const int gw = split ? F.bid * NWAVES + F.wave : F.vcu * NWAVES + F.wave, NGW = split ? 64 * NWAVES : F.G * NWAVES;
        const int it_end = split ? TI_IN + TI_OUT : TI_N;
        int it = (split && F.bid >= 64) ? it_end : gw;
        if (it < it_end) {
            TItem d, d2; f32x4 v[16], v2[16];
            titem_decode(args, ws, it, d); titem_load(d, v, F.lane);
            for (;;) {
                const int itn = it + NGW; const bool more = itn < it_end;
                if (more) { titem_decode(args, ws, itn, d2); titem_load(d2, v2, F.lane); }
                titem_store(d, v, F.lane);
                if (!more) break;
                d = d2; it = itn;
#pragma unroll
                for (int i = 0; i < 16; ++i) v[i] = v2[i];
            }
        }
    }
    {
        const int gt = F.bid * NTHREADS + F.tid, NGT = F.G * NTHREADS;
        const float* sgu_w = args.in[15]; const float* rgw = args.in[19]; const float* rew = args.in[21]; const float* lam = args.in[12];
        bf16_t* SGUW = (bf16_t*)(ws + OFF_SGUW); bf16_t* ROUTW = (bf16_t*)(ws + OFF_ROUTW); float* N8SP = (float*)(ws + OFF_N8SP);
        for (int i = gt; i < 8 * 128 * 128; i += NGT) { const int ii = (i >> 7) & 127, j = i & 127; SGUW[i] = (bf16_t)(((j >> 6) <= (ii >> 6)) ? f2bf(sgu_w[i]) : 0u); }
        for (int i = gt; i < 48 * 1024; i += NGT) { const int n = i >> 10, k = i & 1023; const float v = n < 4 ? rgw[k * 4 + n] : (n < 36 ? rew[k * 32 + n - 4] : 0.f); ROUTW[i] = (bf16_t)f2bf(v); }
        for (int i = gt; i < 512; i += NGT) N8SP[i] = -8.0f * 1.4426950408889634f * log1pf(expf(-lam[i]));
        { float* GB = (float*)(ws + OFF_GBIAS); const float* gab_ = args.in[9]; const float* gib_ = args.in[11];
          for (int i = gt; i < 1024; i += NGT) GB[i] = -1.4426950408889634f * (i < 512 ? gab_[i] : gib_[i - 512]); }
        { const float* gaw = args.in[8]; const float* giw = args.in[10]; bf16_t* GATEW = (bf16_t*)(ws + OFF_GATEW);
          for (int i = gt; i < 8 * 128 * 64; i += NGT) { const int h = i >> 13, ee = (i >> 6) & 127, dd = i & 63; const float v = -1.4426950408889634f * (ee < 64 ? gaw : giw)[h * 4096 + dd * 64 + (ee & 63)]; GATEW[i] = (bf16_t)f2bf(v); } }
    }
}

template <int SEL>
__device__ __forceinline__ int conv_item(int j) { return SEL == 1 ? (j >> 8) * 384 + (j & 255) : (j >> 7) * 384 + 256 + (j & 127); }
template <int SEL>
__device__ __forceinline__ void convert_experts(Frame& F, const Args& args, int gw, int NGW, int count) {
    unsigned char* ws = F.ws;
    int it = gw;
    if (it < count) {
        TItem d, d2; f32x4 v[16], v2[16];
        titem_decode(args, ws, TI_IN + TI_OUT + conv_item<SEL>(it), d); titem_load<true>(d, v, F.lane);
        for (;;) {
            const int itn = it + NGW; const bool more = itn < count;
            if (more) { titem_decode(args, ws, TI_IN + TI_OUT + conv_item<SEL>(itn), d2); titem_load<true>(d2, v2, F.lane); }
            titem_store(d, v, F.lane);
            if (!more) break;
            d = d2; it = itn;
#pragma unroll
            for (int i = 0; i < 16; ++i) v[i] = v2[i];
        }
    }
}

__device__ __forceinline__ void phase_B(Frame& F, const Args& args) {
    const float* x = args.in[0]; const float* g = args.in[4]; const float* mod = (const float*)(F.ws + OFF_MOD); bf16_t* XN = (bf16_t*)(F.ws + OFF_XN);
    const int gw = F.vcu * NWAVES + F.wave, NGW = F.G * NWAVES, lane = F.lane;
    constexpr int RPW = 16;
    for (int item = gw; item < T / RPW; item += NGW) {
        const int row0 = item * RPW, b = row0 / SEQ;
        const float* sh = mod + b * 6144; const float* sc = sh + 1024;
        f32x4 gm[4], sv[4];
#pragma unroll
        for (int j = 0; j < 4; ++j) { const int col = 4 * (lane + 64 * j); const f32x4 gg = *(const f32x4*)(g + col), s1 = *(const f32x4*)(sc + col); sv[j] = *(const f32x4*)(sh + col); gm[j] = gg * (1.0f + s1); }
        f32x4 v[4], nv[4];
#pragma unroll
        for (int j = 0; j < 4; ++j) v[j] = ((const f32x4*)(x + (size_t)row0 * D))[lane + 64 * j];
#pragma unroll 1
        for (int r = 0; r < RPW; ++r) {
            const int row = row0 + r, nrow = (r + 1 < RPW) ? row + 1 : row;
#pragma unroll
            for (int j = 0; j < 4; ++j) nv[j] = ((const f32x4*)(x + (size_t)nrow * D))[lane + 64 * j];
            float ss = 0.f;
#pragma unroll
            for (int j = 0; j < 4; ++j) ss += v[j][0] * v[j][0] + v[j][1] * v[j][1] + v[j][2] * v[j][2] + v[j][3] * v[j][3];
            const float rs = rsqrtf(wave_sum(ss) * (1.0f / D) + EPS);
            u32x2 o[4];
#pragma unroll
            for (int j = 0; j < 4; ++j) { const f32x4 h = v[j] * rs * gm[j] + sv[j]; o[j].x = pk2(h[0], h[1]); o[j].y = pk2(h[2], h[3]); v[j] = nv[j]; }
#pragma unroll
            for (int jp = 0; jp < 2; ++jp) { const bool odd = lane & 1; u32x2 t = odd ? o[2 * jp] : o[2 * jp + 1], r;
                r.x = (unsigned)__builtin_amdgcn_mov_dpp((int)t.x, 0xB1, 0xF, 0xF, true); r.y = (unsigned)__builtin_amdgcn_mov_dpp((int)t.y, 0xB1, 0xF, 0xF, true);
                u32x4 w; if (odd) { w.x = r.x; w.y = r.y; w.z = o[2 * jp + 1].x; w.w = o[2 * jp + 1].y; } else { w.x = o[2 * jp].x; w.y = o[2 * jp].y; w.z = r.x; w.w = r.y; }
                *(u32x4*)(XN + (size_t)row * D + 4 * ((lane & ~1) + 64 * (2 * jp + (odd ? 1 : 0)))) = w; }
        }
    }
}

#ifndef SGU_TR
#define SGU_TR 1
#endif
typedef short s16x4 __attribute__((ext_vector_type(4)));
typedef short v4i16_t __attribute__((ext_vector_type(4)));
constexpr int IMG_STRIDE = 1040;
__device__ __forceinline__ float bflo(unsigned w) { return __uint_as_float(w << 16); }
__device__ __forceinline__ float bfhi(unsigned w) { return __uint_as_float(w & 0xffff0000u); }
__device__ __forceinline__ void sgu_block(Frame& F, const Args& args, int blk) {
    const bf16_t* Z = (const bf16_t*)(F.ws + OFF_Z); bf16_t* YMIX = (bf16_t*)(F.ws + OFF_YMIX); const bf16_t* SGUW = (const bf16_t*)(F.ws + OFF_SGUW);
    const float* ln_g = args.in[13]; const float* ln_b = args.in[14]; const float* sgu_b = args.in[16];
    const int lane = F.lane, w = F.wave; const size_t t0 = (size_t)blk * 128;
    {
        u32x4 raw[16];
#pragma unroll
        for (int r = 0; r < 16; ++r) raw[r] = __builtin_nontemporal_load((const u32x4*)(Z + (t0 + w * 16 + r) * ZLD + 1536 + 8 * lane));
        const f32x4 g0 = *(const f32x4*)(ln_g + 8 * lane), g1 = *(const f32x4*)(ln_g + 8 * lane + 4), b0 = *(const f32x4*)(ln_b + 8 * lane), b1 = *(const f32x4*)(ln_b + 8 * lane + 4);
#pragma unroll
        for (int r = 0; r < 16; ++r) {
            float v[8];
#pragma unroll
            for (int q = 0; q < 4; ++q) { v[2 * q] = bflo(raw[r][q]); v[2 * q + 1] = bfhi(raw[r][q]); }
            float s = 0.f;
#pragma unroll
            for (int q = 0; q < 8; ++q) s += v[q];
            const float mu = wave_sum(s) * (1.0f / 512.0f);
            float s2 = 0.f;
#pragma unroll
            for (int q = 0; q < 8; ++q) { v[q] -= mu; s2 += v[q] * v[q]; }
            const float rstd = rsqrtf(wave_sum(s2) * (1.0f / 512.0f) + EPS);
            u32x4 o;
            o.x = pk2(v[0] * rstd * g0[0] + b0[0], v[1] * rstd * g0[1] + b0[1]); o.y = pk2(v[2] * rstd * g0[2] + b0[2], v[3] * rstd * g0[3] + b0[3]);
            o.z = pk2(v[4] * rstd * g1[0] + b1[0], v[5] * rstd * g1[1] + b1[1]); o.w = pk2(v[6] * rstd * g1[2] + b1[2], v[7] * rstd * g1[3] + b1[3]);
            *(LAS u32x4*)(F.lds + (w * 16 + r) * IMG_STRIDE + 16 * lane) = o;
        }
    }
    __syncthreads();
    {
        const int g = w;
        int fr = lane & 15, fq = lane >> 4; asm volatile("" : "+v"(fr), "+v"(fq));
        bf16x8 af[4][4];
#pragma unroll
        for (int kt = 0; kt < 4; ++kt)
#pragma unroll
            for (int ct = 0; ct < 4; ++ct) {
#if SGU_TR
                LAS unsigned char* p = F.lds + (32 * kt + 8 * fq + (fr >> 2)) * IMG_STRIDE + (g * 64 + 32 * (ct >> 1) + 8 * (fr & 3) + 4 * (ct & 1)) * 2;
                const s16x4 lo = __builtin_bit_cast(s16x4, __builtin_amdgcn_ds_read_tr16_b64_v4i16((LAS v4i16_t*)p));
                const s16x4 hi = __builtin_bit_cast(s16x4, __builtin_amdgcn_ds_read_tr16_b64_v4i16((LAS v4i16_t*)(p + 4 * IMG_STRIDE)));
                af[kt][ct] = (bf16x8){lo[0], lo[1], lo[2], lo[3], hi[0], hi[1], hi[2], hi[3]};
#else
                const LAS bf16_t* p = (const LAS bf16_t*)(F.lds + (32 * kt + 8 * fq) * IMG_STRIDE) + g * 64 + 16 * (fr >> 2) + 4 * ct + (fr & 3);
#pragma unroll
                for (int e = 0; e < 8; ++e) af[kt][ct][e] = (short)p[e * (IMG_STRIDE / 2)];
#endif
            }
        bf16x8 wf[4], nwf[4]; u32x4 gu0, gu1, ngu0, ngu1; float bias, nbias;
        { const bf16_t* wp = SGUW + ((size_t)(g * 128 + fr)) * 128 + 8 * fq;
#pragma unroll
          for (int kt = 0; kt < 4; ++kt) wf[kt] = *(const bf16x8*)(wp + 32 * kt);
          const size_t t = t0 + fr; gu0 = *(const u32x4*)(Z + t * ZLD + 1024 + g * 64 + 8 * fq); gu1 = *(const u32x4*)(Z + t * ZLD + 1024 + g * 64 + 32 + 8 * fq); bias = sgu_b[g * 128 + fr]; }
#pragma unroll 1
        for (int it = 0; it < 8; ++it) {
            const int i0 = 16 * it, in0 = it < 7 ? i0 + 16 : i0;
            { const bf16_t* wp = SGUW + ((size_t)(g * 128 + in0 + fr)) * 128 + 8 * fq;
#pragma unroll
              for (int kt = 0; kt < 4; ++kt) nwf[kt] = *(const bf16x8*)(wp + 32 * kt);
              const size_t tn = t0 + in0 + fr; ngu0 = *(const u32x4*)(Z + tn * ZLD + 1024 + g * 64 + 8 * fq); ngu1 = *(const u32x4*)(Z + tn * ZLD + 1024 + g * 64 + 32 + 8 * fq); nbias = sgu_b[g * 128 + in0 + fr]; }
            f32x4 acc[4];
#pragma unroll
            for (int ct = 0; ct < 4; ++ct) acc[ct] = (f32x4){0.f, 0.f, 0.f, 0.f};
#pragma unroll
            for (int kt = 0; kt < 4; ++kt)
#pragma unroll
                for (int ct = 0; ct < 4; ++ct) acc[ct] = __builtin_amdgcn_mfma_f32_16x16x32_bf16(af[kt][ct], wf[kt], acc[ct], 0, 0, 0);
            const size_t t = t0 + i0 + fr;
            u32x4 o0, o1;
            o0.x = pk2(bflo(gu0.x) * (acc[0][0] + bias), bfhi(gu0.x) * (acc[0][1] + bias)); o0.y = pk2(bflo(gu0.y) * (acc[0][2] + bias), bfhi(gu0.y) * (acc[0][3] + bias));
            o0.z = pk2(bflo(gu0.z) * (acc[1][0] + bias), bfhi(gu0.z) * (acc[1][1] + bias)); o0.w = pk2(bflo(gu0.w) * (acc[1][2] + bias), bfhi(gu0.w) * (acc[1][3] + bias));
            o1.x = pk2(bflo(gu1.x) * (acc[2][0] + bias), bfhi(gu1.x) * (acc[2][1] + bias)); o1.y = pk2(bflo(gu1.y) * (acc[2][2] + bias), bfhi(gu1.y) * (acc[2][3] + bias));
            o1.z = pk2(bflo(gu1.z) * (acc[3][0] + bias), bfhi(gu1.z) * (acc[3][1] + bias)); o1.w = pk2(bflo(gu1.w) * (acc[3][2] + bias), bfhi(gu1.w) * (acc[3][3] + bias));
            *(u32x4*)(YMIX + t * D + 512 + g * 64 + 8 * fq) = o0; *(u32x4*)(YMIX + t * D + 512 + g * 64 + 32 + 8 * fq) = o1;
#pragma unroll
            for (int kt = 0; kt < 4; ++kt) wf[kt] = nwf[kt];
            gu0 = ngu0; gu1 = ngu1; bias = nbias;
        }
    }
}

constexpr int XC_STRIDE = 144;
constexpr int AU_STRIDE = 68;
constexpr int LRU_WAVE_BYTES = 64 * XC_STRIDE + 2 * 16 * AU_STRIDE * 4;
__device__ __forceinline__ float sigm_fast(float x) { return __builtin_amdgcn_rcpf(1.0f + __builtin_amdgcn_exp2f(-1.4426950408889634f * x)); }
template <int PASS>
__device__ __forceinline__ void lru_block(Frame& F, const Args& args, int blk) {
    const bf16_t* Z = (const bf16_t*)(F.ws + OFF_Z); bf16_t* YMIX = (bf16_t*)(F.ws + OFF_YMIX); const bf16_t* GATEW = (const bf16_t*)(F.ws + OFF_GATEW);
    const float* N8SP = (const float*)(F.ws + OFF_N8SP); float* CA = (float*)(F.ws + OFF_CARRY); float* CH = CA + 256 * 512;
    const float* cw = args.in[6]; const float* cb = args.in[7]; const float* gab = (const float*)(F.ws + OFF_GBIAS); const float* gib = gab + 512;
    const int lane = F.lane, h = F.wave, fr = lane & 15, fq = lane >> 4, cg = lane & 7, run = lane >> 3; const size_t t0 = (size_t)blk * 128;
    LAS unsigned char* xcT = F.lds + h * LRU_WAVE_BYTES; LAS float* Abuf = (LAS float*)(xcT + 64 * XC_STRIDE); LAS float* Ubuf = Abuf + 16 * AU_STRIDE;
    LAS float* tbl = (LAS float*)(F.lds + TAB_OFF) + h * 192;
    if (PASS == 2) { tbl[lane] = gab[64 * h + lane]; tbl[64 + lane] = gib[64 * h + lane]; tbl[128 + lane] = N8SP[64 * h + lane]; }
    float hst = 0.f, pp = 1.f;
    if (PASS == 2) { const int b0 = blk & ~31, n = blk & 31;
        float ca[31], ch[31];
#pragma unroll
        for (int k = 0; k < 31; ++k) { const int kk = k < n ? k : 0; ca[k] = CA[(size_t)(b0 + kk) * 512 + 64 * h + lane]; ch[k] = CH[(size_t)(b0 + kk) * 512 + 64 * h + lane]; }
#pragma unroll
        for (int k = 0; k < 31; ++k) hst = k < n ? ca[k] * hst + ch[k] : hst; }
    bf16x8 gw[8][2];
#pragma unroll
    for (int et = 0; et < 8; ++et)
#pragma unroll
        for (int kt = 0; kt < 2; ++kt) gw[et][kt] = *(const bf16x8*)(GATEW + ((size_t)(h * 128 + 16 * et + fr)) * 64 + 32 * kt + 8 * fq);
    const bool seq_start = (blk & 31) == 0;
#pragma unroll 1
    for (int hb = 0; hb < 2; ++hb) {
        const size_t tb = t0 + 64 * hb;
        {
            float cwv[4][8], cbv[8];
#pragma unroll
            for (int k = 0; k < 4; ++k) { const f32x4 a = *(const f32x4*)(cw + k * 512 + 64 * h + 8 * cg), b = *(const f32x4*)(cw + k * 512 + 64 * h + 8 * cg + 4);
#pragma unroll
                for (int q = 0; q < 4; ++q) { cwv[k][q] = a[q]; cwv[k][4 + q] = b[q]; } }
            { const f32x4 a = *(const f32x4*)(cb + 64 * h + 8 * cg), b = *(const f32x4*)(cb + 64 * h + 8 * cg + 4);
#pragma unroll
              for (int q = 0; q < 4; ++q) { cbv[q] = a[q]; cbv[4 + q] = b[q]; } }
            u32x4 xr[11];
#pragma unroll
            for (int j = 0; j < 11; ++j) { const int rel = 8 * run - 3 + j;
                const bool pad = (j < 3) && (rel < 0) && (hb == 0) && seq_start;
                const u32x4* zq = (const u32x4*)(Z + (size_t)((long)tb + (pad ? 0 : rel)) * ZLD + 64 * h + 8 * cg);
                const u32x4 v = PASS == 2 ? __builtin_nontemporal_load(zq) : *zq;
                xr[j] = pad ? (u32x4){0u, 0u, 0u, 0u} : v; }
#pragma unroll
            for (int s = 0; s < 8; ++s) { float o[8];
#pragma unroll
                for (int q = 0; q < 8; ++q) o[q] = cbv[q];
#pragma unroll
                for (int k = 0; k < 4; ++k) { const u32x4 r = xr[s + k];
#pragma unroll
                    for (int q = 0; q < 4; ++q) { o[2 * q] += cwv[k][2 * q] * bflo(r[q]); o[2 * q + 1] += cwv[k][2 * q + 1] * bfhi(r[q]); } }
                u32x4 pkd; pkd.x = pk2(o[0], o[1]); pkd.y = pk2(o[2], o[3]); pkd.z = pk2(o[4], o[5]); pkd.w = pk2(o[6], o[7]);
                *(LAS u32x4*)(xcT + (8 * run + s) * XC_STRIDE + 16 * cg) = pkd; }
        }
        WAVE_SYNC();
        u32x4 g0 = {0u, 0u, 0u, 0u}, g1 = g0, ng0 = g0, ng1 = g0;
        if (PASS == 2) { const size_t t = tb + (lane >> 2); g0 = *(const u32x4*)(Z + t * ZLD + 512 + 64 * h + 8 * (lane & 3)); g1 = *(const u32x4*)(Z + t * ZLD + 512 + 64 * h + 32 + 8 * (lane & 3)); }
#pragma unroll 1
        for (int it = 0; it < 4; ++it) {
            if (PASS == 2) { const size_t t = tb + 16 * (it < 3 ? it + 1 : it) + (lane >> 2); ng0 = *(const u32x4*)(Z + t * ZLD + 512 + 64 * h + 8 * (lane & 3)); ng1 = *(const u32x4*)(Z + t * ZLD + 512 + 64 * h + 32 + 8 * (lane & 3)); }
            bf16x8 xf[2];
#pragma unroll
            for (int kt = 0; kt < 2; ++kt) xf[kt] = *(const LAS bf16x8*)(xcT + (16 * it + fr) * XC_STRIDE + (32 * kt + 8 * fq) * 2);
            int fqv = fq; asm volatile("" : "+v"(fqv));
            f32x4 acc[8];
#pragma unroll
            for (int et = 0; et < 4; ++et) {
                if (PASS == 2) { acc[et] = *(const LAS f32x4*)(tbl + 16 * et + 4 * fqv); acc[4 + et] = *(const LAS f32x4*)(tbl + 64 + 16 * et + 4 * fqv); }
                else { acc[et] = *(const f32x4*)(gab + 64 * h + 16 * et + 4 * fqv); acc[4 + et] = *(const f32x4*)(gib + 64 * h + 16 * et + 4 * fqv); } }
#pragma unroll
            for (int et = 0; et < 8; ++et)
#pragma unroll
                for (int kt = 0; kt < 2; ++kt) acc[et] = __builtin_amdgcn_mfma_f32_16x16x32_bf16(gw[et][kt], xf[kt], acc[et], 0, 0, 0);
#pragma unroll
            for (int et = 0; et < 4; ++et) {
                const f32x4 sp = PASS == 2 ? *(const LAS f32x4*)(tbl + 128 + 16 * et + 4 * fqv) : *(const f32x4*)(N8SP + 64 * h + 16 * et + 4 * fqv);
                const u32x2 xw = *(const LAS u32x2*)(xcT + (16 * it + fr) * XC_STRIDE + (16 * et + 4 * fq) * 2);
                const float xv[4] = {bflo(xw.x), bfhi(xw.x), bflo(xw.y), bfhi(xw.y)};
                f32x4 av, uv;
#pragma unroll
                for (int r = 0; r < 4; ++r) {
                    const float rg = __builtin_amdgcn_rcpf(1.0f + __builtin_amdgcn_exp2f(acc[et][r])), ig = __builtin_amdgcn_rcpf(1.0f + __builtin_amdgcn_exp2f(acc[4 + et][r]));
                    const float a = __builtin_amdgcn_exp2f(rg * sp[r]);
                    av[r] = a;
                    uv[r] = __builtin_amdgcn_sqrtf(__builtin_fmaf(-a, a, 1.0f)) * (ig * xv[r]);
                }
                *(LAS f32x4*)(Abuf + fr * AU_STRIDE + 16 * et + 4 * fq) = av; *(LAS f32x4*)(Ubuf + fr * AU_STRIDE + 16 * et + 4 * fq) = uv;
            }
            WAVE_SYNC();
            {
                float a[16], u[16];
#pragma unroll
                for (int tk = 0; tk < 16; ++tk) { a[tk] = Abuf[tk * AU_STRIDE + lane]; u[tk] = Ubuf[tk * AU_STRIDE + lane]; }
#pragma unroll
                for (int tk = 0; tk < 16; ++tk) { hst = a[tk] * hst + u[tk]; if (PASS == 1) pp *= a[tk]; else Ubuf[tk * AU_STRIDE + lane] = hst; }
            }
            if (PASS == 2) {
                WAVE_SYNC();
                const int tok = lane >> 2, cq = lane & 3; const size_t t = tb + 16 * it + tok;
                const LAS float* hp = Ubuf + tok * AU_STRIDE + 8 * cq;
                const f32x4 h0 = *(const LAS f32x4*)(hp), h1 = *(const LAS f32x4*)(hp + 4), h2 = *(const LAS f32x4*)(hp + 32), h3 = *(const LAS f32x4*)(hp + 36);
                u32x4 o0, o1;
                o0.x = pk2(h0[0] * bflo(g0.x), h0[1] * bfhi(g0.x)); o0.y = pk2(h0[2] * bflo(g0.y), h0[3] * bfhi(g0.y));
                o0.z = pk2(h1[0] * bflo(g0.z), h1[1] * bfhi(g0.z)); o0.w = pk2(h1[2] * bflo(g0.w), h1[3] * bfhi(g0.w));
                o1.x = pk2(h2[0] * bflo(g1.x), h2[1] * bfhi(g1.x)); o1.y = pk2(h2[2] * bflo(g1.y), h2[3] * bfhi(g1.y));
                o1.z = pk2(h3[0] * bflo(g1.z), h3[1] * bfhi(g1.z)); o1.w = pk2(h3[2] * bflo(g1.w), h3[3] * bfhi(g1.w));
                *(u32x4*)(YMIX + t * D + 64 * h + 8 * cq) = o0; *(u32x4*)(YMIX + t * D + 64 * h + 32 + 8 * cq) = o1;
                g0 = ng0; g1 = ng1;
            }
            WAVE_SYNC();
        }
    }
    if (PASS == 1) { CA[(size_t)blk * 512 + 64 * h + lane] = pp; CH[(size_t)blk * 512 + 64 * h + lane] = hst; }
}

constexpr int HT_STRIDE = 2064;
constexpr int RG_W_OFF = 0, RG_H_OFF = 36 * HT_STRIDE, RG_LOG_OFF = RG_H_OFF + 32 * HT_STRIDE, RG_MISC_OFF = RG_LOG_OFF + 32 * 48 * 4;
static_assert(RG_MISC_OFF + 512 <= SCR_BYTES, "phase G LDS map");
__device__ __forceinline__ void phase_G(Frame& F, const Args& args, bool routw_in_lds) {
    const bf16_t* X1 = (const bf16_t*)(F.ws + OFF_X1); bf16_t* H2 = (bf16_t*)(F.ws + OFF_XN); const bf16_t* ROUTW = (const bf16_t*)(F.ws + OFF_ROUTW);
    const float* mod = (const float*)(F.ws + OFF_MOD); const float* g2w = args.in[18]; const float* bg = args.in[20]; const float* be = args.in[22];
    int* list = (int*)(F.ws + OFF_LIST); int* toke = (int*)(F.ws + OFF_TOKE); float* tokw = (float*)(F.ws + OFF_TOKW); int* tokp = (int*)(F.ws + OFF_TOKP);
    const int lane = F.lane, w = F.wave, fr = lane & 15, fq = lane >> 4;
    LAS float* LG = (LAS float*)(F.lds + RG_LOG_OFF); LAS int* hist = (LAS int*)(F.lds + RG_MISC_OFF); LAS int* base = hist + 32; LAS float* rb = (LAS float*)(base + 32);
    __syncthreads();
    if (!routw_in_lds) for (int i = F.tid; i < 36 * 128; i += NTHREADS) { const int r = i >> 7, c = i & 127; *(LAS u32x4*)(F.lds + RG_W_OFF + r * HT_STRIDE + c * 16) = *(const u32x4*)(ROUTW + (size_t)r * 1024 + c * 8); }
    for (int grp = F.vcu; grp < T / 128; grp += F.G) {
        const int grow0 = grp * 128, b = grow0 / SEQ;
        const float* sh = mod + b * 6144 + 3072; const float* sc = sh + 1024;
        float gm[16], sv[16];
#pragma unroll
        for (int jj = 0; jj < 2; ++jj)
#pragma unroll
            for (int q = 0; q < 8; ++q) { const int c = 512 * jj + 8 * lane + q; gm[8 * jj + q] = g2w[c] * (1.0f + sc[c]); sv[8 * jj + q] = sh[c]; }
        if (F.tid < 32) hist[F.tid] = 0;
        if (F.tid >= 64 && F.tid < 100) { const int j = F.tid - 64; rb[j] = j < 4 ? bg[j] : be[j - 4]; }
        u32x4 raw[4][2];
#pragma unroll
        for (int r = 0; r < 4; ++r)
#pragma unroll
            for (int jj = 0; jj < 2; ++jj) raw[r][jj] = *(const u32x4*)(X1 + (size_t)(grow0 + 4 * w + r) * D + 512 * jj + 8 * lane);
        int e1 = 0, e2 = 0, l1 = 0, l2 = 0; float w1 = 0.f, w2 = 0.f;
#pragma unroll 1
        for (int ti = 0; ti < 4; ++ti) {
            const int row0 = grow0 + 32 * ti;
#pragma unroll
            for (int r = 0; r < 4; ++r) {
                float h[16]; float ss = 0.f;
#pragma unroll
                for (int jj = 0; jj < 2; ++jj)
#pragma unroll
                    for (int q = 0; q < 4; ++q) { h[8 * jj + 2 * q] = bflo(raw[r][jj][q]); h[8 * jj + 2 * q + 1] = bfhi(raw[r][jj][q]); }
#pragma unroll
                for (int q = 0; q < 16; ++q) ss += h[q] * h[q];
                const float rs = rsqrtf(wave_sum(ss) * (1.0f / D) + EPS);
                u32x2 f8[2];
#pragma unroll
                for (int jj = 0; jj < 2; ++jj) { u32x4 o; float hv[8];
#pragma unroll
                    for (int q = 0; q < 8; ++q) hv[q] = h[8 * jj + q] * rs * gm[8 * jj + q] + sv[8 * jj + q];
#pragma unroll
                    for (int q = 0; q < 4; ++q) o[q] = pk2(hv[2 * q], hv[2 * q + 1]);
#if MOE_FP8
                    f8[jj].x = pg8::pk4_fp8(hv[0], hv[1], hv[2], hv[3]); f8[jj].y = pg8::pk4_fp8(hv[4], hv[5], hv[6], hv[7]);
#else
                    *(u32x4*)(H2 + (size_t)(row0 + 4 * w + r) * D + 512 * jj + 8 * lane) = o;
#endif
                    *(LAS u32x4*)(F.lds + RG_H_OFF + (4 * w + r) * HT_STRIDE + (512 * jj + 8 * lane) * 2) = o; }
#if MOE_FP8
                {
                    const bool odd = lane & 1; const u32x2 t = odd ? f8[0] : f8[1]; u32x2 rr;
                    rr.x = (unsigned)__builtin_amdgcn_mov_dpp((int)t.x, 0xB1, 0xF, 0xF, true); rr.y = (unsigned)__builtin_amdgcn_mov_dpp((int)t.y, 0xB1, 0xF, 0xF, true);
                    u32x4 wv; if (odd) { wv.x = rr.x; wv.y = rr.y; wv.z = f8[1].x; wv.w = f8[1].y; } else { wv.x = f8[0].x; wv.y = f8[0].y; wv.z = rr.x; wv.w = rr.y; }
                    *(u32x4*)((unsigned char*)H2 + (size_t)(row0 + 4 * w + r) * D + (odd ? 512 : 0) + 8 * (lane & ~1)) = wv; }
#endif
            }
            if (ti < 3) {
#pragma unroll
                for (int r = 0; r < 4; ++r)
#pragma unroll
                    for (int jj = 0; jj < 2; ++jj) raw[r][jj] = *(const u32x4*)(X1 + (size_t)(row0 + 32 + 4 * w + r) * D + 512 * jj + 8 * lane);
            }
            __syncthreads();
            if (w < 6) {
                const int rt = w / 3, ct = w % 3; int wrow = 16 * ct + fr; wrow = wrow < 36 ? wrow : 35;
                const LAS unsigned char* hp = F.lds + RG_H_OFF + (16 * rt + fr) * HT_STRIDE + 16 * fq; const LAS unsigned char* wp = F.lds + RG_W_OFF + wrow * HT_STRIDE + 16 * fq;
                f32x4 acc0 = {0.f, 0.f, 0.f, 0.f}, acc1 = {0.f, 0.f, 0.f, 0.f};
#pragma unroll 8
                for (int kt = 0; kt < 32; kt += 2) {
                    acc0 = __builtin_amdgcn_mfma_f32_16x16x32_bf16(*(const LAS bf16x8*)(wp + 64 * kt), *(const LAS bf16x8*)(hp + 64 * kt), acc0, 0, 0, 0);
                    acc1 = __builtin_amdgcn_mfma_f32_16x16x32_bf16(*(const LAS bf16x8*)(wp + 64 * kt + 64), *(const LAS bf16x8*)(hp + 64 * kt + 64), acc1, 0, 0, 0); }
                *(LAS f32x4*)(LG + (16 * rt + fr) * 48 + 16 * ct + 4 * fq) = acc0 + acc1;
            }
            __syncthreads();
            if ((F.tid >> 5) == ti) {
                const LAS float* L = LG + (F.tid & 31) * 48;
                float gl[4], el[8];
#pragma unroll
                for (int j = 0; j < 4; ++j) gl[j] = L[j] + rb[j];
                int gs = 0; float gmax = gl[0];
#pragma unroll
                for (int j = 1; j < 4; ++j) if (gl[j] > gmax) { gmax = gl[j]; gs = j; }
#pragma unroll
                for (int j = 0; j < 8; ++j) el[j] = L[4 + gs * 8 + j] + rb[4 + gs * 8 + j];
                float gsum = 0.f;
#pragma unroll
                for (int j = 0; j < 4; ++j) gsum += __expf(gl[j] - gmax);
                const float pg = 1.0f / gsum;
                int i1 = 0; float m1 = el[0];
#pragma unroll
                for (int j = 1; j < 8; ++j) if (el[j] > m1) { m1 = el[j]; i1 = j; }
                int i2 = -1; float m2 = -INFINITY;
#pragma unroll
                for (int j = 0; j < 8; ++j) if (j != i1 && el[j] > m2) { m2 = el[j]; i2 = j; }
                const float r = __expf(m2 - m1);
                w1 = pg / (1.0f + r); w2 = pg * r / (1.0f + r); e1 = gs * 8 + i1; e2 = gs * 8 + i2;
                l1 = __hip_atomic_fetch_add(hist + e1, 1, __ATOMIC_RELAXED, __HIP_MEMORY_SCOPE_WORKGROUP);
                l2 = __hip_atomic_fetch_add(hist + e2, 1, __ATOMIC_RELAXED, __HIP_MEMORY_SCOPE_WORKGROUP);
            }
        }
        __syncthreads();
        if (F.tid < 32) { const int n = hist[F.tid]; base[F.tid] = n ? (int)__hip_atomic_fetch_add(F.ctl + CW_CNT + CNT_STRIDE * F.tid, (unsigned)n, __ATOMIC_RELAXED, __HIP_MEMORY_SCOPE_AGENT) : 0; }
        __syncthreads();
        if (F.tid < 128) { const int row = grow0 + F.tid, p1 = base[e1] + l1, p2 = base[e2] + l2;
            list[(size_t)e1 * LISTCAP + p1] = row; list[(size_t)e2 * LISTCAP + p2] = row;
            toke[2 * row] = e1; toke[2 * row + 1] = e2; tokw[2 * row] = w1; tokw[2 * row + 1] = w2; tokp[2 * row] = p1; tokp[2 * row + 1] = p2; }
        __syncthreads();
    }
}

__device__ __forceinline__ void phase_J(Frame& F, const Args& args) {
    const bf16_t* X1 = (const bf16_t*)(F.ws + OFF_X1); const bf16_t* Y = (const bf16_t*)(F.ws + OFF_Y); const float* mod = (const float*)(F.ws + OFF_MOD);
    const int* toke = (const int*)(F.ws + OFF_TOKE); const float* tokw = (const float*)(F.ws + OFF_TOKW); const int* tokp = (const int*)(F.ws + OFF_TOKP);
    const float* fg = args.in[26]; float* out = args.out;
    const int gw = F.vcu * NWAVES + F.wave, NGW = F.G * NWAVES, lane = F.lane;
    constexpr int RPW = 16;
    for (int item = gw; item < T / RPW; item += NGW) {
        const int row0 = item * RPW, b = row0 / SEQ;
        int q0l = 0, q1l = 0; float w0l = 0.f, w1l = 0.f;
        { const int rr = row0 + (lane & 15); const int e0 = toke[2 * rr], e1 = toke[2 * rr + 1];
          q0l = F.tab[TAB_P0 + e0] * 256 + tokp[2 * rr]; q1l = F.tab[TAB_P0 + e1] * 256 + tokp[2 * rr + 1]; w0l = tokw[2 * rr]; w1l = tokw[2 * rr + 1]; }
        const float* g2 = mod + b * 6144 + 5120;
        f32x4 g2v[4], fgv[4];
#pragma unroll
        for (int jj = 0; jj < 2; ++jj)
#pragma unroll
            for (int hh = 0; hh < 2; ++hh) { const int c = 512 * jj + 8 * lane + 4 * hh; g2v[2 * jj + hh] = *(const f32x4*)(g2 + c); fgv[2 * jj + hh] = *(const f32x4*)(fg + c); }
#if MOE_FP8
        typedef u32x2 yvec; const unsigned char* Yb = (const unsigned char*)Y;
#define YLOAD(q_, c0_) (*(const u32x2*)(Yb + (q_) * D + (c0_)))
#define YUNPACK(v_, o_) do { const auto a0_ = __builtin_amdgcn_cvt_pk_f32_fp8((v_).x, false), a1_ = __builtin_amdgcn_cvt_pk_f32_fp8((v_).x, true), a2_ = __builtin_amdgcn_cvt_pk_f32_fp8((v_).y, false), a3_ = __builtin_amdgcn_cvt_pk_f32_fp8((v_).y, true); \
        o_[0] = a0_[0]; o_[1] = a0_[1]; o_[2] = a1_[0]; o_[3] = a1_[1]; o_[4] = a2_[0]; o_[5] = a2_[1]; o_[6] = a3_[0]; o_[7] = a3_[1]; } while (0)
        constexpr float YINV = 1.0f / Y_SCALE;
#else
        typedef u32x4 yvec;
#define YLOAD(q_, c0_) (*(const u32x4*)(Y + (q_) * D + (c0_)))
#define YUNPACK(v_, o_) do { _Pragma("unroll") for (int q_ = 0; q_ < 4; ++q_) { o_[2 * q_] = bflo((v_)[q_]); o_[2 * q_ + 1] = bfhi((v_)[q_]); } } while (0)
        constexpr float YINV = 1.0f;
#endif
        u32x4 xr[2], nxr[2]; yvec ya[2], yb[2], nya[2], nyb[2];
        { const size_t q0 = (size_t)__shfl(q0l, 0), q1 = (size_t)__shfl(q1l, 0);
#pragma unroll
          for (int jj = 0; jj < 2; ++jj) { const int c0 = 512 * jj + 8 * lane; xr[jj] = *(const u32x4*)(X1 + (size_t)row0 * D + c0); ya[jj] = YLOAD(q0, c0); yb[jj] = YLOAD(q1, c0); } }
#pragma unroll 1
        for (int r = 0; r < RPW; ++r) {
            const int row = row0 + r, rn = (r + 1 < RPW) ? r + 1 : r;
            { const size_t q0 = (size_t)__shfl(q0l, rn), q1 = (size_t)__shfl(q1l, rn);
#pragma unroll
              for (int jj = 0; jj < 2; ++jj) { const int c0 = 512 * jj + 8 * lane; nxr[jj] = *(const u32x4*)(X1 + (size_t)(row0 + rn) * D + c0); nya[jj] = YLOAD(q0, c0); nyb[jj] = YLOAD(q1, c0); } }
            const float w0 = __shfl(w0l, r), w1 = __shfl(w1l, r);
            float v[16]; float ss = 0.f;
#pragma unroll
            for (int jj = 0; jj < 2; ++jj) { float yav[8], ybv[8]; YUNPACK(ya[jj], yav); YUNPACK(yb[jj], ybv);
#pragma unroll
                for (int q = 0; q < 4; ++q) {
                    const float y0 = (w0 * yav[2 * q] + w1 * ybv[2 * q]) * YINV, y1 = (w0 * yav[2 * q + 1] + w1 * ybv[2 * q + 1]) * YINV;
                    const f32x4 gg = g2v[2 * jj + (q >> 1)];
                    v[8 * jj + 2 * q] = bflo(xr[jj][q]) + gg[(2 * q) & 3] * y0; v[8 * jj + 2 * q + 1] = bfhi(xr[jj][q]) + gg[(2 * q + 1) & 3] * y1; } }
#pragma unroll
            for (int q = 0; q < 16; ++q) ss += v[q] * v[q];
            const float rs = rsqrtf(wave_sum(ss) * (1.0f / D) + EPS);
#pragma unroll
            for (int jj = 0; jj < 2; ++jj) { const int c0 = 512 * jj + 8 * lane;
                f32x4 o0, o1;
#pragma unroll
                for (int q = 0; q < 4; ++q) { o0[q] = v[8 * jj + q] * rs * fgv[2 * jj][q]; o1[q] = v[8 * jj + 4 + q] * rs * fgv[2 * jj + 1][q]; }
                *(f32x4*)(out + (size_t)row * D + c0) = o0; *(f32x4*)(out + (size_t)row * D + c0 + 4) = o1;
                xr[jj] = nxr[jj]; ya[jj] = nya[jj]; yb[jj] = nyb[jj]; }
        }
    }
#undef YLOAD
#undef YUNPACK
}

__global__ void __launch_bounds__(NTHREADS, 2) mk(Args args) {
    extern __shared__ __attribute__((aligned(16))) unsigned char lds_raw[];
    Frame F;
    F.lds = (LAS unsigned char*)lds_raw; F.tab = (LAS int*)(F.lds + TAB_OFF);
    F.tid = threadIdx.x; F.lane = F.tid & 63; F.wave = __builtin_amdgcn_readfirstlane(F.tid >> 6);
    F.G = gridDim.x; F.bid = blockIdx.x; F.vcu = (F.G % 8 == 0) ? (F.bid % 8) * (F.G / 8) + F.bid / 8 : F.bid;
    F.ws = args.ws; F.ctl = (unsigned*)(args.ws + OFF_CTL);
    unsigned char* ws = args.ws;
    bf16_t* WIN = (bf16_t*)(ws + OFF_WIN); bf16_t* WOUT = (bf16_t*)(ws + OFF_WOUT); bf16_t* W13 = (bf16_t*)(ws + OFF_W13); bf16_t* W2 = (bf16_t*)(ws + OFF_W2);
    bf16_t* XN = (bf16_t*)(ws + OFF_XN); bf16_t* Z = (bf16_t*)(ws + OFF_Z); bf16_t* YMIX = (bf16_t*)(ws + OFF_YMIX); bf16_t* X1 = (bf16_t*)(ws + OFF_X1);
    bf16_t* ACT = (bf16_t*)(ws + OFF_ACT); bf16_t* Y = (bf16_t*)(ws + OFF_Y); bf16_t* H2 = XN;
    const float* mod = (const float*)(ws + OFF_MOD); const int* list = (const int*)(ws + OFF_LIST);
    const int lo = args.ph_lo, hi = args.ph_hi;
    for (int u = F.tid; u < (LDS_BYTES - LDSCTL_OFF) / 4; u += NTHREADS) ((LAS unsigned*)(F.lds + LDSCTL_OFF))[u] = 0u;
    __syncthreads();
    XcdBarrier bar; bar.bar = F.ctl + CW_BAR; bar.x = 0; bar.st = nullptr;
    if (hi - lo > 1) bar = xcd_barrier_post(F.ctl + CW_BAR, (volatile LAS unsigned*)(F.lds + LDSCTL_OFF) + 8);
#ifndef PHMASK
#define PHMASK 0x3ff
#endif
#define IN(k) (((PHMASK >> (k)) & 1) && lo <= (k) && (k) < hi)
#ifdef PROBE_SPAN
#define STAMP(i) do { if (F.bid == 0 && F.tid == 0) { const unsigned long long t_ = __builtin_amdgcn_s_memrealtime(); LAS unsigned* st_ = (LAS unsigned*)(F.lds + LDSCTL_OFF) + 32 + 2 * (i); st_[0] = (unsigned)t_; st_[1] = (unsigned)(t_ >> 32); } } while (0)
#else
#define STAMP(i) do { } while (0)
#endif
#define SEAM(k) do { if (IN(k) && IN((k) + 1)) xcd_barrier(bar); STAMP((k) + 1); } while (0)

    STAMP(0);
    if (IN(PH_A)) phase_A(F, args);
    SEAM(PH_A);
    if (IN(PH_B)) phase_B(F, args);
    SEAM(PH_B);
    if (IN(PH_C)) {
        pg8::Gemm g{XN, WIN, 2048}; pg8::EpiZ E{Z};
        if (F.G == 256) {
            const bool cfirst = ((F.bid >> 3) & 1) == 0;
            if (cfirst) { convert_experts<1>(F, args, F.bid * NWAVES + F.wave, 256 * NWAVES, 8192); __syncthreads(); }
            pg8::StaticOrder S; S.tokt = F.lds; S.init(T, 2048, 2048, F.G, F.bid);
            pg8::gemm_phase<pg8::EpiZ, pg8::StaticOrder, true, false, false>(F.lds, g, S, E);
            if (!cfirst) convert_experts<1>(F, args, F.bid * NWAVES + F.wave, 256 * NWAVES, 8192);
        } else {
            pg8::StaticOrder S; S.tokt = F.lds; S.init(T, 2048, 2048, F.G, F.bid);
            pg8::gemm_phase<pg8::EpiZ, pg8::StaticOrder, true, false, false>(F.lds, g, S, E);
        }
    }
    SEAM(PH_C);
    if (IN(PH_D)) { for (int blk = F.vcu; blk < T / 128; blk += F.G) { __syncthreads(); sgu_block(F, args, blk); __syncthreads(); lru_block<1>(F, args, blk); } }
    SEAM(PH_D);
    if (IN(PH_E)) { for (int blk = F.vcu; blk < T / 128; blk += F.G) { __syncthreads(); lru_block<2>(F, args, blk); } }
    SEAM(PH_E);
    if (IN(PH_F)) {
        __syncthreads();
        pg8::Gemm g{YMIX, WOUT, 2048}; pg8::StaticOrder S; S.tokt = F.lds; S.init(T, 1024, 2048, F.G, F.bid);
        pg8::EpiX1 E{args.in[0], mod, X1};
        pg8::gemm_phase<pg8::EpiX1, pg8::StaticOrder, true, false, false>(F.lds, g, S, E);
    }
    const bool fg = IN(PH_F) && IN(PH_G);
    if (fg) {
        const bf16_t* ROUTW = (const bf16_t*)(ws + OFF_ROUTW); LAS unsigned char* ldsp = F.lds;
        xcd_barrier_pw(bar, [=](int t, int n) { for (int i = t; i < 36 * 128; i += n) { const int r = i >> 7, c = i & 127; *(LAS u32x4*)(ldsp + RG_W_OFF + r * HT_STRIDE + c * 16) = *(const u32x4*)(ROUTW + (size_t)r * 1024 + c * 8); } });
        STAMP(PH_F + 1);
    } else SEAM(PH_F);
    if (IN(PH_G)) phase_G(F, args, fg);
    SEAM(PH_G);
    if (IN(PH_H)) {
        build_moe_table(F);
        pg8::MoeOrder S; S.nunits = F.tab[TAB_P0 + NE] * 4; S.G = F.G; S.c = F.vcu;
        S.tile_e = F.tab + TAB_TE; S.p0 = F.tab + TAB_P0; S.cnt = F.tab + TAB_CNT; S.list = list; S.gather = true; S.tokt = F.lds + TOKT_OFF;
#if MOE_FP8
        S.Kb = 1024; S.estride = (size_t)1024 * 1024;
        pg8::Gemm g{H2, W13, 1024}; pg8::EpiAct8 E{(unsigned char*)ACT, 1.0f / W13_SCALE, ACT_SCALE};
        pg8::gemm_phase<pg8::EpiAct8, pg8::MoeOrder, true, true, true>(F.lds, g, S, E);
        if (F.G == 256) {
            const int rounds = (S.nunits + 255) >> 8; int c0 = S.nunits - (rounds - 1) * 256; if (c0 >= 256 || c0 < 0) c0 = 0;
            if (S.c >= c0) convert_experts<2>(F, args, (S.c - c0) * NWAVES + F.wave, (256 - c0) * NWAVES, 4096);
        }
#else
        S.Kb = 2048; S.estride = (size_t)1024 * 1024 * 2;
        pg8::Gemm g{H2, W13, 2048}; pg8::EpiAct E{ACT};
        pg8::gemm_phase<pg8::EpiAct, pg8::MoeOrder, true, true, false>(F.lds, g, S, E);
#endif
    }
    SEAM(PH_H);
    if (IN(PH_I)) {
        build_moe_table(F);
        pg8::MoeOrder S; S.nunits = F.tab[TAB_P0 + NE] * 4; S.G = F.G; S.c = F.vcu;
        S.tile_e = F.tab + TAB_TE; S.p0 = F.tab + TAB_P0; S.cnt = F.tab + TAB_CNT; S.list = list; S.gather = false; S.tokt = F.lds + TOKT_OFF;
#if MOE_FP8
        S.Kb = 512; S.estride = (size_t)1024 * 512;
        pg8::Gemm g{ACT, W2, 512}; pg8::EpiY8 E{(unsigned char*)Y, Y_SCALE / (W2_SCALE * ACT_SCALE)};
        pg8::gemm_phase<pg8::EpiY8, pg8::MoeOrder, true, false, true>(F.lds, g, S, E);
#else
        S.Kb = 1024; S.estride = (size_t)1024 * 512 * 2;
        pg8::Gemm g{ACT, W2, 1024}; pg8::EpiY E{Y};
        pg8::gemm_phase<pg8::EpiY, pg8::MoeOrder, true, false, false>(F.lds, g, S, E);
#endif
    }
    SEAM(PH_I);
    if (IN(PH_J)) { build_moe_table(F); phase_J(F, args); }
#ifdef PROBE_SPAN
    STAMP(PH_N);
    if (F.bid == 0 && F.tid == 0) { LAS unsigned* st_ = (LAS unsigned*)(F.lds + LDSCTL_OFF) + 32;
        const unsigned long long a_ = ((unsigned long long)st_[2 * PROBE_SPAN + 1] << 32) | st_[2 * PROBE_SPAN], b_ = ((unsigned long long)st_[2 * PROBE_SPAN + 3] << 32) | st_[2 * PROBE_SPAN + 2];
        const unsigned long long t0_ = __builtin_amdgcn_s_memrealtime(), dt_ = (b_ - a_) * PROBE_MULT;
        while (__builtin_amdgcn_s_memrealtime() - t0_ < dt_) __builtin_amdgcn_s_sleep(8); }
#endif
#undef IN
#undef SEAM
}
#ifndef FUSED
#define FUSED 1
#endif
extern "C" void kernel_launch(void* const* d_in, const int* in_sizes, int n_in, void* d_out, int out_size, void* d_ws, size_t ws_size, hipStream_t stream) {
    if (n_in != 27 || out_size != T * D || ws_size < WS_NEED) { fprintf(stderr, "kernel_launch: unexpected shapes (n_in %d out %d ws %zu)\n", n_in, out_size, ws_size); return; }
    static int grid = 0;
    if (grid == 0) {
        int dev = 0, cus = 0;
        if (hipGetDevice(&dev) != hipSuccess || hipDeviceGetAttribute(&cus, hipDeviceAttributeMultiprocessorCount, dev) != hipSuccess) { fprintf(stderr, "kernel_launch: device query failed\n"); grid = -1; return; }
        if (hipFuncSetAttribute((const void*)mk, hipFuncAttributeMaxDynamicSharedMemorySize, LDS_BYTES) != hipSuccess) { fprintf(stderr, "kernel_launch: hipFuncSetAttribute failed\n"); grid = -1; return; }
        int per_cu = 0;
        if (hipOccupancyMaxActiveBlocksPerMultiprocessor(&per_cu, (const void*)mk, NTHREADS, LDS_BYTES) != hipSuccess || per_cu < 1) fprintf(stderr, "kernel_launch: occupancy query says %d\n", per_cu);
        (void)hipGetLastError();
        grid = cus;
    }
    if (grid < 0) return;
    Args a{}; for (int i = 0; i < 27; ++i) a.in[i] = (const float*)d_in[i]; a.out = (float*)d_out; a.ws = (unsigned char*)d_ws;
#define MK(lo_, hi_) do { a.ph_lo = (lo_); a.ph_hi = (hi_); hipLaunchKernelGGL(mk, dim3(grid), dim3(NTHREADS), LDS_BYTES, stream, a); } while (0)
    (void)hipMemsetAsync((char*)d_ws + OFF_CTL, 0, CTL_BYTES, stream);
#if FUSED
    MK(0, PH_N);
#else
    for (int p = 0; p < PH_N; ++p) MK(p, p + 1);
#endif
}
```
